# Optimizing an MI355X kernel written in HIP

```python
import jax
import jax.numpy as jnp
from jax import lax
import numpy as np


D_MODEL = 1024
BATCH = 8
SEQ = 8192
DEPTH = 2

HEAD_DIM = 64
ROPE_THETA = 10000.0
EPS = 1e-6
Q_BLOCK = 128

A_HEADS = 4
IDX_HEADS = 8
IDX_DIM = 32
TOPK_MAX = 256

B_HEADS = 4
B_NOPE = 64
B_ROPE = 32
B_V = 64
B_Q_RANK = 256
B_KV_RANK = 128

C_HEADS = 8
C_KV_HEADS = 2
WINDOW = 128

D_FF = 2816
N_EXPERTS = 8
TOP_K = 2
EXPERT_FF = 3584
MOE_BLOCK = 256

N_DENSE = (DEPTH + 1) // 2
N_MOE = DEPTH // 2

IN_SIZES = (A_HEADS * HEAD_DIM, HEAD_DIM, HEAD_DIM,
            IDX_HEADS * IDX_DIM, IDX_DIM, IDX_HEADS,
            B_Q_RANK, B_KV_RANK, B_ROPE,
            C_HEADS * HEAD_DIM, C_KV_HEADS * HEAD_DIM, C_KV_HEADS * HEAD_DIM,
            3 * D_MODEL)
D_IN = sum(IN_SIZES)

kernel_name = 'hybrid_dsa_mla_swa_gated_moe'


def rms_norm(x, g):
    xf = x.astype(jnp.float32)
    y = xf * lax.rsqrt(jnp.mean(xf * xf, axis=-1, keepdims=True) + EPS)
    return (y * g.astype(jnp.float32)).astype(x.dtype)


def rope(x, pos):
    half = x.shape[-1] // 2
    inv_freq = ROPE_THETA ** (-jnp.arange(half, dtype=jnp.float32) / half)
    ang = pos.astype(jnp.float32)[:, :, None] * inv_freq
    cos = jnp.cos(ang)[:, :, None, :]
    sin = jnp.sin(ang)[:, :, None, :]
    xf = x.astype(jnp.float32)
    x1, x2 = xf[..., :half], xf[..., half:]
    return jnp.concatenate([x1 * cos - x2 * sin, x2 * cos + x1 * sin], axis=-1).astype(x.dtype)


def to_blocks(x, blk=Q_BLOCK):
    b, s = x.shape[0], x.shape[1]
    return jnp.moveaxis(x.reshape((b, s // blk, blk) + x.shape[2:]), 1, 0)


def from_blocks(y):
    n, b, blk = y.shape[0], y.shape[1], y.shape[2]
    return jnp.moveaxis(y, 0, 1).reshape((b, n * blk) + y.shape[3:])


def split_columns(p):
    cuts = np.cumsum(IN_SIZES)[:-1].tolist()
    return jnp.split(p, cuts, axis=-1)


def dsa_attention(q, k, v, iq, ik, iw):
    s = q.shape[1]
    n_sel = min(TOPK_MAX, s // 4)
    key_pos = jnp.arange(s)

    def block(args):
        qb, iqb, iwb, t = args
        sc = jnp.einsum('bqhd,bsd->bqhs', iqb, ik, preferred_element_type=jnp.float32) * IDX_DIM ** -0.5
        score = jnp.einsum('bqhs,bqh->bqs', jax.nn.relu(sc), iwb.astype(jnp.float32))
        score = jnp.where((key_pos[None, :] <= t[:, None])[None], score, -jnp.inf)
        _, sel = lax.top_k(score, n_sel)
        valid = sel <= t[None, :, None]
        k_g = jax.vmap(lambda kk, ii: kk[ii])(k, sel)
        v_g = jax.vmap(lambda vv, ii: vv[ii])(v, sel)
        logits = jnp.einsum('bqhd,bqkd->bqhk', qb, k_g, preferred_element_type=jnp.float32) * HEAD_DIM ** -0.5
        logits = jnp.where(valid[:, :, None, :], logits, -jnp.inf)
        p = jax.nn.softmax(logits, axis=-1)
        return jnp.einsum('bqhk,bqkd->bqhd', p.astype(v.dtype), v_g)

    t_blocks = jnp.arange(s).reshape(s // Q_BLOCK, Q_BLOCK)
    out = lax.map(block, (to_blocks(q), to_blocks(iq), to_blocks(iw), t_blocks))
    return from_blocks(out)


def mla_attention(q_nope, q_rope, k_nope, k_rope, v):
    s = q_nope.shape[1]
    key_pos = jnp.arange(s)
    scale = (B_NOPE + B_ROPE) ** -0.5

    def block(args):
        qn, qr, t = args
        logits = (jnp.einsum('bqhd,bshd->bhqs', qn, k_nope, preferred_element_type=jnp.float32)
                  + jnp.einsum('bqhr,bsr->bhqs', qr, k_rope, preferred_element_type=jnp.float32)) * scale
        logits = jnp.where(key_pos[None, :] <= t[:, None], logits, -jnp.inf)
        p = jax.nn.softmax(logits, axis=-1)
        return jnp.einsum('bhqs,bshd->bqhd', p.astype(v.dtype), v)

    t_blocks = jnp.arange(s).reshape(s // Q_BLOCK, Q_BLOCK)
    out = lax.map(block, (to_blocks(q_nope), to_blocks(q_rope), t_blocks))
    return from_blocks(out)


def swa_attention(q, k, v, sinks):
    b, s, _, d = q.shape
    g = C_HEADS // C_KV_HEADS
    n = s // WINDOW
    qb = q.reshape(b, n, WINDOW, C_KV_HEADS, g, d)

    def band(x):
        xb = x.reshape(b, n, WINDOW, C_KV_HEADS, d)
        prev = jnp.concatenate([jnp.zeros_like(xb[:, :1]), xb[:, :-1]], axis=1)
        return jnp.concatenate([prev, xb], axis=2)

    kb, vb = band(k), band(v)
    i = jnp.arange(WINDOW)[:, None]
    j = jnp.arange(2 * WINDOW)[None, :]
    in_window = (j > i) & (j <= i + WINDOW)
    sink = sinks.reshape(C_KV_HEADS, g).astype(jnp.float32)[None, :, :, None, None]

    def block(args):
        qn, kn, vn, blk = args
        mask = in_window & (blk * WINDOW - WINDOW + j >= 0)
        logits = jnp.einsum('bqkgd,bskd->bkgqs', qn, kn, preferred_element_type=jnp.float32) * d ** -0.5
        logits = jnp.where(mask, logits, -jnp.inf)
        m = jnp.maximum(jnp.max(logits, axis=-1, keepdims=True), sink)
        p = jnp.exp(logits - m)
        denom = jnp.sum(p, axis=-1, keepdims=True) + jnp.exp(sink - m)
        return jnp.einsum('bkgqs,bskd->bqkgd', (p / denom).astype(v.dtype), vn)

    out = lax.map(block, (jnp.moveaxis(qb, 1, 0), jnp.moveaxis(kb, 1, 0), jnp.moveaxis(vb, 1, 0), jnp.arange(n)))
    return jnp.moveaxis(out, 0, 1).reshape(b, s, C_HEADS, d)


def swiglu(h, w1, w3, w2):
    return (jax.nn.silu(h @ w1) * (h @ w3)) @ w2


def moe_ffn(h, w_router, w1, w3, w2):
    b, s, d = h.shape
    n_tok = b * s
    hf = h.reshape(n_tok, d)
    logits = jnp.matmul(hf, w_router, preferred_element_type=jnp.float32)
    top_logits, top_e = lax.top_k(logits, TOP_K)
    gates = jax.nn.softmax(top_logits, axis=-1)
    n_asg = n_tok * TOP_K
    e_flat = top_e.reshape(n_asg)
    tok_flat = jnp.repeat(jnp.arange(n_tok), TOP_K)
    order = jnp.argsort(e_flat)
    e_s, tok_s = e_flat[order], tok_flat[order]
    gate_s = gates.reshape(n_asg)[order]
    counts = jnp.bincount(e_flat, length=N_EXPERTS)
    padded = (counts + MOE_BLOCK - 1) // MOE_BLOCK * MOE_BLOCK
    start = jnp.cumsum(counts) - counts
    pend = jnp.cumsum(padded)
    pstart = pend - padded
    dest = pstart[e_s] + (jnp.arange(n_asg) - start[e_s])
    n_blocks = -(-n_asg // MOE_BLOCK) + N_EXPERTS
    rows = n_blocks * MOE_BLOCK
    xbuf = jnp.zeros((rows, d), h.dtype).at[dest].set(hf[tok_s])
    block_e = jnp.minimum(jnp.searchsorted(pend, jnp.arange(n_blocks) * MOE_BLOCK, side='right'), N_EXPERTS - 1)

    def expert_block(args):
        xb, e = args
        return swiglu(xb, w1[e], w3[e], w2[e])

    ybuf = lax.map(expert_block, (xbuf.reshape(n_blocks, MOE_BLOCK, d), block_e)).reshape(rows, d)
    y_s = ybuf[dest] * gate_s[:, None].astype(h.dtype)
    out = jax.ops.segment_sum(y_s, tok_s, num_segments=n_tok)
    return out.reshape(b, s, d)


def setup_inputs(seed: int = 0) -> dict:
    key = jax.random.key(seed)
    ks = jax.random.split(key, 29)

    def w(k, shape, fan_in):
        return jax.random.normal(k, shape, jnp.float32) * fan_in ** -0.5

    def gain(k, shape):
        return 1.0 + 0.1 * jax.random.normal(k, shape, jnp.float32)

    b_qk = B_HEADS * (B_NOPE + B_ROPE)
    b_kv = B_HEADS * (B_NOPE + B_V)
    return {
        'x': jax.random.normal(ks[0], (BATCH, SEQ, D_MODEL), jnp.float32),
        'positions': (jnp.arange(SEQ, dtype=jnp.int32)[None, :]
                      + jax.random.randint(ks[1], (BATCH, 1), 0, 4096, dtype=jnp.int32)),
        'attn_norm_g': gain(ks[2], (DEPTH, D_MODEL)),
        'w_in': w(ks[3], (DEPTH, D_MODEL, D_IN), D_MODEL),
        'a_q_norm_g': gain(ks[4], (DEPTH, HEAD_DIM)),
        'a_k_norm_g': gain(ks[5], (DEPTH, HEAD_DIM)),
        'b_cq_norm_g': gain(ks[6], (DEPTH, B_Q_RANK)),
        'b_ckv_norm_g': gain(ks[7], (DEPTH, B_KV_RANK)),
        'b_w_uq': w(ks[8], (DEPTH, B_Q_RANK, b_qk), B_Q_RANK),
        'b_w_ukv': w(ks[9], (DEPTH, B_KV_RANK, b_kv), B_KV_RANK),
        'b_qn_g': gain(ks[10], (DEPTH, B_NOPE)),
        'b_qr_g': gain(ks[11], (DEPTH, B_ROPE)),
        'b_kn_g': gain(ks[12], (DEPTH, B_NOPE)),
        'b_kr_g': gain(ks[13], (DEPTH, B_ROPE)),
        'c_q_norm_g': gain(ks[14], (DEPTH, HEAD_DIM)),
        'c_k_norm_g': gain(ks[15], (DEPTH, HEAD_DIM)),
        'c_sinks': 0.5 * jax.random.normal(ks[16], (DEPTH, C_HEADS), jnp.float32),
        'w_a_out': w(ks[17], (DEPTH, A_HEADS * HEAD_DIM, D_MODEL), A_HEADS * HEAD_DIM),
        'w_b_out': w(ks[18], (DEPTH, B_HEADS * B_V, D_MODEL), B_HEADS * B_V),
        'w_c_out': w(ks[19], (DEPTH, C_HEADS * HEAD_DIM, D_MODEL), C_HEADS * HEAD_DIM),
        'w_o': w(ks[20], (DEPTH, D_MODEL, D_MODEL), D_MODEL),
        'ffn_norm_g': gain(ks[21], (DEPTH, D_MODEL)),
        'ffn_w1': w(ks[22], (N_DENSE, D_MODEL, D_FF), D_MODEL),
        'ffn_w3': w(ks[23], (N_DENSE, D_MODEL, D_FF), D_MODEL),
        'ffn_w2': w(ks[24], (N_DENSE, D_FF, D_MODEL), D_FF),
        'router_w': w(ks[25], (N_MOE, D_MODEL, N_EXPERTS), D_MODEL),
        'moe_w1': w(ks[26], (N_MOE, N_EXPERTS, D_MODEL, EXPERT_FF), D_MODEL),
        'moe_w3': w(ks[27], (N_MOE, N_EXPERTS, D_MODEL, EXPERT_FF), D_MODEL),
        'moe_w2': w(ks[28], (N_MOE, N_EXPERTS, EXPERT_FF, D_MODEL), EXPERT_FF),
    }


def reference(x, positions, attn_norm_g, w_in, a_q_norm_g, a_k_norm_g, b_cq_norm_g, b_ckv_norm_g,
              b_w_uq, b_w_ukv, b_qn_g, b_qr_g, b_kn_g, b_kr_g, c_q_norm_g, c_k_norm_g, c_sinks,
              w_a_out, w_b_out, w_c_out, w_o, ffn_norm_g, ffn_w1, ffn_w3, ffn_w2,
              router_w, moe_w1, moe_w3, moe_w2):
    b, s, _ = x.shape
    for l in range(DEPTH):
        h = rms_norm(x, attn_norm_g[l])
        proj = h @ w_in[l]
        qa, ka, va, iq, ik, iw, cq, ckv, kr, qc, kc, vc, gates = split_columns(proj)

        qa = rope(rms_norm(qa.reshape(b, s, A_HEADS, HEAD_DIM), a_q_norm_g[l]), positions)
        ka = rope(rms_norm(ka[:, :, None, :], a_k_norm_g[l]), positions)[:, :, 0]
        iq = rope(iq.reshape(b, s, IDX_HEADS, IDX_DIM), positions)
        ik = rope(ik[:, :, None, :], positions)[:, :, 0]
        ya = dsa_attention(qa, ka, va, iq, ik, iw * IDX_HEADS ** -0.5)

        q_b = (rms_norm(cq, b_cq_norm_g[l]) @ b_w_uq[l]).reshape(b, s, B_HEADS, B_NOPE + B_ROPE)
        kv_b = (rms_norm(ckv, b_ckv_norm_g[l]) @ b_w_ukv[l]).reshape(b, s, B_HEADS, B_NOPE + B_V)
        q_nope = rms_norm(q_b[..., :B_NOPE], b_qn_g[l])
        q_rope = rope(rms_norm(q_b[..., B_NOPE:], b_qr_g[l]), positions)
        k_nope = rms_norm(kv_b[..., :B_NOPE], b_kn_g[l])
        v_b = kv_b[..., B_NOPE:]
        k_rope = rope(rms_norm(kr[:, :, None, :], b_kr_g[l]), positions)[:, :, 0]
        yb = mla_attention(q_nope, q_rope, k_nope, k_rope, v_b)

        qc = rope(rms_norm(qc.reshape(b, s, C_HEADS, HEAD_DIM), c_q_norm_g[l]), positions)
        kc = rope(rms_norm(kc.reshape(b, s, C_KV_HEADS, HEAD_DIM), c_k_norm_g[l]), positions)
        vc = vc.reshape(b, s, C_KV_HEADS, HEAD_DIM)
        yc = swa_attention(qc, kc, vc, c_sinks[l])

        ga, gb, gc = jnp.split(jax.nn.sigmoid(gates), 3, axis=-1)
        merged = (ga * (ya.reshape(b, s, -1) @ w_a_out[l])
                  + gb * (yb.reshape(b, s, -1) @ w_b_out[l])
                  + gc * (yc.reshape(b, s, -1) @ w_c_out[l]))
        x = x + merged @ w_o[l]

        h2 = rms_norm(x, ffn_norm_g[l])
        if l % 2 == 0:
            x = x + swiglu(h2, ffn_w1[l // 2], ffn_w3[l // 2], ffn_w2[l // 2])
        else:
            x = x + moe_ffn(h2, router_w[l // 2], moe_w1[l // 2], moe_w3[l // 2], moe_w2[l // 2])
    return x
```

```cpp
#include <hip/hip_runtime.h>
#include <cstdio>
#include <cstdint>

#define GAS __attribute__((address_space(1)))
#define LAS __attribute__((address_space(3)))
typedef unsigned short bf16_t;
typedef short bf16x8 __attribute__((ext_vector_type(8)));
typedef float f32x2 __attribute__((ext_vector_type(2)));
typedef float f32x4 __attribute__((ext_vector_type(4)));
typedef float f32x16 __attribute__((ext_vector_type(16)));
typedef unsigned u32x2 __attribute__((ext_vector_type(2)));
typedef unsigned u32x4 __attribute__((ext_vector_type(4)));

constexpr int NB = 8, SEQ = 8192, NTOK = NB * SEQ, DM = 1024, DEPTH = 2;
constexpr int DIN = 4936;
constexpr int CHB = 4, TCH = CHB * SEQ, NCHUNK = NB / CHB;
constexpr int DFF = 2816, NEXP = 8, EFF = 3584;
constexpr int P1W = 2048, GW = 3072;
constexpr int NINP = P1W + GW;
constexpr float EPS = 1e-6f;
constexpr float LOG2E = 1.4426950408889634f;
constexpr int C_QA = 0, C_KA = 256, C_VA = 320, C_IQ = 384, C_IK = 640, C_IW = 672, C_CQ = 680, C_CKV = 936, C_KR = 1064, C_QC = 1096, C_KC = 1608, C_VC = 1736, C_G = 1864;
constexpr int NPOS = 12288;
constexpr int MOE_ROWS = 2 * TCH + NEXP * 256;

__device__ __forceinline__ float bf2f(bf16_t v) { return __uint_as_float((unsigned)v << 16); }
__device__ __forceinline__ float bflo(unsigned w) { return __uint_as_float(w << 16); }
__device__ __forceinline__ float bfhi(unsigned w) { return __uint_as_float(w & 0xffff0000u); }
__device__ __forceinline__ unsigned f2bf(float f) { unsigned u = __float_as_uint(f); return (u + 0x7fffu + ((u >> 16) & 1u)) >> 16; }
__device__ __forceinline__ unsigned pk2(float lo, float hi) { return f2bf(lo) | (f2bf(hi) << 16); }
__device__ __forceinline__ unsigned cvt_pk_bf16(float lo, float hi) { unsigned r; asm volatile("v_cvt_pk_bf16_f32 %0, %1, %2" : "=v"(r) : "v"(lo), "v"(hi)); return r; }
__device__ __forceinline__ float fast_exp2(float x) { return __builtin_amdgcn_exp2f(x); }
__device__ __forceinline__ float fast_rcp(float x) { return __builtin_amdgcn_rcpf(x); }
__device__ __forceinline__ float sigmoidf_(float x) { return fast_rcp(1.0f + fast_exp2(-LOG2E * x)); }
__device__ __forceinline__ float wave_sum(float v) {
#pragma unroll
    for (int o = 1; o < 64; o <<= 1) v += __shfl_xor(v, o);
    return v;
}
__device__ __forceinline__ float sum32(float v) {
#pragma unroll
    for (int o = 1; o < 32; o <<= 1) v += __shfl_xor(v, o);
    return v;
}
__device__ __forceinline__ float sum16(float v) {
#pragma unroll
    for (int o = 1; o < 16; o <<= 1) v += __shfl_xor(v, o);
    return v;
}
__device__ __forceinline__ unsigned lds_add(LAS unsigned* p, unsigned v) { return __hip_atomic_fetch_add(p, v, __ATOMIC_RELAXED, __HIP_MEMORY_SCOPE_WORKGROUP); }
__device__ __forceinline__ unsigned lds_or(LAS unsigned* p, unsigned v) { return __hip_atomic_fetch_or(p, v, __ATOMIC_RELAXED, __HIP_MEMORY_SCOPE_WORKGROUP); }
__device__ __forceinline__ int lane_id() { int l; asm volatile("v_mbcnt_lo_u32_b32 %0, -1, 0\n\tv_mbcnt_hi_u32_b32 %0, -1, %0" : "=v"(l)); return l; }
#define LDS_WAIT() asm volatile("s_waitcnt lgkmcnt(0)" ::: "memory")
#define VM_WAIT() asm volatile("s_waitcnt vmcnt(0)" ::: "memory")

namespace pg8 {
constexpr int BM = 256, BK = 64, HALF = 128, HTB = HALF * BK * 2, STAGE_BYTES = 8 * HTB, NXCD = 8, WGM = 8;
__host__ __device__ __forceinline__ int lds_byte(int r, int c) { const int st = (r >> 4) * 2 + (c >> 5), rr = r & 15, cc = c & 31, ob = rr * 64 + cc * 2; return st * 1024 + (ob ^ (((ob >> 9) & 1) << 5)); }
__host__ __device__ __forceinline__ void stage_rc(int b, int& R, int& C) { const int st = b / 1024, sb = b % 1024, swz = sb ^ (((sb >> 9) & 1) << 5); R = (st >> 1) * 16 + swz / 64; C = (st & 1) * 32 + (swz % 64) / 2; }
__host__ __device__ __forceinline__ int perm32(int rho) { const int n = rho >> 4, i = rho & 15; return 8 * (i >> 2) + 4 * n + (i & 3); }

struct Unit { int pm, pn; };
struct Gemm {
    const bf16_t* A; int lda;
    const bf16_t* A2; int pn_split;
    const bf16_t* Bt; int K;
    const int* blk_e; size_t e_stride;
};
struct StaticOrder {
    int nM, nN, nwg, G, c;
    __device__ void init(int nM_, int nN_, int G_, int c_) { nM = nM_; nN = nN_; nwg = nM * nN; G = G_; c = c_; }
    __device__ bool next(int i, Unit& u) const {
        const long L = (long)i * G + c; if (L >= nwg) return false;
        int wgid = (int)L; { const int q = nwg / NXCD, r = nwg % NXCD, xcd = wgid % NXCD, off = wgid / NXCD; wgid = (xcd < r ? xcd * (q + 1) : r * (q + 1) + (xcd - r) * q) + off; }
        const int nig = WGM * nN, gid = wgid / nig, fm = gid * WGM, gsz = (nM - fm) < WGM ? (nM - fm) : WGM;
        u.pm = fm + ((wgid % nig) % gsz); u.pn = (wgid % nig) / gsz; return true;
    }
};

template <class Epi, class Sched>
__device__ __forceinline__ void gemm_phase(LAS unsigned char* lds, int wave_, const Gemm g, const Sched& S, const Epi& E) {
    int tid = wave_ * 64 + lane_id(); asm volatile("" : "+v"(tid));
    const int wid = __builtin_amdgcn_readfirstlane(tid >> 6), lane = tid & 63, wr = wid >> 2, wc = wid & 3, fr = lane & 15, fq = lane >> 4;
    int K = g.K; asm volatile("" : "+s"(K));
    const int nt = K / BK;
    unsigned voffA[2], voffB[2];
#pragma unroll
    for (int i = 0; i < 2; ++i) { int R, C; stage_rc(tid * 16 + i * 8192, R, C); const int Rb = Epi::PERM ? ((R & ~31) + perm32(R & 31)) : R;
        voffA[i] = (unsigned)(R * g.lda + C) * 2u; voffB[i] = (unsigned)(Rb * K + C) * 2u; }
    const size_t kstep = (size_t)(BK * 2);
    const size_t hstepB = (size_t)HALF * K * 2, tstepB = 2 * hstepB;
    const size_t hstepA = (size_t)HALF * g.lda * 2, tstepA = 2 * hstepA;
    const unsigned ldsw = (unsigned)wid * 1024u;
    const int aoff = lds_byte(wr * 64 + fr, fq * 8), boff = lds_byte(wc * 32 + fr, fq * 8);
#define PG8_SA(b, h) (((b) * 2 + (h)) * HTB)
#define PG8_SB(b, h) ((4 + (b) * 2 + (h)) * HTB)
#define PG8_STAGE(bufoff, gbase, voff) do { _Pragma("unroll") for (int _i = 0; _i < 2; ++_i) \
        __builtin_amdgcn_global_load_lds((const unsigned*)((const char*)(gbase) + (voff)[_i]), (LAS unsigned*)(lds + (bufoff) + ldsw + _i * 8192), 16, 0, 0); } while (0)
#define PG8_LDA(dst, b, h) do { _Pragma("unroll") for (int m = 0; m < 4; ++m) _Pragma("unroll") for (int k = 0; k < 2; ++k) dst[m][k] = *(const LAS bf16x8*)(lds + PG8_SA(b, h) + aoff + m * 2048 + k * 1024); } while (0)
#define PG8_LDB(dst, b, h) do { _Pragma("unroll") for (int n = 0; n < 2; ++n) _Pragma("unroll") for (int k = 0; k < 2; ++k) dst[n][k] = *(const LAS bf16x8*)(lds + PG8_SB(b, h) + boff + n * 2048 + k * 1024); } while (0)
#define PG8_MMA(ai, bj, At, Bt) do { __builtin_amdgcn_s_setprio(1); _Pragma("unroll") for (int m = 0; m < 4; ++m) _Pragma("unroll") for (int n = 0; n < 2; ++n) _Pragma("unroll") for (int k = 0; k < 2; ++k) \
        acc[ai][bj][m][n] = __builtin_amdgcn_mfma_f32_16x16x32_bf16(Bt[n][k], At[m][k], acc[ai][bj][m][n], 0, 0, 0); __builtin_amdgcn_s_setprio(0); } while (0)
#define PG8_WAIT_V(n) asm volatile("s_waitcnt vmcnt(" #n ")" ::: "memory")
#define PG8_WAIT_L(n) asm volatile("s_waitcnt lgkmcnt(" #n ")" ::: "memory")
#define PG8_BAR __builtin_amdgcn_s_barrier()
#define PG8_SCHED __builtin_amdgcn_sched_barrier(0)
#define PG8_BPTR(u) ((const char*)g.Bt + ((g.blk_e ? (size_t)g.blk_e[(u).pm] * g.e_stride * 2 : (size_t)0) + (size_t)(u).pn * tstepB))
    Unit cur, nxt; int ui = 0;
    if (!S.next(0, cur)) return;
    f32x4 acc[2][2][4][2];
#pragma unroll
    for (int a = 0; a < 2; ++a)
#pragma unroll
        for (int b = 0; b < 2; ++b)
#pragma unroll
            for (int m = 0; m < 4; ++m)
#pragma unroll
                for (int n = 0; n < 2; ++n) acc[a][b][m][n] = (f32x4){0.f, 0.f, 0.f, 0.f};
    bf16x8 At[4][2], B0[2][2], B1[2][2];
    const char* cA = (const char*)(cur.pn >= g.pn_split ? g.A2 : g.A) + (size_t)cur.pm * tstepA; const char* cB = PG8_BPTR(cur);
    PG8_STAGE(PG8_SB(0, 0), cB, voffB); PG8_STAGE(PG8_SB(0, 1), cB + hstepB, voffB); PG8_STAGE(PG8_SA(0, 0), cA, voffA); PG8_STAGE(PG8_SA(0, 1), cA + hstepA, voffA);
    if (wr == 1) PG8_BAR;
    PG8_WAIT_V(2); PG8_BAR;
    PG8_STAGE(PG8_SB(1, 0), cB + kstep, voffB); PG8_STAGE(PG8_SA(1, 0), cA + kstep, voffA); PG8_STAGE(PG8_SB(1, 1), cB + hstepB + kstep, voffB);
    PG8_WAIT_V(6); PG8_BAR;
    for (;;) {
        const bool has_next = S.next(ui + 1, nxt);
        const char* nA = has_next ? (const char*)(nxt.pn >= g.pn_split ? g.A2 : g.A) + (size_t)nxt.pm * tstepA : cA; const char* nB = has_next ? PG8_BPTR(nxt) : cB;
        for (int t = 0; t < nt; t += 2) {
            const bool last = (t == nt - 2);
            const char* a1 = cA + (size_t)(t + 1) * kstep;
            const char* a2 = last ? nA : cA + (size_t)(t + 2) * kstep; const char* b2 = last ? nB : cB + (size_t)(t + 2) * kstep;
            const char* a3 = a2 + kstep; const char* b3 = b2 + kstep;
            PG8_LDB(B0, 0, 0); PG8_LDB(B1, 0, 1); PG8_SCHED; PG8_LDA(At, 0, 0); PG8_STAGE(PG8_SA(1, 1), a1 + hstepA, voffA);
            PG8_WAIT_V(8); PG8_WAIT_L(0); PG8_BAR; PG8_MMA(0, 0, At, B0); PG8_MMA(0, 1, At, B1); PG8_BAR; PG8_SCHED;
            PG8_LDA(At, 0, 1); PG8_STAGE(PG8_SB(0, 0), b2, voffB); PG8_STAGE(PG8_SB(0, 1), b2 + hstepB, voffB); PG8_STAGE(PG8_SA(0, 0), a2, voffA);
            PG8_WAIT_V(8); PG8_WAIT_L(0); PG8_BAR; PG8_MMA(1, 0, At, B0); PG8_MMA(1, 1, At, B1); PG8_BAR; PG8_SCHED;
            PG8_LDB(B0, 1, 0); PG8_LDB(B1, 1, 1); PG8_SCHED; PG8_LDA(At, 1, 0); PG8_STAGE(PG8_SA(0, 1), a2 + hstepA, voffA);
            PG8_WAIT_V(8); PG8_WAIT_L(0); PG8_BAR; PG8_MMA(0, 0, At, B0); PG8_MMA(0, 1, At, B1); PG8_BAR; PG8_SCHED;
            PG8_LDA(At, 1, 1); PG8_STAGE(PG8_SB(1, 0), b3, voffB); PG8_STAGE(PG8_SB(1, 1), b3 + hstepB, voffB); PG8_STAGE(PG8_SA(1, 0), a3, voffA);
            PG8_WAIT_V(8); PG8_WAIT_L(0); PG8_BAR; PG8_MMA(1, 0, At, B0); PG8_MMA(1, 1, At, B1); PG8_BAR; PG8_SCHED;
        }
        if (wr == 0) PG8_BAR;
        E(acc, cur, wr, wc, fr, fq);
        if (!has_next) break;
#pragma unroll
        for (int a = 0; a < 2; ++a)
#pragma unroll
            for (int b = 0; b < 2; ++b)
#pragma unroll
                for (int m = 0; m < 4; ++m)
#pragma unroll
                    for (int n = 0; n < 2; ++n) acc[a][b][m][n] = (f32x4){0.f, 0.f, 0.f, 0.f};
        cur = nxt; cA = nA; cB = nB; ++ui;
        if (wr == 1) PG8_BAR;
    }
    PG8_WAIT_V(0);
    PG8_BAR;
#undef PG8_SA
#undef PG8_SB
#undef PG8_STAGE
#undef PG8_LDA
#undef PG8_LDB
#undef PG8_MMA
#undef PG8_WAIT_V
#undef PG8_WAIT_L
#undef PG8_BAR
#undef PG8_SCHED
#undef PG8_BPTR
}

typedef const f32x4 (&AccRef)[2][2][4][2];
struct EpiInProj {
    static constexpr bool PERM = true;
    bf16_t* P1; bf16_t* G;
    __device__ __forceinline__ void operator()(AccRef acc, const Unit& u, int wr, int wc, int fr, int fq) const {
        const int row0 = u.pm * BM + wr * 64 + fr; const bool gate = u.pn >= 8;
        bf16_t* base = gate ? G : P1; const int ldc = gate ? GW : P1W; const int col0 = (gate ? (u.pn - 8) : u.pn) * BM + wc * 32 + 8 * fq;
#pragma unroll
        for (int ai = 0; ai < 2; ++ai)
#pragma unroll
            for (int m = 0; m < 4; ++m) { bf16_t* rowp = base + (size_t)(row0 + ai * HALF + m * 16) * ldc + col0;
#pragma unroll
                for (int bj = 0; bj < 2; ++bj) { f32x4 v0 = acc[ai][bj][m][0], v1 = acc[ai][bj][m][1];
                    if (gate) {
#pragma unroll
                        for (int j = 0; j < 4; ++j) { v0[j] = sigmoidf_(v0[j]); v1[j] = sigmoidf_(v1[j]); } }
                    u32x4 w; w.x = cvt_pk_bf16(v0[0], v0[1]); w.y = cvt_pk_bf16(v0[2], v0[3]); w.z = cvt_pk_bf16(v1[0], v1[1]); w.w = cvt_pk_bf16(v1[2], v1[3]);
                    *(u32x4*)(rowp + bj * HALF) = w; } }
    }
};
struct EpiBf16 {
    static constexpr bool PERM = true;
    bf16_t* O; int ldc;
    __device__ __forceinline__ void operator()(AccRef acc, const Unit& u, int wr, int wc, int fr, int fq) const {
        const int row0 = u.pm * BM + wr * 64 + fr; const int col0 = u.pn * BM + wc * 32 + 8 * fq;
#pragma unroll
        for (int ai = 0; ai < 2; ++ai)
#pragma unroll
            for (int m = 0; m < 4; ++m) { bf16_t* rowp = O + (size_t)(row0 + ai * HALF + m * 16) * ldc + col0;
#pragma unroll
                for (int bj = 0; bj < 2; ++bj) { const f32x4 v0 = acc[ai][bj][m][0], v1 = acc[ai][bj][m][1];
                    u32x4 w; w.x = cvt_pk_bf16(v0[0], v0[1]); w.y = cvt_pk_bf16(v0[2], v0[3]); w.z = cvt_pk_bf16(v1[0], v1[1]); w.w = cvt_pk_bf16(v1[2], v1[3]);
                    *(u32x4*)(rowp + bj * HALF) = w; } }
    }
};
template <bool ACCUM> struct EpiMerge {
    static constexpr bool PERM = true;
    bf16_t* Mg; const bf16_t* G; int goff;
    __device__ __forceinline__ void operator()(AccRef acc, const Unit& u, int wr, int wc, int fr, int fq) const {
        const int row0 = u.pm * BM + wr * 64 + fr; const int col0 = u.pn * BM + wc * 32 + 8 * fq;
#pragma unroll
        for (int ai = 0; ai < 2; ++ai)
#pragma unroll
            for (int m = 0; m < 4; ++m) { const size_t row = (size_t)(row0 + ai * HALF + m * 16);
#pragma unroll
                for (int bj = 0; bj < 2; ++bj) { const f32x4 v0 = acc[ai][bj][m][0], v1 = acc[ai][bj][m][1];
                    const u32x4 gw = *(const u32x4*)(G + row * GW + goff + col0 + bj * HALF);
                    u32x4* mp = (u32x4*)(Mg + row * DM + col0 + bj * HALF);
                    float r[8] = { bflo(gw.x) * v0[0], bfhi(gw.x) * v0[1], bflo(gw.y) * v0[2], bfhi(gw.y) * v0[3], bflo(gw.z) * v1[0], bfhi(gw.z) * v1[1], bflo(gw.w) * v1[2], bfhi(gw.w) * v1[3] };
                    if (ACCUM) { const u32x4 o = *mp; r[0] += bflo(o.x); r[1] += bfhi(o.x); r[2] += bflo(o.y); r[3] += bfhi(o.y); r[4] += bflo(o.z); r[5] += bfhi(o.z); r[6] += bflo(o.w); r[7] += bfhi(o.w); }
                    u32x4 w; w.x = cvt_pk_bf16(r[0], r[1]); w.y = cvt_pk_bf16(r[2], r[3]); w.z = cvt_pk_bf16(r[4], r[5]); w.w = cvt_pk_bf16(r[6], r[7]);
                    *mp = w; } }
    }
};
struct EpiResid {
    static constexpr bool PERM = false;
    const float* R; float* O;
    __device__ __forceinline__ void operator()(AccRef acc, const Unit& u, int wr, int wc, int fr, int fq) const {
        const int row0 = u.pm * BM + wr * 64 + fr, col0 = u.pn * BM + wc * 32 + 4 * fq;
#pragma unroll
        for (int ai = 0; ai < 2; ++ai)
#pragma unroll
            for (int m = 0; m < 4; ++m) { const size_t off = (size_t)(row0 + ai * HALF + m * 16) * DM + col0;
#pragma unroll
                for (int bj = 0; bj < 2; ++bj)
#pragma unroll
                    for (int n = 0; n < 2; ++n) { const f32x4 r = *(const f32x4*)(R + off + bj * HALF + n * 16); *(f32x4*)(O + off + bj * HALF + n * 16) = r + acc[ai][bj][m][n]; }
                asm volatile("" ::: "memory"); }
    }
};
struct EpiSwiglu {
    static constexpr bool PERM = true;
    bf16_t* O; int ldc;
    __device__ __forceinline__ void operator()(AccRef acc, const Unit& u, int wr, int wc, int fr, int fq) const {
        const int row0 = u.pm * BM + wr * 64 + fr; const int col0 = u.pn * HALF + wc * 32 + 8 * fq;
#pragma unroll
        for (int ai = 0; ai < 2; ++ai)
#pragma unroll
            for (int m = 0; m < 4; ++m) { bf16_t* rowp = O + (size_t)(row0 + ai * HALF + m * 16) * ldc + col0;
                float r[8];
#pragma unroll
                for (int n = 0; n < 2; ++n)
#pragma unroll
                    for (int j = 0; j < 4; ++j) { const float gt = acc[ai][0][m][n][j], up = acc[ai][1][m][n][j]; r[4 * n + j] = gt * sigmoidf_(gt) * up; }
                u32x4 w; w.x = cvt_pk_bf16(r[0], r[1]); w.y = cvt_pk_bf16(r[2], r[3]); w.z = cvt_pk_bf16(r[4], r[5]); w.w = cvt_pk_bf16(r[6], r[7]);
                *(u32x4*)rowp = w; }
    }
};
}

constexpr size_t MiB = 1u << 20;
constexpr size_t WS_CTL = 0, CTL_ZERO_BYTES = 1 * MiB;
constexpr size_t SZ_WIN = (size_t)NINP * DM * 2;
constexpr size_t SZ_WUQ = (size_t)512 * 256 * 2, SZ_WUKV = SZ_WUQ;
constexpr size_t SZ_WAO = (size_t)DM * 256 * 2, SZ_WBO = SZ_WAO, SZ_WCO = (size_t)DM * 512 * 2, SZ_WO = (size_t)DM * DM * 2;
constexpr size_t SZ_LAYERW = SZ_WIN + SZ_WUQ + SZ_WUKV + SZ_WAO + SZ_WBO + SZ_WCO + SZ_WO;
constexpr size_t WS_LAYERW = 1 * MiB;
constexpr size_t OFF_WIN = 0, OFF_WUQ = OFF_WIN + SZ_WIN, OFF_WUKV = OFF_WUQ + SZ_WUQ, OFF_WAO = OFF_WUKV + SZ_WUKV, OFF_WBO = OFF_WAO + SZ_WAO, OFF_WCO = OFF_WBO + SZ_WBO, OFF_WO = OFF_WCO + SZ_WCO;
constexpr size_t WS_W13 = WS_LAYERW + 2 * SZ_LAYERW;
constexpr size_t SZ_W13 = (size_t)2 * DFF * DM * 2, SZ_W2 = (size_t)DM * DFF * 2;
constexpr size_t WS_W2 = WS_W13 + SZ_W13;
constexpr size_t WS_E13 = WS_W2 + SZ_W2;
constexpr size_t SZ_E13 = (size_t)2 * EFF * DM * 2, SZ_E2 = (size_t)DM * EFF * 2;
constexpr size_t WS_E2 = WS_E13 + NEXP * SZ_E13;
constexpr size_t WS_ROPE = WS_E2 + NEXP * SZ_E2;
constexpr size_t SZ_ROPE = (size_t)NPOS * (32 + 32 + 16 + 16) * 4;
constexpr size_t WS_HB = ((WS_ROPE + SZ_ROPE + MiB - 1) / MiB) * MiB;
constexpr size_t SZ_HB = (size_t)(TCH + 1) * DM * 2;
constexpr size_t WS_ACT = ((WS_HB + SZ_HB + MiB - 1) / MiB) * MiB;
constexpr size_t A_P1 = 0;                                  constexpr size_t SZ_P1 = (size_t)TCH * P1W * 2;
constexpr size_t A_G = A_P1 + SZ_P1;                        constexpr size_t SZ_G = (size_t)TCH * GW * 2;
constexpr size_t A_QA = A_G + SZ_G;
constexpr size_t A_KA = A_QA + (size_t)TCH * 256 * 2;
constexpr size_t A_VA = A_KA + (size_t)TCH * 64 * 2;
constexpr size_t A_IQ = A_VA + (size_t)TCH * 64 * 2;
constexpr size_t A_IK = A_IQ + (size_t)TCH * 256 * 2;
constexpr size_t A_IW = A_IK + (size_t)TCH * 32 * 2;
constexpr size_t A_CQN = A_IW + (size_t)TCH * 8 * 4;
constexpr size_t A_CKVN = A_CQN + (size_t)TCH * 256 * 2;
constexpr size_t A_KR = A_CKVN + (size_t)TCH * 256 * 2;
constexpr size_t A_QC = A_KR + (size_t)TCH * 32 * 2;
constexpr size_t A_KC = A_QC + (size_t)TCH * 512 * 2;
constexpr size_t A_VCT = A_KC + (size_t)TCH * 128 * 2;
constexpr size_t A_QBR = A_VCT + (size_t)TCH * 128 * 2;
constexpr size_t A_KVBR = A_QBR + (size_t)TCH * 512 * 2;
constexpr size_t A_QB = A_KVBR + (size_t)TCH * 512 * 2;
constexpr size_t A_KB = A_QB + (size_t)TCH * 384 * 2;
constexpr size_t A_VBT = A_KB + (size_t)TCH * 384 * 2;
constexpr size_t A_SEL = A_VBT + (size_t)TCH * 256 * 2;
constexpr size_t A_SELN = A_SEL + (size_t)TCH * 256 * 2;
constexpr size_t A_Y = A_SELN + (size_t)TCH * 4;
constexpr size_t A_END = A_Y + (size_t)TCH * DM * 2;
constexpr size_t F_ACT = 0;
constexpr size_t F_YM = F_ACT + (size_t)MOE_ROWS * EFF * 2;
constexpr size_t F_ROWTOK = F_YM + (size_t)MOE_ROWS * DM * 2;
constexpr size_t F_TOPD = F_ROWTOK + (size_t)MOE_ROWS * 4;
constexpr size_t F_TOPE = F_TOPD + (size_t)TCH * 2 * 4;
constexpr size_t F_TOPG = F_TOPE + (size_t)TCH * 2 * 4;
constexpr size_t F_BLKE = F_TOPG + (size_t)TCH * 2 * 4;
constexpr size_t F_END = F_BLKE + 4096;
constexpr size_t WS_END = WS_ACT + (A_END > F_END ? A_END : F_END);
constexpr int CW_BAR = 4096;
constexpr int CW_Q = 16384;
constexpr int CW_MOE = 32768;
constexpr int CW_DBG = 65536;

constexpr int RING_OFF = 0;
constexpr int IDX_HIST = 0, IDX_BITMAP = 0, IDX_CANDK = 32768, IDX_CANDI = 98304, IDX_SUBH = 131072, IDX_QT = 131072  , IDX_QPAR = 147968, IDX_CCNT = 148480, IDX_FLAG = 148608;
constexpr int IDX_CCAP = 512, IDX_RCAP = 256;
constexpr int MISC_OFF = 148736;
constexpr int LDS_BYTES = 149504;
constexpr int NWAVES = 8;

#define XB_TMO      128
#define XB_XCNT(j)  (256  + 64 * (j))
#define XB_XSUB(j)  (1280 + 64 * (j))
#define XB_XGEN(j)  (2304 + 64 * (j))
#define XB_TOP      3328
#define XB_TOPGEN   3392
#define XCD_BAR_WORDS 3456
#define XB_SPIN_CAP (1u << 18)

__device__ __forceinline__ unsigned xb_ld(unsigned* p)              { return __hip_atomic_load(p, __ATOMIC_RELAXED, __HIP_MEMORY_SCOPE_AGENT); }
__device__ __forceinline__ unsigned xb_add(unsigned* p, unsigned v) { return __hip_atomic_fetch_add(p, v, __ATOMIC_RELAXED, __HIP_MEMORY_SCOPE_AGENT); }
__device__ __forceinline__ unsigned xb_xcc_id() { return (unsigned)__builtin_amdgcn_s_getreg((3 << 11) | 20) & 0xFu; }
#define XB_SPIN(cond, bar) do { unsigned _sp = 0; while (cond) { __builtin_amdgcn_s_sleep(1); \
    if ((++_sp & 255u) == 0u) { if (xb_ld(&(bar)[XB_TMO])) break; if (_sp > XB_SPIN_CAP) { atomicAdd(&(bar)[XB_TMO], 1u); break; } } } } while (0)

struct XcdBarrier {
    unsigned* bar; unsigned x;
    volatile LAS unsigned* st;
};
__device__ __forceinline__ XcdBarrier xcd_barrier_post(unsigned* bar, volatile LAS unsigned* st, int wave_) {
    XcdBarrier b; b.bar = bar; b.x = xb_xcc_id(); b.st = st;
    if (wave_ == 0 && lane_id() == 0) (void)xb_add(&bar[XB_XCNT(b.x)], 1u);
    return b;
}
__device__ __forceinline__ void xcd_barrier_complete(unsigned* bar, unsigned x, unsigned& nloc, unsigned& nx) {
    const unsigned G = gridDim.x * gridDim.y * gridDim.z;
    unsigned sum, cnt, mine, sp = 0u;
    for (;;) {
        sum = 0u; cnt = 0u; mine = 0u;
#pragma unroll
        for (unsigned j = 0; j < 16; ++j) { const unsigned c = xb_ld(&bar[XB_XCNT(j)]); sum += c; cnt += (c > 0u) ? 1u : 0u; mine = (j == x) ? c : mine; }
        if (sum == G) break;
        __builtin_amdgcn_s_sleep(1);
        if ((++sp & 255u) == 0u) { if (xb_ld(&bar[XB_TMO])) break; if (sp > XB_SPIN_CAP) { atomicAdd(&bar[XB_TMO], 1u); break; } }
    }
    nloc = mine > 0u ? mine : 1u; nx = cnt > 0u ? cnt : 1u;
}
__device__ __forceinline__ void xcd_barrier(const XcdBarrier& b, int wave_) {
    asm volatile("s_waitcnt vmcnt(0)" ::: "memory");
    __syncthreads();
    if (wave_ == 0 && lane_id() == 0) {
        unsigned* bar = b.bar;
        __builtin_amdgcn_s_waitcnt(0);
        unsigned nloc = b.st[0], nx = b.st[1];
        if (nloc == 0u) { xcd_barrier_complete(bar, b.x, nloc, nx); b.st[0] = nloc; b.st[1] = nx; }
        const unsigned old = xb_add(&bar[XB_XSUB(b.x)], 1u);
        const unsigned gen = old / nloc;
        if (old + 1u == (gen + 1u) * nloc) {
            __builtin_amdgcn_fence(__ATOMIC_RELEASE, "agent");
            asm volatile("s_waitcnt vmcnt(0)" ::: "memory");
            const unsigned og = xb_add(&bar[XB_TOP], 1u);
            const unsigned tg = og / nx;
            if (og + 1u == (tg + 1u) * nx) xb_add(&bar[XB_TOPGEN], 1u);
            else XB_SPIN(xb_ld(&bar[XB_TOPGEN]) == tg, bar);
            __builtin_amdgcn_fence(__ATOMIC_ACQUIRE, "agent");
            xb_add(&bar[XB_XGEN(b.x)], 1u);
            asm volatile("s_waitcnt vmcnt(0)" ::: "memory");
        } else {
            XB_SPIN(xb_ld(&bar[XB_XGEN(b.x)]) == gen, bar);
            __builtin_amdgcn_fence(__ATOMIC_ACQUIRE, "agent");
            asm volatile("s_waitcnt vmcnt(0)" ::: "memory");
        }
    }
    __syncthreads();
}

template <int MAP> __device__ __forceinline__ int wt_row(int n) {
    if (MAP == 1) return n < C_G ? n : n + (P1W - C_G);
    if (MAP == 2) return 256 * (n >> 7) + (n & 127);
    if (MAP == 3) return 256 * (n >> 7) + 128 + (n & 127);
    return n;
}
template <int MAP>
__device__ __forceinline__ void transpose_item(const float* W, int K, int N, bf16_t* WT, int ldk, LAS float* scr, int item, int lane) {
    const int nblk = (N + 31) / 32, kb = item / nblk, nb = item % nblk, k0 = 64 * kb, n0 = 32 * nb;
    const int nn = n0 + (lane & 31); const bool nok = nn < N;
#pragma unroll 8
    for (int i = 0; i < 32; ++i) { const int kk = 2 * i + (lane >> 5); scr[kk * 33 + (lane & 31)] = nok ? W[(size_t)(k0 + kk) * N + nn] : 0.f; }
    LDS_WAIT(); asm volatile("" ::: "memory");
    const int c = lane & 7;
#pragma unroll
    for (int j = 0; j < 4; ++j) { const int n = (lane >> 3) + 8 * j; const LAS float* s = scr + (8 * c) * 33 + n;
        u32x4 o; o.x = pk2(s[0 * 33], s[1 * 33]); o.y = pk2(s[2 * 33], s[3 * 33]); o.z = pk2(s[4 * 33], s[5 * 33]); o.w = pk2(s[6 * 33], s[7 * 33]);
        if (n0 + n < N) *(u32x4*)(WT + (size_t)wt_row<MAP>(n0 + n) * ldk + k0 + 8 * c) = o; }
    LDS_WAIT(); asm volatile("" ::: "memory");
}

struct RopeTab { const float* c64; const float* s64; const float* c32; const float* s32; };

__device__ __forceinline__ void rope_cs(const RopeTab& R, int pos, int i, int half, float& c, float& s) {
    pos = pos < 0 ? 0 : (pos >= NPOS ? NPOS - 1 : pos);
    if (half == 32) { c = R.c64[pos * 32 + i]; s = R.s64[pos * 32 + i]; } else { c = R.c32[pos * 16 + i]; s = R.s32[pos * 16 + i]; }
}

__device__ __forceinline__ void norm_rows(const float* x, const float* g, bf16_t* HB, int gw, int ngw, int lane) {
    asm volatile("" : "+v"(lane));
    f32x4 gv[4];
#pragma unroll
    for (int j = 0; j < 4; ++j) gv[j] = *(const f32x4*)(g + 4 * lane + 256 * j);
    for (int tok = gw; tok < TCH; tok += ngw) {
        const float* xr = x + (size_t)tok * DM; f32x4 v[4]; float ss = 0.f;
#pragma unroll
        for (int j = 0; j < 4; ++j) { v[j] = *(const f32x4*)(xr + 4 * lane + 256 * j); ss += (v[j].x * v[j].x + v[j].y * v[j].y) + (v[j].z * v[j].z + v[j].w * v[j].w); }
        const float rstd = 1.0f / sqrtf(wave_sum(ss) * (1.0f / DM) + EPS);
        bf16_t* o = HB + (size_t)tok * DM;
#pragma unroll
        for (int j = 0; j < 4; ++j) { u32x2 w; w.x = pk2(v[j].x * rstd * gv[j].x, v[j].y * rstd * gv[j].y); w.y = pk2(v[j].z * rstd * gv[j].z, v[j].w * rstd * gv[j].w); *(u32x2*)(o + 4 * lane + 256 * j) = w; }
    }
}

struct PP1Args {
    const bf16_t* P1; const int* pos;
    const float *aq_g, *ak_g, *cq_g, *ckv_g, *kr_g, *qc_g, *kc_g;
    unsigned char* act;
    RopeTab R;
};
constexpr float SC_A = 0.125f * LOG2E;
constexpr float SC_B = 0.10206207261596577f * LOG2E;
constexpr float SC_IW = 0.35355339059327373f * 0.17677669529663687f;
__device__ __forceinline__ void pp1_rows(const PP1Args& a, int gw, int ngw, int lane) {
    asm volatile("" : "+v"(lane));
    const int i32 = lane & 31, hf = lane >> 5, i16 = lane & 15, qt = lane >> 4;
    const float gaq1 = a.aq_g[i32], gaq2 = a.aq_g[32 + i32], gak1 = a.ak_g[i32], gak2 = a.ak_g[32 + i32], gqc1 = a.qc_g[i32], gqc2 = a.qc_g[32 + i32], gkc1 = a.kc_g[i32], gkc2 = a.kc_g[32 + i32];
    const float gkr1 = a.kr_g[i16], gkr2 = a.kr_g[16 + i16];
    for (int tok = gw; tok < TCH; tok += ngw) {
        const bf16_t* p = a.P1 + (size_t)tok * P1W; const int pos = a.pos[tok];
        const int bl = tok / SEQ, s = tok % SEQ;
        float c64, s64, c32, s32; rope_cs(a.R, pos, i32, 32, c64, s64); rope_cs(a.R, pos, i16, 16, c32, s32);
#pragma unroll 1
        for (int it = 0; it < 8; ++it) {
            const int hh = 2 * it + hf;
            const int kind = hh < 4 ? 0 : (hh == 4 ? 1 : (hh < 13 ? 2 : 3));
            const int hsub = kind == 0 ? hh : (kind == 1 ? 0 : (kind == 2 ? hh - 5 : ((hh - 13) & 1)));
            const int src = (kind == 0 ? C_QA : (kind == 1 ? C_KA : (kind == 2 ? C_QC : C_KC))) + 64 * hsub;
            const size_t dbase = kind == 0 ? A_QA : (kind == 1 ? A_KA : (kind == 2 ? A_QC : A_KC));
            const int dpitch = kind == 0 ? 256 : (kind == 1 ? 64 : (kind == 2 ? 512 : 128));
            const float g1 = kind == 0 ? gaq1 : (kind == 1 ? gak1 : (kind == 2 ? gqc1 : gkc1)), g2 = kind == 0 ? gaq2 : (kind == 1 ? gak2 : (kind == 2 ? gqc2 : gkc2));
            const float sc = (kind == 0 || kind == 2) ? SC_A : 1.f;
            bf16_t* dst = (bf16_t*)(a.act + dbase) + (size_t)tok * dpitch + 64 * hsub;
            const float x1 = bf2f(p[src + i32]), x2 = bf2f(p[src + 32 + i32]);
            const float rstd = 1.0f / sqrtf(sum32(x1 * x1 + x2 * x2) * (1.0f / 64.0f) + EPS);
            const float y1 = x1 * rstd * g1, y2 = x2 * rstd * g2;
            const float o1 = (y1 * c64 - y2 * s64) * sc, o2 = (y2 * c64 + y1 * s64) * sc;
            if (hh < 15) { dst[i32] = (bf16_t)f2bf(o1); dst[32 + i32] = (bf16_t)f2bf(o2); }
        }
#pragma unroll 1
        for (int it = 0; it < 3; ++it) {
            const int hh = 4 * it + qt; const int kind = hh < 8 ? 0 : (hh == 8 ? 1 : 2);
            const int src = kind == 0 ? C_IQ + 32 * hh : (kind == 1 ? C_IK : C_KR);
            const size_t dbase = kind == 0 ? A_IQ : (kind == 1 ? A_IK : A_KR);
            bf16_t* dst = (bf16_t*)(a.act + dbase) + (size_t)tok * (kind == 0 ? 256 : 32) + (kind == 0 ? 32 * hh : 0);
            float x1 = bf2f(p[src + i16]), x2 = bf2f(p[src + 16 + i16]);
            const float ss = sum16(x1 * x1 + x2 * x2);
            if (kind == 2) { const float rstd = 1.0f / sqrtf(ss * (1.0f / 32.0f) + EPS); x1 *= rstd * gkr1; x2 *= rstd * gkr2; }
            const float o1 = x1 * c32 - x2 * s32, o2 = x2 * c32 + x1 * s32;
            if (hh < 10) { dst[i16] = (bf16_t)f2bf(o1); dst[16 + i16] = (bf16_t)f2bf(o2); }
        }
        if (lane < 8) ((float*)(a.act + A_IW))[(size_t)tok * 8 + lane] = bf2f(p[C_IW + lane]) * SC_IW;
        ((bf16_t*)(a.act + A_VA))[(size_t)tok * 64 + lane] = p[C_VA + lane];
        { const u32x2 w = *(const u32x2*)(p + C_CQ + 4 * lane); const float x0 = bflo(w.x), x1 = bfhi(w.x), x2 = bflo(w.y), x3 = bfhi(w.y);
          const float rstd = 1.0f / sqrtf(wave_sum((x0 * x0 + x1 * x1) + (x2 * x2 + x3 * x3)) * (1.0f / 256.0f) + EPS);
          const f32x4 g = *(const f32x4*)(a.cq_g + 4 * lane);
          u32x2 o; o.x = pk2(x0 * rstd * g.x, x1 * rstd * g.y); o.y = pk2(x2 * rstd * g.z, x3 * rstd * g.w); *(u32x2*)((bf16_t*)(a.act + A_CQN) + (size_t)tok * 256 + 4 * lane) = o; }
        { const unsigned w = *(const unsigned*)(p + C_CKV + 2 * lane); const float x0 = bflo(w), x1 = bfhi(w);
          const float rstd = 1.0f / sqrtf(wave_sum(x0 * x0 + x1 * x1) * (1.0f / 128.0f) + EPS);
          const f32x2 g = *(const f32x2*)(a.ckv_g + 2 * lane);
          bf16_t* ck = (bf16_t*)(a.act + A_CKVN) + (size_t)tok * 256;
          *(unsigned*)(ck + 2 * lane) = pk2(x0 * rstd * g.x, x1 * rstd * g.y);
          *(unsigned*)(ck + 128 + 2 * lane) = 0u; }
#pragma unroll
        for (int kvh = 0; kvh < 2; ++kvh) ((bf16_t*)(a.act + A_VCT))[((size_t)(bl * 2 + kvh) * 64 + lane) * SEQ + s] = p[C_VC + 64 * kvh + lane];
    }
}

struct PP2Args {
    const bf16_t *QBR, *KVBR, *KR; const int* pos;
    const float *qn_g, *qr_g, *kn_g;
    bf16_t *QB, *KB, *VBT; RopeTab R;
};
__device__ __forceinline__ void pp2_rows(const PP2Args& a, int gw, int ngw, int lane) {
    asm volatile("" : "+v"(lane));
    const int i32 = lane & 31, hf = lane >> 5;
    for (int tok = gw; tok < TCH; tok += ngw) {
        const int pos = a.pos[tok]; const int bl = tok / SEQ, s = tok % SEQ;
        float c32 = 0.f, s32 = 0.f; if (i32 < 16) rope_cs(a.R, pos, i32, 16, c32, s32);
        const bf16_t* q = a.QBR + (size_t)tok * 1024; const bf16_t* kv = a.KVBR + (size_t)tok * 1024;
        bf16_t* qo = a.QB + (size_t)tok * 384; bf16_t* ko = a.KB + (size_t)tok * 384;
#pragma unroll 1
        for (int it = 0; it < 2; ++it) {
            const int h = 2 * it + hf;
            { const float x1 = bf2f(q[h * 96 + i32]), x2 = bf2f(q[h * 96 + 32 + i32]);
              const float rstd = 1.0f / sqrtf(sum32(x1 * x1 + x2 * x2) * (1.0f / 64.0f) + EPS);
              qo[h * 96 + i32] = (bf16_t)f2bf(x1 * rstd * a.qn_g[i32] * SC_B); qo[h * 96 + 32 + i32] = (bf16_t)f2bf(x2 * rstd * a.qn_g[32 + i32] * SC_B); }
            { const bool on = i32 < 16; const float x1 = on ? bf2f(q[h * 96 + 64 + i32]) : 0.f, x2 = on ? bf2f(q[h * 96 + 80 + i32]) : 0.f;
              const float rstd = 1.0f / sqrtf(sum32(x1 * x1 + x2 * x2) * (1.0f / 32.0f) + EPS);
              const float y1 = x1 * rstd * (on ? a.qr_g[i32] : 0.f), y2 = x2 * rstd * (on ? a.qr_g[16 + i32] : 0.f);
              if (on) { qo[h * 96 + 64 + i32] = (bf16_t)f2bf((y1 * c32 - y2 * s32) * SC_B); qo[h * 96 + 80 + i32] = (bf16_t)f2bf((y2 * c32 + y1 * s32) * SC_B); } }
            { const float x1 = bf2f(kv[h * 128 + i32]), x2 = bf2f(kv[h * 128 + 32 + i32]);
              const float rstd = 1.0f / sqrtf(sum32(x1 * x1 + x2 * x2) * (1.0f / 64.0f) + EPS);
              ko[h * 96 + i32] = (bf16_t)f2bf(x1 * rstd * a.kn_g[i32]); ko[h * 96 + 32 + i32] = (bf16_t)f2bf(x2 * rstd * a.kn_g[32 + i32]);
              ko[h * 96 + 64 + i32] = a.KR[(size_t)tok * 32 + i32];
              a.VBT[((size_t)(bl * 4 + h) * 64 + i32) * SEQ + s] = kv[h * 128 + 64 + i32];
              a.VBT[((size_t)(bl * 4 + h) * 64 + 32 + i32) * SEQ + s] = kv[h * 128 + 96 + i32]; }
        }
    }
}

struct RouteArgs { const float* rw; int* TOPE; float* TOPG; int* TOPD; unsigned* cursor; };
template <bool ROUTE>
__device__ __forceinline__ void norm2_rows(const float* x, const float* g, bf16_t* HB, const RouteArgs& ra, LAS unsigned* lcnt  , int vcu, int wave, int lane, int G) {
    asm volatile("" : "+v"(lane));
    int tidx = wave * 64 + lane;
    const int tpw = TCH / G; const int t0 = vcu * tpw;
    f32x4 gv[4];
#pragma unroll
    for (int j = 0; j < 4; ++j) gv[j] = *(const f32x4*)(g + 4 * lane + 256 * j);
    for (int tl = wave; tl < tpw; tl += NWAVES) {
        const int tok = t0 + tl;
        const float* xr = x + (size_t)tok * DM; f32x4 v[4]; float ss = 0.f;
#pragma unroll
        for (int j = 0; j < 4; ++j) { v[j] = *(const f32x4*)(xr + 4 * lane + 256 * j); ss += (v[j].x * v[j].x + v[j].y * v[j].y) + (v[j].z * v[j].z + v[j].w * v[j].w); }
        const float rstd = 1.0f / sqrtf(wave_sum(ss) * (1.0f / DM) + EPS);
        bf16_t* o = HB + (size_t)tok * DM;
#pragma unroll
        for (int j = 0; j < 4; ++j) { v[j].x *= rstd * gv[j].x; v[j].y *= rstd * gv[j].y; v[j].z *= rstd * gv[j].z; v[j].w *= rstd * gv[j].w;
            u32x2 w; w.x = pk2(v[j].x, v[j].y); w.y = pk2(v[j].z, v[j].w); *(u32x2*)(o + 4 * lane + 256 * j) = w; }
        if (ROUTE) {
            float lg[NEXP];
#pragma unroll
            for (int e = 0; e < NEXP; ++e) lg[e] = 0.f;
#pragma unroll
            for (int j = 0; j < 4; ++j)
#pragma unroll
                for (int c = 0; c < 4; ++c) { const float hv = v[j][c]; const float* wr = ra.rw + (size_t)(4 * lane + 256 * j + c) * NEXP;
                    const f32x4 w0 = *(const f32x4*)wr, w1 = *(const f32x4*)(wr + 4);
                    lg[0] += hv * w0.x; lg[1] += hv * w0.y; lg[2] += hv * w0.z; lg[3] += hv * w0.w; lg[4] += hv * w1.x; lg[5] += hv * w1.y; lg[6] += hv * w1.z; lg[7] += hv * w1.w; }
#pragma unroll
            for (int e = 0; e < NEXP; ++e) lg[e] = wave_sum(lg[e]);
            int e1 = 0; float l1 = lg[0];
#pragma unroll
            for (int e = 1; e < NEXP; ++e) if (lg[e] > l1) { l1 = lg[e]; e1 = e; }
            int e2 = -1; float l2 = -INFINITY;
#pragma unroll
            for (int e = 0; e < NEXP; ++e) if (e != e1 && lg[e] > l2) { l2 = lg[e]; e2 = e; }
            const float ex = __expf(l2 - l1); const float g1 = 1.0f / (1.0f + ex), g2 = ex / (1.0f + ex);
            if (lane == 0) {
                const unsigned p1 = lds_add(lcnt + e1, 1u), p2 = lds_add(lcnt + e2, 1u);
                ra.TOPE[2 * tok] = e1; ra.TOPE[2 * tok + 1] = e2; ra.TOPG[2 * tok] = g1; ra.TOPG[2 * tok + 1] = g2; ra.TOPD[2 * tok] = (int)p1; ra.TOPD[2 * tok + 1] = (int)p2;
            }
        }
    }
    if (ROUTE) {
        VM_WAIT(); __syncthreads();
        if (tidx < NEXP) { const unsigned n = lcnt[tidx]; lcnt[8 + tidx] = __hip_atomic_fetch_add(ra.cursor + tidx, n, __ATOMIC_RELAXED, __HIP_MEMORY_SCOPE_AGENT); }
        __syncthreads();
        for (int i = tidx; i < 2 * tpw; i += NWAVES * 64) { const int idx = 2 * t0 + i; const int e = ra.TOPE[idx]; ra.TOPD[idx] += (int)lcnt[8 + e]; }
        __syncthreads();
        if (tidx < 16) lcnt[tidx] = 0u;
        __syncthreads();
    }
}

__device__ __forceinline__ void moe_layout(const unsigned* cursor, int* pstart  ) {
    int acc = 0;
#pragma unroll
    for (int e = 0; e < NEXP; ++e) { pstart[e] = acc; const int c = (int)__hip_atomic_load(cursor + e, __ATOMIC_RELAXED, __HIP_MEMORY_SCOPE_AGENT); acc += (c + 255) / 256 * 256; }
    pstart[NEXP] = acc;
}
__device__ __forceinline__ void moe_scatter(const unsigned* cursor, const int* TOPE, int* TOPD, const bf16_t* HB, bf16_t* XB, int* BLKE, int gw, int ngw, int lane) {
    asm volatile("" : "+v"(lane));
    int ps[NEXP + 1]; moe_layout(cursor, ps);
    for (int i = gw; i < 2 * TCH; i += ngw) { const int e = TOPE[i];
        int base = 0;
#pragma unroll
        for (int k = 1; k < NEXP; ++k) base = (e == k) ? ps[k] : base;
        const int dest = base + TOPD[i];
        const u32x4* src = (const u32x4*)(HB + (size_t)(i >> 1) * DM); u32x4* dst = (u32x4*)(XB + (size_t)dest * DM);
        const u32x4 v0 = src[lane], v1 = src[64 + lane]; dst[lane] = v0; dst[64 + lane] = v1;
        if (lane == 0) TOPD[i] = dest; }
#pragma unroll
    for (int e = 0; e < NEXP; ++e) { const int cnt = (int)__hip_atomic_load(cursor + e, __ATOMIC_RELAXED, __HIP_MEMORY_SCOPE_AGENT);
        for (int r = ps[e] + cnt + gw; r < ps[e + 1]; r += ngw) { u32x4* dst = (u32x4*)(XB + (size_t)r * DM); dst[lane] = (u32x4){0u, 0u, 0u, 0u}; dst[64 + lane] = (u32x4){0u, 0u, 0u, 0u}; }
        for (int blk = ps[e] / 256 + gw * 64 + lane; blk < ps[e + 1] / 256; blk += ngw * 64) BLKE[blk] = e; }
}
__device__ __forceinline__ void moe_combine(float* xio, const bf16_t* YM, const int* TOPD, const float* TOPG, int gw, int ngw, int lane) {
    asm volatile("" : "+v"(lane));
    for (int tok = gw; tok < TCH; tok += ngw) {
        const int d1 = TOPD[2 * tok], d2 = TOPD[2 * tok + 1]; const float g1 = TOPG[2 * tok], g2 = TOPG[2 * tok + 1];
        float* xr = xio + (size_t)tok * DM; const bf16_t* y1 = YM + (size_t)d1 * DM; const bf16_t* y2 = YM + (size_t)d2 * DM;
#pragma unroll
        for (int j = 0; j < 4; ++j) { const int c = 4 * lane + 256 * j; f32x4 v = *(const f32x4*)(xr + c); const u32x2 a = *(const u32x2*)(y1 + c), b = *(const u32x2*)(y2 + c);
            v.x += bflo(a.x) * g1 + bflo(b.x) * g2; v.y += bfhi(a.x) * g1 + bfhi(b.x) * g2; v.z += bflo(a.y) * g1 + bflo(b.y) * g2; v.w += bfhi(a.y) * g1 + bfhi(b.y) * g2;
            *(f32x4*)(xr + c) = v; }
    }
}

__device__ __forceinline__ int kappa32(int m) { return (m & ~12) | ((m & 8) >> 1) | ((m & 4) << 1); }
template <int DQK>
__device__ __forceinline__ void fa_unit(LAS unsigned char* lds, int wave_, const bf16_t* Qw, int qpitch, const bf16_t* Kb, int kpitch, const bf16_t* VTb,
                                        int tile_lo, int tile_hi, int qpos0w, int window, float m_init, float l_init, bf16_t* Ow, int opitch) {
    constexpr int KP = DQK * 2 + 16, VP = 144, KBUF = 64 * KP, VBUF = 64 * VP, KCH = DQK / 8, NKC = 64 * KCH;
    int tid = wave_ * 64 + lane_id(); asm volatile("" : "+v"(tid));
    const int lane = tid & 63, r32 = lane & 31, hi = lane >> 5;
    bf16x8 qf[DQK / 16];
#pragma unroll
    for (int d0 = 0; d0 < DQK / 16; ++d0) qf[d0] = *(const bf16x8*)(Qw + (size_t)r32 * qpitch + d0 * 16 + hi * 8);
    const int kr0 = tid / KCH, kc0 = tid % KCH, kr1 = (tid + 512) / KCH, kc1 = (tid + 512) % KCH; const bool has1 = (tid + 512) < NKC;
    const int vr = tid >> 3, vc = tid & 7;
    u32x4 pk0, pk1 = (u32x4){0u, 0u, 0u, 0u}, pv;
#define FA_LOAD(t) do { const bf16_t* kt_ = Kb + (size_t)(64 * (t)) * kpitch; pk0 = *(const u32x4*)(kt_ + (size_t)kr0 * kpitch + kc0 * 8); if (has1) pk1 = *(const u32x4*)(kt_ + (size_t)kr1 * kpitch + kc1 * 8); \
        pv = *(const u32x4*)(VTb + (size_t)vr * SEQ + 64 * (t) + vc * 8); } while (0)
#define FA_STORE(b) do { LAS unsigned char* kd_ = lds + (b) * KBUF; *(LAS u32x4*)(kd_ + kr0 * KP + kc0 * 16) = pk0; if (has1) *(LAS u32x4*)(kd_ + kr1 * KP + kc1 * 16) = pk1; \
        *(LAS u32x4*)(lds + 2 * KBUF + (b) * VBUF + vr * VP + vc * 16) = pv; } while (0)
    float m_run = m_init, l_run = (hi == 0) ? l_init : 0.f;
    f32x16 o0, o1;
#pragma unroll
    for (int i = 0; i < 16; ++i) { o0[i] = 0.f; o1[i] = 0.f; }
    const int qpos = qpos0w + r32; const int krow = kappa32(r32);
    __syncthreads();
    FA_LOAD(tile_lo); FA_STORE(0);
    __syncthreads();
    for (int t = tile_lo; t < tile_hi; ++t) {
        const int buf = (t - tile_lo) & 1;
        if (t + 1 < tile_hi) FA_LOAD(t + 1);
        const int kbase = 64 * t;
        const bool active = (kbase <= qpos0w + 31) && (window == 0 || kbase + 63 > qpos0w - window);
        if (active) {
            const LAS unsigned char* Kt = lds + buf * KBUF; const LAS unsigned char* Vt = lds + 2 * KBUF + buf * VBUF;
            f32x16 s0, s1;
#pragma unroll
            for (int i = 0; i < 16; ++i) { s0[i] = 0.f; s1[i] = 0.f; }
#pragma unroll
            for (int d0 = 0; d0 < DQK / 16; ++d0) {
                const bf16x8 k0 = *(const LAS bf16x8*)(Kt + krow * KP + d0 * 32 + hi * 16);
                const bf16x8 k1 = *(const LAS bf16x8*)(Kt + (32 + krow) * KP + d0 * 32 + hi * 16);
                s0 = __builtin_amdgcn_mfma_f32_32x32x16_bf16(k0, qf[d0], s0, 0, 0, 0);
                s1 = __builtin_amdgcn_mfma_f32_32x32x16_bf16(k1, qf[d0], s1, 0, 0, 0);
            }
            const bool need_mask = (kbase + 63 > qpos0w) || (window != 0 && kbase <= qpos0w + 31 - window);
            if (need_mask) {
#pragma unroll
                for (int i = 0; i < 16; ++i) { const int key = kbase + 16 * (i >> 3) + 8 * hi + (i & 7);
                    const bool ok0 = (key <= qpos) && (window == 0 || key > qpos - window), ok1 = (key + 32 <= qpos) && (window == 0 || key + 32 > qpos - window);
                    s0[i] = ok0 ? s0[i] : -INFINITY; s1[i] = ok1 ? s1[i] : -INFINITY; }
            }
            float mx = fmaxf(s0[0], s1[0]);
#pragma unroll
            for (int i = 1; i < 16; ++i) mx = fmaxf(mx, fmaxf(s0[i], s1[i]));
            mx = fmaxf(mx, __shfl_xor(mx, 32));
            const float m_new = fmaxf(m_run, mx); const float m_use = (m_new == -INFINITY) ? 0.f : m_new;
            const float alpha = fast_exp2(m_run - m_use);
            m_run = m_new;
            float rs = 0.f;
#pragma unroll
            for (int i = 0; i < 16; ++i) { s0[i] = fast_exp2(s0[i] - m_use); s1[i] = fast_exp2(s1[i] - m_use); rs += s0[i] + s1[i]; }
            l_run = l_run * alpha + rs;
#pragma unroll
            for (int i = 0; i < 16; ++i) { o0[i] *= alpha; o1[i] *= alpha; }
            u32x4 w0, w1, w2, w3;
            w0.x = cvt_pk_bf16(s0[0], s0[1]); w0.y = cvt_pk_bf16(s0[2], s0[3]); w0.z = cvt_pk_bf16(s0[4], s0[5]); w0.w = cvt_pk_bf16(s0[6], s0[7]);
            w1.x = cvt_pk_bf16(s0[8], s0[9]); w1.y = cvt_pk_bf16(s0[10], s0[11]); w1.z = cvt_pk_bf16(s0[12], s0[13]); w1.w = cvt_pk_bf16(s0[14], s0[15]);
            w2.x = cvt_pk_bf16(s1[0], s1[1]); w2.y = cvt_pk_bf16(s1[2], s1[3]); w2.z = cvt_pk_bf16(s1[4], s1[5]); w2.w = cvt_pk_bf16(s1[6], s1[7]);
            w3.x = cvt_pk_bf16(s1[8], s1[9]); w3.y = cvt_pk_bf16(s1[10], s1[11]); w3.z = cvt_pk_bf16(s1[12], s1[13]); w3.w = cvt_pk_bf16(s1[14], s1[15]);
            const bf16x8 pa0 = __builtin_bit_cast(bf16x8, w0), pa1 = __builtin_bit_cast(bf16x8, w1), pa2 = __builtin_bit_cast(bf16x8, w2), pa3 = __builtin_bit_cast(bf16x8, w3);
#define FA_PV(o, dt) do { const LAS unsigned char* vrow_ = Vt + (32 * (dt) + r32) * VP + hi * 16; \
                o = __builtin_amdgcn_mfma_f32_32x32x16_bf16(*(const LAS bf16x8*)(vrow_), pa0, o, 0, 0, 0); o = __builtin_amdgcn_mfma_f32_32x32x16_bf16(*(const LAS bf16x8*)(vrow_ + 32), pa1, o, 0, 0, 0); \
                o = __builtin_amdgcn_mfma_f32_32x32x16_bf16(*(const LAS bf16x8*)(vrow_ + 64), pa2, o, 0, 0, 0); o = __builtin_amdgcn_mfma_f32_32x32x16_bf16(*(const LAS bf16x8*)(vrow_ + 96), pa3, o, 0, 0, 0); } while (0)
            FA_PV(o0, 0); FA_PV(o1, 1);
#undef FA_PV
        }
        if (t + 1 < tile_hi) FA_STORE(buf ^ 1);
        __syncthreads();
    }
#undef FA_LOAD
#undef FA_STORE
    const float l_tot = l_run + __shfl_xor(l_run, 32); const float inv = 1.0f / l_tot;
    bf16_t* orow = Ow + (size_t)r32 * opitch + 4 * hi;
#pragma unroll
    for (int g = 0; g < 4; ++g) {
        u32x2 a; a.x = cvt_pk_bf16(o0[4 * g] * inv, o0[4 * g + 1] * inv); a.y = cvt_pk_bf16(o0[4 * g + 2] * inv, o0[4 * g + 3] * inv); *(u32x2*)(orow + 8 * g) = a;
        u32x2 b; b.x = cvt_pk_bf16(o1[4 * g] * inv, o1[4 * g + 1] * inv); b.y = cvt_pk_bf16(o1[4 * g + 2] * inv, o1[4 * g + 3] * inv); *(u32x2*)(orow + 32 + 8 * g) = b;
    }
}

struct IdxArgs { const bf16_t* IQ; const bf16_t* IK; const float* IW; unsigned short* SEL; int* SELN; };
__device__ __forceinline__ unsigned mono_key(float f) { const unsigned u = __float_as_uint(f); return u ^ ((unsigned)((int)u >> 31) | 0x80000000u); }
__device__ __forceinline__ int crow32(int i, int hi) { return (i & 3) + 8 * (i >> 2) + 4 * hi; }

constexpr int IDX_QP = 528;
__device__ __forceinline__ void idx_scores(f32x16& sc, const LAS unsigned char* qrow  , const float (&w)[8], const bf16_t* ikt  , int r32, int hi) {
    const bf16x8 ka0 = *(const bf16x8*)(ikt + r32 * 32 + hi * 8), ka1 = *(const bf16x8*)(ikt + r32 * 32 + 16 + hi * 8);
    f32x16 zc, zn, zero;
#pragma unroll
    for (int i = 0; i < 16; ++i) { sc[i] = 0.f; zero[i] = 0.f; }
    zc = __builtin_amdgcn_mfma_f32_32x32x16_bf16(ka0, *(const LAS bf16x8*)(qrow), zero, 0, 0, 0);
    zc = __builtin_amdgcn_mfma_f32_32x32x16_bf16(ka1, *(const LAS bf16x8*)(qrow + 32), zc, 0, 0, 0);
#pragma unroll
    for (int h = 0; h < 8; ++h) {
        if (h < 7) { zn = __builtin_amdgcn_mfma_f32_32x32x16_bf16(ka0, *(const LAS bf16x8*)(qrow + (h + 1) * 64), zero, 0, 0, 0); zn = __builtin_amdgcn_mfma_f32_32x32x16_bf16(ka1, *(const LAS bf16x8*)(qrow + (h + 1) * 64 + 32), zn, 0, 0, 0); }
#pragma unroll
        for (int i = 0; i < 16; ++i) sc[i] += fmaxf(zc[i], 0.f) * w[h];
        __builtin_amdgcn_sched_barrier(0);
        if (h < 7) zc = zn;
    }
}
template <int WPL>
__device__ __forceinline__ bool hist_scan(const LAS unsigned* hw, int lane, unsigned need, int& bin, unsigned& above, unsigned& nb) {
    unsigned w[WPL]; unsigned tot = 0;
#pragma unroll
    for (int i = 0; i < WPL; i += 4) { const u32x4 v = *(const LAS u32x4*)(hw + WPL * lane + i); w[i] = v.x; w[i + 1] = v.y; w[i + 2] = v.z; w[i + 3] = v.w; }
#pragma unroll
    for (int i = 0; i < WPL; ++i) tot += (w[i] & 0xffffu) + (w[i] >> 16);
    unsigned suf = tot;
#pragma unroll
    for (int d = 1; d < 64; d <<= 1) { const unsigned t = __shfl_down(suf, d); if (lane + d < 64) suf += t; }
    const unsigned total = __shfl(suf, 0);
    if (total < need) return false;
    const unsigned ab = suf - tot;
    const bool mine = (ab < need) && (need <= suf);
    int b_ = 0; unsigned a_ = 0, n_ = 0;
    if (mine) { unsigned acc = ab; bool done = false;
#pragma unroll
        for (int i = WPL - 1; i >= 0; --i) {
            const unsigned chi = w[i] >> 16, clo = w[i] & 0xffffu;
            if (!done && acc + chi >= need) { done = true; b_ = 2 * (WPL * lane + i) + 1; a_ = acc; n_ = chi; } if (!done) acc += chi;
            if (!done && acc + clo >= need) { done = true; b_ = 2 * (WPL * lane + i); a_ = acc; n_ = clo; } if (!done) acc += clo; } }
    const unsigned long long bal = __ballot(mine); const int src = __ffsll((long long)bal) - 1;
    bin = __shfl(b_, src); above = __shfl(a_, src); nb = __shfl(n_, src);
    return true;
}
__device__ __forceinline__ void idx_unit(LAS unsigned char* lds, int wave_, const IdxArgs& a, int rowb  , int qb32) {
    int tid = wave_ * 64 + lane_id(); asm volatile("" : "+v"(tid));
    const int lane = tid & 63, wid = wave_, r32 = lane & 31, hi = lane >> 5;
    const int q0 = 32 * qb32, ntile = qb32 + 1, qpos = q0 + r32;
    LAS unsigned* hist = (LAS unsigned*)(lds + IDX_HIST);
    LAS unsigned* bitmap = (LAS unsigned*)(lds + IDX_BITMAP);
    LAS unsigned* candk = (LAS unsigned*)(lds + IDX_CANDK);
    LAS unsigned short* candi = (LAS unsigned short*)(lds + IDX_CANDI);
    LAS unsigned* subh = (LAS unsigned*)(lds + IDX_SUBH) + wid * 512;
    LAS unsigned* qpar = (LAS unsigned*)(lds + IDX_QPAR);
    LAS unsigned* ccnt = (LAS unsigned*)(lds + IDX_CCNT);
    LAS unsigned* flag = (LAS unsigned*)(lds + IDX_FLAG);
    if (q0 + 32 <= 256) {
        __syncthreads();
        for (int q = wid; q < 32; q += NWAVES) { const int t = q0 + q; unsigned short* sp = a.SEL + (size_t)(rowb + t) * 256;
#pragma unroll
            for (int j = 0; j < 4; ++j) { const int k = lane + 64 * j; sp[k] = (unsigned short)(k <= t ? k : 0); }
            if (lane == 0) a.SELN[rowb + t] = t + 1; }
        return;
    }
    float w[8];
#pragma unroll
    for (int h = 0; h < 8; ++h) w[h] = a.IW[(size_t)(rowb + qpos) * 8 + h];
    const LAS unsigned char* qrow = lds + IDX_QT + r32 * IDX_QP + hi * 16;
    const bf16_t* ikb = a.IK + (size_t)rowb * 32;
    __syncthreads();
#pragma unroll
    for (int i = 0; i < 2; ++i) { const int c = tid + 512 * i, row = c >> 5, c16 = c & 31;
        *(LAS u32x4*)(lds + IDX_QT + row * IDX_QP + c16 * 16) = *(const u32x4*)(a.IQ + (size_t)(rowb + q0 + row) * 256 + c16 * 8); }
    if (tid < 128) qpar[tid] = ((tid & 3) == 2) ? 256u : 0u;
    if (tid < 32) ccnt[tid] = 0u;
#pragma unroll 1
    for (int p = 0; p < 3; ++p) {
        for (int i = tid; i < 32 * 1024 / 4; i += NWAVES * 64) ((LAS u32x4*)hist)[i] = (u32x4){0u, 0u, 0u, 0u};
        if (tid == 0) flag[0] = 0u;
        __syncthreads();
        const unsigned st = qpar[4 * r32], pfx = qpar[4 * r32 + 1];
        const int cshift = (p == 0) ? 0 : (p == 1 ? 21 : 10), bshift = (p == 0) ? 21 : (p == 1 ? 10 : 0); const unsigned bmask = (p == 2) ? 1023u : 2047u;
        if (__any(st == 0u)) {
            for (int tile = wid; tile < ntile; tile += NWAVES) {
                f32x16 sc; idx_scores(sc, qrow, w, ikb + (size_t)tile * 32 * 32, r32, hi);
#pragma unroll
                for (int i = 0; i < 16; ++i) { const int key = 32 * tile + crow32(i, hi); const unsigned k = mono_key(sc[i]);
                    const bool ok = (st == 0u) && (key <= qpos) && (p == 0 || (k >> cshift) == pfx);
                    if (ok) { const unsigned bin = (k >> bshift) & bmask; lds_add(hist + r32 * 1024 + (bin >> 1), 1u << (16 * (bin & 1u))); } }
            }
        }
        __syncthreads();
        for (int j = 0; j < 4; ++j) { const int q = 4 * wid + j; const unsigned qs = qpar[4 * q], need = qpar[4 * q + 2], qp = qpar[4 * q + 1];
            if (qs != 0u) continue;
            int bin; unsigned above, nb; const bool found = hist_scan<16>(hist + q * 1024, lane, need, bin, above, nb);
            if (lane == 0) {
                if (!found) { qpar[4 * q] = 2u; qpar[4 * q + 2] = 0u; }
                else { const unsigned np = (p == 0) ? (unsigned)bin : ((qp << (p == 1 ? 11 : 10)) | (unsigned)bin);
                    qpar[4 * q + 1] = np; qpar[4 * q + 2] = need - above; qpar[4 * q + 3] = (unsigned)bshift;
                    if (nb <= (unsigned)IDX_CCAP || p == 2) qpar[4 * q] = 1u; else flag[0] = 1u; } }
        }
        __syncthreads();
        const unsigned more = flag[0];
        __syncthreads();
        if (more == 0u) break;
    }
    __syncthreads();
    for (int i = tid; i < 32 * 256 / 4; i += NWAVES * 64) ((LAS u32x4*)bitmap)[i] = (u32x4){0u, 0u, 0u, 0u};
    __syncthreads();
    { const unsigned st = qpar[4 * r32], pfx = qpar[4 * r32 + 1], sh = qpar[4 * r32 + 3];
      for (int tile = wid; tile < ntile; tile += NWAVES) {
          f32x16 sc; idx_scores(sc, qrow, w, ikb + (size_t)tile * 32 * 32, r32, hi);
#pragma unroll
          for (int i = 0; i < 16; ++i) { const int key = 32 * tile + crow32(i, hi); const unsigned k = mono_key(sc[i]);
              if (key <= qpos) { const unsigned top = k >> sh;
                  if (st == 2u || top > pfx) lds_or(bitmap + r32 * 256 + (key >> 5), 1u << (key & 31));
                  else if (top == pfx) { const unsigned pos = lds_add(ccnt + r32, 1u); if (pos < (unsigned)IDX_CCAP) { candk[r32 * IDX_CCAP + pos] = k; candi[r32 * IDX_CCAP + pos] = (unsigned short)key; } } } }
      } }
    __syncthreads();
    for (int j = 0; j < 4; ++j) {
        const int q = 4 * wid + j; const unsigned st = qpar[4 * q]; unsigned need = qpar[4 * q + 2]; const unsigned sh = qpar[4 * q + 3];
        const int nc = (st == 1u) ? (int)min(ccnt[q], (unsigned)IDX_CCAP) : 0;
        LAS unsigned* bm = bitmap + q * 256; const LAS unsigned* ck = candk + q * IDX_CCAP; const LAS unsigned short* ci = candi + q * IDX_CCAP;
        if (nc > 0) {
            if ((unsigned)nc <= need) { for (int c = lane; c < nc; c += 64) { const unsigned key = ci[c]; lds_or(bm + (key >> 5), 1u << (key & 31)); } }
            else {
                int nR = 0; LAS unsigned long long* R = (LAS unsigned long long*)subh;
                if (sh >= 10u) {
                    const int fs = (int)sh - 10;
#pragma unroll
                    for (int i = 0; i < 8; ++i) subh[8 * lane + i] = 0u;
                    LDS_WAIT();
                    for (int c = lane; c < nc; c += 64) { const unsigned sub = (ck[c] >> fs) & 1023u; lds_add(subh + (sub >> 1), 1u << (16 * (sub & 1u))); }
                    LDS_WAIT();
                    int b2; unsigned ab2, nb2; (void)hist_scan<8>(subh, lane, need, b2, ab2, nb2);
                    need -= ab2; LDS_WAIT();
                    for (int c0 = 0; c0 < nc; c0 += 64) { const int c = c0 + lane; bool inb = false; unsigned k = 0, key = 0;
                        if (c < nc) { k = ck[c]; key = ci[c]; const int sub = (int)((k >> fs) & 1023u); if (sub > b2) lds_or(bm + (key >> 5), 1u << (key & 31)); inb = (sub == b2); }
                        const unsigned long long bal = __ballot(inb); const int pos = nR + __popcll(bal & ((1ull << lane) - 1ull));
                        if (inb && pos < IDX_RCAP) R[pos] = ((unsigned long long)k << 13) | (unsigned long long)(8191u - key);
                        nR += __popcll(bal); }
                } else {
                    for (int c0 = 0; c0 < nc; c0 += 64) { const int c = c0 + lane; if (c < nc && c < IDX_RCAP) R[c] = ((unsigned long long)ck[c] << 13) | (unsigned long long)(8191u - ci[c]); }
                    nR = nc;
                }
                nR = min(nR, IDX_RCAP); LDS_WAIT();
                for (int r = lane; r < nR; r += 64) { const unsigned long long me = R[r]; unsigned better = 0;
                    for (int x = 0; x < nR; ++x) better += (R[x] > me) ? 1u : 0u;
                    if (better < need) { const unsigned key = 8191u - (unsigned)(me & 8191ull); lds_or(bm + (key >> 5), 1u << (key & 31)); } }
            }
        }
        LDS_WAIT();
        { const u32x4 bw = *(const LAS u32x4*)(bm + 4 * lane); unsigned wv[4] = {bw.x, bw.y, bw.z, bw.w};
          const int mycnt = __popc(wv[0]) + __popc(wv[1]) + __popc(wv[2]) + __popc(wv[3]);
          int pre = mycnt;
#pragma unroll
          for (int d = 1; d < 64; d <<= 1) { const int t = __shfl_up(pre, d); if (lane >= d) pre += t; }
          const int total = __shfl(pre, 63); int pos = pre - mycnt;
          unsigned short* sp = a.SEL + (size_t)(rowb + q0 + q) * 256;
#pragma unroll
          for (int wi = 0; wi < 4; ++wi) { unsigned m = wv[wi]; while (m) { const int b = __ffs((int)m) - 1; m &= m - 1u; if (pos < 256) sp[pos] = (unsigned short)(32 * (4 * lane + wi) + b); ++pos; } }
          if (lane == 0) a.SELN[rowb + q0 + q] = min(total, 256); }
        LDS_WAIT();
    }
}

struct SpaArgs { const bf16_t* QA; const bf16_t* KA; const bf16_t* VA; const unsigned short* SEL; const int* SELN; bf16_t* Y; };
__device__ __forceinline__ void sparse_query(LAS unsigned char* wl  , const SpaArgs& a, int rowb, int t, int lane) {
    asm volatile("" : "+v"(lane));
    LAS float* lg = (LAS float*)wl;
    LAS unsigned short* sl = (LAS unsigned short*)(wl + 4096);
    const int row = rowb + t; const int nv = a.SELN[row];
    { const u32x2 s4 = *(const u32x2*)(a.SEL + (size_t)row * 256 + 4 * lane); *(LAS u32x2*)(sl + 4 * lane) = s4; }
    LDS_WAIT();
    const int m16 = lane & 15, kq = lane >> 4;
    bf16x8 qf0 = (bf16x8){0, 0, 0, 0, 0, 0, 0, 0}, qf1 = qf0;
    if (m16 < 4) { const bf16_t* qp = a.QA + (size_t)row * 256 + m16 * 64 + kq * 8; qf0 = *(const bf16x8*)qp; qf1 = *(const bf16x8*)(qp + 32); }
#pragma unroll 4
    for (int tile = 0; tile < 16; ++tile) {
        const int j = 16 * tile + m16; const int s = (j < nv) ? (int)sl[j] : 0;
        const bf16_t* kp = a.KA + (size_t)(rowb + s) * 64 + kq * 8;
        const bf16x8 k0 = *(const bf16x8*)kp, k1 = *(const bf16x8*)(kp + 32);
        f32x4 acc = (f32x4){0.f, 0.f, 0.f, 0.f};
        acc = __builtin_amdgcn_mfma_f32_16x16x32_bf16(qf0, k0, acc, 0, 0, 0);
        acc = __builtin_amdgcn_mfma_f32_16x16x32_bf16(qf1, k1, acc, 0, 0, 0);
        if (kq == 0) { const bool ok = j < nv; f32x4 v; v.x = ok ? acc.x : -INFINITY; v.y = ok ? acc.y : -INFINITY; v.z = ok ? acc.z : -INFINITY; v.w = ok ? acc.w : -INFINITY; *(LAS f32x4*)(lg + 4 * j) = v; }
    }
    LDS_WAIT();
    const int h = lane >> 4; float pv[16]; float mx = -INFINITY;
#pragma unroll
    for (int i = 0; i < 16; ++i) { pv[i] = lg[4 * (m16 + 16 * i) + h]; mx = fmaxf(mx, pv[i]); }
#pragma unroll
    for (int o = 1; o < 16; o <<= 1) mx = fmaxf(mx, __shfl_xor(mx, o));
    float sm = 0.f;
#pragma unroll
    for (int i = 0; i < 16; ++i) { pv[i] = fast_exp2(pv[i] - mx); sm += pv[i]; }
    sm = sum16(sm);
    LDS_WAIT();
#pragma unroll
    for (int i = 0; i < 16; ++i) lg[4 * (m16 + 16 * i) + h] = pv[i];
    LDS_WAIT();
    const float l0 = __shfl(sm, 0), l1 = __shfl(sm, 16), l2 = __shfl(sm, 32), l3 = __shfl(sm, 48);
    float a0 = 0.f, a1 = 0.f, a2 = 0.f, a3 = 0.f;
    const bf16_t* vb = a.VA + (size_t)rowb * 64 + lane;
    int j = 0;
    for (; j + 8 <= nv; j += 8) {
        float vv[8];
#pragma unroll
        for (int u = 0; u < 8; ++u) vv[u] = bf2f(vb[(size_t)sl[j + u] * 64]);
#pragma unroll
        for (int u = 0; u < 8; ++u) { const f32x4 p = *(const LAS f32x4*)(lg + 4 * (j + u)); a0 += p.x * vv[u]; a1 += p.y * vv[u]; a2 += p.z * vv[u]; a3 += p.w * vv[u]; }
    }
    for (; j < nv; ++j) { const float v = bf2f(vb[(size_t)sl[j] * 64]); const f32x4 p = *(const LAS f32x4*)(lg + 4 * j); a0 += p.x * v; a1 += p.y * v; a2 += p.z * v; a3 += p.w * v; }
    bf16_t* yo = a.Y + (size_t)row * DM + lane;
    yo[0] = (bf16_t)f2bf(a0 / l0); yo[64] = (bf16_t)f2bf(a1 / l1); yo[128] = (bf16_t)f2bf(a2 / l2); yo[192] = (bf16_t)f2bf(a3 / l3);
    LDS_WAIT();
}

#ifndef MK_PER_PHASE
#define MK_PER_PHASE 0
#endif
struct Args { const void* in[29]; float* out; unsigned char* ws; int ph_lo, ph_hi, pad0, pad1; };
enum { I_X = 0, I_POS, I_ANG, I_WIN, I_AQG, I_AKG, I_BCQG, I_BCKVG, I_WUQ, I_WUKV, I_BQNG, I_BQRG, I_BKNG, I_BKRG, I_CQG, I_CKG, I_SINK, I_WAO, I_WBO, I_WCO, I_WO, I_FNG, I_FW1, I_FW3, I_FW2, I_RW, I_MW1, I_MW3, I_MW2 };

__device__ __forceinline__ int q_next(unsigned* head, volatile LAS unsigned* bc, int wave_) {
    __syncthreads();
    if (wave_ == 0 && lane_id() == 0) bc[0] = __hip_atomic_fetch_add(head, 1u, __ATOMIC_RELAXED, __HIP_MEMORY_SCOPE_AGENT);
    __syncthreads();
    return (int)bc[0];
}

typedef __attribute__((address_space(4))) const unsigned char* kptr_t;
#define PHASE_ENV() kptr_t kp_ = (kptr_t)__builtin_amdgcn_kernarg_segment_ptr(); asm volatile("; MKPHASE %1" : "+s"(kp_) : "n"(__LINE__)); \
    unsigned char* const ws = *(unsigned char* const __attribute__((address_space(4)))*)(kp_ + 240); float* const out = *(float* const __attribute__((address_space(4)))*)(kp_ + 232); \
    unsigned char* const act = ws + WS_ACT; bf16_t* const HB = (bf16_t*)(ws + WS_HB); unsigned* const ctl = (unsigned*)(ws + WS_CTL); \
    const size_t row0 = (size_t)ch * TCH; const unsigned char* const lw = ws + WS_LAYERW + (size_t)l * SZ_LAYERW; \
    int gwl = gw, ngwl = ngw; asm volatile("" : "+s"(gwl), "+s"(ngwl)); \
    (void)out; (void)act; (void)HB; (void)ctl; (void)row0; (void)lw; (void)gwl; (void)ngwl
#define INP(k) (*(const void* const __attribute__((address_space(4)))*)(kp_ + 8 * (k)))
#define FIN(k) ((const float*)INP(k))
#define ROPE_TAB(RT) RopeTab RT; RT.c64 = (const float*)(ws + WS_ROPE); RT.s64 = RT.c64 + (size_t)NPOS * 32; RT.c32 = RT.s64 + (size_t)NPOS * 32; RT.s32 = RT.c32 + (size_t)NPOS * 16
#define ABUF(T, off) ((T*)(act + (off)))

#ifndef MK_NV
#define MK_NV 256
#endif
#ifndef MK_LB
#define MK_LB 2
#endif
__global__ void __launch_bounds__(NWAVES * 64, MK_LB) mk_fwd(Args args) {
    extern __shared__ __attribute__((aligned(16))) unsigned char lds_raw[];
    LAS unsigned char* lds = (LAS unsigned char*)lds_raw;
    volatile LAS unsigned* MISC = (volatile LAS unsigned*)(lds + MISC_OFF);
    const int wave = __builtin_amdgcn_readfirstlane((int)threadIdx.x >> 6);
#define tid (wave * 64 + lane_id())
    const int G = gridDim.x; const int bx = blockIdx.x; const int vcu = (G % 8 == 0) ? (bx % 8) * (G / 8) + bx / 8 : bx;
    const int gw = vcu * NWAVES + wave, ngw = G * NWAVES;
    for (int u = tid; u < 64; u += NWAVES * 64) MISC[u] = 0u;
    __syncthreads();
    XcdBarrier bar; bar.bar = (unsigned*)(args.ws + WS_CTL) + CW_BAR; bar.x = 0; bar.st = nullptr;
    if (!MK_PER_PHASE) bar = xcd_barrier_post((unsigned*)(args.ws + WS_CTL) + CW_BAR, MISC + 8, wave);
    int pid = 0;
#ifndef MK_ATT
#define MK_ATT 7
#endif
#ifndef MK_EN
#define MK_EN 0xffffffffu
#endif
#define EN(k) (((MK_EN) >> (k)) & 1u)
#define RUN() (args.ph_lo <= pid && pid < args.ph_hi)
#define SEAM() do { if (args.ph_lo <= pid && pid + 1 < args.ph_hi) xcd_barrier(bar, wave); ++pid; } while (0)

    if (EN(0) && RUN()) {
        const int l = 0, ch = 0; PHASE_ENV();
        int lane = tid & 63; asm volatile("" : "+v"(lane)); int tid0 = tid; asm volatile("" : "+v"(tid0));
        LAS float* scr = (LAS float*)(lds + wave * 16384);
        constexpr int IT_WIN = (DM / 64) * ((DIN + 31) / 32), IT_WUQ = (256 / 64) * (384 / 32), IT_WUKV = (128 / 64) * (512 / 32), IT_WAO = (256 / 64) * (DM / 32), IT_WCO = (512 / 64) * (DM / 32), IT_WO = (DM / 64) * (DM / 32);
        constexpr int IT_LAYER = IT_WIN + IT_WUQ + IT_WUKV + 2 * IT_WAO + IT_WCO + IT_WO;
        constexpr int IT_F1 = (DM / 64) * (DFF / 32), IT_F2 = (DFF / 64) * (DM / 32), IT_E1 = (DM / 64) * (EFF / 32), IT_E2 = (EFF / 64) * (DM / 32);
        constexpr int IT_FFN = 2 * IT_F1 + IT_F2, IT_EXP = 2 * IT_E1 + IT_E2;
        constexpr int NITEMS = 2 * IT_LAYER + IT_FFN + NEXP * IT_EXP;
        for (int it = gwl; it < NITEMS; it += ngwl) {
            int r = it;
            if (r < 2 * IT_LAYER) {
                const int ll = r / IT_LAYER; r -= ll * IT_LAYER; unsigned char* lwp = ws + WS_LAYERW + (size_t)ll * SZ_LAYERW;
                if (r < IT_WIN) { transpose_item<1>(FIN(I_WIN) + (size_t)ll * DM * DIN, DM, DIN, (bf16_t*)(lwp + OFF_WIN), DM, scr, r, lane); continue; } r -= IT_WIN;
                if (r < IT_WUQ) { transpose_item<0>(FIN(I_WUQ) + (size_t)ll * 256 * 384, 256, 384, (bf16_t*)(lwp + OFF_WUQ), 256, scr, r, lane); continue; } r -= IT_WUQ;
                if (r < IT_WUKV) { transpose_item<0>(FIN(I_WUKV) + (size_t)ll * 128 * 512, 128, 512, (bf16_t*)(lwp + OFF_WUKV), 256, scr, r, lane); continue; } r -= IT_WUKV;
                if (r < IT_WAO) { transpose_item<0>(FIN(I_WAO) + (size_t)ll * 256 * DM, 256, DM, (bf16_t*)(lwp + OFF_WAO), 256, scr, r, lane); continue; } r -= IT_WAO;
                if (r < IT_WAO) { transpose_item<0>(FIN(I_WBO) + (size_t)ll * 256 * DM, 256, DM, (bf16_t*)(lwp + OFF_WBO), 256, scr, r, lane); continue; } r -= IT_WAO;
                if (r < IT_WCO) { transpose_item<0>(FIN(I_WCO) + (size_t)ll * 512 * DM, 512, DM, (bf16_t*)(lwp + OFF_WCO), 512, scr, r, lane); continue; } r -= IT_WCO;
                transpose_item<0>(FIN(I_WO) + (size_t)ll * DM * DM, DM, DM, (bf16_t*)(lwp + OFF_WO), DM, scr, r, lane); continue;
            }
            r -= 2 * IT_LAYER;
            if (r < IT_FFN) {
                if (r < IT_F1) { transpose_item<2>(FIN(I_FW1), DM, DFF, (bf16_t*)(ws + WS_W13), DM, scr, r, lane); continue; } r -= IT_F1;
                if (r < IT_F1) { transpose_item<3>(FIN(I_FW3), DM, DFF, (bf16_t*)(ws + WS_W13), DM, scr, r, lane); continue; } r -= IT_F1;
                transpose_item<0>(FIN(I_FW2), DFF, DM, (bf16_t*)(ws + WS_W2), DFF, scr, r, lane); continue;
            }
            r -= IT_FFN;
            { const int e = r / IT_EXP; r -= e * IT_EXP;
              if (r < IT_E1) { transpose_item<2>(FIN(I_MW1) + (size_t)e * DM * EFF, DM, EFF, (bf16_t*)(ws + WS_E13 + (size_t)e * SZ_E13), DM, scr, r, lane); continue; } r -= IT_E1;
              if (r < IT_E1) { transpose_item<3>(FIN(I_MW3) + (size_t)e * DM * EFF, DM, EFF, (bf16_t*)(ws + WS_E13 + (size_t)e * SZ_E13), DM, scr, r, lane); continue; } r -= IT_E1;
              transpose_item<0>(FIN(I_MW2) + (size_t)e * EFF * DM, EFF, DM, (bf16_t*)(ws + WS_E2 + (size_t)e * SZ_E2), EFF, scr, r, lane); }
        }
        const int gt = vcu * NWAVES * 64 + tid0, ngt = G * NWAVES * 64;
        for (int ll = 0; ll < DEPTH; ++ll) { unsigned char* lwp = ws + WS_LAYERW + (size_t)ll * SZ_LAYERW;
            for (int i = gt; i < (P1W - C_G) * DM / 8; i += ngt) ((u32x4*)(lwp + OFF_WIN + (size_t)C_G * DM * 2))[i] = (u32x4){0u, 0u, 0u, 0u};
            for (int i = gt; i < 128 * 256 / 8; i += ngt) ((u32x4*)(lwp + OFF_WUQ + (size_t)384 * 256 * 2))[i] = (u32x4){0u, 0u, 0u, 0u};
            for (int i = gt; i < 512 * 128 / 8; i += ngt) { const int rr = i / 16, cc = i % 16; ((u32x4*)(lwp + OFF_WUKV + (size_t)rr * 512 + 256))[cc] = (u32x4){0u, 0u, 0u, 0u}; } }
        for (int i = gt; i < DM / 8; i += ngt) ((u32x4*)(HB + (size_t)TCH * DM))[i] = (u32x4){0u, 0u, 0u, 0u};
        float* c64 = (float*)(ws + WS_ROPE); float* s64 = c64 + (size_t)NPOS * 32; float* c32 = s64 + (size_t)NPOS * 32; float* s32 = c32 + (size_t)NPOS * 16;
        for (int i = gt; i < NPOS * 32; i += ngt) { const int pos = i >> 5, k = i & 31; const float inv = (float)pow(10000.0, -(double)k / 32.0); const float ang = (float)pos * inv; c64[i] = cosf(ang); s64[i] = sinf(ang); }
        for (int i = gt; i < NPOS * 16; i += ngt) { const int pos = i >> 4, k = i & 15; const float inv = (float)pow(10000.0, -(double)k / 16.0); const float ang = (float)pos * inv; c32[i] = cosf(ang); s32[i] = sinf(ang); }
    }
    SEAM();

#pragma unroll 1
    for (int l = 0; l < DEPTH; ++l) {
#pragma unroll 1
        for (int ch = 0; ch < NCHUNK; ++ch) {
            if (EN(1) && RUN()) { PHASE_ENV(); norm_rows((l == 0 ? FIN(I_X) : (const float*)out) + row0 * DM, FIN(I_ANG) + l * DM, HB, gwl, ngwl, tid & 63); }
            SEAM();
            if (EN(2) && RUN()) { PHASE_ENV(); pg8::Gemm g{HB, DM, HB, 1 << 30, (const bf16_t*)(lw + OFF_WIN), DM, nullptr, 0}; pg8::StaticOrder S; S.init(TCH / 256, NINP / 256, G, bx);
                pg8::EpiInProj E{ABUF(bf16_t, A_P1), ABUF(bf16_t, A_G)}; pg8::gemm_phase<pg8::EpiInProj, pg8::StaticOrder>(lds + RING_OFF, wave, g, S, E); }
            SEAM();
            if (EN(3) && RUN()) { PHASE_ENV(); ROPE_TAB(RT); PP1Args a; a.P1 = ABUF(bf16_t, A_P1); a.pos = (const int*)INP(I_POS) + row0; a.aq_g = FIN(I_AQG) + l * 64; a.ak_g = FIN(I_AKG) + l * 64; a.cq_g = FIN(I_BCQG) + l * 256;
                a.ckv_g = FIN(I_BCKVG) + l * 128; a.kr_g = FIN(I_BKRG) + l * 32; a.qc_g = FIN(I_CQG) + l * 64; a.kc_g = FIN(I_CKG) + l * 64;
                a.act = act; a.R = RT;
                pp1_rows(a, gwl, ngwl, tid & 63); }
            SEAM();
            if (EN(4) && RUN()) { PHASE_ENV(); pg8::StaticOrder S; S.init(TCH / 256, 4, G, bx);
                pg8::Gemm g{ABUF(bf16_t, A_CQN), 256, ABUF(bf16_t, A_CKVN), 2, (const bf16_t*)(lw + OFF_WUQ), 256, nullptr, 0}; pg8::EpiBf16 E{ABUF(bf16_t, A_QBR), 1024}; pg8::gemm_phase<pg8::EpiBf16, pg8::StaticOrder>(lds + RING_OFF, wave, g, S, E); }
            SEAM();
            if (EN(5) && RUN()) { PHASE_ENV(); ROPE_TAB(RT); PP2Args a; a.QBR = ABUF(bf16_t, A_QBR); a.KVBR = ABUF(bf16_t, A_QBR) + 512; a.KR = ABUF(bf16_t, A_KR); a.pos = (const int*)INP(I_POS) + row0;
                a.qn_g = FIN(I_BQNG) + l * 64; a.qr_g = FIN(I_BQRG) + l * 32; a.kn_g = FIN(I_BKNG) + l * 64;
                a.QB = ABUF(bf16_t, A_QB); a.KB = ABUF(bf16_t, A_KB); a.VBT = ABUF(bf16_t, A_VBT); a.R = RT; pp2_rows(a, gwl, ngwl, tid & 63); }
            SEAM();
            if (EN(6) && RUN()) {
                PHASE_ENV();
                unsigned* head = ctl + CW_Q + 64 * (2 * (l * NCHUNK + ch));
                bf16_t* const Y = ABUF(bf16_t, A_Y);
                for (;;) {
                    const int u = q_next(head, MISC + 16, wave);
                    if (u >= 512 + 1024 + 1024) break;
                    if (u < 512) { if (!(MK_ATT & 1)) continue;
                        const int qb = 31 - u / 16, bl = (u % 16) / 4, h = u % 4; const int rowb = bl * SEQ; const int q0w = 256 * qb + 32 * wave;
                        fa_unit<96>(lds, wave, ABUF(bf16_t, A_QB) + (size_t)(rowb + q0w) * 384 + h * 96, 384, ABUF(bf16_t, A_KB) + (size_t)rowb * 384 + h * 96, 384, ABUF(bf16_t, A_VBT) + (size_t)(bl * 4 + h) * 64 * SEQ,
                                    0, 4 * qb + 4, q0w, 0, -INFINITY, 0.f, Y + (size_t)(rowb + q0w) * DM + 256 + h * 64, DM);
                    } else if (u < 512 + 1024) { if (!(MK_ATT & 2)) continue;
                        const int v = u - 512; const int qb32 = 255 - v / 4, bl = v % 4;
                        IdxArgs ia{ABUF(bf16_t, A_IQ), ABUF(bf16_t, A_IK), ABUF(float, A_IW), ABUF(unsigned short, A_SEL), ABUF(int, A_SELN)};
                        idx_unit(lds, wave, ia, bl * SEQ, qb32);
                    } else { if (!(MK_ATT & 4)) continue;
                        const int v = u - 1536; const int bl = v / 256, kvh = (v / 128) % 2, qt = v % 128; const int rowb = bl * SEQ;
                        const int hq = kvh * 4 + (wave >> 1), q0w = 64 * qt + 32 * (wave & 1);
                        const float sink = (FIN(I_SINK) + l * 8)[hq];
                        fa_unit<64>(lds, wave, ABUF(bf16_t, A_QC) + (size_t)(rowb + q0w) * 512 + hq * 64, 512, ABUF(bf16_t, A_KC) + (size_t)rowb * 128 + kvh * 64, 128, ABUF(bf16_t, A_VCT) + (size_t)(bl * 2 + kvh) * 64 * SEQ,
                                    qt >= 2 ? qt - 2 : 0, qt + 1, q0w, 128, sink * LOG2E, 1.f, Y + (size_t)(rowb + q0w) * DM + 512 + hq * 64, DM);
                    }
                }
            }
            SEAM();
            if (EN(7) && RUN()) { PHASE_ENV(); SpaArgs sa{ABUF(bf16_t, A_QA), ABUF(bf16_t, A_KA), ABUF(bf16_t, A_VA), ABUF(unsigned short, A_SEL), ABUF(int, A_SELN), ABUF(bf16_t, A_Y)}; LAS unsigned char* wl = lds + wave * 8192;
                for (int tok = gwl; tok < TCH; tok += ngwl) sparse_query(wl, sa, (tok / SEQ) * SEQ, tok % SEQ, tid & 63); }
            SEAM();
            if (EN(8) && RUN()) { PHASE_ENV(); pg8::StaticOrder S; S.init(TCH / 256, DM / 256, G, bx); bf16_t* const Y = ABUF(bf16_t, A_Y); const bf16_t* const GT = ABUF(bf16_t, A_G);
                { pg8::Gemm g{Y, DM, Y, 1 << 30, (const bf16_t*)(lw + OFF_WAO), 256, nullptr, 0}; pg8::EpiMerge<false> E{HB, GT, 0}; pg8::gemm_phase<pg8::EpiMerge<false>, pg8::StaticOrder>(lds + RING_OFF, wave, g, S, E); }
                { pg8::Gemm g{Y + 256, DM, Y + 256, 1 << 30, (const bf16_t*)(lw + OFF_WBO), 256, nullptr, 0}; pg8::EpiMerge<true> E{HB, GT, DM}; pg8::gemm_phase<pg8::EpiMerge<true>, pg8::StaticOrder>(lds + RING_OFF, wave, g, S, E); }
                { pg8::Gemm g{Y + 512, DM, Y + 512, 1 << 30, (const bf16_t*)(lw + OFF_WCO), 512, nullptr, 0}; pg8::EpiMerge<true> E{HB, GT, 2 * DM}; pg8::gemm_phase<pg8::EpiMerge<true>, pg8::StaticOrder>(lds + RING_OFF, wave, g, S, E); } }
            SEAM();
            if (EN(9) && RUN()) { PHASE_ENV(); pg8::Gemm g{HB, DM, HB, 1 << 30, (const bf16_t*)(lw + OFF_WO), DM, nullptr, 0}; pg8::StaticOrder S; S.init(TCH / 256, DM / 256, G, bx);
                pg8::EpiResid E{(l == 0 ? FIN(I_X) : (const float*)out) + row0 * DM, out + row0 * DM}; pg8::gemm_phase<pg8::EpiResid, pg8::StaticOrder>(lds + RING_OFF, wave, g, S, E); }
            SEAM();
            if (l == 0) {
                if (EN(10) && RUN()) { PHASE_ENV(); RouteArgs ra{}; norm2_rows<false>(out + row0 * DM, FIN(I_FNG) + l * DM, HB, ra, (LAS unsigned*)(lds + MISC_OFF + 128), vcu, wave, tid & 63, G); }
                SEAM();
                if (EN(11) && RUN()) { PHASE_ENV(); pg8::Gemm g{HB, DM, HB, 1 << 30, (const bf16_t*)(ws + WS_W13), DM, nullptr, 0}; pg8::StaticOrder S; S.init(TCH / 256, 2 * DFF / 256, G, bx);
                    pg8::EpiSwiglu E{ABUF(bf16_t, F_ACT), DFF}; pg8::gemm_phase<pg8::EpiSwiglu, pg8::StaticOrder>(lds + RING_OFF, wave, g, S, E); }
                SEAM();
                if (EN(12) && RUN()) { PHASE_ENV(); pg8::Gemm g{ABUF(bf16_t, F_ACT), DFF, ABUF(bf16_t, F_ACT), 1 << 30, (const bf16_t*)(ws + WS_W2), DFF, nullptr, 0}; pg8::StaticOrder S; S.init(TCH / 256, DM / 256, G, bx);
                    pg8::EpiResid E{out + row0 * DM, out + row0 * DM}; pg8::gemm_phase<pg8::EpiResid, pg8::StaticOrder>(lds + RING_OFF, wave, g, S, E); }
                SEAM();
            } else {
                if (EN(13) && RUN()) { PHASE_ENV(); RouteArgs ra{FIN(I_RW), ABUF(int, F_TOPE), ABUF(float, F_TOPG), ABUF(int, F_TOPD), ctl + CW_MOE + 64 * ch};
                    norm2_rows<true>(out + row0 * DM, FIN(I_FNG) + l * DM, HB, ra, (LAS unsigned*)(lds + MISC_OFF + 128), vcu, wave, tid & 63, G); }
                SEAM();
                if (EN(14) && RUN()) { PHASE_ENV(); moe_scatter(ctl + CW_MOE + 64 * ch, ABUF(int, F_TOPE), ABUF(int, F_TOPD), HB, ABUF(bf16_t, F_YM), ABUF(int, F_BLKE), gwl, ngwl, tid & 63); }
                SEAM();
                if (EN(15) && RUN()) { PHASE_ENV(); int ps[NEXP + 1]; moe_layout(ctl + CW_MOE + 64 * ch, ps); const int nblk = ps[NEXP] / 256;
                    pg8::Gemm g{ABUF(bf16_t, F_YM), DM, ABUF(bf16_t, F_YM), 1 << 30, (const bf16_t*)(ws + WS_E13), DM, ABUF(int, F_BLKE), (size_t)2 * EFF * DM}; pg8::StaticOrder S; S.init(nblk, 2 * EFF / 256, G, bx);
                    pg8::EpiSwiglu E{ABUF(bf16_t, F_ACT), EFF}; pg8::gemm_phase<pg8::EpiSwiglu, pg8::StaticOrder>(lds + RING_OFF, wave, g, S, E); }
                SEAM();
                if (EN(16) && RUN()) { PHASE_ENV(); int ps[NEXP + 1]; moe_layout(ctl + CW_MOE + 64 * ch, ps); const int nblk = ps[NEXP] / 256;
                    pg8::Gemm g{ABUF(bf16_t, F_ACT), EFF, ABUF(bf16_t, F_ACT), 1 << 30, (const bf16_t*)(ws + WS_E2), EFF, ABUF(int, F_BLKE), (size_t)DM * EFF}; pg8::StaticOrder S; S.init(nblk, DM / 256, G, bx);
                    pg8::EpiBf16 E{ABUF(bf16_t, F_YM), DM}; pg8::gemm_phase<pg8::EpiBf16, pg8::StaticOrder>(lds + RING_OFF, wave, g, S, E); }
                SEAM();
                if (EN(17) && RUN()) { PHASE_ENV(); moe_combine(out + row0 * DM, ABUF(bf16_t, F_YM), ABUF(int, F_TOPD), ABUF(float, F_TOPG), gwl, ngwl, tid & 63); }
                SEAM();
            }
        }
    }
#undef RUN
#undef SEAM
#undef tid
}
constexpr int N_PHASES = 1 + NCHUNK * (9 + 3) + NCHUNK * (9 + 5);

extern "C" void kernel_launch(void* const* d_in, const int* in_sizes, int n_in, void* d_out, int out_size, void* d_ws, size_t ws_size, hipStream_t stream) {
    static int grid = 0;
    if (grid == 0) {
        if (n_in != 29 || in_sizes[0] != NTOK * DM || out_size != NTOK * DM || ws_size < WS_END) {
            fprintf(stderr, "kernel_launch: built for 29 inputs, x/out of %d floats, >= %zu bytes of workspace; got n_in %d, in0 %d, out %d, ws %zu; nothing launched\n", NTOK * DM, (size_t)WS_END, n_in, n_in > 0 ? in_sizes[0] : -1, out_size, ws_size); grid = -1; return; }
        int dev = 0, cus = 0, per_cu = 0;
        if (hipGetDevice(&dev) != hipSuccess || hipDeviceGetAttribute(&cus, hipDeviceAttributeMultiprocessorCount, dev) != hipSuccess) { fprintf(stderr, "kernel_launch: device query failed\n"); grid = -1; return; }
        if (hipFuncSetAttribute((const void*)mk_fwd, hipFuncAttributeMaxDynamicSharedMemorySize, LDS_BYTES) != hipSuccess) { fprintf(stderr, "kernel_launch: hipFuncSetAttribute failed\n"); grid = -1; return; }
        if (hipOccupancyMaxActiveBlocksPerMultiprocessor(&per_cu, (const void*)mk_fwd, NWAVES * 64, LDS_BYTES) != hipSuccess || per_cu < 1)
            fprintf(stderr, "kernel_launch: note: occupancy query reports %d workgroups per CU\n", per_cu);
        (void)hipGetLastError();
        grid = cus;
        if (grid != 256) fprintf(stderr, "kernel_launch: note: %d CUs (built and tuned for 256)\n", grid);
    }
    if (grid < 0) return;
    if (hipMemsetAsync((char*)d_ws + WS_CTL, 0, CTL_ZERO_BYTES, stream) != hipSuccess) { fprintf(stderr, "kernel_launch: memset failed\n"); return; }
    Args a{};
    for (int i = 0; i < 29; ++i) a.in[i] = d_in[i];
    a.out = (float*)d_out; a.ws = (unsigned char*)d_ws;
#if MK_PER_PHASE
    for (int p = 0; p < N_PHASES; ++p) { a.ph_lo = p; a.ph_hi = p + 1; hipLaunchKernelGGL(mk_fwd, dim3(grid), dim3(NWAVES * 64), LDS_BYTES, stream, a); }
#else
    a.ph_lo = 0; a.ph_hi = N_PHASES;
    hipLaunchKernelGGL(mk_fwd, dim3(grid), dim3(NWAVES * 64), LDS_BYTES, stream, a);
#endif
    const hipError_t le = hipPeekAtLastError();
    if (le != hipSuccess) fprintf(stderr, "kernel_launch: launch failed: %s\n", hipGetErrorName(le));
}
```

```cpp
#include <hip/hip_runtime.h>
#include <cstdio>
#include <cstdint>

#define GAS __attribute__((address_space(1)))
#define LAS __attribute__((address_space(3)))
typedef unsigned short bf16_t;
typedef short bf16x8 __attribute__((ext_vector_type(8)));
typedef float f32x2 __attribute__((ext_vector_type(2)));
typedef float f32x4 __attribute__((ext_vector_type(4)));
typedef float f32x16 __attribute__((ext_vector_type(16)));
typedef unsigned u32x2 __attribute__((ext_vector_type(2)));
typedef unsigned u32x4 __attribute__((ext_vector_type(4)));
typedef int i32x4 __attribute__((ext_vector_type(4)));
typedef int i32x8 __attribute__((ext_vector_type(8)));

constexpr int NB = 8, SEQ = 8192, NTOK = NB * SEQ, DM = 1024, DEPTH = 2;
constexpr int DIN = 4936;
constexpr int CHB = 4, TCH = CHB * SEQ, NCHUNK = NB / CHB;
constexpr int DFF = 2816, NEXP = 8, EFF = 3584;
constexpr int P1W = 2048, GW = 3072;
constexpr int NINP = P1W + GW;
constexpr float EPS = 1e-6f;
constexpr float LOG2E = 1.4426950408889634f;
constexpr int C_QA = 0, C_KA = 256, C_VA = 320, C_IQ = 384, C_IK = 640, C_IW = 672, C_CQ = 680, C_CKV = 936, C_KR = 1064, C_QC = 1096, C_KC = 1608, C_VC = 1736, C_G = 1864;
constexpr int NPOS = 12288;
constexpr int MOE_ROWS = 2 * TCH + NEXP * 256;

__device__ __forceinline__ float bf2f(bf16_t v) { return __uint_as_float((unsigned)v << 16); }
__device__ __forceinline__ float bflo(unsigned w) { return __uint_as_float(w << 16); }
__device__ __forceinline__ float bfhi(unsigned w) { return __uint_as_float(w & 0xffff0000u); }
__device__ __forceinline__ unsigned f2bf(float f) { unsigned u = __float_as_uint(f); return (u + 0x7fffu + ((u >> 16) & 1u)) >> 16; }
__device__ __forceinline__ unsigned pk2(float lo, float hi) { return f2bf(lo) | (f2bf(hi) << 16); }
__device__ __forceinline__ unsigned cvt_pk_bf16(float lo, float hi) { unsigned r; asm volatile("v_cvt_pk_bf16_f32 %0, %1, %2" : "=v"(r) : "v"(lo), "v"(hi)); return r; }
__device__ __forceinline__ unsigned pk4_fp8(float a, float b, float c, float d) { unsigned w = 0u; w = (unsigned)__builtin_amdgcn_cvt_pk_fp8_f32(a, b, (int)w, false); w = (unsigned)__builtin_amdgcn_cvt_pk_fp8_f32(c, d, (int)w, true); return w; }
__device__ __forceinline__ float fast_exp2(float x) { return __builtin_amdgcn_exp2f(x); }
__device__ __forceinline__ float fast_rcp(float x) { return __builtin_amdgcn_rcpf(x); }
__device__ __forceinline__ float sigmoidf_(float x) { return fast_rcp(1.0f + fast_exp2(-LOG2E * x)); }
template <int O> __device__ __forceinline__ float xor_lane(float v) {
    return __int_as_float(__builtin_amdgcn_ds_swizzle(__float_as_int(v), (O << 10) | 0x1f)); }
__device__ __forceinline__ float half_sum(float v) { const auto rr = __builtin_amdgcn_permlane32_swap(__float_as_uint(v), __float_as_uint(v), false, false); return __uint_as_float(rr[0]) + __uint_as_float(rr[1]); }
__device__ __forceinline__ float half_max(float v) { const auto rr = __builtin_amdgcn_permlane32_swap(__float_as_uint(v), __float_as_uint(v), false, false); return fmaxf(__uint_as_float(rr[0]), __uint_as_float(rr[1])); }
__device__ __forceinline__ float sum16(float v) { v += xor_lane<1>(v); v += xor_lane<2>(v); v += xor_lane<4>(v); v += xor_lane<8>(v); return v; }
__device__ __forceinline__ float max16(float v) { v = fmaxf(v, xor_lane<1>(v)); v = fmaxf(v, xor_lane<2>(v)); v = fmaxf(v, xor_lane<4>(v)); v = fmaxf(v, xor_lane<8>(v)); return v; }
__device__ __forceinline__ float sum32(float v) { v = sum16(v); v += xor_lane<16>(v); return v; }
__device__ __forceinline__ float wave_sum(float v) { return half_sum(sum32(v)); }
__device__ __forceinline__ int lane_get(int v, int src_lane) { return __builtin_amdgcn_ds_bpermute(src_lane << 2, v); }
__device__ __forceinline__ int lane_bcast(int v, int uniform_lane) { return __builtin_amdgcn_readlane(v, uniform_lane); }
__device__ __forceinline__ unsigned lds_add(LAS unsigned* p, unsigned v) { return __hip_atomic_fetch_add(p, v, __ATOMIC_RELAXED, __HIP_MEMORY_SCOPE_WORKGROUP); }
__device__ __forceinline__ unsigned lds_or(LAS unsigned* p, unsigned v) { return __hip_atomic_fetch_or(p, v, __ATOMIC_RELAXED, __HIP_MEMORY_SCOPE_WORKGROUP); }
__device__ __forceinline__ int lane_id() { int l; asm volatile("v_mbcnt_lo_u32_b32 %0, -1, 0\n\tv_mbcnt_hi_u32_b32 %0, -1, %0" : "=v"(l)); return l; }
#define LDS_WAIT() asm volatile("s_waitcnt lgkmcnt(0)" ::: "memory")
#define VM_WAIT() asm volatile("s_waitcnt vmcnt(0)" ::: "memory")

namespace pg8 {
constexpr int BM = 256, BK = 64, HALF = 128, HTB = HALF * BK * 2, STAGE_BYTES = 8 * HTB, NXCD = 8, WGM = 8;
__host__ __device__ __forceinline__ int lds_byte(int r, int c) { const int st = (r >> 4) * 2 + (c >> 5), rr = r & 15, cc = c & 31, ob = rr * 64 + cc * 2; return st * 1024 + (ob ^ (((ob >> 9) & 1) << 5)); }
__host__ __device__ __forceinline__ void stage_rc(int b, int& R, int& C) { const int st = b / 1024, sb = b % 1024, swz = sb ^ (((sb >> 9) & 1) << 5); R = (st >> 1) * 16 + swz / 64; C = (st & 1) * 32 + (swz % 64) / 2; }
__host__ __device__ __forceinline__ int perm32(int rho) { const int n = rho >> 4, i = rho & 15; return 8 * (i >> 2) + 4 * n + (i & 3); }

struct Unit { int pm, pn, seg; };
struct Gemm {
    const bf16_t* A; int lda;
    const bf16_t* A2; int pn_split;
    const bf16_t* Bt; int K;
    const int* blk_e; size_t e_stride;
    int nseg, k1, k2;
};
struct StaticOrder {
    int nM, nN, nwg, G, c;
    __device__ void init(int nM_, int nN_, int G_, int c_) { nM = nM_; nN = nN_; nwg = nM * nN; G = G_; c = c_; }
    __device__ bool next(int i, Unit& u) const {
        const long L = (long)i * G + c; if (L >= nwg) return false;
        int wgid = (int)L; { const int q = nwg / NXCD, r = nwg % NXCD, xcd = wgid % NXCD, off = wgid / NXCD; wgid = (xcd < r ? xcd * (q + 1) : r * (q + 1) + (xcd - r) * q) + off; }
        const int nig = WGM * nN, gid = wgid / nig, fm = gid * WGM, gsz = (nM - fm) < WGM ? (nM - fm) : WGM;
        u.pm = fm + ((wgid % nig) % gsz); u.pn = (wgid % nig) / gsz; u.seg = 0; return true;
    }
};
struct GateOrder { StaticOrder S;
    __device__ bool next(int i, Unit& u) const { if (!S.next(i, u)) return false; u.pn += 8; return true; } };
struct SegOrder { StaticOrder S;
    __device__ bool next(int i, Unit& u) const { const int q = i / 3; if (!S.next(q, u)) return false; u.seg = i - 3 * q; return true; } };

template <class Epi, class Sched, bool FP8 = false>
__device__ __forceinline__ void gemm_phase(LAS unsigned char* lds, int wave_, const Gemm g, const Sched& S, const Epi& E) {
    int tid = wave_ * 64 + lane_id(); asm volatile("" : "+v"(tid));
    const int wid = __builtin_amdgcn_readfirstlane(tid >> 6), lane = tid & 63, wr = wid >> 2, wc = wid & 3, fr = lane & 15, fq = lane >> 4;
    int K = g.K; asm volatile("" : "+s"(K));
    unsigned voffA[2], voffB[2];
#pragma unroll
    for (int i = 0; i < 2; ++i) { int R, C; stage_rc(tid * 16 + i * 8192, R, C); const int Rb = Epi::PERM ? ((R & ~31) + perm32(R & 31)) : R;
        voffA[i] = (unsigned)(R * g.lda + C) * 2u; voffB[i] = (unsigned)(Rb * K + C) * 2u; }
    const size_t kstep = (size_t)(BK * 2);
    const size_t hstepB = (size_t)HALF * K * 2, tstepB = 2 * hstepB;
    const size_t hstepA = (size_t)HALF * g.lda * 2, tstepA = 2 * hstepA;
    const unsigned ldsw = (unsigned)wid * 1024u;
    const int aoff0 = FP8 ? lds_byte(wr * 64 + fr, (2 * (fq & 1)) * 8) + (fq >> 1) * 1024 : lds_byte(wr * 64 + fr, fq * 8);
    const int boff0 = FP8 ? lds_byte(wc * 32 + fr, (2 * (fq & 1)) * 8) + (fq >> 1) * 1024 : lds_byte(wc * 32 + fr, fq * 8);
    constexpr int OFF1 = FP8 ? 16 : 1024;
#define PG8_SA(b, h) (((b) * 2 + (h)) * HTB)
#define PG8_SB(b, h) ((4 + (b) * 2 + (h)) * HTB)
#define PG8_STAGE(bufoff, gbase, voff) do { _Pragma("unroll") for (int _i = 0; _i < 2; ++_i) \
        __builtin_amdgcn_global_load_lds((const unsigned*)((const char*)(gbase) + (voff)[_i]), (LAS unsigned*)(lds + (bufoff) + ldsw + _i * 8192), 16, 0, 0); } while (0)
#define PG8_LDA(dst, b, h) do { _Pragma("unroll") for (int m = 0; m < 4; ++m) { \
        if constexpr (FP8) { dst##8[m].lo = *(const LAS i32x4*)(lds + PG8_SA(b, h) + aoff0 + m * 2048); dst##8[m].hi = *(const LAS i32x4*)(lds + PG8_SA(b, h) + aoff0 + OFF1 + m * 2048); } \
        else { dst[m][0] = *(const LAS bf16x8*)(lds + PG8_SA(b, h) + aoff0 + m * 2048); dst[m][1] = *(const LAS bf16x8*)(lds + PG8_SA(b, h) + aoff0 + OFF1 + m * 2048); } } } while (0)
#define PG8_LDB(dst, b, h) do { _Pragma("unroll") for (int n = 0; n < 2; ++n) { \
        if constexpr (FP8) { dst##8[n].lo = *(const LAS i32x4*)(lds + PG8_SB(b, h) + boff0 + n * 2048); dst##8[n].hi = *(const LAS i32x4*)(lds + PG8_SB(b, h) + boff0 + OFF1 + n * 2048); } \
        else { dst[n][0] = *(const LAS bf16x8*)(lds + PG8_SB(b, h) + boff0 + n * 2048); dst[n][1] = *(const LAS bf16x8*)(lds + PG8_SB(b, h) + boff0 + OFF1 + n * 2048); } } } while (0)
#define PG8_MMA(ai, bj, At, Bt) do { __builtin_amdgcn_s_setprio(1); _Pragma("unroll") for (int m = 0; m < 4; ++m) _Pragma("unroll") for (int n = 0; n < 2; ++n) { \
        if constexpr (FP8) asm volatile("v_mfma_scale_f32_16x16x128_f8f6f4 %0, %1, %2, %0, %3, %3 op_sel_hi:[0,0,0]" : "+v"(acc[ai][bj][m][n]) : "v"(Bt##8[n]), "v"(At##8[m]), "v"(one_scale));   \
        else { _Pragma("unroll") for (int k = 0; k < 2; ++k) acc[ai][bj][m][n] = __builtin_amdgcn_mfma_f32_16x16x32_bf16(Bt[n][k], At[m][k], acc[ai][bj][m][n], 0, 0, 0); } } \
        __builtin_amdgcn_s_setprio(0); } while (0)
#define PG8_WAIT_V(n) asm volatile("s_waitcnt vmcnt(" #n ")" ::: "memory")
#define PG8_WAIT_L(n) asm volatile("s_waitcnt lgkmcnt(" #n ")" ::: "memory")
#define PG8_BAR __builtin_amdgcn_s_barrier()
#define PG8_SCHED __builtin_amdgcn_sched_barrier(0)
#define PG8_K0(u) ((u).seg == 0 ? 0 : ((u).seg == 1 ? g.k1 : g.k2))
#define PG8_NT(u) ((g.nseg == 1 ? K : ((u).seg == 0 ? g.k1 : ((u).seg == 1 ? g.k2 - g.k1 : K - g.k2))) / BK)
#define PG8_BPTR(u) ((const char*)g.Bt + ((g.blk_e ? (size_t)g.blk_e[(u).pm] * g.e_stride * 2 : (size_t)0) + (size_t)(u).pn * tstepB + (size_t)PG8_K0(u) * 2))
    Unit cur, nxt; int ui = 0;
    if (!S.next(0, cur)) return;
    f32x4 acc[2][2][4][2];
#pragma unroll
    for (int a = 0; a < 2; ++a)
#pragma unroll
        for (int b = 0; b < 2; ++b)
#pragma unroll
            for (int m = 0; m < 4; ++m)
#pragma unroll
                for (int n = 0; n < 2; ++n) acc[a][b][m][n] = (f32x4){0.f, 0.f, 0.f, 0.f};
    bf16x8 At[4][2], B0[2][2], B1[2][2];
    i32x8 At8[4], B08[2], B18[2];
    int one_scale = 0x7f7f7f7f; asm volatile("" : "+v"(one_scale));
    const char* cA = (const char*)(cur.pn >= g.pn_split ? g.A2 : g.A) + (size_t)cur.pm * tstepA + (size_t)PG8_K0(cur) * 2; const char* cB = PG8_BPTR(cur);
    int nt = PG8_NT(cur);
    PG8_STAGE(PG8_SB(0, 0), cB, voffB); PG8_STAGE(PG8_SB(0, 1), cB + hstepB, voffB); PG8_STAGE(PG8_SA(0, 0), cA, voffA); PG8_STAGE(PG8_SA(0, 1), cA + hstepA, voffA);
    if (wr == 1) PG8_BAR;
    PG8_WAIT_V(2); PG8_BAR;
    PG8_STAGE(PG8_SB(1, 0), cB + kstep, voffB); PG8_STAGE(PG8_SA(1, 0), cA + kstep, voffA); PG8_STAGE(PG8_SB(1, 1), cB + hstepB + kstep, voffB);
    PG8_WAIT_V(6); PG8_BAR;
    for (;;) {
        const bool has_next = S.next(ui + 1, nxt);
        const char* nA = has_next ? (const char*)(nxt.pn >= g.pn_split ? g.A2 : g.A) + (size_t)nxt.pm * tstepA + (size_t)PG8_K0(nxt) * 2 : cA; const char* nB = has_next ? PG8_BPTR(nxt) : cB;
        for (int t = 0; t < nt; t += 2) {
            const bool last = (t == nt - 2);
            const char* a1 = cA + (size_t)(t + 1) * kstep;
            const char* a2 = last ? nA : cA + (size_t)(t + 2) * kstep; const char* b2 = last ? nB : cB + (size_t)(t + 2) * kstep;
            const char* a3 = a2 + kstep; const char* b3 = b2 + kstep;
            PG8_LDB(B0, 0, 0); PG8_LDB(B1, 0, 1); PG8_SCHED; PG8_LDA(At, 0, 0); PG8_STAGE(PG8_SA(1, 1), a1 + hstepA, voffA);
            PG8_WAIT_V(8); PG8_WAIT_L(0); PG8_BAR; PG8_MMA(0, 0, At, B0); PG8_MMA(0, 1, At, B1); PG8_BAR; PG8_SCHED;
            PG8_LDA(At, 0, 1); PG8_STAGE(PG8_SB(0, 0), b2, voffB); PG8_STAGE(PG8_SB(0, 1), b2 + hstepB, voffB); PG8_STAGE(PG8_SA(0, 0), a2, voffA);
            PG8_WAIT_V(8); PG8_WAIT_L(0); PG8_BAR; PG8_MMA(1, 0, At, B0); PG8_MMA(1, 1, At, B1); PG8_BAR; PG8_SCHED;
            PG8_LDB(B0, 1, 0); PG8_LDB(B1, 1, 1); PG8_SCHED; PG8_LDA(At, 1, 0); PG8_STAGE(PG8_SA(0, 1), a2 + hstepA, voffA);
            PG8_WAIT_V(8); PG8_WAIT_L(0); PG8_BAR; PG8_MMA(0, 0, At, B0); PG8_MMA(0, 1, At, B1); PG8_BAR; PG8_SCHED;
            PG8_LDA(At, 1, 1); PG8_STAGE(PG8_SB(1, 0), b3, voffB); PG8_STAGE(PG8_SB(1, 1), b3 + hstepB, voffB); PG8_STAGE(PG8_SA(1, 0), a3, voffA);
            PG8_WAIT_V(8); PG8_WAIT_L(0); PG8_BAR; PG8_MMA(1, 0, At, B0); PG8_MMA(1, 1, At, B1); PG8_BAR; PG8_SCHED;
        }
        if (wr == 0) PG8_BAR;
        if constexpr (FP8) { asm volatile("s_nop 15\n\ts_nop 7" ::: "memory");
#pragma unroll
            for (int a = 0; a < 2; ++a)
#pragma unroll
                for (int b = 0; b < 2; ++b)
#pragma unroll
                    for (int m = 0; m < 4; ++m)
#pragma unroll
                        for (int n = 0; n < 2; ++n) asm volatile("" : "+v"(acc[a][b][m][n])); }
        E(acc, cur, wr, wc, fr, fq);
        if (!has_next) break;
#pragma unroll
        for (int a = 0; a < 2; ++a)
#pragma unroll
            for (int b = 0; b < 2; ++b)
#pragma unroll
                for (int m = 0; m < 4; ++m)
#pragma unroll
                    for (int n = 0; n < 2; ++n) acc[a][b][m][n] = (f32x4){0.f, 0.f, 0.f, 0.f};
        cur = nxt; cA = nA; cB = nB; ++ui; nt = PG8_NT(cur);
        if (wr == 1) PG8_BAR;
    }
    PG8_WAIT_V(0);
    PG8_BAR;
#undef PG8_SA
#undef PG8_SB
#undef PG8_STAGE
#undef PG8_LDA
#undef PG8_LDB
#undef PG8_MMA
#undef PG8_WAIT_V
#undef PG8_WAIT_L
#undef PG8_BAR
#undef PG8_SCHED
#undef PG8_BPTR
#undef PG8_K0
#undef PG8_NT
}

typedef const f32x4 (&AccRef)[2][2][4][2];
struct EpiInProj {
    static constexpr bool PERM = true;
    bf16_t* P1; bf16_t* G; float sg;
    __device__ __forceinline__ void operator()(AccRef acc, const Unit& u, int wr, int wc, int fr, int fq) const {
        const int row0 = u.pm * BM + wr * 64 + fr; const bool gate = u.pn >= 8;
        bf16_t* base = gate ? G : P1; const int ldc = gate ? GW : P1W; const int col0 = (gate ? (u.pn - 8) : u.pn) * BM + wc * 32 + 8 * fq;
#pragma unroll
        for (int ai = 0; ai < 2; ++ai)
#pragma unroll
            for (int m = 0; m < 4; ++m) { bf16_t* rowp = base + (size_t)(row0 + ai * HALF + m * 16) * ldc + col0;
#pragma unroll
                for (int bj = 0; bj < 2; ++bj) { f32x4 v0 = acc[ai][bj][m][0], v1 = acc[ai][bj][m][1];
                    if (gate) {
#pragma unroll
                        for (int j = 0; j < 4; ++j) { v0[j] = sigmoidf_(v0[j] * sg); v1[j] = sigmoidf_(v1[j] * sg); } }
                    u32x4 w; w.x = cvt_pk_bf16(v0[0], v0[1]); w.y = cvt_pk_bf16(v0[2], v0[3]); w.z = cvt_pk_bf16(v1[0], v1[1]); w.w = cvt_pk_bf16(v1[2], v1[3]);
                    *(u32x4*)(rowp + bj * HALF) = w; } }
    }
};
struct EpiBf16 {
    static constexpr bool PERM = true;
    bf16_t* O; int ldc;
    __device__ __forceinline__ void operator()(AccRef acc, const Unit& u, int wr, int wc, int fr, int fq) const {
        const int row0 = u.pm * BM + wr * 64 + fr; const int col0 = u.pn * BM + wc * 32 + 8 * fq;
#pragma unroll
        for (int ai = 0; ai < 2; ++ai)
#pragma unroll
            for (int m = 0; m < 4; ++m) { bf16_t* rowp = O + (size_t)(row0 + ai * HALF + m * 16) * ldc + col0;
#pragma unroll
                for (int bj = 0; bj < 2; ++bj) { const f32x4 v0 = acc[ai][bj][m][0], v1 = acc[ai][bj][m][1];
                    u32x4 w; w.x = cvt_pk_bf16(v0[0], v0[1]); w.y = cvt_pk_bf16(v0[2], v0[3]); w.z = cvt_pk_bf16(v1[0], v1[1]); w.w = cvt_pk_bf16(v1[2], v1[3]);
                    *(u32x4*)(rowp + bj * HALF) = w; } }
    }
};
struct EpiMerge {
    static constexpr bool PERM = true;
    bf16_t* Mg; const bf16_t* G; unsigned char* M8; float s8;
    __device__ __forceinline__ void operator()(AccRef acc, const Unit& u, int wr, int wc, int fr, int fq) const {
        const int row0 = u.pm * BM + wr * 64 + fr; const int col0 = u.pn * BM + wc * 32 + 8 * fq; const int goff = u.seg * DM; const bool accum = u.seg != 0;
#pragma unroll
        for (int ai = 0; ai < 2; ++ai) {
            u32x4 gv[8], ov[8];
#pragma unroll
            for (int m = 0; m < 4; ++m)
#pragma unroll
                for (int bj = 0; bj < 2; ++bj) { const size_t row = (size_t)(row0 + ai * HALF + m * 16);
                    gv[m * 2 + bj] = *(const u32x4*)(G + row * GW + goff + col0 + bj * HALF);
                    if (accum) ov[m * 2 + bj] = *(const u32x4*)(Mg + row * DM + col0 + bj * HALF); }
#pragma unroll
            for (int m = 0; m < 4; ++m)
#pragma unroll
                for (int bj = 0; bj < 2; ++bj) { const size_t row = (size_t)(row0 + ai * HALF + m * 16); const f32x4 v0 = acc[ai][bj][m][0], v1 = acc[ai][bj][m][1]; const u32x4 gw = gv[m * 2 + bj];
                    float r[8] = { bflo(gw.x) * v0[0], bfhi(gw.x) * v0[1], bflo(gw.y) * v0[2], bfhi(gw.y) * v0[3], bflo(gw.z) * v1[0], bfhi(gw.z) * v1[1], bflo(gw.w) * v1[2], bfhi(gw.w) * v1[3] };
                    if (accum) { const u32x4 o = ov[m * 2 + bj]; r[0] += bflo(o.x); r[1] += bfhi(o.x); r[2] += bflo(o.y); r[3] += bfhi(o.y); r[4] += bflo(o.z); r[5] += bfhi(o.z); r[6] += bflo(o.w); r[7] += bfhi(o.w); }
                    u32x4 w; w.x = cvt_pk_bf16(r[0], r[1]); w.y = cvt_pk_bf16(r[2], r[3]); w.z = cvt_pk_bf16(r[4], r[5]); w.w = cvt_pk_bf16(r[6], r[7]);
                    *(u32x4*)(Mg + row * DM + col0 + bj * HALF) = w;
                    if (u.seg == 2) { u32x2 q; q.x = pk4_fp8(r[0] * s8, r[1] * s8, r[2] * s8, r[3] * s8); q.y = pk4_fp8(r[4] * s8, r[5] * s8, r[6] * s8, r[7] * s8); *(u32x2*)(M8 + row * DM + col0 + bj * HALF) = q; } }
        }
    }
};
struct EpiResid {
    static constexpr bool PERM = false;
    const float* R; float* O;
    __device__ __forceinline__ void operator()(AccRef acc, const Unit& u, int wr, int wc, int fr, int fq) const {
        const int row0 = u.pm * BM + wr * 64 + fr, col0 = u.pn * BM + wc * 32 + 4 * fq;
#pragma unroll
        for (int ai = 0; ai < 2; ++ai) {
            f32x4 rv[16];
#pragma unroll
            for (int m = 0; m < 4; ++m)
#pragma unroll
                for (int bj = 0; bj < 2; ++bj)
#pragma unroll
                    for (int n = 0; n < 2; ++n) rv[m * 4 + bj * 2 + n] = *(const f32x4*)(R + (size_t)(row0 + ai * HALF + m * 16) * DM + col0 + bj * HALF + n * 16);
#pragma unroll
            for (int m = 0; m < 4; ++m)
#pragma unroll
                for (int bj = 0; bj < 2; ++bj)
#pragma unroll
                    for (int n = 0; n < 2; ++n) *(f32x4*)(O + (size_t)(row0 + ai * HALF + m * 16) * DM + col0 + bj * HALF + n * 16) = rv[m * 4 + bj * 2 + n] + acc[ai][bj][m][n];
            asm volatile("" ::: "memory"); }
    }
};
struct EpiResidS {
    static constexpr bool PERM = false;
    const float* R; float* O; float s;
    __device__ __forceinline__ void operator()(AccRef acc, const Unit& u, int wr, int wc, int fr, int fq) const {
        const int row0 = u.pm * BM + wr * 64 + fr, col0 = u.pn * BM + wc * 32 + 4 * fq;
#pragma unroll
        for (int ai = 0; ai < 2; ++ai) {
            f32x4 rv[16];
#pragma unroll
            for (int m = 0; m < 4; ++m)
#pragma unroll
                for (int bj = 0; bj < 2; ++bj)
#pragma unroll
                    for (int n = 0; n < 2; ++n) rv[m * 4 + bj * 2 + n] = *(const f32x4*)(R + (size_t)(row0 + ai * HALF + m * 16) * DM + col0 + bj * HALF + n * 16);
#pragma unroll
            for (int m = 0; m < 4; ++m)
#pragma unroll
                for (int bj = 0; bj < 2; ++bj)
#pragma unroll
                    for (int n = 0; n < 2; ++n) *(f32x4*)(O + (size_t)(row0 + ai * HALF + m * 16) * DM + col0 + bj * HALF + n * 16) = rv[m * 4 + bj * 2 + n] + acc[ai][bj][m][n] * s;
            asm volatile("" ::: "memory"); }
    }
};
struct EpiSwiglu {
    static constexpr bool PERM = true;
    bf16_t* O; int ldc;
    __device__ __forceinline__ void operator()(AccRef acc, const Unit& u, int wr, int wc, int fr, int fq) const {
        const int row0 = u.pm * BM + wr * 64 + fr; const int col0 = u.pn * HALF + wc * 32 + 8 * fq;
#pragma unroll
        for (int ai = 0; ai < 2; ++ai)
#pragma unroll
            for (int m = 0; m < 4; ++m) { bf16_t* rowp = O + (size_t)(row0 + ai * HALF + m * 16) * ldc + col0;
                float r[8];
#pragma unroll
                for (int n = 0; n < 2; ++n)
#pragma unroll
                    for (int j = 0; j < 4; ++j) { const float gt = acc[ai][0][m][n][j], up = acc[ai][1][m][n][j]; r[4 * n + j] = gt * sigmoidf_(gt) * up; }
                u32x4 w; w.x = cvt_pk_bf16(r[0], r[1]); w.y = cvt_pk_bf16(r[2], r[3]); w.z = cvt_pk_bf16(r[4], r[5]); w.w = cvt_pk_bf16(r[6], r[7]);
                *(u32x4*)rowp = w; }
    }
};
struct EpiSwigluF8 {
    static constexpr bool PERM = true;
    unsigned char* O; int ldc; float s_in, s_out;
    __device__ __forceinline__ void operator()(AccRef acc, const Unit& u, int wr, int wc, int fr, int fq) const {
        const int row0 = u.pm * BM + wr * 64 + fr; const int col0 = u.pn * HALF + wc * 32 + 8 * fq;
#pragma unroll
        for (int ai = 0; ai < 2; ++ai)
#pragma unroll
            for (int m = 0; m < 4; ++m) { unsigned char* rowp = O + (size_t)(row0 + ai * HALF + m * 16) * ldc + col0;
                float r[8];
#pragma unroll
                for (int n = 0; n < 2; ++n)
#pragma unroll
                    for (int j = 0; j < 4; ++j) { const float gt = acc[ai][0][m][n][j] * s_in, up = acc[ai][1][m][n][j] * s_in; r[4 * n + j] = gt * sigmoidf_(gt) * up * s_out; }
                u32x2 w; w.x = pk4_fp8(r[0], r[1], r[2], r[3]); w.y = pk4_fp8(r[4], r[5], r[6], r[7]);
                *(u32x2*)rowp = w; }
    }
};
struct EpiBf16S {
    static constexpr bool PERM = true;
    bf16_t* O; int ldc; float s;
    __device__ __forceinline__ void operator()(AccRef acc, const Unit& u, int wr, int wc, int fr, int fq) const {
        const int row0 = u.pm * BM + wr * 64 + fr; const int col0 = u.pn * BM + wc * 32 + 8 * fq;
#pragma unroll
        for (int ai = 0; ai < 2; ++ai)
#pragma unroll
            for (int m = 0; m < 4; ++m) { bf16_t* rowp = O + (size_t)(row0 + ai * HALF + m * 16) * ldc + col0;
#pragma unroll
                for (int bj = 0; bj < 2; ++bj) { const f32x4 v0 = acc[ai][bj][m][0] * s, v1 = acc[ai][bj][m][1] * s;
                    u32x4 w; w.x = cvt_pk_bf16(v0[0], v0[1]); w.y = cvt_pk_bf16(v0[2], v0[3]); w.z = cvt_pk_bf16(v1[0], v1[1]); w.w = cvt_pk_bf16(v1[2], v1[3]);
                    *(u32x4*)(rowp + bj * HALF) = w; } }
    }
};
}
struct Args { const void* in[29]; float* out; unsigned char* ws; int ph_lo, ph_hi, pad0, pad1; };
enum { I_X = 0, I_POS, I_ANG, I_WIN, I_AQG, I_AKG, I_BCQG, I_BCKVG, I_WUQ, I_WUKV, I_BQNG, I_BQRG, I_BKNG, I_BKRG, I_CQG, I_CKG, I_SINK, I_WAO, I_WBO, I_WCO, I_WO, I_FNG, I_FW1, I_FW3, I_FW2, I_RW, I_MW1, I_MW3, I_MW2 };

constexpr size_t MiB = 1u << 20;
constexpr size_t WS_CTL = 0, CTL_ZERO_BYTES = 1 * MiB;
constexpr size_t SZ_WIN = (size_t)NINP * DM * 2;
constexpr size_t SZ_WUQ = (size_t)512 * 256 * 2, SZ_WUKV = SZ_WUQ;
constexpr size_t SZ_WAO = (size_t)DM * 256 * 2, SZ_WBO = SZ_WAO, SZ_WCO = (size_t)DM * 512 * 2, SZ_WO = (size_t)DM * DM * 2;
constexpr size_t SZ_WIN8 = (size_t)GW * DM;
constexpr size_t SZ_WO8 = (size_t)DM * DM;
constexpr size_t SZ_LAYERW = SZ_WIN + SZ_WUQ + SZ_WUKV + SZ_WAO + SZ_WBO + SZ_WCO + SZ_WO + SZ_WIN8 + SZ_WO8;
constexpr size_t WS_LAYERW = 1 * MiB;
constexpr size_t OFF_WIN = 0, OFF_WUQ = OFF_WIN + SZ_WIN, OFF_WUKV = OFF_WUQ + SZ_WUQ, OFF_WAO = OFF_WUKV + SZ_WUKV, OFF_WBO = OFF_WAO + SZ_WAO, OFF_WCO = OFF_WBO + SZ_WBO, OFF_WO = OFF_WCO + SZ_WCO, OFF_WIN8 = OFF_WO + SZ_WO, OFF_WO8 = OFF_WIN8 + SZ_WIN8;
constexpr size_t WS_W13 = WS_LAYERW + 2 * SZ_LAYERW;
constexpr size_t SZ_W13 = (size_t)2 * DFF * DM * 2, SZ_W2 = (size_t)DM * DFF * 2;
constexpr size_t WS_W2 = WS_W13 + SZ_W13;
constexpr size_t WS_E13 = WS_W2 + SZ_W2;
constexpr size_t SZ_E13 = (size_t)2 * EFF * DM, SZ_E2 = (size_t)DM * EFF;
constexpr float S_W13 = 32.f, S_W2 = 64.f, S_ACT = 4.f, S_WG = 32.f, S_WO = 32.f, S_MG = 8.f;
constexpr size_t WS_E2 = WS_E13 + NEXP * SZ_E13;
constexpr size_t WS_ROPE = WS_E2 + NEXP * SZ_E2;
constexpr size_t SZ_ROPE = (size_t)NPOS * (32 + 32 + 16 + 16) * 4;
constexpr size_t WS_HB = ((WS_ROPE + SZ_ROPE + MiB - 1) / MiB) * MiB;
constexpr size_t SZ_HB = (size_t)(TCH + 1) * DM * 2;
constexpr size_t WS_HF8 = ((WS_HB + SZ_HB + MiB - 1) / MiB) * MiB;
constexpr size_t WS_ACT = WS_HF8 + (size_t)TCH * DM;
constexpr size_t A_P1 = 0;                                  constexpr size_t SZ_P1 = (size_t)TCH * P1W * 2;
constexpr size_t A_G = A_P1 + SZ_P1;                        constexpr size_t SZ_G = (size_t)TCH * GW * 2;
constexpr size_t A_QA = A_G + SZ_G;
constexpr size_t A_KA = A_QA + (size_t)TCH * 256 * 2;
constexpr size_t A_VA = A_KA + (size_t)TCH * 64 * 2;
constexpr size_t A_IQ = A_VA + (size_t)TCH * 64 * 2;
constexpr size_t A_IK = A_IQ + (size_t)TCH * 256 * 2;
constexpr size_t A_IW = A_IK + (size_t)TCH * 32 * 2;
constexpr size_t A_CQN = A_IW + (size_t)TCH * 8 * 4;
constexpr size_t A_CKVN = A_CQN + (size_t)TCH * 256 * 2;
constexpr size_t A_KR = A_CKVN + (size_t)TCH * 256 * 2;
constexpr size_t A_QC = A_KR + (size_t)TCH * 32 * 2;
constexpr size_t A_KC = A_QC + (size_t)TCH * 512 * 2;
constexpr size_t A_VCT = A_KC + (size_t)TCH * 128 * 2;
constexpr size_t A_QBR = A_VCT + (size_t)TCH * 128 * 2;
constexpr size_t A_KVBR = A_QBR + (size_t)TCH * 512 * 2;
constexpr size_t A_QB = A_KVBR + (size_t)TCH * 512 * 2;
constexpr size_t A_KB = A_QB + (size_t)TCH * 384 * 2;
constexpr size_t A_VBT = A_KB + (size_t)TCH * 384 * 2;
constexpr size_t A_SEL = A_VBT + (size_t)TCH * 256 * 2;
constexpr size_t A_SELN = A_SEL + (size_t)TCH * 256 * 2;
constexpr size_t A_Y = A_SELN + (size_t)TCH * 4;
constexpr size_t A_END = A_Y + (size_t)TCH * DM * 2;
constexpr size_t F_ACT = 0;
constexpr size_t F_YM = F_ACT + (size_t)MOE_ROWS * EFF * 2;
constexpr size_t F_ROWTOK = F_YM + (size_t)MOE_ROWS * DM * 2;
constexpr size_t F_TOPD = F_ROWTOK + (size_t)MOE_ROWS * 4;
constexpr size_t F_TOPE = F_TOPD + (size_t)TCH * 2 * 4;
constexpr size_t F_TOPG = F_TOPE + (size_t)TCH * 2 * 4;
constexpr size_t F_BLKE = F_TOPG + (size_t)TCH * 2 * 4;
constexpr size_t F_END = F_BLKE + 4096;
constexpr size_t WS_END = WS_ACT + (A_END > F_END ? A_END : F_END);
constexpr int CW_BAR = 4096;
constexpr int CW_Q = 16384;
constexpr int CW_MOE = 32768;
constexpr int CW_DBG = 65536;

constexpr int RING_OFF = 0;
constexpr int IDX_HP = 1028;
constexpr int IDX_HIST = 0, IDX_BITMAP = 0, IDX_CANDK = 32768, IDX_CANDI = 98304, IDX_QT = 131584  , IDX_SUBH = IDX_QT  ,
              IDX_QPAR = 152576, IDX_CCNT = 153600, IDX_FLAG = 153728;
constexpr int IDX_CCAP = 512, IDX_RCAP = 256;
constexpr int MISC_OFF = 153856;
constexpr int LDS_BYTES = 155648;
constexpr int NWAVES = 8;
#ifndef MK_TIMER
#define MK_TIMER 0
#endif
#define TMR_ACC ((LAS unsigned*)(size_t)(MISC_OFF + 192))
#define TB(id) unsigned long long tb_##id = 0ull; if (MK_TIMER == (id)) tb_##id = __builtin_amdgcn_s_memrealtime()
#define TE(id) do { if (MK_TIMER == (id)) { const unsigned d_ = (unsigned)(__builtin_amdgcn_s_memrealtime() - tb_##id); if (lane_id() == 0) lds_add(TMR_ACC, d_); } } while (0)

#define XB_TMO      128
#define XB_XCNT(j)  (256  + 64 * (j))
#define XB_XSUB(j)  (1280 + 64 * (j))
#define XB_XGEN(j)  (2304 + 64 * (j))
#define XB_TOP      3328
#define XB_TOPGEN   3392
#define XCD_BAR_WORDS 3456
#define XB_SPIN_CAP (1u << 18)

__device__ __forceinline__ unsigned xb_ld(unsigned* p)              { return __hip_atomic_load(p, __ATOMIC_RELAXED, __HIP_MEMORY_SCOPE_AGENT); }
__device__ __forceinline__ unsigned xb_add(unsigned* p, unsigned v) { return __hip_atomic_fetch_add(p, v, __ATOMIC_RELAXED, __HIP_MEMORY_SCOPE_AGENT); }
__device__ __forceinline__ unsigned xb_xcc_id() { return (unsigned)__builtin_amdgcn_s_getreg((3 << 11) | 20) & 0xFu; }
#define XB_SPIN(cond, bar) do { unsigned _sp = 0; while (cond) { __builtin_amdgcn_s_sleep(1); \
    if ((++_sp & 255u) == 0u) { if (xb_ld(&(bar)[XB_TMO])) break; if (_sp > XB_SPIN_CAP) { atomicAdd(&(bar)[XB_TMO], 1u); break; } } } } while (0)

struct XcdBarrier {
    unsigned* bar; unsigned x;
    volatile LAS unsigned* st;
};
__device__ __forceinline__ XcdBarrier xcd_barrier_post(unsigned* bar, volatile LAS unsigned* st, int wave_) {
    XcdBarrier b; b.bar = bar; b.x = xb_xcc_id(); b.st = st;
    if (wave_ == 0 && lane_id() == 0) (void)xb_add(&bar[XB_XCNT(b.x)], 1u);
    return b;
}
__device__ __forceinline__ void xcd_barrier_complete(unsigned* bar, unsigned x, unsigned& nloc, unsigned& nx) {
    const unsigned G = gridDim.x * gridDim.y * gridDim.z;
    unsigned sum, cnt, mine, sp = 0u;
    for (;;) {
        sum = 0u; cnt = 0u; mine = 0u;
#pragma unroll
        for (unsigned j = 0; j < 16; ++j) { const unsigned c = xb_ld(&bar[XB_XCNT(j)]); sum += c; cnt += (c > 0u) ? 1u : 0u; mine = (j == x) ? c : mine; }
        if (sum == G) break;
        __builtin_amdgcn_s_sleep(1);
        if ((++sp & 255u) == 0u) { if (xb_ld(&bar[XB_TMO])) break; if (sp > XB_SPIN_CAP) { atomicAdd(&bar[XB_TMO], 1u); break; } }
    }
    nloc = mine > 0u ? mine : 1u; nx = cnt > 0u ? cnt : 1u;
}
__device__ __forceinline__ void xcd_barrier(const XcdBarrier& b, int wave_) {
    asm volatile("s_waitcnt vmcnt(0)" ::: "memory");
    __syncthreads();
    if (wave_ == 0 && lane_id() == 0) {
        unsigned* bar = b.bar;
        __builtin_amdgcn_s_waitcnt(0);
        unsigned nloc = b.st[0], nx = b.st[1];
        if (nloc == 0u) { xcd_barrier_complete(bar, b.x, nloc, nx); b.st[0] = nloc; b.st[1] = nx; }
        const unsigned old = xb_add(&bar[XB_XSUB(b.x)], 1u);
        const unsigned gen = old / nloc;
        if (old + 1u == (gen + 1u) * nloc) {
            __builtin_amdgcn_fence(__ATOMIC_RELEASE, "agent");
            asm volatile("s_waitcnt vmcnt(0)" ::: "memory");
            const unsigned og = xb_add(&bar[XB_TOP], 1u);
            const unsigned tg = og / nx;
            if (og + 1u == (tg + 1u) * nx) xb_add(&bar[XB_TOPGEN], 1u);
            else XB_SPIN(xb_ld(&bar[XB_TOPGEN]) == tg, bar);
            __builtin_amdgcn_fence(__ATOMIC_ACQUIRE, "agent");
            xb_add(&bar[XB_XGEN(b.x)], 1u);
            asm volatile("s_waitcnt vmcnt(0)" ::: "memory");
        } else {
            XB_SPIN(xb_ld(&bar[XB_XGEN(b.x)]) == gen, bar);
            __builtin_amdgcn_fence(__ATOMIC_ACQUIRE, "agent");
            asm volatile("s_waitcnt vmcnt(0)" ::: "memory");
        }
    }
    __syncthreads();
}

template <int MAP> __device__ __forceinline__ int wt_row(int n) {
    if (MAP == 1) return n < C_G ? n : n + (P1W - C_G);
    if (MAP == 2) return 256 * (n >> 7) + (n & 127);
    if (MAP == 3) return 256 * (n >> 7) + 128 + (n & 127);
    return n;
}
template <int MAP>
__device__ __forceinline__ void transpose_item(const float* W, int K, int N, bf16_t* WT, int ldk, LAS float* scr, int item, int lane) {
    const int nblk = (N + 31) / 32, kb = item / nblk, nb = item % nblk, k0 = 64 * kb, n0 = 32 * nb;
    const int nn = n0 + (lane & 31); const bool nok = nn < N;
#pragma unroll
    for (int i = 0; i < 32; ++i) { const int kk = 2 * i + (lane >> 5); scr[kk * 33 + (lane & 31)] = nok ? W[(size_t)(k0 + kk) * N + nn] : 0.f; }
    LDS_WAIT(); asm volatile("" ::: "memory");
    const int c = lane & 7;
#pragma unroll
    for (int j = 0; j < 4; ++j) { const int n = (lane >> 3) + 8 * j; const LAS float* s = scr + (8 * c) * 33 + n;
        u32x4 o; o.x = pk2(s[0 * 33], s[1 * 33]); o.y = pk2(s[2 * 33], s[3 * 33]); o.z = pk2(s[4 * 33], s[5 * 33]); o.w = pk2(s[6 * 33], s[7 * 33]);
        if (n0 + n < N) *(u32x4*)(WT + (size_t)wt_row<MAP>(n0 + n) * ldk + k0 + 8 * c) = o; }
    LDS_WAIT(); asm volatile("" ::: "memory");
}

template <int MAP>
__device__ __forceinline__ void transpose_item_f8(const float* W, int K, int N, unsigned char* WT, int ldk, float sc, LAS float* scr, int item, int lane, int ldn = 0  ) {
    if (ldn == 0) ldn = N;
    const int nblk = (N + 31) / 32, kb = item / nblk, nb = item % nblk, n0 = 32 * nb;
    const int nn = n0 + (lane & 31); const bool nok = nn < N;
    const int c = lane & 7;
#pragma unroll 1
    for (int h = 0; h < 2; ++h) { const int k0 = 128 * kb + 64 * h;
#pragma unroll
        for (int i = 0; i < 32; ++i) { const int kk = 2 * i + (lane >> 5); scr[kk * 33 + (lane & 31)] = nok ? W[(size_t)(k0 + kk) * ldn + nn] * sc : 0.f; }
        LDS_WAIT(); asm volatile("" ::: "memory");
#pragma unroll
        for (int j = 0; j < 4; ++j) { const int n = (lane >> 3) + 8 * j; const LAS float* s = scr + (8 * c) * 33 + n;
            u32x2 o; o.x = pk4_fp8(s[0 * 33], s[1 * 33], s[2 * 33], s[3 * 33]); o.y = pk4_fp8(s[4 * 33], s[5 * 33], s[6 * 33], s[7 * 33]);
            if (n0 + n < N) *(u32x2*)(WT + (size_t)wt_row<MAP>(n0 + n) * ldk + k0 + 8 * c) = o; }
        LDS_WAIT(); asm volatile("" ::: "memory"); }
}
struct RopeTab { const float* c64; const float* s64; const float* c32; const float* s32; };

__device__ __forceinline__ void rope_cs(const RopeTab& R, int pos, int i, int half, float& c, float& s) {
    pos = pos < 0 ? 0 : (pos >= NPOS ? NPOS - 1 : pos);
    if (half == 32) { c = R.c64[pos * 32 + i]; s = R.s64[pos * 32 + i]; } else { c = R.c32[pos * 16 + i]; s = R.s32[pos * 16 + i]; }
}

__device__ __forceinline__ void norm_rows(const float* x, const float* g, bf16_t* HB, unsigned char* HF8, int gw, int ngw, int lane) {
    asm volatile("" : "+v"(lane));
    f32x4 gv[4];
#pragma unroll
    for (int j = 0; j < 4; ++j) gv[j] = *(const f32x4*)(g + 4 * lane + 256 * j);
    for (int tok = gw; tok < TCH; tok += ngw) {
        const float* xr = x + (size_t)tok * DM; f32x4 v[4]; float ss = 0.f;
#pragma unroll
        for (int j = 0; j < 4; ++j) { v[j] = *(const f32x4*)(xr + 4 * lane + 256 * j); ss += (v[j].x * v[j].x + v[j].y * v[j].y) + (v[j].z * v[j].z + v[j].w * v[j].w); }
        const float rstd = 1.0f / sqrtf(wave_sum(ss) * (1.0f / DM) + EPS);
        bf16_t* o = HB + (size_t)tok * DM;
#pragma unroll
        for (int j = 0; j < 4; ++j) { const float y0 = v[j].x * rstd * gv[j].x, y1 = v[j].y * rstd * gv[j].y, y2 = v[j].z * rstd * gv[j].z, y3 = v[j].w * rstd * gv[j].w;
            u32x2 w; w.x = pk2(y0, y1); w.y = pk2(y2, y3); *(u32x2*)(o + 4 * lane + 256 * j) = w;
            *(unsigned*)(HF8 + (size_t)tok * DM + 4 * lane + 256 * j) = pk4_fp8(y0, y1, y2, y3); }
    }
}

struct PP1Args {
    const bf16_t* P1; const int* pos;
    const float *aq_g, *ak_g, *cq_g, *ckv_g, *kr_g, *qc_g, *kc_g;
    unsigned char* act;
    RopeTab R;
};
constexpr float SC_A = 0.125f * LOG2E;
constexpr float SC_B = 0.10206207261596577f * LOG2E;
constexpr float SC_IW = 0.35355339059327373f * 0.17677669529663687f;
__device__ __forceinline__ void pp1_rows(const PP1Args& a, LAS unsigned char* wl  , int gw, int ngw, int lane) {
    asm volatile("" : "+v"(lane));
    const int i32 = lane & 31, hf = lane >> 5, i16 = lane & 15, qt = lane >> 4;
    const float gaq1 = a.aq_g[i32], gaq2 = a.aq_g[32 + i32], gak1 = a.ak_g[i32], gak2 = a.ak_g[32 + i32], gqc1 = a.qc_g[i32], gqc2 = a.qc_g[32 + i32], gkc1 = a.kc_g[i32], gkc2 = a.kc_g[32 + i32];
    const float gkr1 = a.kr_g[i16], gkr2 = a.kr_g[16 + i16];
    u32x4 nx[4]; int npos = 0;
    if (gw < TCH) { const u32x4* src = (const u32x4*)(a.P1 + (size_t)gw * P1W);
#pragma unroll
        for (int j = 0; j < 4; ++j) nx[j] = src[lane + 64 * j];
        npos = a.pos[gw]; }
    int buf = 0;
    for (int tok = gw; tok < TCH; tok += ngw, buf ^= 1) {
        LAS unsigned char* rowb = wl + buf * 4096;
#pragma unroll
        for (int j = 0; j < 4; ++j) *(LAS u32x4*)(rowb + (lane + 64 * j) * 16) = nx[j];
        const int pos = npos;
        if (tok + ngw < TCH) { const u32x4* src = (const u32x4*)(a.P1 + (size_t)(tok + ngw) * P1W);
#pragma unroll
            for (int j = 0; j < 4; ++j) nx[j] = src[lane + 64 * j];
            npos = a.pos[tok + ngw]; }
        const LAS bf16_t* p = (const LAS bf16_t*)rowb;
        const int bl = tok / SEQ, s = tok % SEQ;
        float c64, s64, c32, s32; rope_cs(a.R, pos, i32, 32, c64, s64); rope_cs(a.R, pos, i16, 16, c32, s32);
#pragma unroll
        for (int it = 0; it < 8; ++it) {
            const int hh = 2 * it + hf;
            const int kind = hh < 4 ? 0 : (hh == 4 ? 1 : (hh < 13 ? 2 : 3));
            const int hsub = kind == 0 ? hh : (kind == 1 ? 0 : (kind == 2 ? hh - 5 : ((hh - 13) & 1)));
            const int src = (kind == 0 ? C_QA : (kind == 1 ? C_KA : (kind == 2 ? C_QC : C_KC))) + 64 * hsub;
            const size_t dbase = kind == 0 ? A_QA : (kind == 1 ? A_KA : (kind == 2 ? A_QC : A_KC));
            const int dpitch = kind == 0 ? 256 : (kind == 1 ? 64 : (kind == 2 ? 512 : 128));
            const float g1 = kind == 0 ? gaq1 : (kind == 1 ? gak1 : (kind == 2 ? gqc1 : gkc1)), g2 = kind == 0 ? gaq2 : (kind == 1 ? gak2 : (kind == 2 ? gqc2 : gkc2));
            const float sc = (kind == 0 || kind == 2) ? SC_A : 1.f;
            bf16_t* dst = (bf16_t*)(a.act + dbase) + (size_t)tok * dpitch + 64 * hsub;
            const float x1 = bf2f(p[src + i32]), x2 = bf2f(p[src + 32 + i32]);
            const float rstd = 1.0f / sqrtf(sum32(x1 * x1 + x2 * x2) * (1.0f / 64.0f) + EPS);
            const float y1 = x1 * rstd * g1, y2 = x2 * rstd * g2;
            const float o1 = (y1 * c64 - y2 * s64) * sc, o2 = (y2 * c64 + y1 * s64) * sc;
            if (hh < 15) { dst[i32] = (bf16_t)f2bf(o1); dst[32 + i32] = (bf16_t)f2bf(o2); }
        }
#pragma unroll
        for (int it = 0; it < 3; ++it) {
            const int hh = 4 * it + qt; const int kind = hh < 8 ? 0 : (hh == 8 ? 1 : 2);
            const int src = kind == 0 ? C_IQ + 32 * hh : (kind == 1 ? C_IK : C_KR);
            const size_t dbase = kind == 0 ? A_IQ : (kind == 1 ? A_IK : A_KR);
            bf16_t* dst = (bf16_t*)(a.act + dbase) + (size_t)tok * (kind == 0 ? 256 : 32) + (kind == 0 ? 32 * hh : 0);
            float x1 = bf2f(p[src + i16]), x2 = bf2f(p[src + 16 + i16]);
            const float ss = sum16(x1 * x1 + x2 * x2);
            if (kind == 2) { const float rstd = 1.0f / sqrtf(ss * (1.0f / 32.0f) + EPS); x1 *= rstd * gkr1; x2 *= rstd * gkr2; }
            const float o1 = x1 * c32 - x2 * s32, o2 = x2 * c32 + x1 * s32;
            if (hh < 10) { dst[i16] = (bf16_t)f2bf(o1); dst[16 + i16] = (bf16_t)f2bf(o2); }
        }
        if (lane < 8) ((float*)(a.act + A_IW))[(size_t)tok * 8 + lane] = bf2f(p[C_IW + lane]) * SC_IW;
        ((bf16_t*)(a.act + A_VA))[(size_t)tok * 64 + lane] = p[C_VA + lane];
        { const u32x2 w = *(const LAS u32x2*)(p + C_CQ + 4 * lane); const float x0 = bflo(w.x), x1 = bfhi(w.x), x2 = bflo(w.y), x3 = bfhi(w.y);
          const float rstd = 1.0f / sqrtf(wave_sum((x0 * x0 + x1 * x1) + (x2 * x2 + x3 * x3)) * (1.0f / 256.0f) + EPS);
          const f32x4 g = *(const f32x4*)(a.cq_g + 4 * lane);
          u32x2 o; o.x = pk2(x0 * rstd * g.x, x1 * rstd * g.y); o.y = pk2(x2 * rstd * g.z, x3 * rstd * g.w); *(u32x2*)((bf16_t*)(a.act + A_CQN) + (size_t)tok * 256 + 4 * lane) = o; }
        { const unsigned w = *(const LAS unsigned*)(p + C_CKV + 2 * lane); const float x0 = bflo(w), x1 = bfhi(w);
          const float rstd = 1.0f / sqrtf(wave_sum(x0 * x0 + x1 * x1) * (1.0f / 128.0f) + EPS);
          const f32x2 g = *(const f32x2*)(a.ckv_g + 2 * lane);
          bf16_t* ck = (bf16_t*)(a.act + A_CKVN) + (size_t)tok * 256;
          *(unsigned*)(ck + 2 * lane) = pk2(x0 * rstd * g.x, x1 * rstd * g.y);
          *(unsigned*)(ck + 128 + 2 * lane) = 0u; }
#pragma unroll
        for (int kvh = 0; kvh < 2; ++kvh) ((bf16_t*)(a.act + A_VCT))[((size_t)(bl * 2 + kvh) * 64 + lane) * SEQ + s] = p[C_VC + 64 * kvh + lane];
    }
}

struct PP2Args {
    const bf16_t *QBR, *KVBR, *KR; const int* pos;
    const float *qn_g, *qr_g, *kn_g;
    bf16_t *QB, *KB, *VBT; RopeTab R;
};
__device__ __forceinline__ void pp2_rows(const PP2Args& a, LAS unsigned char* wl  , int gw, int ngw, int lane) {
    asm volatile("" : "+v"(lane));
    const int i32 = lane & 31, hf = lane >> 5;
    u32x4 nx[2]; unsigned nkr = 0u; int npos = 0;
    if (gw < TCH) { const u32x4* src = (const u32x4*)(a.QBR + (size_t)gw * 1024); nx[0] = src[lane]; nx[1] = src[64 + lane]; if (lane < 16) nkr = ((const unsigned*)(a.KR + (size_t)gw * 32))[lane]; npos = a.pos[gw]; }
    int buf = 0;
    for (int tok = gw; tok < TCH; tok += ngw, buf ^= 1) {
        LAS unsigned char* rowb = wl + buf * 4096;
        *(LAS u32x4*)(rowb + lane * 16) = nx[0]; *(LAS u32x4*)(rowb + (64 + lane) * 16) = nx[1]; if (lane < 16) *(LAS unsigned*)(rowb + 2048 + lane * 4) = nkr;
        const int pos = npos;
        if (tok + ngw < TCH) { const u32x4* src = (const u32x4*)(a.QBR + (size_t)(tok + ngw) * 1024); nx[0] = src[lane]; nx[1] = src[64 + lane]; if (lane < 16) nkr = ((const unsigned*)(a.KR + (size_t)(tok + ngw) * 32))[lane]; npos = a.pos[tok + ngw]; }
        const int bl = tok / SEQ, s = tok % SEQ;
        float c32 = 0.f, s32 = 0.f; if (i32 < 16) rope_cs(a.R, pos, i32, 16, c32, s32);
        const LAS bf16_t* q = (const LAS bf16_t*)rowb; const LAS bf16_t* kv = q + 512; const LAS bf16_t* krl = q + 1024;
        bf16_t* qo = a.QB + (size_t)tok * 384; bf16_t* ko = a.KB + (size_t)tok * 384;
#pragma unroll
        for (int it = 0; it < 2; ++it) {
            const int h = 2 * it + hf;
            { const float x1 = bf2f(q[h * 96 + i32]), x2 = bf2f(q[h * 96 + 32 + i32]);
              const float rstd = 1.0f / sqrtf(sum32(x1 * x1 + x2 * x2) * (1.0f / 64.0f) + EPS);
              qo[h * 96 + i32] = (bf16_t)f2bf(x1 * rstd * a.qn_g[i32] * SC_B); qo[h * 96 + 32 + i32] = (bf16_t)f2bf(x2 * rstd * a.qn_g[32 + i32] * SC_B); }
            { const bool on = i32 < 16; const float x1 = on ? bf2f(q[h * 96 + 64 + i32]) : 0.f, x2 = on ? bf2f(q[h * 96 + 80 + i32]) : 0.f;
              const float rstd = 1.0f / sqrtf(sum32(x1 * x1 + x2 * x2) * (1.0f / 32.0f) + EPS);
              const float y1 = x1 * rstd * (on ? a.qr_g[i32] : 0.f), y2 = x2 * rstd * (on ? a.qr_g[16 + i32] : 0.f);
              if (on) { qo[h * 96 + 64 + i32] = (bf16_t)f2bf((y1 * c32 - y2 * s32) * SC_B); qo[h * 96 + 80 + i32] = (bf16_t)f2bf((y2 * c32 + y1 * s32) * SC_B); } }
            { const float x1 = bf2f(kv[h * 128 + i32]), x2 = bf2f(kv[h * 128 + 32 + i32]);
              const float rstd = 1.0f / sqrtf(sum32(x1 * x1 + x2 * x2) * (1.0f / 64.0f) + EPS);
              ko[h * 96 + i32] = (bf16_t)f2bf(x1 * rstd * a.kn_g[i32]); ko[h * 96 + 32 + i32] = (bf16_t)f2bf(x2 * rstd * a.kn_g[32 + i32]);
              ko[h * 96 + 64 + i32] = krl[i32];
              a.VBT[((size_t)(bl * 4 + h) * 64 + i32) * SEQ + s] = kv[h * 128 + 64 + i32];
              a.VBT[((size_t)(bl * 4 + h) * 64 + 32 + i32) * SEQ + s] = kv[h * 128 + 96 + i32]; }
        }
    }
}

struct RouteArgs { const float* rw; int* TOPE; float* TOPG; int* TOPD; unsigned* cursor; };
template <bool ROUTE>
__device__ __forceinline__ void norm2_rows(const float* x, const float* g, bf16_t* HB, unsigned char* HF8  , const RouteArgs& ra, LAS unsigned* lcnt  , int vcu, int wave, int lane, int G) {
    asm volatile("" : "+v"(lane));
    int tidx = wave * 64 + lane;
    const int tpw = TCH / G; const int t0 = vcu * tpw;
    f32x4 gv[4];
#pragma unroll
    for (int j = 0; j < 4; ++j) gv[j] = *(const f32x4*)(g + 4 * lane + 256 * j);
    for (int tl = wave; tl < tpw; tl += NWAVES) {
        const int tok = t0 + tl;
        const float* xr = x + (size_t)tok * DM; f32x4 v[4]; float ss = 0.f;
#pragma unroll
        for (int j = 0; j < 4; ++j) { v[j] = *(const f32x4*)(xr + 4 * lane + 256 * j); ss += (v[j].x * v[j].x + v[j].y * v[j].y) + (v[j].z * v[j].z + v[j].w * v[j].w); }
        const float rstd = 1.0f / sqrtf(wave_sum(ss) * (1.0f / DM) + EPS);
        bf16_t* o = HB + (size_t)tok * DM;
#pragma unroll
        for (int j = 0; j < 4; ++j) { v[j].x *= rstd * gv[j].x; v[j].y *= rstd * gv[j].y; v[j].z *= rstd * gv[j].z; v[j].w *= rstd * gv[j].w;
            u32x2 w; w.x = pk2(v[j].x, v[j].y); w.y = pk2(v[j].z, v[j].w); *(u32x2*)(o + 4 * lane + 256 * j) = w;
            if (!ROUTE) *(unsigned*)(HF8 + (size_t)tok * DM + 4 * lane + 256 * j) = pk4_fp8(v[j].x, v[j].y, v[j].z, v[j].w); }
        if (ROUTE) {
            float lg[NEXP];
#pragma unroll
            for (int e = 0; e < NEXP; ++e) lg[e] = 0.f;
#pragma unroll
            for (int j = 0; j < 4; ++j)
#pragma unroll
                for (int c = 0; c < 4; ++c) { const float hv = v[j][c]; const float* wr = ra.rw + (size_t)(4 * lane + 256 * j + c) * NEXP;
                    const f32x4 w0 = *(const f32x4*)wr, w1 = *(const f32x4*)(wr + 4);
                    lg[0] += hv * w0.x; lg[1] += hv * w0.y; lg[2] += hv * w0.z; lg[3] += hv * w0.w; lg[4] += hv * w1.x; lg[5] += hv * w1.y; lg[6] += hv * w1.z; lg[7] += hv * w1.w; }
#pragma unroll
            for (int e = 0; e < NEXP; ++e) lg[e] = wave_sum(lg[e]);
            int e1 = 0; float l1 = lg[0];
#pragma unroll
            for (int e = 1; e < NEXP; ++e) if (lg[e] > l1) { l1 = lg[e]; e1 = e; }
            int e2 = -1; float l2 = -INFINITY;
#pragma unroll
            for (int e = 0; e < NEXP; ++e) if (e != e1 && lg[e] > l2) { l2 = lg[e]; e2 = e; }
            const float ex = __expf(l2 - l1); const float g1 = 1.0f / (1.0f + ex), g2 = ex / (1.0f + ex);
            if (lane == 0) {
                const unsigned p1 = lds_add(lcnt + e1, 1u), p2 = lds_add(lcnt + e2, 1u);
                ra.TOPE[2 * tok] = e1; ra.TOPE[2 * tok + 1] = e2; ra.TOPG[2 * tok] = g1; ra.TOPG[2 * tok + 1] = g2; ra.TOPD[2 * tok] = (int)p1; ra.TOPD[2 * tok + 1] = (int)p2;
            }
        }
    }
    if (ROUTE) {
        VM_WAIT(); __syncthreads();
        if (tidx < NEXP) { const unsigned n = lcnt[tidx]; lcnt[8 + tidx] = __hip_atomic_fetch_add(ra.cursor + tidx, n, __ATOMIC_RELAXED, __HIP_MEMORY_SCOPE_AGENT); }
        __syncthreads();
        for (int i = tidx; i < 2 * tpw; i += NWAVES * 64) { const int idx = 2 * t0 + i; const int e = ra.TOPE[idx]; ra.TOPD[idx] += (int)lcnt[8 + e]; }
        __syncthreads();
        if (tidx < 16) lcnt[tidx] = 0u;
        __syncthreads();
    }
}

__device__ __forceinline__ void moe_layout(const unsigned* cursor, int* pstart  ) {
    int acc = 0;
#pragma unroll
    for (int e = 0; e < NEXP; ++e) { pstart[e] = acc; const int c = (int)__hip_atomic_load(cursor + e, __ATOMIC_RELAXED, __HIP_MEMORY_SCOPE_AGENT); acc += (c + 255) / 256 * 256; }
    pstart[NEXP] = acc;
}
__device__ __forceinline__ void moe_scatter(const unsigned* cursor, const int* TOPE, int* TOPD, const bf16_t* HB, bf16_t* XB, int* BLKE, int gw, int ngw, int lane) {
    asm volatile("" : "+v"(lane));
    int ps[NEXP + 1]; moe_layout(cursor, ps);
    for (int i = gw; i < 2 * TCH; i += ngw) { const int e = TOPE[i];
        int base = 0;
#pragma unroll
        for (int k = 1; k < NEXP; ++k) base = (e == k) ? ps[k] : base;
        const int dest = base + TOPD[i];
        const u32x4* src = (const u32x4*)(HB + (size_t)(i >> 1) * DM); u32x4* dst = (u32x4*)((unsigned char*)XB + (size_t)dest * DM);
        const u32x4 v0 = src[2 * lane], v1 = src[2 * lane + 1];
        u32x4 o; o.x = pk4_fp8(bflo(v0.x), bfhi(v0.x), bflo(v0.y), bfhi(v0.y)); o.y = pk4_fp8(bflo(v0.z), bfhi(v0.z), bflo(v0.w), bfhi(v0.w));
        o.z = pk4_fp8(bflo(v1.x), bfhi(v1.x), bflo(v1.y), bfhi(v1.y)); o.w = pk4_fp8(bflo(v1.z), bfhi(v1.z), bflo(v1.w), bfhi(v1.w));
        dst[lane] = o;
        if (lane == 0) TOPD[i] = dest; }
#pragma unroll
    for (int e = 0; e < NEXP; ++e) { const int cnt = (int)__hip_atomic_load(cursor + e, __ATOMIC_RELAXED, __HIP_MEMORY_SCOPE_AGENT);
        for (int r = ps[e] + cnt + gw; r < ps[e + 1]; r += ngw) { u32x4* dst = (u32x4*)((unsigned char*)XB + (size_t)r * DM); dst[lane] = (u32x4){0u, 0u, 0u, 0u}; }
        for (int blk = ps[e] / 256 + gw * 64 + lane; blk < ps[e + 1] / 256; blk += ngw * 64) BLKE[blk] = e; }
}
__device__ __forceinline__ void moe_combine(float* xio, const bf16_t* YM, const int* TOPD, const float* TOPG, int gw, int ngw, int lane) {
    asm volatile("" : "+v"(lane));
    for (int tok = gw; tok < TCH; tok += ngw) {
        const int d1 = TOPD[2 * tok], d2 = TOPD[2 * tok + 1]; const float g1 = TOPG[2 * tok], g2 = TOPG[2 * tok + 1];
        float* xr = xio + (size_t)tok * DM; const bf16_t* y1 = YM + (size_t)d1 * DM; const bf16_t* y2 = YM + (size_t)d2 * DM;
#pragma unroll
        for (int j = 0; j < 4; ++j) { const int c = 4 * lane + 256 * j; f32x4 v = *(const f32x4*)(xr + c); const u32x2 a = *(const u32x2*)(y1 + c), b = *(const u32x2*)(y2 + c);
            v.x += bflo(a.x) * g1 + bflo(b.x) * g2; v.y += bfhi(a.x) * g1 + bfhi(b.x) * g2; v.z += bflo(a.y) * g1 + bflo(b.y) * g2; v.w += bfhi(a.y) * g1 + bfhi(b.y) * g2;
            *(f32x4*)(xr + c) = v; }
    }
}

__device__ __forceinline__ int kappa32(int m) { return (m & ~12) | ((m & 8) >> 1) | ((m & 4) << 1); }
template <int DQK>
__device__ __forceinline__ void fa_unit(LAS unsigned char* lds, int wave_, const bf16_t* Qw, int qpitch, const bf16_t* Kb, int kpitch, const bf16_t* VTb,
                                        int tile_lo, int tile_hi, int qpos0w, int window, float m_init, float l_init, bf16_t* Ow, int opitch) {
    constexpr int KP = DQK * 2 + 16, VP = 144, KBUF = 64 * KP, VBUF = 64 * VP, KCH = DQK / 8, NKC = 64 * KCH;
    int tid = wave_ * 64 + lane_id(); asm volatile("" : "+v"(tid));
    const int lane = tid & 63, r32 = lane & 31, hi = lane >> 5;
    bf16x8 qf[DQK / 16];
#pragma unroll
    for (int d0 = 0; d0 < DQK / 16; ++d0) qf[d0] = *(const bf16x8*)(Qw + (size_t)r32 * qpitch + d0 * 16 + hi * 8);
    const int kr0 = tid / KCH, kc0 = tid % KCH, kr1 = (tid + 512) / KCH, kc1 = (tid + 512) % KCH; const bool has1 = (tid + 512) < NKC;
    const int vr = tid >> 3, vc = tid & 7;
    u32x4 pk0, pk1 = (u32x4){0u, 0u, 0u, 0u}, pv;
#define FA_LOAD(t) do { const bf16_t* kt_ = Kb + (size_t)(64 * (t)) * kpitch; pk0 = *(const u32x4*)(kt_ + (size_t)kr0 * kpitch + kc0 * 8); if (has1) pk1 = *(const u32x4*)(kt_ + (size_t)kr1 * kpitch + kc1 * 8); \
        pv = *(const u32x4*)(VTb + (size_t)vr * SEQ + 64 * (t) + vc * 8); } while (0)
#define FA_STORE(b) do { LAS unsigned char* kd_ = lds + (b) * KBUF; *(LAS u32x4*)(kd_ + kr0 * KP + kc0 * 16) = pk0; if (has1) *(LAS u32x4*)(kd_ + kr1 * KP + kc1 * 16) = pk1; \
        *(LAS u32x4*)(lds + 2 * KBUF + (b) * VBUF + vr * VP + vc * 16) = pv; } while (0)
    float m_run = m_init, l_run = (hi == 0) ? l_init : 0.f;
    f32x16 o0, o1;
#pragma unroll
    for (int i = 0; i < 16; ++i) { o0[i] = 0.f; o1[i] = 0.f; }
    const int qpos = qpos0w + r32; const int krow = kappa32(r32);
    __syncthreads();
    FA_LOAD(tile_lo); FA_STORE(0);
    __syncthreads();
    for (int t = tile_lo; t < tile_hi; ++t) {
        const int buf = (t - tile_lo) & 1;
        if (t + 1 < tile_hi) FA_LOAD(t + 1);
        const int kbase = 64 * t;
        const bool active = (kbase <= qpos0w + 31) && (window == 0 || kbase + 63 > qpos0w - window);
        if (active) {
            const LAS unsigned char* Kt = lds + buf * KBUF; const LAS unsigned char* Vt = lds + 2 * KBUF + buf * VBUF;
            f32x16 s0, s1;
#pragma unroll
            for (int i = 0; i < 16; ++i) { s0[i] = 0.f; s1[i] = 0.f; }
#pragma unroll
            for (int d0 = 0; d0 < DQK / 16; ++d0) {
                const bf16x8 k0 = *(const LAS bf16x8*)(Kt + krow * KP + d0 * 32 + hi * 16);
                const bf16x8 k1 = *(const LAS bf16x8*)(Kt + (32 + krow) * KP + d0 * 32 + hi * 16);
                s0 = __builtin_amdgcn_mfma_f32_32x32x16_bf16(k0, qf[d0], s0, 0, 0, 0);
                s1 = __builtin_amdgcn_mfma_f32_32x32x16_bf16(k1, qf[d0], s1, 0, 0, 0);
            }
            const bool need_mask = (kbase + 63 > qpos0w) || (window != 0 && kbase <= qpos0w + 31 - window);
            if (need_mask) {
#pragma unroll
                for (int i = 0; i < 16; ++i) { const int key = kbase + 16 * (i >> 3) + 8 * hi + (i & 7);
                    const bool ok0 = (key <= qpos) && (window == 0 || key > qpos - window), ok1 = (key + 32 <= qpos) && (window == 0 || key + 32 > qpos - window);
                    s0[i] = ok0 ? s0[i] : -INFINITY; s1[i] = ok1 ? s1[i] : -INFINITY; }
            }
            float mx = fmaxf(s0[0], s1[0]);
#pragma unroll
            for (int i = 1; i < 16; ++i) mx = fmaxf(mx, fmaxf(s0[i], s1[i]));
            mx = half_max(mx);
            const float m_new = fmaxf(m_run, mx); const float m_use = (m_new == -INFINITY) ? 0.f : m_new;
            const float alpha = fast_exp2(m_run - m_use);
            m_run = m_new;
            float rs = 0.f;
#pragma unroll
            for (int i = 0; i < 16; ++i) { s0[i] = fast_exp2(s0[i] - m_use); s1[i] = fast_exp2(s1[i] - m_use); rs += s0[i] + s1[i]; }
            l_run = l_run * alpha + rs;
#pragma unroll
            for (int i = 0; i < 16; ++i) { o0[i] *= alpha; o1[i] *= alpha; }
            u32x4 w0, w1, w2, w3;
            w0.x = cvt_pk_bf16(s0[0], s0[1]); w0.y = cvt_pk_bf16(s0[2], s0[3]); w0.z = cvt_pk_bf16(s0[4], s0[5]); w0.w = cvt_pk_bf16(s0[6], s0[7]);
            w1.x = cvt_pk_bf16(s0[8], s0[9]); w1.y = cvt_pk_bf16(s0[10], s0[11]); w1.z = cvt_pk_bf16(s0[12], s0[13]); w1.w = cvt_pk_bf16(s0[14], s0[15]);
            w2.x = cvt_pk_bf16(s1[0], s1[1]); w2.y = cvt_pk_bf16(s1[2], s1[3]); w2.z = cvt_pk_bf16(s1[4], s1[5]); w2.w = cvt_pk_bf16(s1[6], s1[7]);
            w3.x = cvt_pk_bf16(s1[8], s1[9]); w3.y = cvt_pk_bf16(s1[10], s1[11]); w3.z = cvt_pk_bf16(s1[12], s1[13]); w3.w = cvt_pk_bf16(s1[14], s1[15]);
            const bf16x8 pa0 = __builtin_bit_cast(bf16x8, w0), pa1 = __builtin_bit_cast(bf16x8, w1), pa2 = __builtin_bit_cast(bf16x8, w2), pa3 = __builtin_bit_cast(bf16x8, w3);
#define FA_PV(o, dt) do { const LAS unsigned char* vrow_ = Vt + (32 * (dt) + r32) * VP + hi * 16; \
                o = __builtin_amdgcn_mfma_f32_32x32x16_bf16(*(const LAS bf16x8*)(vrow_), pa0, o, 0, 0, 0); o = __builtin_amdgcn_mfma_f32_32x32x16_bf16(*(const LAS bf16x8*)(vrow_ + 32), pa1, o, 0, 0, 0); \
                o = __builtin_amdgcn_mfma_f32_32x32x16_bf16(*(const LAS bf16x8*)(vrow_ + 64), pa2, o, 0, 0, 0); o = __builtin_amdgcn_mfma_f32_32x32x16_bf16(*(const LAS bf16x8*)(vrow_ + 96), pa3, o, 0, 0, 0); } while (0)
            FA_PV(o0, 0); FA_PV(o1, 1);
#undef FA_PV
        }
        if (t + 1 < tile_hi) FA_STORE(buf ^ 1);
        __syncthreads();
    }
#undef FA_LOAD
#undef FA_STORE
    const float l_tot = half_sum(l_run); const float inv = 1.0f / l_tot;
    bf16_t* orow = Ow + (size_t)r32 * opitch + 4 * hi;
#pragma unroll
    for (int g = 0; g < 4; ++g) {
        u32x2 a; a.x = cvt_pk_bf16(o0[4 * g] * inv, o0[4 * g + 1] * inv); a.y = cvt_pk_bf16(o0[4 * g + 2] * inv, o0[4 * g + 3] * inv); *(u32x2*)(orow + 8 * g) = a;
        u32x2 b; b.x = cvt_pk_bf16(o1[4 * g] * inv, o1[4 * g + 1] * inv); b.y = cvt_pk_bf16(o1[4 * g + 2] * inv, o1[4 * g + 3] * inv); *(u32x2*)(orow + 32 + 8 * g) = b;
    }
}

struct IdxArgs { const bf16_t* IQ; const bf16_t* IK; const float* IW; unsigned short* SEL; int* SELN; };
__device__ __forceinline__ unsigned mono_key(float f) { const unsigned u = __float_as_uint(f); return u ^ ((unsigned)((int)u >> 31) | 0x80000000u); }
__device__ __forceinline__ int crow32(int i, int hi) { return (i & 3) + 8 * (i >> 2) + 4 * hi; }

#ifndef MK_SC2
#define MK_SC2 0
#endif
constexpr int IDX_QP = 656;
__device__ __forceinline__ void idx_scores(f32x16& sc, const LAS unsigned char* qrow  , const float (&c)[8], const bf16x8 ka0, const bf16x8 ka1) {
    f32x16 z[8], zero;
#pragma unroll
    for (int i = 0; i < 16; ++i) zero[i] = 0.f;
#define IDX_F(slot, ks) (*(const LAS bf16x8*)(qrow + (slot) * 64 + (ks) * 32))
    bf16x8 f0 = IDX_F(8, 0), f1 = IDX_F(0, 0);
    sc = __builtin_amdgcn_mfma_f32_32x32x16_bf16(ka0, f0, zero, 0, 0, 0); f0 = IDX_F(1, 0);
#pragma unroll
    for (int h = 0; h < 8; h += 2) {
        z[h] = __builtin_amdgcn_mfma_f32_32x32x16_bf16(ka0, f1, zero, 0, 0, 0); f1 = (h + 2 < 8) ? IDX_F(h + 2, 0) : IDX_F(9, 0);
        z[h + 1] = __builtin_amdgcn_mfma_f32_32x32x16_bf16(ka0, f0, zero, 0, 0, 0); f0 = (h + 3 < 8) ? IDX_F(h + 3, 0) : IDX_F(8, 1);
    }
    sc = __builtin_amdgcn_mfma_f32_32x32x16_bf16(ka0, f1, sc, 0, 0, 0); f1 = IDX_F(0, 1);
    sc = __builtin_amdgcn_mfma_f32_32x32x16_bf16(ka1, f0, sc, 0, 0, 0); f0 = IDX_F(1, 1);
#pragma unroll
    for (int h = 0; h < 8; h += 2) {
        z[h] = __builtin_amdgcn_mfma_f32_32x32x16_bf16(ka1, f1, z[h], 0, 0, 0); f1 = (h + 2 < 8) ? IDX_F(h + 2, 1) : IDX_F(9, 1);
        z[h + 1] = __builtin_amdgcn_mfma_f32_32x32x16_bf16(ka1, f0, z[h + 1], 0, 0, 0); if (h + 3 < 8) f0 = IDX_F(h + 3, 1);
    }
    sc = __builtin_amdgcn_mfma_f32_32x32x16_bf16(ka1, f1, sc, 0, 0, 0);
#undef IDX_F
#pragma unroll
    for (int h = 0; h < 8; ++h)
#pragma unroll
        for (int i = 0; i < 16; ++i) sc[i] = __builtin_fmaf(__builtin_fabsf(z[h][i]), c[h], sc[i]);
}
#define IDX_LOADK(k0, k1, tile_) do { const bf16_t* ikt_ = ikb + (size_t)(tile_) * 32 * 32; k0 = *(const bf16x8*)(ikt_ + r32 * 32 + hi * 8); k1 = *(const bf16x8*)(ikt_ + r32 * 32 + 16 + hi * 8); } while (0)
template <int WPL>
__device__ __forceinline__ bool hist_scan(const LAS unsigned* hw, int lane, unsigned need, int& bin, unsigned& above, unsigned& nb) {
    asm volatile("" : "+v"(lane));
    unsigned w[WPL]; unsigned tot = 0;
#pragma unroll
    for (int i = 0; i < WPL; i += 4) { const u32x4 v = *(const LAS u32x4*)(hw + WPL * lane + i); w[i] = v.x; w[i + 1] = v.y; w[i + 2] = v.z; w[i + 3] = v.w; }
#pragma unroll
    for (int i = 0; i < WPL; ++i) tot += (w[i] & 0xffffu) + (w[i] >> 16);
    unsigned suf = tot;
#pragma unroll
    for (int d = 1; d < 64; d <<= 1) { const unsigned t = (unsigned)lane_get((int)suf, (lane + d) & 63); if (lane + d < 64) suf += t; }
    const unsigned total = (unsigned)lane_bcast((int)suf, 0);
    if (total < need) { above = total; return false; }
    const unsigned ab = suf - tot;
    const bool mine = (ab < need) && (need <= suf);
    int b_ = 0; unsigned a_ = 0, n_ = 0;
    if (mine) { unsigned acc = ab; bool done = false;
#pragma unroll
        for (int i = WPL - 1; i >= 0; --i) {
            const unsigned chi = w[i] >> 16, clo = w[i] & 0xffffu;
            if (!done && acc + chi >= need) { done = true; b_ = 2 * (WPL * lane + i) + 1; a_ = acc; n_ = chi; } if (!done) acc += chi;
            if (!done && acc + clo >= need) { done = true; b_ = 2 * (WPL * lane + i); a_ = acc; n_ = clo; } if (!done) acc += clo; } }
    const unsigned long long bal = __ballot(mine); const int src = __ffsll((long long)bal) - 1;
    bin = lane_bcast(b_, src); above = (unsigned)lane_bcast((int)a_, src); nb = (unsigned)lane_bcast((int)n_, src);
    return true;
}
template <int P>
__device__ __forceinline__ void idx_hist_tiles(LAS unsigned* hrow, const LAS unsigned char* qrow, const float (&w)[8], const bf16_t* ikb, int wid, int ntile, int qpos, int r32, int hi, bool mine, unsigned pfx) {
    bf16x8 kb[4][2];
#pragma unroll
    for (int u = 0; u < 4; ++u) if (wid + 8 * u < ntile) IDX_LOADK(kb[u][0], kb[u][1], wid + 8 * u);
#pragma unroll 1
    for (int base = wid; base < ntile; base += 32) {
#pragma unroll
        for (int u = 0; u < 4; ++u) { const int tile = base + 8 * u; if (tile < ntile) {
            const bf16x8 ka0 = kb[u][0], ka1 = kb[u][1];
            f32x16 sc; idx_scores(sc, qrow, w, ka0, ka1);
            if (tile + 32 < ntile) IDX_LOADK(kb[u][0], kb[u][1], tile + 32);
            const int lim = (tile == ntile - 1) ? qpos - 32 * tile : 64;
#pragma unroll
            for (int i = 0; i < 16; ++i) {
                bool ok = mine && (crow32(i, hi) <= lim); unsigned bin;
                if (P == 0) { bin = mono_key(sc[i]) >> 21; }
                else { const unsigned k = mono_key(sc[i]);
                    if (P == 1) { ok = false; bin = 0u; }
                    else if (P == 2) { ok = ok && ((k >> 21) == pfx); bin = (k >> 10) & 2047u; }
                    else { ok = ok && ((k >> 10) == pfx); bin = k & 1023u; } }
                if (ok) lds_add(hrow + (bin >> 1), 1u << (16 * (bin & 1u))); }
            __builtin_amdgcn_sched_barrier(0);
        } }
    }
}
__device__ __forceinline__ void idx_unit(LAS unsigned char* lds, int wave_, const IdxArgs& a, int rowb  , int qb32) {
    int tid = wave_ * 64 + lane_id(); asm volatile("" : "+v"(tid));
    const int lane = tid & 63, wid = wave_, r32 = lane & 31, hi = lane >> 5;
    const int q0 = 32 * qb32, ntile = qb32 + 1, qpos = q0 + r32;
    LAS unsigned* hist = (LAS unsigned*)(lds + IDX_HIST);
    LAS unsigned* bitmap = (LAS unsigned*)(lds + IDX_BITMAP);
    LAS unsigned* candk = (LAS unsigned*)(lds + IDX_CANDK);
    LAS unsigned short* candi = (LAS unsigned short*)(lds + IDX_CANDI);
    LAS unsigned* subh = (LAS unsigned*)(lds + IDX_SUBH) + wid * 512;
    LAS unsigned* qpar = (LAS unsigned*)(lds + IDX_QPAR);
    LAS unsigned* ccnt = (LAS unsigned*)(lds + IDX_CCNT);
    LAS unsigned* flag = (LAS unsigned*)(lds + IDX_FLAG);
    if (q0 + 32 <= 256) {
        __syncthreads();
        for (int q = wid; q < 32; q += NWAVES) { const int t = q0 + q; unsigned short* sp = a.SEL + (size_t)(rowb + t) * 256;
#pragma unroll
            for (int j = 0; j < 4; ++j) { const int k = lane + 64 * j; sp[k] = (unsigned short)(k <= t ? k : 0); }
            if (lane == 0) a.SELN[rowb + t] = t + 1; }
        return;
    }
    float w[8];
#pragma unroll
    for (int h = 0; h < 8; ++h) w[h] = 0.5f * a.IW[(size_t)(rowb + qpos) * 8 + h];
    const LAS unsigned char* qrow = lds + IDX_QT + r32 * IDX_QP + hi * 16;
    const bf16_t* ikb = a.IK + (size_t)rowb * 32;
    __syncthreads();
#pragma unroll
    for (int i = 0; i < 2; ++i) { const int c = tid + 512 * i, row = c >> 5, c16 = c & 31;
        *(LAS u32x4*)(lds + IDX_QT + row * IDX_QP + c16 * 16) = *(const u32x4*)(a.IQ + (size_t)(rowb + q0 + row) * 256 + c16 * 8); }
    __syncthreads();
    { const int q = tid >> 4, d2 = (tid & 15) * 2; const float* wq = a.IW + (size_t)(rowb + q0 + q) * 8; float s0 = 0.f, s1 = 0.f;
#pragma unroll
      for (int h = 0; h < 8; ++h) { const unsigned pr = *(const LAS unsigned*)(lds + IDX_QT + q * IDX_QP + h * 64 + d2 * 2); const float wh = 0.5f * wq[h]; s0 += wh * bflo(pr); s1 += wh * bfhi(pr); }
      const unsigned h0 = f2bf(s0), h1 = f2bf(s1); const float r0 = s0 - bf2f((bf16_t)h0), r1 = s1 - bf2f((bf16_t)h1);
      *(LAS unsigned*)(lds + IDX_QT + q * IDX_QP + 8 * 64 + d2 * 2) = h0 | (h1 << 16);
      *(LAS unsigned*)(lds + IDX_QT + q * IDX_QP + 9 * 64 + d2 * 2) = pk2(r0, r1); }
    if (tid < 256) { const int q = tid >> 3, f = tid & 7; const bool all = (q0 + q + 1 <= 256); qpar[tid] = (f == 0) ? (all ? 2u : 0u) : ((f == 2) ? 256u : 0u); }
    if (tid < 32) ccnt[tid] = 0u;
    if (tid < 8) flag[tid] = (tid == 0) ? 1u : 0u;
#pragma unroll 1
    for (int p = 0; p < 4; ++p) {
        __syncthreads();
        if (flag[p] == 0u) continue;
        for (int i = tid; i < 32 * IDX_HP / 4; i += NWAVES * 64) ((LAS u32x4*)hist)[i] = (u32x4){0u, 0u, 0u, 0u};
        __syncthreads();
        const bool mine = (qpar[8 * r32] == 0u) && (qpar[8 * r32 + 4] == (unsigned)p); const unsigned pfx = qpar[8 * r32 + 1];
        TB(1);
        if (__any(mine)) {
            LAS unsigned* hrow = hist + r32 * IDX_HP;
            if (p == 0) idx_hist_tiles<0>(hrow, qrow, w, ikb, wid, ntile, qpos, r32, hi, mine, pfx);
            else if (p == 1) idx_hist_tiles<1>(hrow, qrow, w, ikb, wid, ntile, qpos, r32, hi, mine, pfx);
            else if (p == 2) idx_hist_tiles<2>(hrow, qrow, w, ikb, wid, ntile, qpos, r32, hi, mine, pfx);
            else idx_hist_tiles<3>(hrow, qrow, w, ikb, wid, ntile, qpos, r32, hi, mine, pfx);
        }
        TE(1);
        __syncthreads();
        TB(2);
        for (int j = 0; j < 4; ++j) { const int q = 4 * wid + j; const unsigned qs = qpar[8 * q], need = qpar[8 * q + 2], qp = qpar[8 * q + 1];
            if (qs != 0u || qpar[8 * q + 4] != (unsigned)p) continue;
            int bin; unsigned above, nb; const bool found = hist_scan<16>(hist + q * IDX_HP, lane, need, bin, above, nb);
            if (lane == 0) {
                if (!found) { if (false) { }
                              else { qpar[8 * q] = 2u; qpar[8 * q + 2] = 0u; } }
                else { const unsigned np = (p == 0) ? (unsigned)bin : (p == 2 ? ((qp << 11) | (unsigned)bin) : ((qp << 10) | (unsigned)bin));
                    qpar[8 * q + 1] = np; qpar[8 * q + 2] = need - above; qpar[8 * q + 3] = (p <= 1) ? 21u : (p == 2 ? 10u : 0u);
                    const unsigned shn = (p <= 1) ? 21u : (p == 2 ? 10u : 0u); const unsigned klo = np << shn; const unsigned long long khi = ((unsigned long long)np + 1ull) << shn;
                    qpar[8 * q + 5] = (klo & 0x80000000u) ? (klo ^ 0x80000000u) : ~klo;
                    qpar[8 * q + 6] = (khi >> 32) ? 0x7f800000u : (((unsigned)khi & 0x80000000u) ? ((unsigned)khi ^ 0x80000000u) : ~(unsigned)khi);
                    if (nb <= (unsigned)IDX_CCAP || p == 3) qpar[8 * q] = 1u; else { const unsigned nx = (p <= 1) ? 2u : 3u; qpar[8 * q + 4] = nx; flag[nx] = 1u; } } }
        }
        TE(2);
    }
    __syncthreads();
    for (int i = tid; i < 32 * 256 / 4; i += NWAVES * 64) ((LAS u32x4*)bitmap)[i] = (u32x4){0u, 0u, 0u, 0u};
    __syncthreads();
    TB(3);
    { const unsigned st = qpar[8 * r32]; const float tcand = (st == 2u) ? -INFINITY : __uint_as_float(qpar[8 * r32 + 5]), tsel = (st == 2u) ? -INFINITY : __uint_as_float(qpar[8 * r32 + 6]);
      bf16x8 kb[4][2];
#pragma unroll
      for (int u = 0; u < 4; ++u) if (wid + 8 * u < ntile) IDX_LOADK(kb[u][0], kb[u][1], wid + 8 * u);
#pragma unroll 1
      for (int base = wid; base < ntile; base += 32) {
#pragma unroll
          for (int u = 0; u < 4; ++u) { const int tile = base + 8 * u; if (tile < ntile) {
              const bf16x8 ka0 = kb[u][0], ka1 = kb[u][1];
              f32x16 sc; idx_scores(sc, qrow, w, ka0, ka1);
#if MK_SC2
              asm volatile("" : "+v"(sc)); { bf16x8 kx0 = ka0, kx1 = ka1; asm volatile("" : "+v"(kx0), "+v"(kx1)); idx_scores(sc, qrow, w, kx0, kx1); asm volatile("" : "+v"(sc)); }
#endif
              if (tile + 32 < ntile) IDX_LOADK(kb[u][0], kb[u][1], tile + 32);
              const int lim = (tile == ntile - 1) ? qpos - 32 * tile : 64;
#pragma unroll
              for (int i = 0; i < 16; ++i) {
                  if (sc[i] >= tcand && crow32(i, hi) <= lim) { const int key = 32 * tile + crow32(i, hi);
                      if (sc[i] >= tsel) lds_or(bitmap + r32 * 256 + (key >> 5), 1u << (key & 31));
                      else { const unsigned pos = lds_add(ccnt + r32, 1u); if (pos < (unsigned)IDX_CCAP) { candk[r32 * IDX_CCAP + pos] = mono_key(sc[i]); candi[r32 * IDX_CCAP + pos] = (unsigned short)key; } } } }
              __builtin_amdgcn_sched_barrier(0);
          } }
      } }
    TE(3);
    __syncthreads();
    TB(4);
    for (int j = 0; j < 4; ++j) {
        const int q = 4 * wid + j; const unsigned st = qpar[8 * q]; unsigned need = qpar[8 * q + 2]; const unsigned sh = qpar[8 * q + 3];
        const int nc = (st == 1u) ? (int)min(ccnt[q], (unsigned)IDX_CCAP) : 0;
        LAS unsigned* bm = bitmap + q * 256; const LAS unsigned* ck = candk + q * IDX_CCAP; const LAS unsigned short* ci = candi + q * IDX_CCAP;
        if (nc > 0) {
            if ((unsigned)nc <= need) { for (int c = lane; c < nc; c += 64) { const unsigned key = ci[c]; lds_or(bm + (key >> 5), 1u << (key & 31)); } }
            else {
                int nR = 0; LAS unsigned long long* R = (LAS unsigned long long*)subh;
                if (sh > 0u) {
                    const int nbit = sh >= 10u ? 10 : (int)sh, fs = (int)sh - nbit; const unsigned smask = (1u << nbit) - 1u;
#pragma unroll
                    for (int i = 0; i < 8; ++i) subh[8 * lane + i] = 0u;
                    LDS_WAIT();
                    for (int c = lane; c < nc; c += 64) { const unsigned sub = (ck[c] >> fs) & smask; lds_add(subh + (sub >> 1), 1u << (16 * (sub & 1u))); }
                    LDS_WAIT();
                    int b2; unsigned ab2, nb2; (void)hist_scan<8>(subh, lane, need, b2, ab2, nb2);
                    need -= ab2; LDS_WAIT();
                    for (int c0 = 0; c0 < nc; c0 += 64) { const int c = c0 + lane; bool inb = false; unsigned k = 0, key = 0;
                        if (c < nc) { k = ck[c]; key = ci[c]; const int sub = (int)((k >> fs) & smask); if (sub > b2) lds_or(bm + (key >> 5), 1u << (key & 31)); inb = (sub == b2); }
                        const unsigned long long bal = __ballot(inb); const int pos = nR + __popcll(bal & ((1ull << lane) - 1ull));
                        if (inb && pos < IDX_RCAP) R[pos] = ((unsigned long long)k << 13) | (unsigned long long)(8191u - key);
                        nR += __popcll(bal); }
                } else {
                    for (int c0 = 0; c0 < nc; c0 += 64) { const int c = c0 + lane; if (c < nc && c < IDX_RCAP) R[c] = ((unsigned long long)ck[c] << 13) | (unsigned long long)(8191u - ci[c]); }
                    nR = nc;
                }
                nR = min(nR, IDX_RCAP); LDS_WAIT();
                for (int r = lane; r < nR; r += 64) { const unsigned long long me = R[r]; unsigned better = 0;
                    for (int x = 0; x < nR; ++x) better += (R[x] > me) ? 1u : 0u;
                    if (better < need) { const unsigned key = 8191u - (unsigned)(me & 8191ull); lds_or(bm + (key >> 5), 1u << (key & 31)); } }
            }
        }
        LDS_WAIT();
        { const u32x4 bw = *(const LAS u32x4*)(bm + 4 * lane); unsigned wv[4] = {bw.x, bw.y, bw.z, bw.w};
          const int mycnt = __popc(wv[0]) + __popc(wv[1]) + __popc(wv[2]) + __popc(wv[3]);
          int pre = mycnt;
#pragma unroll
          for (int d = 1; d < 64; d <<= 1) { const int t = lane_get(pre, (lane - d) & 63); if (lane >= d) pre += t; }
          const int total = lane_bcast(pre, 63); int pos = pre - mycnt;
          unsigned short* sp = a.SEL + (size_t)(rowb + q0 + q) * 256;
#pragma unroll
          for (int wi = 0; wi < 4; ++wi) { unsigned m = wv[wi]; while (m) { const int b = __ffs((int)m) - 1; m &= m - 1u; if (pos < 256) sp[pos] = (unsigned short)(32 * (4 * lane + wi) + b); ++pos; } }
          if (lane == 0) a.SELN[rowb + q0 + q] = min(total, 256); }
        LDS_WAIT();
    }
    TE(4);
}

#undef IDX_LOADK
struct SpaArgs { const bf16_t* QA; const bf16_t* KA; const bf16_t* VA; const unsigned short* SEL; const int* SELN; bf16_t* Y; };
struct SpaPre { int nv[2]; u32x2 s4[2]; };
__device__ __forceinline__ void sparse_prefetch(SpaPre& P, const SpaArgs& a, int rowA, int rowB, int lane) {
    const int row[2] = {rowA, rowB};
#pragma unroll
    for (int q = 0; q < 2; ++q) { P.nv[q] = a.SELN[row[q]]; P.s4[q] = *(const u32x2*)(a.SEL + (size_t)row[q] * 256 + 4 * lane); }
}
__device__ __forceinline__ void sparse_pair(LAS unsigned char* wl, const SpaArgs& a, const SpaPre& P, int rowbA, int tA, int rowbB, int tB, int lane) {
    const int rowb[2] = {rowbA, rowbB}; const int row[2] = {rowbA + tA, rowbB + tB};
    LAS float* lg[2]; LAS unsigned short* sl[2]; int nv[2];
#pragma unroll
    for (int q = 0; q < 2; ++q) { lg[q] = (LAS float*)(wl + q * 8192); sl[q] = (LAS unsigned short*)(wl + q * 8192 + 4096); nv[q] = P.nv[q]; *(LAS u32x2*)(sl[q] + 4 * lane) = P.s4[q]; }
    LDS_WAIT();
    const int m16 = lane & 15, kq = lane >> 4;
    bf16x8 qf0[2], qf1[2];
#pragma unroll
    for (int q = 0; q < 2; ++q) { qf0[q] = (bf16x8){0, 0, 0, 0, 0, 0, 0, 0}; qf1[q] = qf0[q];
        if (m16 < 4) { const bf16_t* qp = a.QA + (size_t)row[q] * 256 + m16 * 64 + kq * 8; qf0[q] = *(const bf16x8*)qp; qf1[q] = *(const bf16x8*)(qp + 32); } }
#pragma unroll
    for (int tile = 0; tile < 16; ++tile)
#pragma unroll
        for (int q = 0; q < 2; ++q) {
            const int j = 16 * tile + m16; const int s = (j < nv[q]) ? (int)sl[q][j] : 0;
            const bf16_t* kp = a.KA + (size_t)(rowb[q] + s) * 64 + kq * 8;
            const bf16x8 k0 = *(const bf16x8*)kp, k1 = *(const bf16x8*)(kp + 32);
            f32x4 acc = (f32x4){0.f, 0.f, 0.f, 0.f};
            acc = __builtin_amdgcn_mfma_f32_16x16x32_bf16(qf0[q], k0, acc, 0, 0, 0);
            acc = __builtin_amdgcn_mfma_f32_16x16x32_bf16(qf1[q], k1, acc, 0, 0, 0);
            if (kq == 0) { const bool ok = j < nv[q]; f32x4 v; v.x = ok ? acc.x : -INFINITY; v.y = ok ? acc.y : -INFINITY; v.z = ok ? acc.z : -INFINITY; v.w = ok ? acc.w : -INFINITY; *(LAS f32x4*)(lg[q] + 4 * j) = v; }
        }
    LDS_WAIT();
    const int h = lane >> 4; float sm[2];
#pragma unroll
    for (int q = 0; q < 2; ++q) { float pv[16]; float mx = -INFINITY;
#pragma unroll
        for (int i = 0; i < 16; ++i) { pv[i] = lg[q][4 * (m16 + 16 * i) + h]; mx = fmaxf(mx, pv[i]); }
        mx = max16(mx);
        float s_ = 0.f;
#pragma unroll
        for (int i = 0; i < 16; ++i) { pv[i] = fast_exp2(pv[i] - mx); s_ += pv[i]; }
        sm[q] = sum16(s_);
#pragma unroll
        for (int i = 0; i < 16; ++i) lg[q][4 * (m16 + 16 * i) + h] = pv[i]; }
    LDS_WAIT();
    const int g = lane >> 3, c8 = lane & 7;
    float acc[2][4][8];
#pragma unroll
    for (int q = 0; q < 2; ++q)
#pragma unroll
        for (int h4 = 0; h4 < 4; ++h4)
#pragma unroll
            for (int c = 0; c < 8; ++c) acc[q][h4][c] = 0.f;
    const int nvm = nv[0] > nv[1] ? nv[0] : nv[1]; const int nit = (nvm + 7) >> 3;
#pragma unroll 8
    for (int it = 0; it < nit; ++it)
#pragma unroll
        for (int q = 0; q < 2; ++q) {
            const int j = 8 * it + g; const int srow = (j < nv[q]) ? (int)sl[q][j] : 0;
            const u32x4 v = *(const u32x4*)(a.VA + (size_t)(rowb[q] + srow) * 64 + c8 * 8);
            const f32x4 p = *(const LAS f32x4*)(lg[q] + 4 * j);
            const float vv[8] = {bflo(v.x), bfhi(v.x), bflo(v.y), bfhi(v.y), bflo(v.z), bfhi(v.z), bflo(v.w), bfhi(v.w)};
#pragma unroll
            for (int c = 0; c < 8; ++c) { acc[q][0][c] += p.x * vv[c]; acc[q][1][c] += p.y * vv[c]; acc[q][2][c] += p.z * vv[c]; acc[q][3][c] += p.w * vv[c]; }
        }
    LDS_WAIT();
#pragma unroll
    for (int q = 0; q < 2; ++q) {
        const float l0 = __int_as_float(lane_bcast(__float_as_int(sm[q]), 0)), l1 = __int_as_float(lane_bcast(__float_as_int(sm[q]), 16)), l2 = __int_as_float(lane_bcast(__float_as_int(sm[q]), 32)), l3 = __int_as_float(lane_bcast(__float_as_int(sm[q]), 48));
        LAS float* red = (LAS float*)(wl + q * 8192);
#pragma unroll
        for (int h4 = 0; h4 < 4; ++h4) { *(LAS f32x4*)(red + g * 256 + h4 * 64 + c8 * 8) = (f32x4){acc[q][h4][0], acc[q][h4][1], acc[q][h4][2], acc[q][h4][3]}; *(LAS f32x4*)(red + g * 256 + h4 * 64 + c8 * 8 + 4) = (f32x4){acc[q][h4][4], acc[q][h4][5], acc[q][h4][6], acc[q][h4][7]}; }
        LDS_WAIT();
        f32x4 o = (f32x4){0.f, 0.f, 0.f, 0.f};
#pragma unroll
        for (int gg = 0; gg < 8; ++gg) o += *(const LAS f32x4*)(red + gg * 256 + 4 * lane);
        const int ho = lane >> 4; const float li = 1.0f / (ho == 0 ? l0 : (ho == 1 ? l1 : (ho == 2 ? l2 : l3)));
        u32x2 w; w.x = pk2(o.x * li, o.y * li); w.y = pk2(o.z * li, o.w * li);
        if (q == 0 || row[1] != row[0]) *(u32x2*)(a.Y + (size_t)row[q] * DM + 4 * lane) = w; }
    LDS_WAIT();
}

#ifndef MK_CHECK
#define MK_CHECK 0
#endif
#ifndef MK_CHECK_L
#define MK_CHECK_L 0
#define MK_CHECK_CH 0
#endif
#ifndef MK_PER_PHASE
#define MK_PER_PHASE 0
#endif

__device__ __forceinline__ int q_next(unsigned* head, volatile LAS unsigned* bc, int wave_) {
    __syncthreads();
    if (wave_ == 0 && lane_id() == 0) bc[0] = __hip_atomic_fetch_add(head, 1u, __ATOMIC_RELAXED, __HIP_MEMORY_SCOPE_AGENT);
    __syncthreads();
    return (int)bc[0];
}

constexpr int N_PHASES_C = 1 + NCHUNK * (9 + 3) + NCHUNK * (9 + 5);
typedef __attribute__((address_space(4))) const unsigned char* kptr_t;
#define PHASE_ENV() kptr_t kp_ = (kptr_t)__builtin_amdgcn_kernarg_segment_ptr(); asm volatile("; MKPHASE %1" : "+s"(kp_) : "n"(__LINE__)); \
    unsigned char* const ws = *(unsigned char* const __attribute__((address_space(4)))*)(kp_ + 240); float* const out = *(float* const __attribute__((address_space(4)))*)(kp_ + 232); \
    unsigned char* const act = ws + WS_ACT; bf16_t* const HB = (bf16_t*)(ws + WS_HB); unsigned* const ctl = (unsigned*)(ws + WS_CTL); \
    const size_t row0 = (size_t)ch * TCH; const unsigned char* const lw = ws + WS_LAYERW + (size_t)l * SZ_LAYERW; \
    int gwl = gw, ngwl = ngw; asm volatile("" : "+s"(gwl), "+s"(ngwl)); \
    (void)out; (void)act; (void)HB; (void)ctl; (void)row0; (void)lw; (void)gwl; (void)ngwl
#define INP(k) (*(const void* const __attribute__((address_space(4)))*)(kp_ + 8 * (k)))
#define FIN(k) ((const float*)INP(k))
#define ROPE_TAB(RT) RopeTab RT; RT.c64 = (const float*)(ws + WS_ROPE); RT.s64 = RT.c64 + (size_t)NPOS * 32; RT.c32 = RT.s64 + (size_t)NPOS * 32; RT.s32 = RT.c32 + (size_t)NPOS * 16
#define ABUF(T, off) ((T*)(act + (off)))

#ifndef MK_NV
#define MK_NV 256
#endif
#ifndef MK_LB
#define MK_LB 2
#endif
__global__ void __launch_bounds__(NWAVES * 64, MK_LB) mk_fwd(Args args) {
    extern __shared__ __attribute__((aligned(16))) unsigned char lds_raw[];
    LAS unsigned char* lds = (LAS unsigned char*)lds_raw;
    volatile LAS unsigned* MISC = (volatile LAS unsigned*)(lds + MISC_OFF);
    const int wave = __builtin_amdgcn_readfirstlane((int)threadIdx.x >> 6);
#define tid (wave * 64 + lane_id())
    const int G = gridDim.x; const int bx = blockIdx.x; const int vcu = (G % 8 == 0) ? (bx % 8) * (G / 8) + bx / 8 : bx;
    const int gw = vcu * NWAVES + wave, ngw = G * NWAVES;
    for (int u = tid; u < 64; u += NWAVES * 64) MISC[u] = 0u;
    __syncthreads();
    XcdBarrier bar; bar.bar = (unsigned*)(args.ws + WS_CTL) + CW_BAR + args.pad0 * XCD_BAR_WORDS; bar.x = 0; bar.st = nullptr;
    if (!MK_PER_PHASE) bar = xcd_barrier_post((unsigned*)(args.ws + WS_CTL) + CW_BAR + args.pad0 * XCD_BAR_WORDS, MISC + 8, wave);
    int pid = 0;
#ifndef MK_ATT
#define MK_ATT 7
#endif
#ifndef MK_EN
#define MK_EN 0xffffffffu
#endif
#define EN(k) (((MK_EN) >> (k)) & 1u)
#ifndef MK_ATT_REP
#define MK_ATT_REP 7
#endif
#ifndef MK_SPA_REP
#define MK_SPA_REP 1
#endif
#ifndef MK_REP
#define MK_REP 0u
#endif
#define REPS(k) (1 + (((MK_REP) >> (k)) & 1u))
#define RUN() (args.ph_lo <= pid && pid < args.ph_hi)
#define SEAM() do { if (args.ph_lo <= pid && pid + 1 < args.ph_hi) { TB(5); xcd_barrier(bar, wave); TE(5); } ++pid; } while (0)

    if (EN(0) && RUN()) for (int rep_ = 0; rep_ < (int)REPS(0); ++rep_) {
        const int l = 0, ch = 0; PHASE_ENV();
        int lane = tid & 63; asm volatile("" : "+v"(lane)); int tid0 = tid; asm volatile("" : "+v"(tid0));
        LAS float* scr = (LAS float*)(lds + wave * 16384);
        constexpr int IT_WIN = (DM / 64) * ((DIN + 31) / 32), IT_WUQ = (256 / 64) * (384 / 32), IT_WUKV = (128 / 64) * (512 / 32), IT_WAO = (256 / 64) * (DM / 32), IT_WCO = (512 / 64) * (DM / 32), IT_WO = (DM / 128) * (DM / 32);
        constexpr int IT_WG8 = (DM / 128) * (GW / 32);
        constexpr int IT_LAYER = IT_WIN + IT_WG8 + IT_WUQ + IT_WUKV + 2 * IT_WAO + IT_WCO + IT_WO;
        constexpr int IT_F1 = (DM / 128) * (DFF / 32), IT_F2 = (DFF / 128) * (DM / 32), IT_E1 = (DM / 128) * (EFF / 32), IT_E2 = (EFF / 128) * (DM / 32);
        constexpr int IT_FFN = 2 * IT_F1 + IT_F2, IT_EXP = 2 * IT_E1 + IT_E2;
        constexpr int NITEMS = 2 * IT_LAYER + IT_FFN + NEXP * IT_EXP;
        for (int it = gwl; it < NITEMS; it += ngwl) {
            int r = it;
            if (r < 2 * IT_LAYER) {
                const int ll = r / IT_LAYER; r -= ll * IT_LAYER; unsigned char* lwp = ws + WS_LAYERW + (size_t)ll * SZ_LAYERW;
                if (r < IT_WIN) { transpose_item<1>(FIN(I_WIN) + (size_t)ll * DM * DIN, DM, DIN, (bf16_t*)(lwp + OFF_WIN), DM, scr, r, lane); continue; } r -= IT_WIN;
                if (r < IT_WG8) { transpose_item_f8<0>(FIN(I_WIN) + (size_t)ll * DM * DIN + C_G, DM, GW, lwp + OFF_WIN8, DM, S_WG, scr, r, lane, DIN); continue; } r -= IT_WG8;
                if (r < IT_WUQ) { transpose_item<0>(FIN(I_WUQ) + (size_t)ll * 256 * 384, 256, 384, (bf16_t*)(lwp + OFF_WUQ), 256, scr, r, lane); continue; } r -= IT_WUQ;
                if (r < IT_WUKV) { transpose_item<0>(FIN(I_WUKV) + (size_t)ll * 128 * 512, 128, 512, (bf16_t*)(lwp + OFF_WUKV), 256, scr, r, lane); continue; } r -= IT_WUKV;
                if (r < IT_WAO) { transpose_item<0>(FIN(I_WAO) + (size_t)ll * 256 * DM, 256, DM, (bf16_t*)(lwp + OFF_WAO), DM, scr, r, lane); continue; } r -= IT_WAO;
                if (r < IT_WAO) { transpose_item<0>(FIN(I_WBO) + (size_t)ll * 256 * DM, 256, DM, (bf16_t*)(lwp + OFF_WAO) + 256, DM, scr, r, lane); continue; } r -= IT_WAO;
                if (r < IT_WCO) { transpose_item<0>(FIN(I_WCO) + (size_t)ll * 512 * DM, 512, DM, (bf16_t*)(lwp + OFF_WAO) + 512, DM, scr, r, lane); continue; } r -= IT_WCO;
                transpose_item_f8<0>(FIN(I_WO) + (size_t)ll * DM * DM, DM, DM, lwp + OFF_WO8, DM, S_WO, scr, r, lane); continue;
            }
            r -= 2 * IT_LAYER;
            if (r < IT_FFN) {
                if (r < IT_F1) { transpose_item_f8<2>(FIN(I_FW1), DM, DFF, ws + WS_W13, DM, S_W13, scr, r, lane); continue; } r -= IT_F1;
                if (r < IT_F1) { transpose_item_f8<3>(FIN(I_FW3), DM, DFF, ws + WS_W13, DM, S_W13, scr, r, lane); continue; } r -= IT_F1;
                transpose_item_f8<0>(FIN(I_FW2), DFF, DM, ws + WS_W2, DFF, S_W2, scr, r, lane); continue;
            }
            r -= IT_FFN;
            { const int e = r / IT_EXP; r -= e * IT_EXP;
              if (r < IT_E1) { transpose_item_f8<2>(FIN(I_MW1) + (size_t)e * DM * EFF, DM, EFF, ws + WS_E13 + (size_t)e * SZ_E13, DM, S_W13, scr, r, lane); continue; } r -= IT_E1;
              if (r < IT_E1) { transpose_item_f8<3>(FIN(I_MW3) + (size_t)e * DM * EFF, DM, EFF, ws + WS_E13 + (size_t)e * SZ_E13, DM, S_W13, scr, r, lane); continue; } r -= IT_E1;
              transpose_item_f8<0>(FIN(I_MW2) + (size_t)e * EFF * DM, EFF, DM, ws + WS_E2 + (size_t)e * SZ_E2, EFF, S_W2, scr, r, lane); }
        }
        const int gt = vcu * NWAVES * 64 + tid0, ngt = G * NWAVES * 64;
        for (int ll = 0; ll < DEPTH; ++ll) { unsigned char* lwp = ws + WS_LAYERW + (size_t)ll * SZ_LAYERW;
            for (int i = gt; i < (P1W - C_G) * DM / 8; i += ngt) ((u32x4*)(lwp + OFF_WIN + (size_t)C_G * DM * 2))[i] = (u32x4){0u, 0u, 0u, 0u};
            for (int i = gt; i < 128 * 256 / 8; i += ngt) ((u32x4*)(lwp + OFF_WUQ + (size_t)384 * 256 * 2))[i] = (u32x4){0u, 0u, 0u, 0u};
            for (int i = gt; i < 512 * 128 / 8; i += ngt) { const int rr = i / 16, cc = i % 16; ((u32x4*)(lwp + OFF_WUKV + (size_t)rr * 512 + 256))[cc] = (u32x4){0u, 0u, 0u, 0u}; } }
        for (int i = gt; i < DM / 8; i += ngt) ((u32x4*)(HB + (size_t)TCH * DM))[i] = (u32x4){0u, 0u, 0u, 0u};
        float* c64 = (float*)(ws + WS_ROPE); float* s64 = c64 + (size_t)NPOS * 32; float* c32 = s64 + (size_t)NPOS * 32; float* s32 = c32 + (size_t)NPOS * 16;
        for (int i = gt; i < NPOS * 32; i += ngt) { const int pos = i >> 5, k = i & 31; const float inv = (float)pow(10000.0, -(double)k / 32.0); const float ang = (float)pos * inv; c64[i] = cosf(ang); s64[i] = sinf(ang); }
        for (int i = gt; i < NPOS * 16; i += ngt) { const int pos = i >> 4, k = i & 15; const float inv = (float)pow(10000.0, -(double)k / 16.0); const float ang = (float)pos * inv; c32[i] = cosf(ang); s32[i] = sinf(ang); }
    }
    SEAM();

#pragma unroll 1
    for (int l = 0; l < DEPTH; ++l) {
#pragma unroll 1
        for (int ch = 0; ch < NCHUNK; ++ch) {
            if (EN(1) && RUN()) for (int rep_ = 0; rep_ < (int)REPS(1); ++rep_) { if (rep_) { __syncthreads(); } PHASE_ENV(); TB(9); norm_rows((l == 0 ? FIN(I_X) : (const float*)out) + row0 * DM, FIN(I_ANG) + l * DM, HB, ws + WS_HF8, gwl, ngwl, tid & 63); TE(9); }
            SEAM();
            if (EN(2) && RUN()) { PHASE_ENV();
                { pg8::Gemm g{HB, DM, HB, 1 << 30, (const bf16_t*)(lw + OFF_WIN), DM, nullptr, 0, 1, 0, 0}; pg8::StaticOrder S; S.init(TCH / 256, P1W / 256, G, bx);
                  pg8::EpiInProj E{ABUF(bf16_t, A_P1), ABUF(bf16_t, A_G), 1.0f}; TB(20); pg8::gemm_phase<pg8::EpiInProj, pg8::StaticOrder>(lds + RING_OFF, wave, g, S, E); TE(20); }
                { pg8::Gemm g{(const bf16_t*)(ws + WS_HF8), DM / 2, (const bf16_t*)(ws + WS_HF8), 1 << 30, (const bf16_t*)(lw + OFF_WIN8 - (size_t)P1W * DM), DM / 2, nullptr, 0, 1, 0, 0};
                  pg8::GateOrder S; S.S.init(TCH / 256, GW / 256, G, bx);
                  pg8::EpiInProj E{ABUF(bf16_t, A_P1), ABUF(bf16_t, A_G), 1.0f / S_WG}; pg8::gemm_phase<pg8::EpiInProj, pg8::GateOrder, true>(lds + RING_OFF, wave, g, S, E); } }
            SEAM();
            if (EN(3) && RUN()) for (int rep_ = 0; rep_ < (int)REPS(3); ++rep_) { if (rep_) { __syncthreads(); } PHASE_ENV(); ROPE_TAB(RT); PP1Args a; a.P1 = ABUF(bf16_t, A_P1); a.pos = (const int*)INP(I_POS) + row0; a.aq_g = FIN(I_AQG) + l * 64; a.ak_g = FIN(I_AKG) + l * 64; a.cq_g = FIN(I_BCQG) + l * 256;
                a.ckv_g = FIN(I_BCKVG) + l * 128; a.kr_g = FIN(I_BKRG) + l * 32; a.qc_g = FIN(I_CQG) + l * 64; a.kc_g = FIN(I_CKG) + l * 64;
                a.act = act; a.R = RT;
                TB(7); pp1_rows(a, lds + wave * 8192, gwl, ngwl, tid & 63); TE(7); }
            SEAM();
            if (EN(4) && RUN()) for (int rep_ = 0; rep_ < (int)REPS(4); ++rep_) { if (rep_) { __syncthreads(); } PHASE_ENV(); pg8::StaticOrder S; S.init(TCH / 256, 4, G, bx);
                pg8::Gemm g{ABUF(bf16_t, A_CQN), 256, ABUF(bf16_t, A_CKVN), 2, (const bf16_t*)(lw + OFF_WUQ), 256, nullptr, 0, 1, 0, 0}; pg8::EpiBf16 E{ABUF(bf16_t, A_QBR), 1024}; TB(21); pg8::gemm_phase<pg8::EpiBf16, pg8::StaticOrder>(lds + RING_OFF, wave, g, S, E); TE(21); }
            SEAM();
            if (EN(5) && RUN()) for (int rep_ = 0; rep_ < (int)REPS(5); ++rep_) { if (rep_) { __syncthreads(); } PHASE_ENV(); ROPE_TAB(RT); PP2Args a; a.QBR = ABUF(bf16_t, A_QBR); a.KVBR = ABUF(bf16_t, A_QBR) + 512; a.KR = ABUF(bf16_t, A_KR); a.pos = (const int*)INP(I_POS) + row0;
                a.qn_g = FIN(I_BQNG) + l * 64; a.qr_g = FIN(I_BQRG) + l * 32; a.kn_g = FIN(I_BKNG) + l * 64;
                a.QB = ABUF(bf16_t, A_QB); a.KB = ABUF(bf16_t, A_KB); a.VBT = ABUF(bf16_t, A_VBT); a.R = RT; TB(8); pp2_rows(a, lds + wave * 8192, gwl, ngwl, tid & 63); TE(8); }
            SEAM();
            if (EN(6) && RUN()) for (int rep_ = 0; rep_ < (int)REPS(6); ++rep_) {
                PHASE_ENV();
                unsigned* head = ctl + CW_Q + 64 * (2 * (l * NCHUNK + ch) + rep_);
                bf16_t* const Y = ABUF(bf16_t, A_Y);
                TB(28);
                for (;;) {
                    TB(17); const int u = q_next(head, MISC + 16, wave); TE(17);
                    if (u >= 512 + 1024 + 1024) break;
                    if (u < 512) { if (!(MK_ATT & 1) || (rep_ && !(MK_ATT_REP & 1))) continue;
                        const int qb = 31 - u / 16, bl = (u % 16) / 4, h = u % 4; const int rowb = bl * SEQ; const int q0w = 256 * qb + 32 * wave;
                        fa_unit<96>(lds, wave, ABUF(bf16_t, A_QB) + (size_t)(rowb + q0w) * 384 + h * 96, 384, ABUF(bf16_t, A_KB) + (size_t)rowb * 384 + h * 96, 384, ABUF(bf16_t, A_VBT) + (size_t)(bl * 4 + h) * 64 * SEQ,
                                    0, 4 * qb + 4, q0w, 0, -INFINITY, 0.f, Y + (size_t)(rowb + q0w) * DM + 256 + h * 64, DM);
                    } else if (u < 512 + 1024) { if (!(MK_ATT & 2) || (rep_ && !(MK_ATT_REP & 2))) continue;
                        const int v = u - 512; const int qb32 = 255 - v / 4, bl = v % 4;
                        IdxArgs ia{ABUF(bf16_t, A_IQ), ABUF(bf16_t, A_IK), ABUF(float, A_IW), ABUF(unsigned short, A_SEL), ABUF(int, A_SELN)};
                        TB(14); idx_unit(lds, wave, ia, bl * SEQ, qb32); TE(14);
                    } else { if (!(MK_ATT & 4) || (rep_ && !(MK_ATT_REP & 4))) continue;
                        const int v = u - 1536; const int bl = v / 256, kvh = (v / 128) % 2, qt = v % 128; const int rowb = bl * SEQ;
                        const int hq = kvh * 4 + (wave >> 1), q0w = 64 * qt + 32 * (wave & 1);
                        const float sink = (FIN(I_SINK) + l * 8)[hq];
                        fa_unit<64>(lds, wave, ABUF(bf16_t, A_QC) + (size_t)(rowb + q0w) * 512 + hq * 64, 512, ABUF(bf16_t, A_KC) + (size_t)rowb * 128 + kvh * 64, 128, ABUF(bf16_t, A_VCT) + (size_t)(bl * 2 + kvh) * 64 * SEQ,
                                    qt >= 2 ? qt - 2 : 0, qt + 1, q0w, 128, sink * LOG2E, 1.f, Y + (size_t)(rowb + q0w) * DM + 512 + hq * 64, DM);
                    }
                }
                TE(28);
            }
            SEAM();
            if (EN(7) && RUN()) for (int rep_ = 0; rep_ < (int)REPS(7); ++rep_) { if (rep_) { __syncthreads(); } PHASE_ENV(); SpaArgs sa{ABUF(bf16_t, A_QA), ABUF(bf16_t, A_KA), ABUF(bf16_t, A_VA), ABUF(unsigned short, A_SEL), ABUF(int, A_SELN), ABUF(bf16_t, A_Y)}; LAS unsigned char* wl = lds + wave * 16384;
                TB(11); { int lane_ = tid & 63; asm volatile("" : "+v"(lane_)); SpaPre P, Pn; P = SpaPre{}; Pn = SpaPre{};
                    if (gwl < TCH) sparse_prefetch(P, sa, gwl, (gwl + ngwl < TCH) ? gwl + ngwl : gwl, lane_);
                    for (int tok = gwl; tok < TCH; tok += 2 * ngwl) { const int tk2 = (tok + ngwl < TCH) ? tok + ngwl : tok; const int nt1 = tok + 2 * ngwl, nt2 = (nt1 + ngwl < TCH) ? nt1 + ngwl : nt1;
                        if (nt1 < TCH) sparse_prefetch(Pn, sa, nt1, nt2, lane_);
                        sparse_pair(wl, sa, P, (tok / SEQ) * SEQ, tok % SEQ, (tk2 / SEQ) * SEQ, tk2 % SEQ, lane_);
                        P = Pn; } } TE(11); }
            SEAM();
            if (EN(8) && RUN()) for (int rep_ = 0; rep_ < (int)REPS(8); ++rep_) { if (rep_) { __syncthreads(); } PHASE_ENV(); pg8::SegOrder S; S.S.init(TCH / 256, DM / 256, G, bx);
                pg8::Gemm g{ABUF(bf16_t, A_Y), DM, ABUF(bf16_t, A_Y), 1 << 30, (const bf16_t*)(lw + OFF_WAO), DM, nullptr, 0, 3, 256, 512}; pg8::EpiMerge E{HB, ABUF(bf16_t, A_G), ws + WS_HF8, S_MG};
                TB(22); pg8::gemm_phase<pg8::EpiMerge, pg8::SegOrder>(lds + RING_OFF, wave, g, S, E); TE(22); }
            SEAM();
            if (EN(9) && RUN()) { PHASE_ENV(); pg8::Gemm g{(const bf16_t*)(ws + WS_HF8), DM / 2, (const bf16_t*)(ws + WS_HF8), 1 << 30, (const bf16_t*)(lw + OFF_WO8), DM / 2, nullptr, 0, 1, 0, 0}; pg8::StaticOrder S; S.init(TCH / 256, DM / 256, G, bx);
                pg8::EpiResidS E{(l == 0 ? FIN(I_X) : (const float*)out) + row0 * DM, out + row0 * DM, 1.0f / (S_MG * S_WO)}; TB(23); pg8::gemm_phase<pg8::EpiResidS, pg8::StaticOrder, true>(lds + RING_OFF, wave, g, S, E); TE(23); }
            SEAM();
            if (l == 0) {
                if (EN(10) && RUN()) { PHASE_ENV(); RouteArgs ra{}; TB(10); norm2_rows<false>(out + row0 * DM, FIN(I_FNG) + l * DM, HB, ws + WS_HF8, ra, (LAS unsigned*)(lds + MISC_OFF + 128), vcu, wave, tid & 63, G); TE(10); }
                SEAM();
                if (EN(11) && RUN()) { PHASE_ENV(); pg8::Gemm g{(const bf16_t*)(ws + WS_HF8), DM / 2, (const bf16_t*)(ws + WS_HF8), 1 << 30, (const bf16_t*)(ws + WS_W13), DM / 2, nullptr, 0, 1, 0, 0}; pg8::StaticOrder S; S.init(TCH / 256, 2 * DFF / 256, G, bx);
                    pg8::EpiSwigluF8 E{ABUF(unsigned char, F_ACT), DFF, 1.0f / S_W13, S_ACT}; TB(24); pg8::gemm_phase<pg8::EpiSwigluF8, pg8::StaticOrder, true>(lds + RING_OFF, wave, g, S, E); TE(24); }
                SEAM();
                if (EN(12) && RUN()) { PHASE_ENV(); pg8::Gemm g{ABUF(bf16_t, F_ACT), DFF / 2, ABUF(bf16_t, F_ACT), 1 << 30, (const bf16_t*)(ws + WS_W2), DFF / 2, nullptr, 0, 1, 0, 0}; pg8::StaticOrder S; S.init(TCH / 256, DM / 256, G, bx);
                    pg8::EpiResidS E{out + row0 * DM, out + row0 * DM, 1.0f / (S_ACT * S_W2)}; TB(25); pg8::gemm_phase<pg8::EpiResidS, pg8::StaticOrder, true>(lds + RING_OFF, wave, g, S, E); TE(25); }
                SEAM();
            } else {
                if (EN(13) && RUN()) { PHASE_ENV(); RouteArgs ra{FIN(I_RW), ABUF(int, F_TOPE), ABUF(float, F_TOPG), ABUF(int, F_TOPD), ctl + CW_MOE + 64 * ch};
                    TB(10); norm2_rows<true>(out + row0 * DM, FIN(I_FNG) + l * DM, HB, nullptr, ra, (LAS unsigned*)(lds + MISC_OFF + 128), vcu, wave, tid & 63, G); TE(10); }
                SEAM();
                if (EN(14) && RUN()) { PHASE_ENV(); TB(12); moe_scatter(ctl + CW_MOE + 64 * ch, ABUF(int, F_TOPE), ABUF(int, F_TOPD), HB, ABUF(bf16_t, F_YM), ABUF(int, F_BLKE), gwl, ngwl, tid & 63); TE(12); }
                SEAM();
                if (EN(15) && RUN()) for (int rep_ = 0; rep_ < (int)REPS(15); ++rep_) { if (rep_) { __syncthreads(); } PHASE_ENV(); int ps[NEXP + 1]; moe_layout(ctl + CW_MOE + 64 * ch, ps); const int nblk = ps[NEXP] / 256;
                    pg8::Gemm g{ABUF(bf16_t, F_YM), DM / 2, ABUF(bf16_t, F_YM), 1 << 30, (const bf16_t*)(ws + WS_E13), DM / 2, ABUF(int, F_BLKE), SZ_E13 / 2, 1, 0, 0}; pg8::StaticOrder S; S.init(nblk, 2 * EFF / 256, G, bx);
                    pg8::EpiSwigluF8 E{ABUF(unsigned char, F_ACT), EFF, 1.0f / S_W13, S_ACT}; TB(26); pg8::gemm_phase<pg8::EpiSwigluF8, pg8::StaticOrder, true>(lds + RING_OFF, wave, g, S, E); TE(26); }
                SEAM();
                if (EN(16) && RUN()) for (int rep_ = 0; rep_ < (int)REPS(16); ++rep_) { if (rep_) { __syncthreads(); } PHASE_ENV(); int ps[NEXP + 1]; moe_layout(ctl + CW_MOE + 64 * ch, ps); const int nblk = ps[NEXP] / 256;
                    pg8::Gemm g{ABUF(bf16_t, F_ACT), EFF / 2, ABUF(bf16_t, F_ACT), 1 << 30, (const bf16_t*)(ws + WS_E2), EFF / 2, ABUF(int, F_BLKE), SZ_E2 / 2, 1, 0, 0}; pg8::StaticOrder S; S.init(nblk, DM / 256, G, bx);
                    pg8::EpiBf16S E{ABUF(bf16_t, F_YM), DM, 1.0f / (S_ACT * S_W2)}; TB(27); pg8::gemm_phase<pg8::EpiBf16S, pg8::StaticOrder, true>(lds + RING_OFF, wave, g, S, E); TE(27); }
                SEAM();
                if (EN(17) && RUN()) { PHASE_ENV(); TB(13); moe_combine(out + row0 * DM, ABUF(bf16_t, F_YM), ABUF(int, F_TOPD), ABUF(float, F_TOPG), gwl, ngwl, tid & 63); TE(13); }
                SEAM();
            }
        }
    }
    if (MK_TIMER != 0 && bx == 0 && args.ph_hi >= N_PHASES_C) { __syncthreads(); const unsigned long long t0 = __builtin_amdgcn_s_memrealtime(); const unsigned long long T = (unsigned long long)(*TMR_ACC) / NWAVES;
        while (__builtin_amdgcn_s_memrealtime() - t0 < T) __builtin_amdgcn_s_sleep(8); }
#undef RUN
#undef SEAM
#undef tid
}
constexpr int N_PHASES = 1 + NCHUNK * (9 + 3) + NCHUNK * (9 + 5);

extern "C" void kernel_launch(void* const* d_in, const int* in_sizes, int n_in, void* d_out, int out_size, void* d_ws, size_t ws_size, hipStream_t stream) {
    static int grid = 0;
    if (grid == 0) {
        if (n_in != 29 || in_sizes[0] != NTOK * DM || out_size != NTOK * DM || ws_size < WS_END) {
            fprintf(stderr, "kernel_launch: built for 29 inputs, x/out of %d floats, >= %zu bytes of workspace; got n_in %d, in0 %d, out %d, ws %zu; nothing launched\n", NTOK * DM, (size_t)WS_END, n_in, n_in > 0 ? in_sizes[0] : -1, out_size, ws_size); grid = -1; return; }
        int dev = 0, cus = 0, per_cu = 0;
        if (hipGetDevice(&dev) != hipSuccess || hipDeviceGetAttribute(&cus, hipDeviceAttributeMultiprocessorCount, dev) != hipSuccess) { fprintf(stderr, "kernel_launch: device query failed\n"); grid = -1; return; }
        if (hipFuncSetAttribute((const void*)mk_fwd, hipFuncAttributeMaxDynamicSharedMemorySize, LDS_BYTES) != hipSuccess) { fprintf(stderr, "kernel_launch: hipFuncSetAttribute failed\n"); grid = -1; return; }
        if (hipOccupancyMaxActiveBlocksPerMultiprocessor(&per_cu, (const void*)mk_fwd, NWAVES * 64, LDS_BYTES) != hipSuccess || per_cu < 1)
            fprintf(stderr, "kernel_launch: note: occupancy query reports %d workgroups per CU\n", per_cu);
        (void)hipGetLastError();
        grid = cus;
        if (grid != 256) fprintf(stderr, "kernel_launch: note: %d CUs (built and tuned for 256)\n", grid);
    }
    if (grid < 0) return;
    if (hipMemsetAsync((char*)d_ws + WS_CTL, 0, CTL_ZERO_BYTES, stream) != hipSuccess) { fprintf(stderr, "kernel_launch: memset failed\n"); return; }
    Args a{};
    for (int i = 0; i < 29; ++i) a.in[i] = d_in[i];
    a.out = (float*)d_out; a.ws = (unsigned char*)d_ws;
#if MK_PER_PHASE
    for (int p = 0; p < N_PHASES; ++p) { a.ph_lo = p; a.ph_hi = p + 1; hipLaunchKernelGGL(mk_fwd, dim3(grid), dim3(NWAVES * 64), LDS_BYTES, stream, a); }
#elif MK_CHECK
    {
        const int base = 1 + (MK_CHECK_L == 0 ? MK_CHECK_CH * 12 : 24 + MK_CHECK_CH * 14);
        a.ph_lo = 0; a.ph_hi = base + 7; a.pad0 = 0; hipLaunchKernelGGL(mk_fwd, dim3(grid), dim3(NWAVES * 64), LDS_BYTES, stream, a);
        hipLaunchKernelGGL(chk_kernel, dim3(grid), dim3(NWAVES * 64), 0, stream, a, 0, MK_CHECK_L, MK_CHECK_CH);
        a.ph_lo = base + 7; a.ph_hi = base + 9; a.pad0 = 1; hipLaunchKernelGGL(mk_fwd, dim3(grid), dim3(NWAVES * 64), LDS_BYTES, stream, a);
        hipLaunchKernelGGL(chk_kernel, dim3(grid), dim3(NWAVES * 64), 0, stream, a, 1, MK_CHECK_L, MK_CHECK_CH);
        a.ph_lo = base + 9; a.ph_hi = N_PHASES; a.pad0 = 2; hipLaunchKernelGGL(mk_fwd, dim3(grid), dim3(NWAVES * 64), LDS_BYTES, stream, a);
        hipLaunchKernelGGL(chk_kernel, dim3(1), dim3(64), 0, stream, a, 2, MK_CHECK_L, MK_CHECK_CH);
    }
#else
    a.ph_lo = 0; a.ph_hi = N_PHASES;
    hipLaunchKernelGGL(mk_fwd, dim3(grid), dim3(NWAVES * 64), LDS_BYTES, stream, a);
#endif
    const hipError_t le = hipPeekAtLastError();
    if (le != hipSuccess) fprintf(stderr, "kernel_launch: launch failed: %s\n", hipGetErrorName(le));
}
```

```cpp
#include <hip/hip_runtime.h>
#include <cstdio>
#include <cstdint>

#define GAS __attribute__((address_space(1)))
#define LAS __attribute__((address_space(3)))
typedef unsigned short bf16_t;
typedef short bf16x8 __attribute__((ext_vector_type(8)));
typedef float f32x2 __attribute__((ext_vector_type(2)));
typedef float f32x4 __attribute__((ext_vector_type(4)));
typedef float f32x16 __attribute__((ext_vector_type(16)));
typedef unsigned u32x2 __attribute__((ext_vector_type(2)));
typedef unsigned u32x4 __attribute__((ext_vector_type(4)));
typedef int i32x4 __attribute__((ext_vector_type(4)));
typedef int i32x8 __attribute__((ext_vector_type(8)));

constexpr int NB = 8, SEQ = 8192, NTOK = NB * SEQ, DM = 1024, DEPTH = 2;
constexpr int DIN = 4936;
constexpr int CHB = 4, TCH = CHB * SEQ, NCHUNK = NB / CHB;
constexpr int DFF = 2816, NEXP = 8, EFF = 3584;
constexpr int P1W = 2048, GW = 3072;
constexpr int NINP = P1W + GW;
constexpr float EPS = 1e-6f;
constexpr float LOG2E = 1.4426950408889634f;
constexpr int C_QA = 0, C_KA = 256, C_VA = 320, C_IQ = 384, C_IK = 640, C_IW = 672, C_CQ = 680, C_CKV = 936, C_KR = 1064, C_QC = 1096, C_KC = 1608, C_VC = 1736, C_G = 1864;
constexpr int NPOS = 12288;
constexpr int MOE_ROWS = 2 * TCH + NEXP * 256;

__device__ __forceinline__ float bf2f(bf16_t v) { return __uint_as_float((unsigned)v << 16); }
__device__ __forceinline__ float bflo(unsigned w) { return __uint_as_float(w << 16); }
__device__ __forceinline__ float bfhi(unsigned w) { return __uint_as_float(w & 0xffff0000u); }
__device__ __forceinline__ unsigned f2bf(float f) { unsigned u = __float_as_uint(f); return (u + 0x7fffu + ((u >> 16) & 1u)) >> 16; }
__device__ __forceinline__ unsigned pk2(float lo, float hi) { return f2bf(lo) | (f2bf(hi) << 16); }
__device__ __forceinline__ unsigned cvt_pk_bf16(float lo, float hi) { unsigned r; asm volatile("v_cvt_pk_bf16_f32 %0, %1, %2" : "=v"(r) : "v"(lo), "v"(hi)); return r; }
__device__ __forceinline__ unsigned pk4_u8(float a, float b, float c, float d) { unsigned w = 0u; w = __builtin_amdgcn_cvt_pk_u8_f32(a, 0u, w); w = __builtin_amdgcn_cvt_pk_u8_f32(b, 1u, w); w = __builtin_amdgcn_cvt_pk_u8_f32(c, 2u, w); w = __builtin_amdgcn_cvt_pk_u8_f32(d, 3u, w); return w; }
__device__ __forceinline__ unsigned pk4_fp8(float a, float b, float c, float d) { unsigned w = 0u; w = (unsigned)__builtin_amdgcn_cvt_pk_fp8_f32(a, b, (int)w, false); w = (unsigned)__builtin_amdgcn_cvt_pk_fp8_f32(c, d, (int)w, true); return w; }
__device__ __forceinline__ float fast_exp2(float x) { return __builtin_amdgcn_exp2f(x); }
__device__ __forceinline__ float fast_rcp(float x) { return __builtin_amdgcn_rcpf(x); }
__device__ __forceinline__ float sigmoidf_(float x) { return fast_rcp(1.0f + fast_exp2(-LOG2E * x)); }
template <int O> __device__ __forceinline__ float xor_lane(float v) {
    return __int_as_float(__builtin_amdgcn_ds_swizzle(__float_as_int(v), (O << 10) | 0x1f)); }
__device__ __forceinline__ float half_sum(float v) { const auto rr = __builtin_amdgcn_permlane32_swap(__float_as_uint(v), __float_as_uint(v), false, false); return __uint_as_float(rr[0]) + __uint_as_float(rr[1]); }
__device__ __forceinline__ float half_max(float v) { const auto rr = __builtin_amdgcn_permlane32_swap(__float_as_uint(v), __float_as_uint(v), false, false); return fmaxf(__uint_as_float(rr[0]), __uint_as_float(rr[1])); }
__device__ __forceinline__ float sum16(float v) { v += xor_lane<1>(v); v += xor_lane<2>(v); v += xor_lane<4>(v); v += xor_lane<8>(v); return v; }
__device__ __forceinline__ float max16(float v) { v = fmaxf(v, xor_lane<1>(v)); v = fmaxf(v, xor_lane<2>(v)); v = fmaxf(v, xor_lane<4>(v)); v = fmaxf(v, xor_lane<8>(v)); return v; }
__device__ __forceinline__ float sum32(float v) { v = sum16(v); v += xor_lane<16>(v); return v; }
__device__ __forceinline__ float wave_sum(float v) { return half_sum(sum32(v)); }
__device__ __forceinline__ int lane_get(int v, int src_lane) { return __builtin_amdgcn_ds_bpermute(src_lane << 2, v); }
__device__ __forceinline__ int lane_bcast(int v, int uniform_lane) { return __builtin_amdgcn_readlane(v, uniform_lane); }
__device__ __forceinline__ unsigned lds_add(LAS unsigned* p, unsigned v) { return __hip_atomic_fetch_add(p, v, __ATOMIC_RELAXED, __HIP_MEMORY_SCOPE_WORKGROUP); }
__device__ __forceinline__ unsigned lds_or(LAS unsigned* p, unsigned v) { return __hip_atomic_fetch_or(p, v, __ATOMIC_RELAXED, __HIP_MEMORY_SCOPE_WORKGROUP); }
__device__ __forceinline__ int lane_id() { int l; asm volatile("v_mbcnt_lo_u32_b32 %0, -1, 0\n\tv_mbcnt_hi_u32_b32 %0, -1, %0" : "=v"(l)); return l; }
#define LDS_WAIT() asm volatile("s_waitcnt lgkmcnt(0)" ::: "memory")
#define VM_WAIT() asm volatile("s_waitcnt vmcnt(0)" ::: "memory")

namespace pg8 {
constexpr int BM = 256, BK = 64, HALF = 128, HTB = HALF * BK * 2, STAGE_BYTES = 8 * HTB, NXCD = 8, WGM = 8;
__host__ __device__ __forceinline__ int lds_byte(int r, int c) { const int st = (r >> 4) * 2 + (c >> 5), rr = r & 15, cc = c & 31, ob = rr * 64 + cc * 2; return st * 1024 + (ob ^ (((ob >> 9) & 1) << 5)); }
__host__ __device__ __forceinline__ void stage_rc(int b, int& R, int& C) { const int st = b / 1024, sb = b % 1024, swz = sb ^ (((sb >> 9) & 1) << 5); R = (st >> 1) * 16 + swz / 64; C = (st & 1) * 32 + (swz % 64) / 2; }
__host__ __device__ __forceinline__ int perm32(int rho) { const int n = rho >> 4, i = rho & 15; return 8 * (i >> 2) + 4 * n + (i & 3); }

struct Unit { int pm, pn, seg; };
struct Gemm {
    const bf16_t* A; int lda;
    const bf16_t* A2; int pn_split;
    const bf16_t* Bt; int K;
    const int* blk_e; size_t e_stride;
    int nseg, k1, k2;
};
struct StaticOrder {
    int nM, nN, nwg, G, c;
    __device__ void init(int nM_, int nN_, int G_, int c_) { nM = nM_; nN = nN_; nwg = nM * nN; G = G_; c = c_; }
    __device__ bool next(int i, Unit& u) const {
        const long L = (long)i * G + c; if (L >= nwg) return false;
        int wgid = (int)L; { const int q = nwg / NXCD, r = nwg % NXCD, xcd = wgid % NXCD, off = wgid / NXCD; wgid = (xcd < r ? xcd * (q + 1) : r * (q + 1) + (xcd - r) * q) + off; }
        const int nig = WGM * nN, gid = wgid / nig, fm = gid * WGM, gsz = (nM - fm) < WGM ? (nM - fm) : WGM;
        u.pm = fm + ((wgid % nig) % gsz); u.pn = (wgid % nig) / gsz; u.seg = 0; return true;
    }
};
struct GateOrder { StaticOrder S;
    __device__ bool next(int i, Unit& u) const { if (!S.next(i, u)) return false; u.pn += 8; return true; } };
struct SegOrder { StaticOrder S;
    __device__ bool next(int i, Unit& u) const { const int q = i / 3; if (!S.next(q, u)) return false; u.seg = i - 3 * q; return true; } };

template <class Epi, class Sched, bool FP8 = false>
__device__ __forceinline__ void gemm_phase(LAS unsigned char* lds, int wave_, const Gemm g, const Sched& S, const Epi& E) {
    int tid = wave_ * 64 + lane_id(); asm volatile("" : "+v"(tid));
    const int wid = __builtin_amdgcn_readfirstlane(tid >> 6), lane = tid & 63, wr = wid >> 2, wc = wid & 3, fr = lane & 15, fq = lane >> 4;
    int K = g.K; asm volatile("" : "+s"(K));
    unsigned voffA[2], voffB[2];
#pragma unroll
    for (int i = 0; i < 2; ++i) { int R, C; stage_rc(tid * 16 + i * 8192, R, C); const int Rb = Epi::PERM ? ((R & ~31) + perm32(R & 31)) : R;
        voffA[i] = (unsigned)(R * g.lda + C) * 2u; voffB[i] = (unsigned)(Rb * K + C) * 2u; }
    const size_t kstep = (size_t)(BK * 2);
    const size_t hstepB = (size_t)HALF * K * 2, tstepB = 2 * hstepB;
    const size_t hstepA = (size_t)HALF * g.lda * 2, tstepA = 2 * hstepA;
    const unsigned ldsw = (unsigned)wid * 1024u;
    const int aoff0 = FP8 ? lds_byte(wr * 64 + fr, (2 * (fq & 1)) * 8) + (fq >> 1) * 1024 : lds_byte(wr * 64 + fr, fq * 8);
    const int boff0 = FP8 ? lds_byte(wc * 32 + fr, (2 * (fq & 1)) * 8) + (fq >> 1) * 1024 : lds_byte(wc * 32 + fr, fq * 8);
    constexpr int OFF1 = FP8 ? 16 : 1024;
#define PG8_SA(b, h) (((b) * 2 + (h)) * HTB)
#define PG8_SB(b, h) ((4 + (b) * 2 + (h)) * HTB)
#define PG8_STAGE(bufoff, gbase, voff) do { _Pragma("unroll") for (int _i = 0; _i < 2; ++_i) \
        __builtin_amdgcn_global_load_lds((const unsigned*)((const char*)(gbase) + (voff)[_i]), (LAS unsigned*)(lds + (bufoff) + ldsw + _i * 8192), 16, 0, 0); } while (0)
#define PG8_LDA(dst, b, h) do { _Pragma("unroll") for (int m = 0; m < 4; ++m) { \
        if constexpr (FP8) { dst##8[m].lo = *(const LAS i32x4*)(lds + PG8_SA(b, h) + aoff0 + m * 2048); dst##8[m].hi = *(const LAS i32x4*)(lds + PG8_SA(b, h) + aoff0 + OFF1 + m * 2048); } \
        else { dst[m][0] = *(const LAS bf16x8*)(lds + PG8_SA(b, h) + aoff0 + m * 2048); dst[m][1] = *(const LAS bf16x8*)(lds + PG8_SA(b, h) + aoff0 + OFF1 + m * 2048); } } } while (0)
#define PG8_LDB(dst, b, h) do { _Pragma("unroll") for (int n = 0; n < 2; ++n) { \
        if constexpr (FP8) { dst##8[n].lo = *(const LAS i32x4*)(lds + PG8_SB(b, h) + boff0 + n * 2048); dst##8[n].hi = *(const LAS i32x4*)(lds + PG8_SB(b, h) + boff0 + OFF1 + n * 2048); } \
        else { dst[n][0] = *(const LAS bf16x8*)(lds + PG8_SB(b, h) + boff0 + n * 2048); dst[n][1] = *(const LAS bf16x8*)(lds + PG8_SB(b, h) + boff0 + OFF1 + n * 2048); } } } while (0)
#define PG8_MMA(ai, bj, At, Bt) do { __builtin_amdgcn_s_setprio(1); _Pragma("unroll") for (int m = 0; m < 4; ++m) _Pragma("unroll") for (int n = 0; n < 2; ++n) { \
        if constexpr (FP8) asm volatile("v_mfma_scale_f32_16x16x128_f8f6f4 %0, %1, %2, %0, %3, %3 op_sel_hi:[0,0,0]" : "+v"(acc[ai][bj][m][n]) : "v"(Bt##8[n]), "v"(At##8[m]), "v"(one_scale));   \
        else { _Pragma("unroll") for (int k = 0; k < 2; ++k) acc[ai][bj][m][n] = __builtin_amdgcn_mfma_f32_16x16x32_bf16(Bt[n][k], At[m][k], acc[ai][bj][m][n], 0, 0, 0); } } \
        __builtin_amdgcn_s_setprio(0); } while (0)
#define PG8_WAIT_V(n) asm volatile("s_waitcnt vmcnt(" #n ")" ::: "memory")
#define PG8_WAIT_L(n) asm volatile("s_waitcnt lgkmcnt(" #n ")" ::: "memory")
#define PG8_BAR __builtin_amdgcn_s_barrier()
#define PG8_SCHED __builtin_amdgcn_sched_barrier(0)
#define PG8_K0(u) ((u).seg == 0 ? 0 : ((u).seg == 1 ? g.k1 : g.k2))
#define PG8_NT(u) ((g.nseg == 1 ? K : ((u).seg == 0 ? g.k1 : ((u).seg == 1 ? g.k2 - g.k1 : K - g.k2))) / BK)
#define PG8_BPTR(u) ((const char*)g.Bt + ((g.blk_e ? (size_t)g.blk_e[(u).pm] * g.e_stride * 2 : (size_t)0) + (size_t)(u).pn * tstepB + (size_t)PG8_K0(u) * 2))
    Unit cur, nxt; int ui = 0;
    if (!S.next(0, cur)) return;
    f32x4 acc[2][2][4][2];
#pragma unroll
    for (int a = 0; a < 2; ++a)
#pragma unroll
        for (int b = 0; b < 2; ++b)
#pragma unroll
            for (int m = 0; m < 4; ++m)
#pragma unroll
                for (int n = 0; n < 2; ++n) acc[a][b][m][n] = (f32x4){0.f, 0.f, 0.f, 0.f};
    bf16x8 At[4][2], B0[2][2], B1[2][2];
    i32x8 At8[4], B08[2], B18[2];
    int one_scale = 0x7f7f7f7f; asm volatile("" : "+v"(one_scale));
    const char* cA = (const char*)(cur.pn >= g.pn_split ? g.A2 : g.A) + (size_t)cur.pm * tstepA + (size_t)PG8_K0(cur) * 2; const char* cB = PG8_BPTR(cur);
    int nt = PG8_NT(cur);
    PG8_STAGE(PG8_SB(0, 0), cB, voffB); PG8_STAGE(PG8_SB(0, 1), cB + hstepB, voffB); PG8_STAGE(PG8_SA(0, 0), cA, voffA); PG8_STAGE(PG8_SA(0, 1), cA + hstepA, voffA);
    if (wr == 1) PG8_BAR;
    PG8_WAIT_V(2); PG8_BAR;
    PG8_STAGE(PG8_SB(1, 0), cB + kstep, voffB); PG8_STAGE(PG8_SA(1, 0), cA + kstep, voffA); PG8_STAGE(PG8_SB(1, 1), cB + hstepB + kstep, voffB);
    PG8_WAIT_V(6); PG8_BAR;
    for (;;) {
        const bool has_next = S.next(ui + 1, nxt);
        const char* nA = has_next ? (const char*)(nxt.pn >= g.pn_split ? g.A2 : g.A) + (size_t)nxt.pm * tstepA + (size_t)PG8_K0(nxt) * 2 : cA; const char* nB = has_next ? PG8_BPTR(nxt) : cB;
        for (int t = 0; t < nt; t += 2) {
            const bool last = (t == nt - 2);
            const char* a1 = cA + (size_t)(t + 1) * kstep;
            const char* a2 = last ? nA : cA + (size_t)(t + 2) * kstep; const char* b2 = last ? nB : cB + (size_t)(t + 2) * kstep;
            const char* a3 = a2 + kstep; const char* b3 = b2 + kstep;
            PG8_LDB(B0, 0, 0); PG8_LDB(B1, 0, 1); PG8_SCHED; PG8_LDA(At, 0, 0); PG8_STAGE(PG8_SA(1, 1), a1 + hstepA, voffA);
            PG8_WAIT_V(8); PG8_WAIT_L(0); PG8_BAR; PG8_MMA(0, 0, At, B0); PG8_MMA(0, 1, At, B1); PG8_BAR; PG8_SCHED;
            PG8_LDA(At, 0, 1); PG8_STAGE(PG8_SB(0, 0), b2, voffB); PG8_STAGE(PG8_SB(0, 1), b2 + hstepB, voffB); PG8_STAGE(PG8_SA(0, 0), a2, voffA);
            PG8_WAIT_V(8); PG8_WAIT_L(0); PG8_BAR; PG8_MMA(1, 0, At, B0); PG8_MMA(1, 1, At, B1); PG8_BAR; PG8_SCHED;
            PG8_LDB(B0, 1, 0); PG8_LDB(B1, 1, 1); PG8_SCHED; PG8_LDA(At, 1, 0); PG8_STAGE(PG8_SA(0, 1), a2 + hstepA, voffA);
            PG8_WAIT_V(8); PG8_WAIT_L(0); PG8_BAR; PG8_MMA(0, 0, At, B0); PG8_MMA(0, 1, At, B1); PG8_BAR; PG8_SCHED;
            PG8_LDA(At, 1, 1); PG8_STAGE(PG8_SB(1, 0), b3, voffB); PG8_STAGE(PG8_SB(1, 1), b3 + hstepB, voffB); PG8_STAGE(PG8_SA(1, 0), a3, voffA);
            PG8_WAIT_V(8); PG8_WAIT_L(0); PG8_BAR; PG8_MMA(1, 0, At, B0); PG8_MMA(1, 1, At, B1); PG8_BAR; PG8_SCHED;
        }
        if (wr == 0) PG8_BAR;
        if constexpr (FP8) { asm volatile("s_nop 15\n\ts_nop 7" ::: "memory");
#pragma unroll
            for (int a = 0; a < 2; ++a)
#pragma unroll
                for (int b = 0; b < 2; ++b)
#pragma unroll
                    for (int m = 0; m < 4; ++m)
#pragma unroll
                        for (int n = 0; n < 2; ++n) asm volatile("" : "+v"(acc[a][b][m][n])); }
        E(acc, cur, wr, wc, fr, fq);
        if (!has_next) break;
#pragma unroll
        for (int a = 0; a < 2; ++a)
#pragma unroll
            for (int b = 0; b < 2; ++b)
#pragma unroll
                for (int m = 0; m < 4; ++m)
#pragma unroll
                    for (int n = 0; n < 2; ++n) acc[a][b][m][n] = (f32x4){0.f, 0.f, 0.f, 0.f};
        cur = nxt; cA = nA; cB = nB; ++ui; nt = PG8_NT(cur);
        if (wr == 1) PG8_BAR;
    }
    PG8_WAIT_V(0);
    PG8_BAR;
#undef PG8_SA
#undef PG8_SB
#undef PG8_STAGE
#undef PG8_LDA
#undef PG8_LDB
#undef PG8_MMA
#undef PG8_WAIT_V
#undef PG8_WAIT_L
#undef PG8_BAR
#undef PG8_SCHED
#undef PG8_BPTR
#undef PG8_K0
#undef PG8_NT
}

typedef const f32x4 (&AccRef)[2][2][4][2];
struct EpiInProj {
    static constexpr bool PERM = true;
    bf16_t* P1; unsigned char* G; float sg;
    __device__ __forceinline__ void operator()(AccRef acc, const Unit& u, int wr, int wc, int fr, int fq) const {
        const int row0 = u.pm * BM + wr * 64 + fr; const bool gate = u.pn >= 8;
        const int col0 = (gate ? (u.pn - 8) : u.pn) * BM + wc * 32 + 8 * fq;
#pragma unroll
        for (int ai = 0; ai < 2; ++ai)
#pragma unroll
            for (int m = 0; m < 4; ++m) { const size_t row = (size_t)(row0 + ai * HALF + m * 16);
#pragma unroll
                for (int bj = 0; bj < 2; ++bj) { f32x4 v0 = acc[ai][bj][m][0], v1 = acc[ai][bj][m][1];
                    if (gate) {
#pragma unroll
                        for (int j = 0; j < 4; ++j) { v0[j] = 255.0f * sigmoidf_(v0[j] * sg); v1[j] = 255.0f * sigmoidf_(v1[j] * sg); }
                        u32x2 q; q.x = pk4_u8(v0[0], v0[1], v0[2], v0[3]); q.y = pk4_u8(v1[0], v1[1], v1[2], v1[3]);
                        *(u32x2*)(G + row * GW + col0 + bj * HALF) = q;
                    } else {
                        u32x4 w; w.x = cvt_pk_bf16(v0[0], v0[1]); w.y = cvt_pk_bf16(v0[2], v0[3]); w.z = cvt_pk_bf16(v1[0], v1[1]); w.w = cvt_pk_bf16(v1[2], v1[3]);
                        *(u32x4*)(P1 + row * P1W + col0 + bj * HALF) = w; } } }
    }
};
struct EpiBf16 {
    static constexpr bool PERM = true;
    bf16_t* O; int ldc;
    __device__ __forceinline__ void operator()(AccRef acc, const Unit& u, int wr, int wc, int fr, int fq) const {
        const int row0 = u.pm * BM + wr * 64 + fr; const int col0 = u.pn * BM + wc * 32 + 8 * fq;
#pragma unroll
        for (int ai = 0; ai < 2; ++ai)
#pragma unroll
            for (int m = 0; m < 4; ++m) { bf16_t* rowp = O + (size_t)(row0 + ai * HALF + m * 16) * ldc + col0;
#pragma unroll
                for (int bj = 0; bj < 2; ++bj) { const f32x4 v0 = acc[ai][bj][m][0], v1 = acc[ai][bj][m][1];
                    u32x4 w; w.x = cvt_pk_bf16(v0[0], v0[1]); w.y = cvt_pk_bf16(v0[2], v0[3]); w.z = cvt_pk_bf16(v1[0], v1[1]); w.w = cvt_pk_bf16(v1[2], v1[3]);
                    *(u32x4*)(rowp + bj * HALF) = w; } }
    }
};
struct EpiMerge {
    static constexpr bool PERM = true;
    bf16_t* Mg; const unsigned char* G; unsigned char* M8; float s8;
    __device__ __forceinline__ void operator()(AccRef acc, const Unit& u, int wr, int wc, int fr, int fq) const {
        const int row0 = u.pm * BM + wr * 64 + fr; const int col0 = u.pn * BM + wc * 32 + 8 * fq; const int goff = u.seg * DM; const bool accum = u.seg != 0;
#pragma unroll
        for (int ai = 0; ai < 2; ++ai) {
            u32x2 gv[8]; u32x4 ov[8];
#pragma unroll
            for (int m = 0; m < 4; ++m)
#pragma unroll
                for (int bj = 0; bj < 2; ++bj) { const size_t row = (size_t)(row0 + ai * HALF + m * 16);
                    gv[m * 2 + bj] = *(const u32x2*)(G + row * GW + goff + col0 + bj * HALF);
                    if (accum) ov[m * 2 + bj] = *(const u32x4*)(Mg + row * DM + col0 + bj * HALF); }
#pragma unroll
            for (int m = 0; m < 4; ++m)
#pragma unroll
                for (int bj = 0; bj < 2; ++bj) { const size_t row = (size_t)(row0 + ai * HALF + m * 16); const f32x4 v0 = acc[ai][bj][m][0], v1 = acc[ai][bj][m][1]; const u32x2 gw = gv[m * 2 + bj]; constexpr float I255 = 1.0f / 255.0f;
                    float r[8] = { (float)(gw.x & 255u) * I255 * v0[0], (float)((gw.x >> 8) & 255u) * I255 * v0[1], (float)((gw.x >> 16) & 255u) * I255 * v0[2], (float)(gw.x >> 24) * I255 * v0[3],
                                   (float)(gw.y & 255u) * I255 * v1[0], (float)((gw.y >> 8) & 255u) * I255 * v1[1], (float)((gw.y >> 16) & 255u) * I255 * v1[2], (float)(gw.y >> 24) * I255 * v1[3] };
                    if (accum) { const u32x4 o = ov[m * 2 + bj]; r[0] += bflo(o.x); r[1] += bfhi(o.x); r[2] += bflo(o.y); r[3] += bfhi(o.y); r[4] += bflo(o.z); r[5] += bfhi(o.z); r[6] += bflo(o.w); r[7] += bfhi(o.w); }
                    u32x4 w; w.x = cvt_pk_bf16(r[0], r[1]); w.y = cvt_pk_bf16(r[2], r[3]); w.z = cvt_pk_bf16(r[4], r[5]); w.w = cvt_pk_bf16(r[6], r[7]);
                    *(u32x4*)(Mg + row * DM + col0 + bj * HALF) = w;
                    if (u.seg == 2) { u32x2 q; q.x = pk4_fp8(r[0] * s8, r[1] * s8, r[2] * s8, r[3] * s8); q.y = pk4_fp8(r[4] * s8, r[5] * s8, r[6] * s8, r[7] * s8); *(u32x2*)(M8 + row * DM + col0 + bj * HALF) = q; } }
        }
    }
};
struct EpiResid {
    static constexpr bool PERM = false;
    const float* R; float* O;
    __device__ __forceinline__ void operator()(AccRef acc, const Unit& u, int wr, int wc, int fr, int fq) const {
        const int row0 = u.pm * BM + wr * 64 + fr, col0 = u.pn * BM + wc * 32 + 4 * fq;
#pragma unroll
        for (int ai = 0; ai < 2; ++ai) {
            f32x4 rv[16];
#pragma unroll
            for (int m = 0; m < 4; ++m)
#pragma unroll
                for (int bj = 0; bj < 2; ++bj)
#pragma unroll
                    for (int n = 0; n < 2; ++n) rv[m * 4 + bj * 2 + n] = *(const f32x4*)(R + (size_t)(row0 + ai * HALF + m * 16) * DM + col0 + bj * HALF + n * 16);
#pragma unroll
            for (int m = 0; m < 4; ++m)
#pragma unroll
                for (int bj = 0; bj < 2; ++bj)
#pragma unroll
                    for (int n = 0; n < 2; ++n) *(f32x4*)(O + (size_t)(row0 + ai * HALF + m * 16) * DM + col0 + bj * HALF + n * 16) = rv[m * 4 + bj * 2 + n] + acc[ai][bj][m][n];
            asm volatile("" ::: "memory"); }
    }
};
struct EpiResidS {
    static constexpr bool PERM = false;
    const float* R; float* O; float s;
    __device__ __forceinline__ void operator()(AccRef acc, const Unit& u, int wr, int wc, int fr, int fq) const {
        const int row0 = u.pm * BM + wr * 64 + fr, col0 = u.pn * BM + wc * 32 + 4 * fq;
#pragma unroll
        for (int ai = 0; ai < 2; ++ai) {
            f32x4 rv[16];
#pragma unroll
            for (int m = 0; m < 4; ++m)
#pragma unroll
                for (int bj = 0; bj < 2; ++bj)
#pragma unroll
                    for (int n = 0; n < 2; ++n) rv[m * 4 + bj * 2 + n] = *(const f32x4*)(R + (size_t)(row0 + ai * HALF + m * 16) * DM + col0 + bj * HALF + n * 16);
#pragma unroll
            for (int m = 0; m < 4; ++m)
#pragma unroll
                for (int bj = 0; bj < 2; ++bj)
#pragma unroll
                    for (int n = 0; n < 2; ++n) *(f32x4*)(O + (size_t)(row0 + ai * HALF + m * 16) * DM + col0 + bj * HALF + n * 16) = rv[m * 4 + bj * 2 + n] + acc[ai][bj][m][n] * s;
            asm volatile("" ::: "memory"); }
    }
};
struct EpiSwiglu {
    static constexpr bool PERM = true;
    bf16_t* O; int ldc;
    __device__ __forceinline__ void operator()(AccRef acc, const Unit& u, int wr, int wc, int fr, int fq) const {
        const int row0 = u.pm * BM + wr * 64 + fr; const int col0 = u.pn * HALF + wc * 32 + 8 * fq;
#pragma unroll
        for (int ai = 0; ai < 2; ++ai)
#pragma unroll
            for (int m = 0; m < 4; ++m) { bf16_t* rowp = O + (size_t)(row0 + ai * HALF + m * 16) * ldc + col0;
                float r[8];
#pragma unroll
                for (int n = 0; n < 2; ++n)
#pragma unroll
                    for (int j = 0; j < 4; ++j) { const float gt = acc[ai][0][m][n][j], up = acc[ai][1][m][n][j]; r[4 * n + j] = gt * sigmoidf_(gt) * up; }
                u32x4 w; w.x = cvt_pk_bf16(r[0], r[1]); w.y = cvt_pk_bf16(r[2], r[3]); w.z = cvt_pk_bf16(r[4], r[5]); w.w = cvt_pk_bf16(r[6], r[7]);
                *(u32x4*)rowp = w; }
    }
};
struct EpiSwigluF8 {
    static constexpr bool PERM = true;
    unsigned char* O; int ldc; float s_in, s_out;
    __device__ __forceinline__ void operator()(AccRef acc, const Unit& u, int wr, int wc, int fr, int fq) const {
        const int row0 = u.pm * BM + wr * 64 + fr; const int col0 = u.pn * HALF + wc * 32 + 8 * fq;
#pragma unroll
        for (int ai = 0; ai < 2; ++ai)
#pragma unroll
            for (int m = 0; m < 4; ++m) { unsigned char* rowp = O + (size_t)(row0 + ai * HALF + m * 16) * ldc + col0;
                float r[8];
#pragma unroll
                for (int n = 0; n < 2; ++n)
#pragma unroll
                    for (int j = 0; j < 4; ++j) { const float gt = acc[ai][0][m][n][j] * s_in, up = acc[ai][1][m][n][j] * s_in; r[4 * n + j] = gt * sigmoidf_(gt) * up * s_out; }
                u32x2 w; w.x = pk4_fp8(r[0], r[1], r[2], r[3]); w.y = pk4_fp8(r[4], r[5], r[6], r[7]);
                *(u32x2*)rowp = w; }
    }
};
struct EpiBf16S {
    static constexpr bool PERM = true;
    bf16_t* O; int ldc; float s;
    __device__ __forceinline__ void operator()(AccRef acc, const Unit& u, int wr, int wc, int fr, int fq) const {
        const int row0 = u.pm * BM + wr * 64 + fr; const int col0 = u.pn * BM + wc * 32 + 8 * fq;
#pragma unroll
        for (int ai = 0; ai < 2; ++ai)
#pragma unroll
            for (int m = 0; m < 4; ++m) { bf16_t* rowp = O + (size_t)(row0 + ai * HALF + m * 16) * ldc + col0;
#pragma unroll
                for (int bj = 0; bj < 2; ++bj) { const f32x4 v0 = acc[ai][bj][m][0] * s, v1 = acc[ai][bj][m][1] * s;
                    u32x4 w; w.x = cvt_pk_bf16(v0[0], v0[1]); w.y = cvt_pk_bf16(v0[2], v0[3]); w.z = cvt_pk_bf16(v1[0], v1[1]); w.w = cvt_pk_bf16(v1[2], v1[3]);
                    *(u32x4*)(rowp + bj * HALF) = w; } }
    }
};
}
struct Args { const void* in[29]; float* out; unsigned char* ws; int ph_lo, ph_hi, pad0, pad1; };
enum { I_X = 0, I_POS, I_ANG, I_WIN, I_AQG, I_AKG, I_BCQG, I_BCKVG, I_WUQ, I_WUKV, I_BQNG, I_BQRG, I_BKNG, I_BKRG, I_CQG, I_CKG, I_SINK, I_WAO, I_WBO, I_WCO, I_WO, I_FNG, I_FW1, I_FW3, I_FW2, I_RW, I_MW1, I_MW3, I_MW2 };

constexpr size_t MiB = 1u << 20;
constexpr size_t WS_CTL = 0, CTL_ZERO_BYTES = 1 * MiB;
constexpr size_t SZ_WIN = (size_t)NINP * DM * 2;
constexpr size_t SZ_WUQ = (size_t)512 * 256 * 2, SZ_WUKV = SZ_WUQ;
constexpr size_t SZ_WAO = (size_t)DM * 256 * 2, SZ_WBO = SZ_WAO, SZ_WCO = (size_t)DM * 512 * 2, SZ_WO = (size_t)DM * DM * 2;
constexpr size_t SZ_WIN8 = (size_t)GW * DM;
constexpr size_t SZ_WO8 = (size_t)DM * DM;
constexpr size_t SZ_LAYERW = SZ_WIN + SZ_WUQ + SZ_WUKV + SZ_WAO + SZ_WBO + SZ_WCO + SZ_WO + SZ_WIN8 + SZ_WO8;
constexpr size_t WS_LAYERW = 1 * MiB;
constexpr size_t OFF_WIN = 0, OFF_WUQ = OFF_WIN + SZ_WIN, OFF_WUKV = OFF_WUQ + SZ_WUQ, OFF_WAO = OFF_WUKV + SZ_WUKV, OFF_WBO = OFF_WAO + SZ_WAO, OFF_WCO = OFF_WBO + SZ_WBO, OFF_WO = OFF_WCO + SZ_WCO, OFF_WIN8 = OFF_WO + SZ_WO, OFF_WO8 = OFF_WIN8 + SZ_WIN8;
constexpr size_t WS_W13 = WS_LAYERW + 2 * SZ_LAYERW;
constexpr size_t SZ_W13 = (size_t)2 * DFF * DM * 2, SZ_W2 = (size_t)DM * DFF * 2;
constexpr size_t WS_W2 = WS_W13 + SZ_W13;
constexpr size_t WS_E13 = WS_W2 + SZ_W2;
constexpr size_t SZ_E13 = (size_t)2 * EFF * DM, SZ_E2 = (size_t)DM * EFF;
constexpr float S_W13 = 32.f, S_W2 = 64.f, S_ACT = 4.f, S_WG = 32.f, S_WO = 32.f, S_MG = 8.f;
constexpr size_t WS_E2 = WS_E13 + NEXP * SZ_E13;
constexpr size_t WS_ROPE = WS_E2 + NEXP * SZ_E2;
constexpr size_t SZ_ROPE = (size_t)NPOS * (32 + 32 + 16 + 16) * 4;
constexpr size_t WS_HB = ((WS_ROPE + SZ_ROPE + MiB - 1) / MiB) * MiB;
constexpr size_t SZ_HB = (size_t)(TCH + 1) * DM * 2;
constexpr size_t WS_HF8 = ((WS_HB + SZ_HB + MiB - 1) / MiB) * MiB;
constexpr size_t WS_ACT = WS_HF8 + (size_t)TCH * DM;
constexpr size_t A_P1 = 0;                                  constexpr size_t SZ_P1 = (size_t)TCH * P1W * 2;
constexpr size_t A_G = A_P1 + SZ_P1;                        constexpr size_t SZ_G = (size_t)TCH * GW * 2;
constexpr size_t A_QA = A_G + SZ_G;
constexpr size_t A_KA = A_QA + (size_t)TCH * 256 * 2;
constexpr size_t A_VA = A_KA + (size_t)TCH * 64 * 2;
constexpr size_t A_IQ = A_VA + (size_t)TCH * 64 * 2;
constexpr size_t A_IK = A_IQ + (size_t)TCH * 256 * 2;
constexpr size_t A_IW = A_IK + (size_t)TCH * 32 * 2;
constexpr size_t A_CQN = A_IW + (size_t)TCH * 8 * 4;
constexpr size_t A_CKVN = A_CQN + (size_t)TCH * 256 * 2;
constexpr size_t A_KR = A_CKVN + (size_t)TCH * 256 * 2;
constexpr size_t A_QC = A_KR + (size_t)TCH * 32 * 2;
constexpr size_t A_KC = A_QC + (size_t)TCH * 512 * 2;
constexpr size_t A_VCT = A_KC + (size_t)TCH * 128 * 2;
constexpr size_t A_QBR = A_VCT + (size_t)TCH * 128 * 2;
constexpr size_t A_KVBR = A_QBR + (size_t)TCH * 512 * 2;
constexpr size_t A_QB = A_KVBR + (size_t)TCH * 512 * 2;
constexpr size_t A_KB = A_QB + (size_t)TCH * 384 * 2;
constexpr size_t A_VBT = A_KB + (size_t)TCH * 384 * 2;
constexpr size_t A_SEL = A_VBT + (size_t)TCH * 256 * 2;
constexpr size_t A_SELN = A_SEL + (size_t)TCH * 256 * 2;
constexpr size_t A_Y = A_SELN + (size_t)TCH * 4;
constexpr size_t A_END = A_Y + (size_t)TCH * DM * 2;
constexpr size_t F_ACT = 0;
constexpr size_t F_YM = F_ACT + (size_t)MOE_ROWS * EFF * 2;
constexpr size_t F_ROWTOK = F_YM + (size_t)MOE_ROWS * DM * 2;
constexpr size_t F_TOPD = F_ROWTOK + (size_t)MOE_ROWS * 4;
constexpr size_t F_TOPE = F_TOPD + (size_t)TCH * 2 * 4;
constexpr size_t F_TOPG = F_TOPE + (size_t)TCH * 2 * 4;
constexpr size_t F_BLKE = F_TOPG + (size_t)TCH * 2 * 4;
constexpr size_t F_END = F_BLKE + 4096;
constexpr size_t WS_END = WS_ACT + (A_END > F_END ? A_END : F_END);
constexpr int CW_BAR = 4096;
constexpr int CW_Q = 16384;
constexpr int CW_MOE = 32768;
constexpr int CW_DBG = 65536;

constexpr int RING_OFF = 0;
constexpr int IDX_HP = 1028;
constexpr int IDX_HIST = 0, IDX_BITMAP = 0, IDX_CANDK = 32768, IDX_CANDI = 98304, IDX_QT = 131584  , IDX_SUBH = IDX_QT  ,
              IDX_QPAR = 152576, IDX_CCNT = 153600, IDX_FLAG = 153728;
constexpr int IDX_CCAP = 512, IDX_RCAP = 256;
constexpr int MISC_OFF = 153856;
constexpr int LDS_BYTES = 155648;
constexpr int NWAVES = 8;
#ifndef MK_TIMER
#define MK_TIMER 0
#endif
#define TMR_ACC ((LAS unsigned*)(size_t)(MISC_OFF + 192))
#define TB(id) unsigned long long tb_##id = 0ull; if (MK_TIMER == (id)) tb_##id = __builtin_amdgcn_s_memrealtime()
#define TE(id) do { if (MK_TIMER == (id)) { const unsigned d_ = (unsigned)(__builtin_amdgcn_s_memrealtime() - tb_##id); if (lane_id() == 0) lds_add(TMR_ACC, d_); } } while (0)

#define XB_TMO      128
#define XB_XCNT(j)  (256  + 64 * (j))
#define XB_XSUB(j)  (1280 + 64 * (j))
#define XB_XGEN(j)  (2304 + 64 * (j))
#define XB_TOP      3328
#define XB_TOPGEN   3392
#define XCD_BAR_WORDS 3456
#define XB_SPIN_CAP (1u << 18)

__device__ __forceinline__ unsigned xb_ld(unsigned* p)              { return __hip_atomic_load(p, __ATOMIC_RELAXED, __HIP_MEMORY_SCOPE_AGENT); }
__device__ __forceinline__ unsigned xb_add(unsigned* p, unsigned v) { return __hip_atomic_fetch_add(p, v, __ATOMIC_RELAXED, __HIP_MEMORY_SCOPE_AGENT); }
__device__ __forceinline__ unsigned xb_xcc_id() { return (unsigned)__builtin_amdgcn_s_getreg((3 << 11) | 20) & 0xFu; }
#define XB_SPIN(cond, bar) do { unsigned _sp = 0; while (cond) { __builtin_amdgcn_s_sleep(1); \
    if ((++_sp & 255u) == 0u) { if (xb_ld(&(bar)[XB_TMO])) break; if (_sp > XB_SPIN_CAP) { atomicAdd(&(bar)[XB_TMO], 1u); break; } } } } while (0)

struct XcdBarrier {
    unsigned* bar; unsigned x;
    volatile LAS unsigned* st;
};
__device__ __forceinline__ XcdBarrier xcd_barrier_post(unsigned* bar, volatile LAS unsigned* st, int wave_) {
    XcdBarrier b; b.bar = bar; b.x = xb_xcc_id(); b.st = st;
    if (wave_ == 0 && lane_id() == 0) (void)xb_add(&bar[XB_XCNT(b.x)], 1u);
    return b;
}
__device__ __forceinline__ void xcd_barrier_complete(unsigned* bar, unsigned x, unsigned& nloc, unsigned& nx) {
    const unsigned G = gridDim.x * gridDim.y * gridDim.z;
    unsigned sum, cnt, mine, sp = 0u;
    for (;;) {
        sum = 0u; cnt = 0u; mine = 0u;
#pragma unroll
        for (unsigned j = 0; j < 16; ++j) { const unsigned c = xb_ld(&bar[XB_XCNT(j)]); sum += c; cnt += (c > 0u) ? 1u : 0u; mine = (j == x) ? c : mine; }
        if (sum == G) break;
        __builtin_amdgcn_s_sleep(1);
        if ((++sp & 255u) == 0u) { if (xb_ld(&bar[XB_TMO])) break; if (sp > XB_SPIN_CAP) { atomicAdd(&bar[XB_TMO], 1u); break; } }
    }
    nloc = mine > 0u ? mine : 1u; nx = cnt > 0u ? cnt : 1u;
}
__device__ __forceinline__ void xcd_barrier(const XcdBarrier& b, int wave_) {
    asm volatile("s_waitcnt vmcnt(0)" ::: "memory");
    __syncthreads();
    if (wave_ == 0 && lane_id() == 0) {
        unsigned* bar = b.bar;
        __builtin_amdgcn_s_waitcnt(0);
        unsigned nloc = b.st[0], nx = b.st[1];
        if (nloc == 0u) { xcd_barrier_complete(bar, b.x, nloc, nx); b.st[0] = nloc; b.st[1] = nx; }
        const unsigned old = xb_add(&bar[XB_XSUB(b.x)], 1u);
        const unsigned gen = old / nloc;
        if (old + 1u == (gen + 1u) * nloc) {
            __builtin_amdgcn_fence(__ATOMIC_RELEASE, "agent");
            asm volatile("s_waitcnt vmcnt(0)" ::: "memory");
            const unsigned og = xb_add(&bar[XB_TOP], 1u);
            const unsigned tg = og / nx;
            if (og + 1u == (tg + 1u) * nx) xb_add(&bar[XB_TOPGEN], 1u);
            else XB_SPIN(xb_ld(&bar[XB_TOPGEN]) == tg, bar);
            __builtin_amdgcn_fence(__ATOMIC_ACQUIRE, "agent");
            xb_add(&bar[XB_XGEN(b.x)], 1u);
            asm volatile("s_waitcnt vmcnt(0)" ::: "memory");
        } else {
            XB_SPIN(xb_ld(&bar[XB_XGEN(b.x)]) == gen, bar);
            __builtin_amdgcn_fence(__ATOMIC_ACQUIRE, "agent");
            asm volatile("s_waitcnt vmcnt(0)" ::: "memory");
        }
    }
    __syncthreads();
}

template <int MAP> __device__ __forceinline__ int wt_row(int n) {
    if (MAP == 1) return n < C_G ? n : n + (P1W - C_G);
    if (MAP == 2) return 256 * (n >> 7) + (n & 127);
    if (MAP == 3) return 256 * (n >> 7) + 128 + (n & 127);
    return n;
}
template <int MAP>
__device__ __forceinline__ void transpose_item(const float* W, int K, int N, bf16_t* WT, int ldk, LAS float* scr, int item, int lane) {
    const int nblk = (N + 31) / 32, kb = item / nblk, nb = item % nblk, k0 = 64 * kb, n0 = 32 * nb;
    const int nn = n0 + (lane & 31); const bool nok = nn < N;
#pragma unroll
    for (int i = 0; i < 32; ++i) { const int kk = 2 * i + (lane >> 5); scr[kk * 33 + (lane & 31)] = nok ? W[(size_t)(k0 + kk) * N + nn] : 0.f; }
    LDS_WAIT(); asm volatile("" ::: "memory");
    const int c = lane & 7;
#pragma unroll
    for (int j = 0; j < 4; ++j) { const int n = (lane >> 3) + 8 * j; const LAS float* s = scr + (8 * c) * 33 + n;
        u32x4 o; o.x = pk2(s[0 * 33], s[1 * 33]); o.y = pk2(s[2 * 33], s[3 * 33]); o.z = pk2(s[4 * 33], s[5 * 33]); o.w = pk2(s[6 * 33], s[7 * 33]);
        if (n0 + n < N) *(u32x4*)(WT + (size_t)wt_row<MAP>(n0 + n) * ldk + k0 + 8 * c) = o; }
    LDS_WAIT(); asm volatile("" ::: "memory");
}

template <int MAP>
__device__ __forceinline__ void transpose_item_f8(const float* W, int K, int N, unsigned char* WT, int ldk, float sc, LAS float* scr, int item, int lane, int ldn = 0  ) {
    if (ldn == 0) ldn = N;
    const int nblk = (N + 31) / 32, kb = item / nblk, nb = item % nblk, n0 = 32 * nb;
    const int nn = n0 + (lane & 31); const bool nok = nn < N;
    const int c = lane & 7;
#pragma unroll 1
    for (int h = 0; h < 2; ++h) { const int k0 = 128 * kb + 64 * h;
#pragma unroll
        for (int i = 0; i < 32; ++i) { const int kk = 2 * i + (lane >> 5); scr[kk * 33 + (lane & 31)] = nok ? W[(size_t)(k0 + kk) * ldn + nn] * sc : 0.f; }
        LDS_WAIT(); asm volatile("" ::: "memory");
#pragma unroll
        for (int j = 0; j < 4; ++j) { const int n = (lane >> 3) + 8 * j; const LAS float* s = scr + (8 * c) * 33 + n;
            u32x2 o; o.x = pk4_fp8(s[0 * 33], s[1 * 33], s[2 * 33], s[3 * 33]); o.y = pk4_fp8(s[4 * 33], s[5 * 33], s[6 * 33], s[7 * 33]);
            if (n0 + n < N) *(u32x2*)(WT + (size_t)wt_row<MAP>(n0 + n) * ldk + k0 + 8 * c) = o; }
        LDS_WAIT(); asm volatile("" ::: "memory"); }
}
struct RopeTab { const float* c64; const float* s64; const float* c32; const float* s32; };

__device__ __forceinline__ void rope_cs(const RopeTab& R, int pos, int i, int half, float& c, float& s) {
    pos = pos < 0 ? 0 : (pos >= NPOS ? NPOS - 1 : pos);
    if (half == 32) { c = R.c64[pos * 32 + i]; s = R.s64[pos * 32 + i]; } else { c = R.c32[pos * 16 + i]; s = R.s32[pos * 16 + i]; }
}

__device__ __forceinline__ void norm_rows(const float* x, const float* g, bf16_t* HB, unsigned char* HF8, int gw, int ngw, int lane) {
    asm volatile("" : "+v"(lane));
    f32x4 gv[4];
#pragma unroll
    for (int j = 0; j < 4; ++j) gv[j] = *(const f32x4*)(g + 4 * lane + 256 * j);
    for (int tok = gw; tok < TCH; tok += ngw) {
        const float* xr = x + (size_t)tok * DM; f32x4 v[4]; float ss = 0.f;
#pragma unroll
        for (int j = 0; j < 4; ++j) { v[j] = *(const f32x4*)(xr + 4 * lane + 256 * j); ss += (v[j].x * v[j].x + v[j].y * v[j].y) + (v[j].z * v[j].z + v[j].w * v[j].w); }
        const float rstd = 1.0f / sqrtf(wave_sum(ss) * (1.0f / DM) + EPS);
        bf16_t* o = HB + (size_t)tok * DM;
#pragma unroll
        for (int j = 0; j < 4; ++j) { const float y0 = v[j].x * rstd * gv[j].x, y1 = v[j].y * rstd * gv[j].y, y2 = v[j].z * rstd * gv[j].z, y3 = v[j].w * rstd * gv[j].w;
            u32x2 w; w.x = pk2(y0, y1); w.y = pk2(y2, y3); *(u32x2*)(o + 4 * lane + 256 * j) = w;
            *(unsigned*)(HF8 + (size_t)tok * DM + 4 * lane + 256 * j) = pk4_fp8(y0, y1, y2, y3); }
    }
}

struct PP1Args {
    const bf16_t* P1; const int* pos;
    const float *aq_g, *ak_g, *cq_g, *ckv_g, *kr_g, *qc_g, *kc_g;
    unsigned char* act;
    RopeTab R;
};
constexpr float SC_A = 0.125f * LOG2E;
constexpr float SC_B = 0.10206207261596577f * LOG2E;
constexpr float SC_IW = 0.35355339059327373f * 0.17677669529663687f;
__device__ __forceinline__ void pp1_rows(const PP1Args& a, LAS unsigned char* wl  , int gw, int ngw, int lane) {
    asm volatile("" : "+v"(lane));
    const int i32 = lane & 31, hf = lane >> 5, i16 = lane & 15, qt = lane >> 4;
    const float gaq1 = a.aq_g[i32], gaq2 = a.aq_g[32 + i32], gak1 = a.ak_g[i32], gak2 = a.ak_g[32 + i32], gqc1 = a.qc_g[i32], gqc2 = a.qc_g[32 + i32], gkc1 = a.kc_g[i32], gkc2 = a.kc_g[32 + i32];
    const float gkr1 = a.kr_g[i16], gkr2 = a.kr_g[16 + i16];
    u32x4 nx[4]; int npos = 0;
    if (gw < TCH) { const u32x4* src = (const u32x4*)(a.P1 + (size_t)gw * P1W);
#pragma unroll
        for (int j = 0; j < 4; ++j) nx[j] = src[lane + 64 * j];
        npos = a.pos[gw]; }
    int buf = 0;
    for (int tok = gw; tok < TCH; tok += ngw, buf ^= 1) {
        LAS unsigned char* rowb = wl + buf * 4096;
#pragma unroll
        for (int j = 0; j < 4; ++j) *(LAS u32x4*)(rowb + (lane + 64 * j) * 16) = nx[j];
        const int pos = npos;
        if (tok + ngw < TCH) { const u32x4* src = (const u32x4*)(a.P1 + (size_t)(tok + ngw) * P1W);
#pragma unroll
            for (int j = 0; j < 4; ++j) nx[j] = src[lane + 64 * j];
            npos = a.pos[tok + ngw]; }
        const LAS bf16_t* p = (const LAS bf16_t*)rowb;
        const int bl = tok / SEQ, s = tok % SEQ;
        float c64, s64, c32, s32; rope_cs(a.R, pos, i32, 32, c64, s64); rope_cs(a.R, pos, i16, 16, c32, s32);
#pragma unroll
        for (int it = 0; it < 8; ++it) {
            const int hh = 2 * it + hf;
            const int kind = hh < 4 ? 0 : (hh == 4 ? 1 : (hh < 13 ? 2 : 3));
            const int hsub = kind == 0 ? hh : (kind == 1 ? 0 : (kind == 2 ? hh - 5 : ((hh - 13) & 1)));
            const int src = (kind == 0 ? C_QA : (kind == 1 ? C_KA : (kind == 2 ? C_QC : C_KC))) + 64 * hsub;
            const size_t dbase = kind == 0 ? A_QA : (kind == 1 ? A_KA : (kind == 2 ? A_QC : A_KC));
            const int dpitch = kind == 0 ? 256 : (kind == 1 ? 64 : (kind == 2 ? 512 : 128));
            const float g1 = kind == 0 ? gaq1 : (kind == 1 ? gak1 : (kind == 2 ? gqc1 : gkc1)), g2 = kind == 0 ? gaq2 : (kind == 1 ? gak2 : (kind == 2 ? gqc2 : gkc2));
            const float sc = (kind == 0 || kind == 2) ? SC_A : 1.f;
            bf16_t* dst = (bf16_t*)(a.act + dbase) + (size_t)tok * dpitch + 64 * hsub;
            const float x1 = bf2f(p[src + i32]), x2 = bf2f(p[src + 32 + i32]);
            const float rstd = 1.0f / sqrtf(sum32(x1 * x1 + x2 * x2) * (1.0f / 64.0f) + EPS);
            const float y1 = x1 * rstd * g1, y2 = x2 * rstd * g2;
            const float o1 = (y1 * c64 - y2 * s64) * sc, o2 = (y2 * c64 + y1 * s64) * sc;
            if (hh < 15) { dst[i32] = (bf16_t)f2bf(o1); dst[32 + i32] = (bf16_t)f2bf(o2); }
        }
#pragma unroll
        for (int it = 0; it < 3; ++it) {
            const int hh = 4 * it + qt; const int kind = hh < 8 ? 0 : (hh == 8 ? 1 : 2);
            const int src = kind == 0 ? C_IQ + 32 * hh : (kind == 1 ? C_IK : C_KR);
            const size_t dbase = kind == 0 ? A_IQ : (kind == 1 ? A_IK : A_KR);
            bf16_t* dst = (bf16_t*)(a.act + dbase) + (size_t)tok * (kind == 0 ? 256 : 32) + (kind == 0 ? 32 * hh : 0);
            float x1 = bf2f(p[src + i16]), x2 = bf2f(p[src + 16 + i16]);
            const float ss = sum16(x1 * x1 + x2 * x2);
            if (kind == 2) { const float rstd = 1.0f / sqrtf(ss * (1.0f / 32.0f) + EPS); x1 *= rstd * gkr1; x2 *= rstd * gkr2; }
            const float o1 = x1 * c32 - x2 * s32, o2 = x2 * c32 + x1 * s32;
            if (hh < 10) { dst[i16] = (bf16_t)f2bf(o1); dst[16 + i16] = (bf16_t)f2bf(o2); }
        }
        if (lane < 8) ((float*)(a.act + A_IW))[(size_t)tok * 8 + lane] = bf2f(p[C_IW + lane]) * SC_IW;
        ((bf16_t*)(a.act + A_VA))[(size_t)tok * 64 + lane] = p[C_VA + lane];
        { const u32x2 w = *(const LAS u32x2*)(p + C_CQ + 4 * lane); const float x0 = bflo(w.x), x1 = bfhi(w.x), x2 = bflo(w.y), x3 = bfhi(w.y);
          const float rstd = 1.0f / sqrtf(wave_sum((x0 * x0 + x1 * x1) + (x2 * x2 + x3 * x3)) * (1.0f / 256.0f) + EPS);
          const f32x4 g = *(const f32x4*)(a.cq_g + 4 * lane);
          u32x2 o; o.x = pk2(x0 * rstd * g.x, x1 * rstd * g.y); o.y = pk2(x2 * rstd * g.z, x3 * rstd * g.w); *(u32x2*)((bf16_t*)(a.act + A_CQN) + (size_t)tok * 256 + 4 * lane) = o; }
        { const unsigned w = *(const LAS unsigned*)(p + C_CKV + 2 * lane); const float x0 = bflo(w), x1 = bfhi(w);
          const float rstd = 1.0f / sqrtf(wave_sum(x0 * x0 + x1 * x1) * (1.0f / 128.0f) + EPS);
          const f32x2 g = *(const f32x2*)(a.ckv_g + 2 * lane);
          bf16_t* ck = (bf16_t*)(a.act + A_CKVN) + (size_t)tok * 256;
          *(unsigned*)(ck + 2 * lane) = pk2(x0 * rstd * g.x, x1 * rstd * g.y);
          *(unsigned*)(ck + 128 + 2 * lane) = 0u; }
#pragma unroll
        for (int kvh = 0; kvh < 2; ++kvh) ((bf16_t*)(a.act + A_VCT))[((size_t)(bl * 2 + kvh) * 64 + lane) * SEQ + s] = p[C_VC + 64 * kvh + lane];
    }
}

struct PP2Args {
    const bf16_t *QBR, *KVBR, *KR; const int* pos;
    const float *qn_g, *qr_g, *kn_g;
    bf16_t *QB, *KB, *VBT; RopeTab R;
};
__device__ __forceinline__ void pp2_rows(const PP2Args& a, LAS unsigned char* wl  , int gw, int ngw, int lane) {
    asm volatile("" : "+v"(lane));
    const int i32 = lane & 31, hf = lane >> 5;
    u32x4 nx[2]; unsigned nkr = 0u; int npos = 0;
    if (gw < TCH) { const u32x4* src = (const u32x4*)(a.QBR + (size_t)gw * 1024); nx[0] = src[lane]; nx[1] = src[64 + lane]; if (lane < 16) nkr = ((const unsigned*)(a.KR + (size_t)gw * 32))[lane]; npos = a.pos[gw]; }
    int buf = 0;
    for (int tok = gw; tok < TCH; tok += ngw, buf ^= 1) {
        LAS unsigned char* rowb = wl + buf * 4096;
        *(LAS u32x4*)(rowb + lane * 16) = nx[0]; *(LAS u32x4*)(rowb + (64 + lane) * 16) = nx[1]; if (lane < 16) *(LAS unsigned*)(rowb + 2048 + lane * 4) = nkr;
        const int pos = npos;
        if (tok + ngw < TCH) { const u32x4* src = (const u32x4*)(a.QBR + (size_t)(tok + ngw) * 1024); nx[0] = src[lane]; nx[1] = src[64 + lane]; if (lane < 16) nkr = ((const unsigned*)(a.KR + (size_t)(tok + ngw) * 32))[lane]; npos = a.pos[tok + ngw]; }
        const int bl = tok / SEQ, s = tok % SEQ;
        float c32 = 0.f, s32 = 0.f; if (i32 < 16) rope_cs(a.R, pos, i32, 16, c32, s32);
        const LAS bf16_t* q = (const LAS bf16_t*)rowb; const LAS bf16_t* kv = q + 512; const LAS bf16_t* krl = q + 1024;
        bf16_t* qo = a.QB + (size_t)tok * 384; bf16_t* ko = a.KB + (size_t)tok * 384;
#pragma unroll
        for (int it = 0; it < 2; ++it) {
            const int h = 2 * it + hf;
            { const float x1 = bf2f(q[h * 96 + i32]), x2 = bf2f(q[h * 96 + 32 + i32]);
              const float rstd = 1.0f / sqrtf(sum32(x1 * x1 + x2 * x2) * (1.0f / 64.0f) + EPS);
              qo[h * 96 + i32] = (bf16_t)f2bf(x1 * rstd * a.qn_g[i32] * SC_B); qo[h * 96 + 32 + i32] = (bf16_t)f2bf(x2 * rstd * a.qn_g[32 + i32] * SC_B); }
            { const bool on = i32 < 16; const float x1 = on ? bf2f(q[h * 96 + 64 + i32]) : 0.f, x2 = on ? bf2f(q[h * 96 + 80 + i32]) : 0.f;
              const float rstd = 1.0f / sqrtf(sum32(x1 * x1 + x2 * x2) * (1.0f / 32.0f) + EPS);
              const float y1 = x1 * rstd * (on ? a.qr_g[i32] : 0.f), y2 = x2 * rstd * (on ? a.qr_g[16 + i32] : 0.f);
              if (on) { qo[h * 96 + 64 + i32] = (bf16_t)f2bf((y1 * c32 - y2 * s32) * SC_B); qo[h * 96 + 80 + i32] = (bf16_t)f2bf((y2 * c32 + y1 * s32) * SC_B); } }
            { const float x1 = bf2f(kv[h * 128 + i32]), x2 = bf2f(kv[h * 128 + 32 + i32]);
              const float rstd = 1.0f / sqrtf(sum32(x1 * x1 + x2 * x2) * (1.0f / 64.0f) + EPS);
              ko[h * 96 + i32] = (bf16_t)f2bf(x1 * rstd * a.kn_g[i32]); ko[h * 96 + 32 + i32] = (bf16_t)f2bf(x2 * rstd * a.kn_g[32 + i32]);
              ko[h * 96 + 64 + i32] = krl[i32];
              a.VBT[((size_t)(bl * 4 + h) * 64 + i32) * SEQ + s] = kv[h * 128 + 64 + i32];
              a.VBT[((size_t)(bl * 4 + h) * 64 + 32 + i32) * SEQ + s] = kv[h * 128 + 96 + i32]; }
        }
    }
}

struct RouteArgs { const float* rw; int* TOPE; float* TOPG; int* TOPD; unsigned* cursor; };
template <bool ROUTE>
__device__ __forceinline__ void norm2_rows(const float* x, const float* g, bf16_t* HB, unsigned char* HF8  , const RouteArgs& ra, LAS unsigned* lcnt  , int vcu, int wave, int lane, int G) {
    asm volatile("" : "+v"(lane));
    int tidx = wave * 64 + lane;
    const int tpw = TCH / G; const int t0 = vcu * tpw;
    f32x4 gv[4];
#pragma unroll
    for (int j = 0; j < 4; ++j) gv[j] = *(const f32x4*)(g + 4 * lane + 256 * j);
    for (int tl = wave; tl < tpw; tl += NWAVES) {
        const int tok = t0 + tl;
        const float* xr = x + (size_t)tok * DM; f32x4 v[4]; float ss = 0.f;
#pragma unroll
        for (int j = 0; j < 4; ++j) { v[j] = *(const f32x4*)(xr + 4 * lane + 256 * j); ss += (v[j].x * v[j].x + v[j].y * v[j].y) + (v[j].z * v[j].z + v[j].w * v[j].w); }
        const float rstd = 1.0f / sqrtf(wave_sum(ss) * (1.0f / DM) + EPS);
        bf16_t* o = HB + (size_t)tok * DM;
#pragma unroll
        for (int j = 0; j < 4; ++j) { v[j].x *= rstd * gv[j].x; v[j].y *= rstd * gv[j].y; v[j].z *= rstd * gv[j].z; v[j].w *= rstd * gv[j].w;
            u32x2 w; w.x = pk2(v[j].x, v[j].y); w.y = pk2(v[j].z, v[j].w); *(u32x2*)(o + 4 * lane + 256 * j) = w;
            if (!ROUTE) *(unsigned*)(HF8 + (size_t)tok * DM + 4 * lane + 256 * j) = pk4_fp8(v[j].x, v[j].y, v[j].z, v[j].w); }
        if (ROUTE) {
            float lg[NEXP];
#pragma unroll
            for (int e = 0; e < NEXP; ++e) lg[e] = 0.f;
#pragma unroll
            for (int j = 0; j < 4; ++j)
#pragma unroll
                for (int c = 0; c < 4; ++c) { const float hv = v[j][c]; const float* wr = ra.rw + (size_t)(4 * lane + 256 * j + c) * NEXP;
                    const f32x4 w0 = *(const f32x4*)wr, w1 = *(const f32x4*)(wr + 4);
                    lg[0] += hv * w0.x; lg[1] += hv * w0.y; lg[2] += hv * w0.z; lg[3] += hv * w0.w; lg[4] += hv * w1.x; lg[5] += hv * w1.y; lg[6] += hv * w1.z; lg[7] += hv * w1.w; }
#pragma unroll
            for (int e = 0; e < NEXP; ++e) lg[e] = wave_sum(lg[e]);
            int e1 = 0; float l1 = lg[0];
#pragma unroll
            for (int e = 1; e < NEXP; ++e) if (lg[e] > l1) { l1 = lg[e]; e1 = e; }
            int e2 = -1; float l2 = -INFINITY;
#pragma unroll
            for (int e = 0; e < NEXP; ++e) if (e != e1 && lg[e] > l2) { l2 = lg[e]; e2 = e; }
            const float ex = __expf(l2 - l1); const float g1 = 1.0f / (1.0f + ex), g2 = ex / (1.0f + ex);
            if (lane == 0) {
                const unsigned p1 = lds_add(lcnt + e1, 1u), p2 = lds_add(lcnt + e2, 1u);
                ra.TOPE[2 * tok] = e1; ra.TOPE[2 * tok + 1] = e2; ra.TOPG[2 * tok] = g1; ra.TOPG[2 * tok + 1] = g2; ra.TOPD[2 * tok] = (int)p1; ra.TOPD[2 * tok + 1] = (int)p2;
            }
        }
    }
    if (ROUTE) {
        VM_WAIT(); __syncthreads();
        if (tidx < NEXP) { const unsigned n = lcnt[tidx]; lcnt[8 + tidx] = __hip_atomic_fetch_add(ra.cursor + tidx, n, __ATOMIC_RELAXED, __HIP_MEMORY_SCOPE_AGENT); }
        __syncthreads();
        for (int i = tidx; i < 2 * tpw; i += NWAVES * 64) { const int idx = 2 * t0 + i; const int e = ra.TOPE[idx]; ra.TOPD[idx] += (int)lcnt[8 + e]; }
        __syncthreads();
        if (tidx < 16) lcnt[tidx] = 0u;
        __syncthreads();
    }
}

__device__ __forceinline__ void moe_layout(const unsigned* cursor, int* pstart  ) {
    int acc = 0;
#pragma unroll
    for (int e = 0; e < NEXP; ++e) { pstart[e] = acc; const int c = (int)__hip_atomic_load(cursor + e, __ATOMIC_RELAXED, __HIP_MEMORY_SCOPE_AGENT); acc += (c + 255) / 256 * 256; }
    pstart[NEXP] = acc;
}
__device__ __forceinline__ void moe_scatter(const unsigned* cursor, const int* TOPE, int* TOPD, const bf16_t* HB, bf16_t* XB, int* BLKE, int gw, int ngw, int lane) {
    asm volatile("" : "+v"(lane));
    int ps[NEXP + 1]; moe_layout(cursor, ps);
    for (int i = gw; i < 2 * TCH; i += ngw) { const int e = TOPE[i];
        int base = 0;
#pragma unroll
        for (int k = 1; k < NEXP; ++k) base = (e == k) ? ps[k] : base;
        const int dest = base + TOPD[i];
        const u32x4* src = (const u32x4*)(HB + (size_t)(i >> 1) * DM); u32x4* dst = (u32x4*)((unsigned char*)XB + (size_t)dest * DM);
        const u32x4 v0 = src[2 * lane], v1 = src[2 * lane + 1];
        u32x4 o; o.x = pk4_fp8(bflo(v0.x), bfhi(v0.x), bflo(v0.y), bfhi(v0.y)); o.y = pk4_fp8(bflo(v0.z), bfhi(v0.z), bflo(v0.w), bfhi(v0.w));
        o.z = pk4_fp8(bflo(v1.x), bfhi(v1.x), bflo(v1.y), bfhi(v1.y)); o.w = pk4_fp8(bflo(v1.z), bfhi(v1.z), bflo(v1.w), bfhi(v1.w));
        dst[lane] = o;
        if (lane == 0) TOPD[i] = dest; }
#pragma unroll
    for (int e = 0; e < NEXP; ++e) { const int cnt = (int)__hip_atomic_load(cursor + e, __ATOMIC_RELAXED, __HIP_MEMORY_SCOPE_AGENT);
        for (int r = ps[e] + cnt + gw; r < ps[e + 1]; r += ngw) { u32x4* dst = (u32x4*)((unsigned char*)XB + (size_t)r * DM); dst[lane] = (u32x4){0u, 0u, 0u, 0u}; }
        for (int blk = ps[e] / 256 + gw * 64 + lane; blk < ps[e + 1] / 256; blk += ngw * 64) BLKE[blk] = e; }
}
__device__ __forceinline__ void moe_combine(float* xio, const bf16_t* YM, const int* TOPD, const float* TOPG, int gw, int ngw, int lane) {
    asm volatile("" : "+v"(lane));
    for (int tok = gw; tok < TCH; tok += ngw) {
        const int d1 = TOPD[2 * tok], d2 = TOPD[2 * tok + 1]; const float g1 = TOPG[2 * tok], g2 = TOPG[2 * tok + 1];
        float* xr = xio + (size_t)tok * DM; const bf16_t* y1 = YM + (size_t)d1 * DM; const bf16_t* y2 = YM + (size_t)d2 * DM;
#pragma unroll
        for (int j = 0; j < 4; ++j) { const int c = 4 * lane + 256 * j; f32x4 v = *(const f32x4*)(xr + c); const u32x2 a = *(const u32x2*)(y1 + c), b = *(const u32x2*)(y2 + c);
            v.x += bflo(a.x) * g1 + bflo(b.x) * g2; v.y += bfhi(a.x) * g1 + bfhi(b.x) * g2; v.z += bflo(a.y) * g1 + bflo(b.y) * g2; v.w += bfhi(a.y) * g1 + bfhi(b.y) * g2;
            *(f32x4*)(xr + c) = v; }
    }
}

__device__ __forceinline__ int kappa32(int m) { return (m & ~12) | ((m & 8) >> 1) | ((m & 4) << 1); }
template <int DQK>
__device__ __forceinline__ void fa_unit(LAS unsigned char* lds, int wave_, const bf16_t* Qw, int qpitch, const bf16_t* Kb, int kpitch, const bf16_t* VTb,
                                        int tile_lo, int tile_hi, int qpos0w, int window, float m_init, float l_init, bf16_t* Ow, int opitch) {
    constexpr int KP = DQK * 2 + 16, VP = 144, KBUF = 64 * KP, VBUF = 64 * VP, KCH = DQK / 8, NKC = 64 * KCH;
    int tid = wave_ * 64 + lane_id(); asm volatile("" : "+v"(tid));
    const int lane = tid & 63, r32 = lane & 31, hi = lane >> 5;
    bf16x8 qf[DQK / 16];
#pragma unroll
    for (int d0 = 0; d0 < DQK / 16; ++d0) qf[d0] = *(const bf16x8*)(Qw + (size_t)r32 * qpitch + d0 * 16 + hi * 8);
    const int kr0 = tid / KCH, kc0 = tid % KCH, kr1 = (tid + 512) / KCH, kc1 = (tid + 512) % KCH; const bool has1 = (tid + 512) < NKC;
    const int vr = tid >> 3, vc = tid & 7;
    u32x4 pk0, pk1 = (u32x4){0u, 0u, 0u, 0u}, pv;
#define FA_LOAD(t) do { const bf16_t* kt_ = Kb + (size_t)(64 * (t)) * kpitch; pk0 = *(const u32x4*)(kt_ + (size_t)kr0 * kpitch + kc0 * 8); if (has1) pk1 = *(const u32x4*)(kt_ + (size_t)kr1 * kpitch + kc1 * 8); \
        pv = *(const u32x4*)(VTb + (size_t)vr * SEQ + 64 * (t) + vc * 8); } while (0)
#define FA_STORE(b) do { LAS unsigned char* kd_ = lds + (b) * KBUF; *(LAS u32x4*)(kd_ + kr0 * KP + kc0 * 16) = pk0; if (has1) *(LAS u32x4*)(kd_ + kr1 * KP + kc1 * 16) = pk1; \
        *(LAS u32x4*)(lds + 2 * KBUF + (b) * VBUF + vr * VP + vc * 16) = pv; } while (0)
    float m_run = m_init, l_run = (hi == 0) ? l_init : 0.f;
    f32x16 o0, o1;
#pragma unroll
    for (int i = 0; i < 16; ++i) { o0[i] = 0.f; o1[i] = 0.f; }
    const int qpos = qpos0w + r32; const int krow = kappa32(r32);
    __syncthreads();
    FA_LOAD(tile_lo); FA_STORE(0);
    __syncthreads();
    for (int t = tile_lo; t < tile_hi; ++t) {
        const int buf = (t - tile_lo) & 1;
        if (t + 1 < tile_hi) FA_LOAD(t + 1);
        const int kbase = 64 * t;
        const bool active = (kbase <= qpos0w + 31) && (window == 0 || kbase + 63 > qpos0w - window);
        if (active) {
            const LAS unsigned char* Kt = lds + buf * KBUF; const LAS unsigned char* Vt = lds + 2 * KBUF + buf * VBUF;
            f32x16 s0, s1;
#pragma unroll
            for (int i = 0; i < 16; ++i) { s0[i] = 0.f; s1[i] = 0.f; }
#pragma unroll
            for (int d0 = 0; d0 < DQK / 16; ++d0) {
                const bf16x8 k0 = *(const LAS bf16x8*)(Kt + krow * KP + d0 * 32 + hi * 16);
                const bf16x8 k1 = *(const LAS bf16x8*)(Kt + (32 + krow) * KP + d0 * 32 + hi * 16);
                s0 = __builtin_amdgcn_mfma_f32_32x32x16_bf16(k0, qf[d0], s0, 0, 0, 0);
                s1 = __builtin_amdgcn_mfma_f32_32x32x16_bf16(k1, qf[d0], s1, 0, 0, 0);
            }
            const bool need_mask = (kbase + 63 > qpos0w) || (window != 0 && kbase <= qpos0w + 31 - window);
            if (need_mask) {
#pragma unroll
                for (int i = 0; i < 16; ++i) { const int key = kbase + 16 * (i >> 3) + 8 * hi + (i & 7);
                    const bool ok0 = (key <= qpos) && (window == 0 || key > qpos - window), ok1 = (key + 32 <= qpos) && (window == 0 || key + 32 > qpos - window);
                    s0[i] = ok0 ? s0[i] : -INFINITY; s1[i] = ok1 ? s1[i] : -INFINITY; }
            }
            float mx = fmaxf(s0[0], s1[0]);
#pragma unroll
            for (int i = 1; i < 16; ++i) mx = fmaxf(mx, fmaxf(s0[i], s1[i]));
            mx = half_max(mx);
            const float m_new = fmaxf(m_run, mx); const float m_use = (m_new == -INFINITY) ? 0.f : m_new;
            const float alpha = fast_exp2(m_run - m_use);
            m_run = m_new;
            float rs = 0.f;
#pragma unroll
            for (int i = 0; i < 16; ++i) { s0[i] = fast_exp2(s0[i] - m_use); s1[i] = fast_exp2(s1[i] - m_use); rs += s0[i] + s1[i]; }
            l_run = l_run * alpha + rs;
#pragma unroll
            for (int i = 0; i < 16; ++i) { o0[i] *= alpha; o1[i] *= alpha; }
            u32x4 w0, w1, w2, w3;
            w0.x = cvt_pk_bf16(s0[0], s0[1]); w0.y = cvt_pk_bf16(s0[2], s0[3]); w0.z = cvt_pk_bf16(s0[4], s0[5]); w0.w = cvt_pk_bf16(s0[6], s0[7]);
            w1.x = cvt_pk_bf16(s0[8], s0[9]); w1.y = cvt_pk_bf16(s0[10], s0[11]); w1.z = cvt_pk_bf16(s0[12], s0[13]); w1.w = cvt_pk_bf16(s0[14], s0[15]);
            w2.x = cvt_pk_bf16(s1[0], s1[1]); w2.y = cvt_pk_bf16(s1[2], s1[3]); w2.z = cvt_pk_bf16(s1[4], s1[5]); w2.w = cvt_pk_bf16(s1[6], s1[7]);
            w3.x = cvt_pk_bf16(s1[8], s1[9]); w3.y = cvt_pk_bf16(s1[10], s1[11]); w3.z = cvt_pk_bf16(s1[12], s1[13]); w3.w = cvt_pk_bf16(s1[14], s1[15]);
            const bf16x8 pa0 = __builtin_bit_cast(bf16x8, w0), pa1 = __builtin_bit_cast(bf16x8, w1), pa2 = __builtin_bit_cast(bf16x8, w2), pa3 = __builtin_bit_cast(bf16x8, w3);
#define FA_PV(o, dt) do { const LAS unsigned char* vrow_ = Vt + (32 * (dt) + r32) * VP + hi * 16; \
                o = __builtin_amdgcn_mfma_f32_32x32x16_bf16(*(const LAS bf16x8*)(vrow_), pa0, o, 0, 0, 0); o = __builtin_amdgcn_mfma_f32_32x32x16_bf16(*(const LAS bf16x8*)(vrow_ + 32), pa1, o, 0, 0, 0); \
                o = __builtin_amdgcn_mfma_f32_32x32x16_bf16(*(const LAS bf16x8*)(vrow_ + 64), pa2, o, 0, 0, 0); o = __builtin_amdgcn_mfma_f32_32x32x16_bf16(*(const LAS bf16x8*)(vrow_ + 96), pa3, o, 0, 0, 0); } while (0)
            FA_PV(o0, 0); FA_PV(o1, 1);
#undef FA_PV
        }
        if (t + 1 < tile_hi) FA_STORE(buf ^ 1);
        __syncthreads();
    }
#undef FA_LOAD
#undef FA_STORE
    const float l_tot = half_sum(l_run); const float inv = 1.0f / l_tot;
    bf16_t* orow = Ow + (size_t)r32 * opitch + 4 * hi;
#pragma unroll
    for (int g = 0; g < 4; ++g) {
        u32x2 a; a.x = cvt_pk_bf16(o0[4 * g] * inv, o0[4 * g + 1] * inv); a.y = cvt_pk_bf16(o0[4 * g + 2] * inv, o0[4 * g + 3] * inv); *(u32x2*)(orow + 8 * g) = a;
        u32x2 b; b.x = cvt_pk_bf16(o1[4 * g] * inv, o1[4 * g + 1] * inv); b.y = cvt_pk_bf16(o1[4 * g + 2] * inv, o1[4 * g + 3] * inv); *(u32x2*)(orow + 32 + 8 * g) = b;
    }
}

struct IdxArgs { const bf16_t* IQ; const bf16_t* IK; const float* IW; unsigned short* SEL; int* SELN; };
__device__ __forceinline__ unsigned mono_key(float f) { const unsigned u = __float_as_uint(f); return u ^ ((unsigned)((int)u >> 31) | 0x80000000u); }
__device__ __forceinline__ int crow32(int i, int hi) { return (i & 3) + 8 * (i >> 2) + 4 * hi; }

#ifndef MK_SC2
#define MK_SC2 0
#endif
constexpr int IDX_QP = 656;
__device__ __forceinline__ void idx_scores(f32x16& sc, const LAS unsigned char* qrow  , const float (&c)[8], const bf16x8 ka0, const bf16x8 ka1) {
    f32x16 z[8], zero;
#pragma unroll
    for (int i = 0; i < 16; ++i) zero[i] = 0.f;
#define IDX_F(slot, ks) (*(const LAS bf16x8*)(qrow + (slot) * 64 + (ks) * 32))
    bf16x8 f0 = IDX_F(8, 0), f1 = IDX_F(0, 0);
    sc = __builtin_amdgcn_mfma_f32_32x32x16_bf16(ka0, f0, zero, 0, 0, 0); f0 = IDX_F(1, 0);
#pragma unroll
    for (int h = 0; h < 8; h += 2) {
        z[h] = __builtin_amdgcn_mfma_f32_32x32x16_bf16(ka0, f1, zero, 0, 0, 0); f1 = (h + 2 < 8) ? IDX_F(h + 2, 0) : IDX_F(9, 0);
        z[h + 1] = __builtin_amdgcn_mfma_f32_32x32x16_bf16(ka0, f0, zero, 0, 0, 0); f0 = (h + 3 < 8) ? IDX_F(h + 3, 0) : IDX_F(8, 1);
    }
    sc = __builtin_amdgcn_mfma_f32_32x32x16_bf16(ka0, f1, sc, 0, 0, 0); f1 = IDX_F(0, 1);
    sc = __builtin_amdgcn_mfma_f32_32x32x16_bf16(ka1, f0, sc, 0, 0, 0); f0 = IDX_F(1, 1);
#pragma unroll
    for (int h = 0; h < 8; h += 2) {
        z[h] = __builtin_amdgcn_mfma_f32_32x32x16_bf16(ka1, f1, z[h], 0, 0, 0); f1 = (h + 2 < 8) ? IDX_F(h + 2, 1) : IDX_F(9, 1);
        z[h + 1] = __builtin_amdgcn_mfma_f32_32x32x16_bf16(ka1, f0, z[h + 1], 0, 0, 0); if (h + 3 < 8) f0 = IDX_F(h + 3, 1);
    }
    sc = __builtin_amdgcn_mfma_f32_32x32x16_bf16(ka1, f1, sc, 0, 0, 0);
#undef IDX_F
#pragma unroll
    for (int h = 0; h < 8; ++h)
#pragma unroll
        for (int i = 0; i < 16; ++i) sc[i] = __builtin_fmaf(__builtin_fabsf(z[h][i]), c[h], sc[i]);
}
#define IDX_LOADK(k0, k1, tile_) do { const bf16_t* ikt_ = ikb + (size_t)(tile_) * 32 * 32; k0 = *(const bf16x8*)(ikt_ + r32 * 32 + hi * 8); k1 = *(const bf16x8*)(ikt_ + r32 * 32 + 16 + hi * 8); } while (0)
template <int WPL>
__device__ __forceinline__ bool hist_scan(const LAS unsigned* hw, int lane, unsigned need, int& bin, unsigned& above, unsigned& nb) {
    asm volatile("" : "+v"(lane));
    unsigned w[WPL]; unsigned tot = 0;
#pragma unroll
    for (int i = 0; i < WPL; i += 4) { const u32x4 v = *(const LAS u32x4*)(hw + WPL * lane + i); w[i] = v.x; w[i + 1] = v.y; w[i + 2] = v.z; w[i + 3] = v.w; }
#pragma unroll
    for (int i = 0; i < WPL; ++i) tot += (w[i] & 0xffffu) + (w[i] >> 16);
    unsigned suf = tot;
#pragma unroll
    for (int d = 1; d < 64; d <<= 1) { const unsigned t = (unsigned)lane_get((int)suf, (lane + d) & 63); if (lane + d < 64) suf += t; }
    const unsigned total = (unsigned)lane_bcast((int)suf, 0);
    if (total < need) { above = total; return false; }
    const unsigned ab = suf - tot;
    const bool mine = (ab < need) && (need <= suf);
    int b_ = 0; unsigned a_ = 0, n_ = 0;
    if (mine) { unsigned acc = ab; bool done = false;
#pragma unroll
        for (int i = WPL - 1; i >= 0; --i) {
            const unsigned chi = w[i] >> 16, clo = w[i] & 0xffffu;
            if (!done && acc + chi >= need) { done = true; b_ = 2 * (WPL * lane + i) + 1; a_ = acc; n_ = chi; } if (!done) acc += chi;
            if (!done && acc + clo >= need) { done = true; b_ = 2 * (WPL * lane + i); a_ = acc; n_ = clo; } if (!done) acc += clo; } }
    const unsigned long long bal = __ballot(mine); const int src = __ffsll((long long)bal) - 1;
    bin = lane_bcast(b_, src); above = (unsigned)lane_bcast((int)a_, src); nb = (unsigned)lane_bcast((int)n_, src);
    return true;
}
template <int P>
__device__ __forceinline__ void idx_hist_tiles(LAS unsigned* hrow, const LAS unsigned char* qrow, const float (&w)[8], const bf16_t* ikb, int wid, int ntile, int qpos, int r32, int hi, bool mine, unsigned pfx) {
    bf16x8 kb[4][2];
#pragma unroll
    for (int u = 0; u < 4; ++u) if (wid + 8 * u < ntile) IDX_LOADK(kb[u][0], kb[u][1], wid + 8 * u);
#pragma unroll 1
    for (int base = wid; base < ntile; base += 32) {
#pragma unroll
        for (int u = 0; u < 4; ++u) { const int tile = base + 8 * u; if (tile < ntile) {
            const bf16x8 ka0 = kb[u][0], ka1 = kb[u][1];
            f32x16 sc; idx_scores(sc, qrow, w, ka0, ka1);
            if (tile + 32 < ntile) IDX_LOADK(kb[u][0], kb[u][1], tile + 32);
            const int lim = (tile == ntile - 1) ? qpos - 32 * tile : 64;
#pragma unroll
            for (int i = 0; i < 16; ++i) {
                bool ok = mine && (crow32(i, hi) <= lim); unsigned bin;
                if (P == 0) { bin = mono_key(sc[i]) >> 21; }
                else { const unsigned k = mono_key(sc[i]);
                    if (P == 1) { ok = false; bin = 0u; }
                    else if (P == 2) { ok = ok && ((k >> 21) == pfx); bin = (k >> 10) & 2047u; }
                    else { ok = ok && ((k >> 10) == pfx); bin = k & 1023u; } }
                if (ok) lds_add(hrow + (bin >> 1), 1u << (16 * (bin & 1u))); }
            __builtin_amdgcn_sched_barrier(0);
        } }
    }
}
__device__ __forceinline__ void idx_unit(LAS unsigned char* lds, int wave_, const IdxArgs& a, int rowb  , int qb32) {
    int tid = wave_ * 64 + lane_id(); asm volatile("" : "+v"(tid));
    const int lane = tid & 63, wid = wave_, r32 = lane & 31, hi = lane >> 5;
    const int q0 = 32 * qb32, ntile = qb32 + 1, qpos = q0 + r32;
    LAS unsigned* hist = (LAS unsigned*)(lds + IDX_HIST);
    LAS unsigned* bitmap = (LAS unsigned*)(lds + IDX_BITMAP);
    LAS unsigned* candk = (LAS unsigned*)(lds + IDX_CANDK);
    LAS unsigned short* candi = (LAS unsigned short*)(lds + IDX_CANDI);
    LAS unsigned* subh = (LAS unsigned*)(lds + IDX_SUBH) + wid * 512;
    LAS unsigned* qpar = (LAS unsigned*)(lds + IDX_QPAR);
    LAS unsigned* ccnt = (LAS unsigned*)(lds + IDX_CCNT);
    LAS unsigned* flag = (LAS unsigned*)(lds + IDX_FLAG);
    if (q0 + 32 <= 256) {
        __syncthreads();
        for (int q = wid; q < 32; q += NWAVES) { const int t = q0 + q; unsigned short* sp = a.SEL + (size_t)(rowb + t) * 256;
#pragma unroll
            for (int j = 0; j < 4; ++j) { const int k = lane + 64 * j; sp[k] = (unsigned short)(k <= t ? k : 0); }
            if (lane == 0) a.SELN[rowb + t] = t + 1; }
        return;
    }
    float w[8];
#pragma unroll
    for (int h = 0; h < 8; ++h) w[h] = 0.5f * a.IW[(size_t)(rowb + qpos) * 8 + h];
    const LAS unsigned char* qrow = lds + IDX_QT + r32 * IDX_QP + hi * 16;
    const bf16_t* ikb = a.IK + (size_t)rowb * 32;
    __syncthreads();
#pragma unroll
    for (int i = 0; i < 2; ++i) { const int c = tid + 512 * i, row = c >> 5, c16 = c & 31;
        *(LAS u32x4*)(lds + IDX_QT + row * IDX_QP + c16 * 16) = *(const u32x4*)(a.IQ + (size_t)(rowb + q0 + row) * 256 + c16 * 8); }
    __syncthreads();
    { const int q = tid >> 4, d2 = (tid & 15) * 2; const float* wq = a.IW + (size_t)(rowb + q0 + q) * 8; float s0 = 0.f, s1 = 0.f;
#pragma unroll
      for (int h = 0; h < 8; ++h) { const unsigned pr = *(const LAS unsigned*)(lds + IDX_QT + q * IDX_QP + h * 64 + d2 * 2); const float wh = 0.5f * wq[h]; s0 += wh * bflo(pr); s1 += wh * bfhi(pr); }
      const unsigned h0 = f2bf(s0), h1 = f2bf(s1); const float r0 = s0 - bf2f((bf16_t)h0), r1 = s1 - bf2f((bf16_t)h1);
      *(LAS unsigned*)(lds + IDX_QT + q * IDX_QP + 8 * 64 + d2 * 2) = h0 | (h1 << 16);
      *(LAS unsigned*)(lds + IDX_QT + q * IDX_QP + 9 * 64 + d2 * 2) = pk2(r0, r1); }
    if (tid < 256) { const int q = tid >> 3, f = tid & 7; const bool all = (q0 + q + 1 <= 256); qpar[tid] = (f == 0) ? (all ? 2u : 0u) : ((f == 2) ? 256u : 0u); }
    if (tid < 32) ccnt[tid] = 0u;
    if (tid < 8) flag[tid] = (tid == 0) ? 1u : 0u;
#pragma unroll 1
    for (int p = 0; p < 4; ++p) {
        __syncthreads();
        if (flag[p] == 0u) continue;
        for (int i = tid; i < 32 * IDX_HP / 4; i += NWAVES * 64) ((LAS u32x4*)hist)[i] = (u32x4){0u, 0u, 0u, 0u};
        __syncthreads();
        const bool mine = (qpar[8 * r32] == 0u) && (qpar[8 * r32 + 4] == (unsigned)p); const unsigned pfx = qpar[8 * r32 + 1];
        TB(1);
        if (__any(mine)) {
            LAS unsigned* hrow = hist + r32 * IDX_HP;
            if (p == 0) idx_hist_tiles<0>(hrow, qrow, w, ikb, wid, ntile, qpos, r32, hi, mine, pfx);
            else if (p == 1) idx_hist_tiles<1>(hrow, qrow, w, ikb, wid, ntile, qpos, r32, hi, mine, pfx);
            else if (p == 2) idx_hist_tiles<2>(hrow, qrow, w, ikb, wid, ntile, qpos, r32, hi, mine, pfx);
            else idx_hist_tiles<3>(hrow, qrow, w, ikb, wid, ntile, qpos, r32, hi, mine, pfx);
        }
        TE(1);
        __syncthreads();
        TB(2);
        for (int j = 0; j < 4; ++j) { const int q = 4 * wid + j; const unsigned qs = qpar[8 * q], need = qpar[8 * q + 2], qp = qpar[8 * q + 1];
            if (qs != 0u || qpar[8 * q + 4] != (unsigned)p) continue;
            int bin; unsigned above, nb; const bool found = hist_scan<16>(hist + q * IDX_HP, lane, need, bin, above, nb);
            if (lane == 0) {
                if (!found) { if (false) { }
                              else { qpar[8 * q] = 2u; qpar[8 * q + 2] = 0u; } }
                else { const unsigned np = (p == 0) ? (unsigned)bin : (p == 2 ? ((qp << 11) | (unsigned)bin) : ((qp << 10) | (unsigned)bin));
                    qpar[8 * q + 1] = np; qpar[8 * q + 2] = need - above; qpar[8 * q + 3] = (p <= 1) ? 21u : (p == 2 ? 10u : 0u);
                    const unsigned shn = (p <= 1) ? 21u : (p == 2 ? 10u : 0u); const unsigned klo = np << shn; const unsigned long long khi = ((unsigned long long)np + 1ull) << shn;
                    qpar[8 * q + 5] = (klo & 0x80000000u) ? (klo ^ 0x80000000u) : ~klo;
                    qpar[8 * q + 6] = (khi >> 32) ? 0x7f800000u : (((unsigned)khi & 0x80000000u) ? ((unsigned)khi ^ 0x80000000u) : ~(unsigned)khi);
                    if (nb <= (unsigned)IDX_CCAP || p == 3) qpar[8 * q] = 1u; else { const unsigned nx = (p <= 1) ? 2u : 3u; qpar[8 * q + 4] = nx; flag[nx] = 1u; } } }
        }
        TE(2);
    }
    __syncthreads();
    for (int i = tid; i < 32 * 256 / 4; i += NWAVES * 64) ((LAS u32x4*)bitmap)[i] = (u32x4){0u, 0u, 0u, 0u};
    __syncthreads();
    TB(3);
    { const unsigned st = qpar[8 * r32]; const float tcand = (st == 2u) ? -INFINITY : __uint_as_float(qpar[8 * r32 + 5]), tsel = (st == 2u) ? -INFINITY : __uint_as_float(qpar[8 * r32 + 6]);
      bf16x8 kb[4][2];
#pragma unroll
      for (int u = 0; u < 4; ++u) if (wid + 8 * u < ntile) IDX_LOADK(kb[u][0], kb[u][1], wid + 8 * u);
#pragma unroll 1
      for (int base = wid; base < ntile; base += 32) {
#pragma unroll
          for (int u = 0; u < 4; ++u) { const int tile = base + 8 * u; if (tile < ntile) {
              const bf16x8 ka0 = kb[u][0], ka1 = kb[u][1];
              f32x16 sc; idx_scores(sc, qrow, w, ka0, ka1);
#if MK_SC2
              asm volatile("" : "+v"(sc)); { bf16x8 kx0 = ka0, kx1 = ka1; asm volatile("" : "+v"(kx0), "+v"(kx1)); idx_scores(sc, qrow, w, kx0, kx1); asm volatile("" : "+v"(sc)); }
#endif
              if (tile + 32 < ntile) IDX_LOADK(kb[u][0], kb[u][1], tile + 32);
              const int lim = (tile == ntile - 1) ? qpos - 32 * tile : 64;
#pragma unroll
              for (int i = 0; i < 16; ++i) {
                  if (sc[i] >= tcand && crow32(i, hi) <= lim) { const int key = 32 * tile + crow32(i, hi);
                      if (sc[i] >= tsel) lds_or(bitmap + r32 * 256 + (key >> 5), 1u << (key & 31));
                      else { const unsigned pos = lds_add(ccnt + r32, 1u); if (pos < (unsigned)IDX_CCAP) { candk[r32 * IDX_CCAP + pos] = mono_key(sc[i]); candi[r32 * IDX_CCAP + pos] = (unsigned short)key; } } } }
              __builtin_amdgcn_sched_barrier(0);
          } }
      } }
    TE(3);
    __syncthreads();
    TB(4);
    for (int j = 0; j < 4; ++j) {
        const int q = 4 * wid + j; const unsigned st = qpar[8 * q]; unsigned need = qpar[8 * q + 2]; const unsigned sh = qpar[8 * q + 3];
        const int nc = (st == 1u) ? (int)min(ccnt[q], (unsigned)IDX_CCAP) : 0;
        LAS unsigned* bm = bitmap + q * 256; const LAS unsigned* ck = candk + q * IDX_CCAP; const LAS unsigned short* ci = candi + q * IDX_CCAP;
        if (nc > 0) {
            if ((unsigned)nc <= need) { for (int c = lane; c < nc; c += 64) { const unsigned key = ci[c]; lds_or(bm + (key >> 5), 1u << (key & 31)); } }
            else {
                int nR = 0; LAS unsigned long long* R = (LAS unsigned long long*)subh;
                if (sh > 0u) {
                    const int nbit = sh >= 10u ? 10 : (int)sh, fs = (int)sh - nbit; const unsigned smask = (1u << nbit) - 1u;
#pragma unroll
                    for (int i = 0; i < 8; ++i) subh[8 * lane + i] = 0u;
                    LDS_WAIT();
                    for (int c = lane; c < nc; c += 64) { const unsigned sub = (ck[c] >> fs) & smask; lds_add(subh + (sub >> 1), 1u << (16 * (sub & 1u))); }
                    LDS_WAIT();
                    int b2; unsigned ab2, nb2; (void)hist_scan<8>(subh, lane, need, b2, ab2, nb2);
                    need -= ab2; LDS_WAIT();
                    for (int c0 = 0; c0 < nc; c0 += 64) { const int c = c0 + lane; bool inb = false; unsigned k = 0, key = 0;
                        if (c < nc) { k = ck[c]; key = ci[c]; const int sub = (int)((k >> fs) & smask); if (sub > b2) lds_or(bm + (key >> 5), 1u << (key & 31)); inb = (sub == b2); }
                        const unsigned long long bal = __ballot(inb); const int pos = nR + __popcll(bal & ((1ull << lane) - 1ull));
                        if (inb && pos < IDX_RCAP) R[pos] = ((unsigned long long)k << 13) | (unsigned long long)(8191u - key);
                        nR += __popcll(bal); }
                } else {
                    for (int c0 = 0; c0 < nc; c0 += 64) { const int c = c0 + lane; if (c < nc && c < IDX_RCAP) R[c] = ((unsigned long long)ck[c] << 13) | (unsigned long long)(8191u - ci[c]); }
                    nR = nc;
                }
                nR = min(nR, IDX_RCAP); LDS_WAIT();
                for (int r = lane; r < nR; r += 64) { const unsigned long long me = R[r]; unsigned better = 0;
                    for (int x = 0; x < nR; ++x) better += (R[x] > me) ? 1u : 0u;
                    if (better < need) { const unsigned key = 8191u - (unsigned)(me & 8191ull); lds_or(bm + (key >> 5), 1u << (key & 31)); } }
            }
        }
        LDS_WAIT();
        { const u32x4 bw = *(const LAS u32x4*)(bm + 4 * lane); unsigned wv[4] = {bw.x, bw.y, bw.z, bw.w};
          const int mycnt = __popc(wv[0]) + __popc(wv[1]) + __popc(wv[2]) + __popc(wv[3]);
          int pre = mycnt;
#pragma unroll
          for (int d = 1; d < 64; d <<= 1) { const int t = lane_get(pre, (lane - d) & 63); if (lane >= d) pre += t; }
          const int total = lane_bcast(pre, 63); int pos = pre - mycnt;
          unsigned short* sp = a.SEL + (size_t)(rowb + q0 + q) * 256;
#pragma unroll
          for (int wi = 0; wi < 4; ++wi) { unsigned m = wv[wi]; while (m) { const int b = __ffs((int)m) - 1; m &= m - 1u; if (pos < 256) sp[pos] = (unsigned short)(32 * (4 * lane + wi) + b); ++pos; } }
          if (lane == 0) a.SELN[rowb + q0 + q] = min(total, 256); }
        LDS_WAIT();
    }
    TE(4);
}

#undef IDX_LOADK
struct SpaArgs { const bf16_t* QA; const bf16_t* KA; const bf16_t* VA; const unsigned short* SEL; const int* SELN; bf16_t* Y; };
struct SpaPre { int nv[2]; u32x2 s4[2]; };
__device__ __forceinline__ void sparse_prefetch(SpaPre& P, const SpaArgs& a, int rowA, int rowB, int lane) {
    const int row[2] = {rowA, rowB};
#pragma unroll
    for (int q = 0; q < 2; ++q) { P.nv[q] = a.SELN[row[q]]; P.s4[q] = *(const u32x2*)(a.SEL + (size_t)row[q] * 256 + 4 * lane); }
}
__device__ __forceinline__ void sparse_pair(LAS unsigned char* wl, const SpaArgs& a, const SpaPre& P, int rowbA, int tA, int rowbB, int tB, int lane) {
    const int rowb[2] = {rowbA, rowbB}; const int row[2] = {rowbA + tA, rowbB + tB};
    LAS float* lg[2]; LAS unsigned short* sl[2]; int nv[2];
#pragma unroll
    for (int q = 0; q < 2; ++q) { lg[q] = (LAS float*)(wl + q * 8192); sl[q] = (LAS unsigned short*)(wl + q * 8192 + 4096); nv[q] = P.nv[q]; *(LAS u32x2*)(sl[q] + 4 * lane) = P.s4[q]; }
    LDS_WAIT();
    const int m16 = lane & 15, kq = lane >> 4;
    bf16x8 qf0[2], qf1[2];
#pragma unroll
    for (int q = 0; q < 2; ++q) { qf0[q] = (bf16x8){0, 0, 0, 0, 0, 0, 0, 0}; qf1[q] = qf0[q];
        if (m16 < 4) { const bf16_t* qp = a.QA + (size_t)row[q] * 256 + m16 * 64 + kq * 8; qf0[q] = *(const bf16x8*)qp; qf1[q] = *(const bf16x8*)(qp + 32); } }
#pragma unroll
    for (int tile = 0; tile < 16; ++tile)
#pragma unroll
        for (int q = 0; q < 2; ++q) {
            const int j = 16 * tile + m16; const int s = (j < nv[q]) ? (int)sl[q][j] : 0;
            const bf16_t* kp = a.KA + (size_t)(rowb[q] + s) * 64 + kq * 8;
            const bf16x8 k0 = *(const bf16x8*)kp, k1 = *(const bf16x8*)(kp + 32);
            f32x4 acc = (f32x4){0.f, 0.f, 0.f, 0.f};
            acc = __builtin_amdgcn_mfma_f32_16x16x32_bf16(qf0[q], k0, acc, 0, 0, 0);
            acc = __builtin_amdgcn_mfma_f32_16x16x32_bf16(qf1[q], k1, acc, 0, 0, 0);
            if (kq == 0) { const bool ok = j < nv[q]; f32x4 v; v.x = ok ? acc.x : -INFINITY; v.y = ok ? acc.y : -INFINITY; v.z = ok ? acc.z : -INFINITY; v.w = ok ? acc.w : -INFINITY; *(LAS f32x4*)(lg[q] + 4 * j) = v; }
        }
    LDS_WAIT();
    const int h = lane >> 4; float sm[2];
#pragma unroll
    for (int q = 0; q < 2; ++q) { float pv[16]; float mx = -INFINITY;
#pragma unroll
        for (int i = 0; i < 16; ++i) { pv[i] = lg[q][4 * (m16 + 16 * i) + h]; mx = fmaxf(mx, pv[i]); }
        mx = max16(mx);
        float s_ = 0.f;
#pragma unroll
        for (int i = 0; i < 16; ++i) { pv[i] = fast_exp2(pv[i] - mx); s_ += pv[i]; }
        sm[q] = sum16(s_);
#pragma unroll
        for (int i = 0; i < 16; ++i) lg[q][4 * (m16 + 16 * i) + h] = pv[i]; }
    LDS_WAIT();
    const int g = lane >> 3, c8 = lane & 7;
    float acc[2][4][8];
#pragma unroll
    for (int q = 0; q < 2; ++q)
#pragma unroll
        for (int h4 = 0; h4 < 4; ++h4)
#pragma unroll
            for (int c = 0; c < 8; ++c) acc[q][h4][c] = 0.f;
    const int nvm = nv[0] > nv[1] ? nv[0] : nv[1]; const int nit = (nvm + 7) >> 3;
#pragma unroll 8
    for (int it = 0; it < nit; ++it)
#pragma unroll
        for (int q = 0; q < 2; ++q) {
            const int j = 8 * it + g; const int srow = (j < nv[q]) ? (int)sl[q][j] : 0;
            const u32x4 v = *(const u32x4*)(a.VA + (size_t)(rowb[q] + srow) * 64 + c8 * 8);
            const f32x4 p = *(const LAS f32x4*)(lg[q] + 4 * j);
            const float vv[8] = {bflo(v.x), bfhi(v.x), bflo(v.y), bfhi(v.y), bflo(v.z), bfhi(v.z), bflo(v.w), bfhi(v.w)};
#pragma unroll
            for (int c = 0; c < 8; ++c) { acc[q][0][c] += p.x * vv[c]; acc[q][1][c] += p.y * vv[c]; acc[q][2][c] += p.z * vv[c]; acc[q][3][c] += p.w * vv[c]; }
        }
    LDS_WAIT();
#pragma unroll
    for (int q = 0; q < 2; ++q) {
        const float l0 = __int_as_float(lane_bcast(__float_as_int(sm[q]), 0)), l1 = __int_as_float(lane_bcast(__float_as_int(sm[q]), 16)), l2 = __int_as_float(lane_bcast(__float_as_int(sm[q]), 32)), l3 = __int_as_float(lane_bcast(__float_as_int(sm[q]), 48));
        LAS float* red = (LAS float*)(wl + q * 8192);
#pragma unroll
        for (int h4 = 0; h4 < 4; ++h4) { *(LAS f32x4*)(red + g * 256 + h4 * 64 + c8 * 8) = (f32x4){acc[q][h4][0], acc[q][h4][1], acc[q][h4][2], acc[q][h4][3]}; *(LAS f32x4*)(red + g * 256 + h4 * 64 + c8 * 8 + 4) = (f32x4){acc[q][h4][4], acc[q][h4][5], acc[q][h4][6], acc[q][h4][7]}; }
        LDS_WAIT();
        f32x4 o = (f32x4){0.f, 0.f, 0.f, 0.f};
#pragma unroll
        for (int gg = 0; gg < 8; ++gg) o += *(const LAS f32x4*)(red + gg * 256 + 4 * lane);
        const int ho = lane >> 4; const float li = 1.0f / (ho == 0 ? l0 : (ho == 1 ? l1 : (ho == 2 ? l2 : l3)));
        u32x2 w; w.x = pk2(o.x * li, o.y * li); w.y = pk2(o.z * li, o.w * li);
        if (q == 0 || row[1] != row[0]) *(u32x2*)(a.Y + (size_t)row[q] * DM + 4 * lane) = w; }
    LDS_WAIT();
}

#ifndef MK_CHECK
#define MK_CHECK 0
#endif
#ifndef MK_CHECK_L
#define MK_CHECK_L 0
#define MK_CHECK_CH 0
#endif
#ifndef MK_PER_PHASE
#define MK_PER_PHASE 0
#endif

__device__ __forceinline__ int q_next(unsigned* head, volatile LAS unsigned* bc, int wave_) {
    __syncthreads();
    if (wave_ == 0 && lane_id() == 0) bc[0] = __hip_atomic_fetch_add(head, 1u, __ATOMIC_RELAXED, __HIP_MEMORY_SCOPE_AGENT);
    __syncthreads();
    return (int)bc[0];
}

constexpr int N_PHASES_C = 1 + NCHUNK * (9 + 3) + NCHUNK * (9 + 5);
typedef __attribute__((address_space(4))) const unsigned char* kptr_t;
#define PHASE_ENV() kptr_t kp_ = (kptr_t)__builtin_amdgcn_kernarg_segment_ptr(); asm volatile("; MKPHASE %1" : "+s"(kp_) : "n"(__LINE__)); \
    unsigned char* const ws = *(unsigned char* const __attribute__((address_space(4)))*)(kp_ + 240); float* const out = *(float* const __attribute__((address_space(4)))*)(kp_ + 232); \
    unsigned char* const act = ws + WS_ACT; bf16_t* const HB = (bf16_t*)(ws + WS_HB); unsigned* const ctl = (unsigned*)(ws + WS_CTL); \
    const size_t row0 = (size_t)ch * TCH; const unsigned char* const lw = ws + WS_LAYERW + (size_t)l * SZ_LAYERW; \
    int gwl = gw, ngwl = ngw; asm volatile("" : "+s"(gwl), "+s"(ngwl)); \
    (void)out; (void)act; (void)HB; (void)ctl; (void)row0; (void)lw; (void)gwl; (void)ngwl
#define INP(k) (*(const void* const __attribute__((address_space(4)))*)(kp_ + 8 * (k)))
#define FIN(k) ((const float*)INP(k))
#define ROPE_TAB(RT) RopeTab RT; RT.c64 = (const float*)(ws + WS_ROPE); RT.s64 = RT.c64 + (size_t)NPOS * 32; RT.c32 = RT.s64 + (size_t)NPOS * 32; RT.s32 = RT.c32 + (size_t)NPOS * 16
#define ABUF(T, off) ((T*)(act + (off)))

#ifndef MK_NV
#define MK_NV 256
#endif
#ifndef MK_LB
#define MK_LB 2
#endif
__global__ void __launch_bounds__(NWAVES * 64, MK_LB) mk_fwd(Args args) {
    extern __shared__ __attribute__((aligned(16))) unsigned char lds_raw[];
    LAS unsigned char* lds = (LAS unsigned char*)lds_raw;
    volatile LAS unsigned* MISC = (volatile LAS unsigned*)(lds + MISC_OFF);
    const int wave = __builtin_amdgcn_readfirstlane((int)threadIdx.x >> 6);
#define tid (wave * 64 + lane_id())
    const int G = gridDim.x; const int bx = blockIdx.x; const int vcu = (G % 8 == 0) ? (bx % 8) * (G / 8) + bx / 8 : bx;
    const int gw = vcu * NWAVES + wave, ngw = G * NWAVES;
    for (int u = tid; u < 64; u += NWAVES * 64) MISC[u] = 0u;
    __syncthreads();
    XcdBarrier bar; bar.bar = (unsigned*)(args.ws + WS_CTL) + CW_BAR + args.pad0 * XCD_BAR_WORDS; bar.x = 0; bar.st = nullptr;
    if (!MK_PER_PHASE) bar = xcd_barrier_post((unsigned*)(args.ws + WS_CTL) + CW_BAR + args.pad0 * XCD_BAR_WORDS, MISC + 8, wave);
    int pid = 0;
#ifndef MK_ATT
#define MK_ATT 7
#endif
#ifndef MK_EN
#define MK_EN 0xffffffffu
#endif
#define EN(k) (((MK_EN) >> (k)) & 1u)
#ifndef MK_ATT_REP
#define MK_ATT_REP 7
#endif
#ifndef MK_SPA_REP
#define MK_SPA_REP 1
#endif
#ifndef MK_REP
#define MK_REP 0u
#endif
#define REPS(k) (1 + (((MK_REP) >> (k)) & 1u))
#define RUN() (args.ph_lo <= pid && pid < args.ph_hi)
#define SEAM() do { if (args.ph_lo <= pid && pid + 1 < args.ph_hi) { TB(5); xcd_barrier(bar, wave); TE(5); } ++pid; } while (0)

    if (EN(0) && RUN()) for (int rep_ = 0; rep_ < (int)REPS(0); ++rep_) {
        const int l = 0, ch = 0; PHASE_ENV();
        int lane = tid & 63; asm volatile("" : "+v"(lane)); int tid0 = tid; asm volatile("" : "+v"(tid0));
        LAS float* scr = (LAS float*)(lds + wave * 16384);
        constexpr int IT_WIN = (DM / 64) * ((DIN + 31) / 32), IT_WUQ = (256 / 64) * (384 / 32), IT_WUKV = (128 / 64) * (512 / 32), IT_WAO = (256 / 64) * (DM / 32), IT_WCO = (512 / 64) * (DM / 32), IT_WO = (DM / 128) * (DM / 32);
        constexpr int IT_WG8 = (DM / 128) * (GW / 32);
        constexpr int IT_LAYER = IT_WIN + IT_WG8 + IT_WUQ + IT_WUKV + 2 * IT_WAO + IT_WCO + IT_WO;
        constexpr int IT_F1 = (DM / 128) * (DFF / 32), IT_F2 = (DFF / 128) * (DM / 32), IT_E1 = (DM / 128) * (EFF / 32), IT_E2 = (EFF / 128) * (DM / 32);
        constexpr int IT_FFN = 2 * IT_F1 + IT_F2, IT_EXP = 2 * IT_E1 + IT_E2;
        constexpr int NITEMS = 2 * IT_LAYER + IT_FFN + NEXP * IT_EXP;
        for (int it = gwl; it < NITEMS; it += ngwl) {
            int r = it;
            if (r < 2 * IT_LAYER) {
                const int ll = r / IT_LAYER; r -= ll * IT_LAYER; unsigned char* lwp = ws + WS_LAYERW + (size_t)ll * SZ_LAYERW;
                if (r < IT_WIN) { transpose_item<1>(FIN(I_WIN) + (size_t)ll * DM * DIN, DM, DIN, (bf16_t*)(lwp + OFF_WIN), DM, scr, r, lane); continue; } r -= IT_WIN;
                if (r < IT_WG8) { transpose_item_f8<0>(FIN(I_WIN) + (size_t)ll * DM * DIN + C_G, DM, GW, lwp + OFF_WIN8, DM, S_WG, scr, r, lane, DIN); continue; } r -= IT_WG8;
                if (r < IT_WUQ) { transpose_item<0>(FIN(I_WUQ) + (size_t)ll * 256 * 384, 256, 384, (bf16_t*)(lwp + OFF_WUQ), 256, scr, r, lane); continue; } r -= IT_WUQ;
                if (r < IT_WUKV) { transpose_item<0>(FIN(I_WUKV) + (size_t)ll * 128 * 512, 128, 512, (bf16_t*)(lwp + OFF_WUKV), 256, scr, r, lane); continue; } r -= IT_WUKV;
                if (r < IT_WAO) { transpose_item<0>(FIN(I_WAO) + (size_t)ll * 256 * DM, 256, DM, (bf16_t*)(lwp + OFF_WAO), DM, scr, r, lane); continue; } r -= IT_WAO;
                if (r < IT_WAO) { transpose_item<0>(FIN(I_WBO) + (size_t)ll * 256 * DM, 256, DM, (bf16_t*)(lwp + OFF_WAO) + 256, DM, scr, r, lane); continue; } r -= IT_WAO;
                if (r < IT_WCO) { transpose_item<0>(FIN(I_WCO) + (size_t)ll * 512 * DM, 512, DM, (bf16_t*)(lwp + OFF_WAO) + 512, DM, scr, r, lane); continue; } r -= IT_WCO;
                transpose_item_f8<0>(FIN(I_WO) + (size_t)ll * DM * DM, DM, DM, lwp + OFF_WO8, DM, S_WO, scr, r, lane); continue;
            }
            r -= 2 * IT_LAYER;
            if (r < IT_FFN) {
                if (r < IT_F1) { transpose_item_f8<2>(FIN(I_FW1), DM, DFF, ws + WS_W13, DM, S_W13, scr, r, lane); continue; } r -= IT_F1;
                if (r < IT_F1) { transpose_item_f8<3>(FIN(I_FW3), DM, DFF, ws + WS_W13, DM, S_W13, scr, r, lane); continue; } r -= IT_F1;
                transpose_item_f8<0>(FIN(I_FW2), DFF, DM, ws + WS_W2, DFF, S_W2, scr, r, lane); continue;
            }
            r -= IT_FFN;
            { const int e = r / IT_EXP; r -= e * IT_EXP;
              if (r < IT_E1) { transpose_item_f8<2>(FIN(I_MW1) + (size_t)e * DM * EFF, DM, EFF, ws + WS_E13 + (size_t)e * SZ_E13, DM, S_W13, scr, r, lane); continue; } r -= IT_E1;
              if (r < IT_E1) { transpose_item_f8<3>(FIN(I_MW3) + (size_t)e * DM * EFF, DM, EFF, ws + WS_E13 + (size_t)e * SZ_E13, DM, S_W13, scr, r, lane); continue; } r -= IT_E1;
              transpose_item_f8<0>(FIN(I_MW2) + (size_t)e * EFF * DM, EFF, DM, ws + WS_E2 + (size_t)e * SZ_E2, EFF, S_W2, scr, r, lane); }
        }
        const int gt = vcu * NWAVES * 64 + tid0, ngt = G * NWAVES * 64;
        for (int ll = 0; ll < DEPTH; ++ll) { unsigned char* lwp = ws + WS_LAYERW + (size_t)ll * SZ_LAYERW;
            for (int i = gt; i < (P1W - C_G) * DM / 8; i += ngt) ((u32x4*)(lwp + OFF_WIN + (size_t)C_G * DM * 2))[i] = (u32x4){0u, 0u, 0u, 0u};
            for (int i = gt; i < 128 * 256 / 8; i += ngt) ((u32x4*)(lwp + OFF_WUQ + (size_t)384 * 256 * 2))[i] = (u32x4){0u, 0u, 0u, 0u};
            for (int i = gt; i < 512 * 128 / 8; i += ngt) { const int rr = i / 16, cc = i % 16; ((u32x4*)(lwp + OFF_WUKV + (size_t)rr * 512 + 256))[cc] = (u32x4){0u, 0u, 0u, 0u}; } }
        for (int i = gt; i < DM / 8; i += ngt) ((u32x4*)(HB + (size_t)TCH * DM))[i] = (u32x4){0u, 0u, 0u, 0u};
        float* c64 = (float*)(ws + WS_ROPE); float* s64 = c64 + (size_t)NPOS * 32; float* c32 = s64 + (size_t)NPOS * 32; float* s32 = c32 + (size_t)NPOS * 16;
        for (int i = gt; i < NPOS * 32; i += ngt) { const int pos = i >> 5, k = i & 31; const float inv = (float)pow(10000.0, -(double)k / 32.0); const float ang = (float)pos * inv; c64[i] = cosf(ang); s64[i] = sinf(ang); }
        for (int i = gt; i < NPOS * 16; i += ngt) { const int pos = i >> 4, k = i & 15; const float inv = (float)pow(10000.0, -(double)k / 16.0); const float ang = (float)pos * inv; c32[i] = cosf(ang); s32[i] = sinf(ang); }
    }
    SEAM();

#pragma unroll 1
    for (int l = 0; l < DEPTH; ++l) {
#pragma unroll 1
        for (int ch = 0; ch < NCHUNK; ++ch) {
            if (EN(1) && RUN()) for (int rep_ = 0; rep_ < (int)REPS(1); ++rep_) { if (rep_) { __syncthreads(); } PHASE_ENV(); TB(9); norm_rows((l == 0 ? FIN(I_X) : (const float*)out) + row0 * DM, FIN(I_ANG) + l * DM, HB, ws + WS_HF8, gwl, ngwl, tid & 63); TE(9); }
            SEAM();
            if (EN(2) && RUN()) { PHASE_ENV();
                { pg8::Gemm g{HB, DM, HB, 1 << 30, (const bf16_t*)(lw + OFF_WIN), DM, nullptr, 0, 1, 0, 0}; pg8::StaticOrder S; S.init(TCH / 256, P1W / 256, G, bx);
                  pg8::EpiInProj E{ABUF(bf16_t, A_P1), ABUF(unsigned char, A_G), 1.0f}; TB(20); pg8::gemm_phase<pg8::EpiInProj, pg8::StaticOrder>(lds + RING_OFF, wave, g, S, E); TE(20); }
                { pg8::Gemm g{(const bf16_t*)(ws + WS_HF8), DM / 2, (const bf16_t*)(ws + WS_HF8), 1 << 30, (const bf16_t*)(lw + OFF_WIN8 - (size_t)P1W * DM), DM / 2, nullptr, 0, 1, 0, 0};
                  pg8::GateOrder S; S.S.init(TCH / 256, GW / 256, G, bx);
                  pg8::EpiInProj E{ABUF(bf16_t, A_P1), ABUF(unsigned char, A_G), 1.0f / S_WG}; pg8::gemm_phase<pg8::EpiInProj, pg8::GateOrder, true>(lds + RING_OFF, wave, g, S, E); } }
            SEAM();
            if (EN(3) && RUN()) for (int rep_ = 0; rep_ < (int)REPS(3); ++rep_) { if (rep_) { __syncthreads(); } PHASE_ENV(); ROPE_TAB(RT); PP1Args a; a.P1 = ABUF(bf16_t, A_P1); a.pos = (const int*)INP(I_POS) + row0; a.aq_g = FIN(I_AQG) + l * 64; a.ak_g = FIN(I_AKG) + l * 64; a.cq_g = FIN(I_BCQG) + l * 256;
                a.ckv_g = FIN(I_BCKVG) + l * 128; a.kr_g = FIN(I_BKRG) + l * 32; a.qc_g = FIN(I_CQG) + l * 64; a.kc_g = FIN(I_CKG) + l * 64;
                a.act = act; a.R = RT;
                TB(7); pp1_rows(a, lds + wave * 8192, gwl, ngwl, tid & 63); TE(7); }
            SEAM();
            if (EN(4) && RUN()) for (int rep_ = 0; rep_ < (int)REPS(4); ++rep_) { if (rep_) { __syncthreads(); } PHASE_ENV(); pg8::StaticOrder S; S.init(TCH / 256, 4, G, bx);
                pg8::Gemm g{ABUF(bf16_t, A_CQN), 256, ABUF(bf16_t, A_CKVN), 2, (const bf16_t*)(lw + OFF_WUQ), 256, nullptr, 0, 1, 0, 0}; pg8::EpiBf16 E{ABUF(bf16_t, A_QBR), 1024}; TB(21); pg8::gemm_phase<pg8::EpiBf16, pg8::StaticOrder>(lds + RING_OFF, wave, g, S, E); TE(21); }
            SEAM();
            if (EN(5) && RUN()) for (int rep_ = 0; rep_ < (int)REPS(5); ++rep_) { if (rep_) { __syncthreads(); } PHASE_ENV(); ROPE_TAB(RT); PP2Args a; a.QBR = ABUF(bf16_t, A_QBR); a.KVBR = ABUF(bf16_t, A_QBR) + 512; a.KR = ABUF(bf16_t, A_KR); a.pos = (const int*)INP(I_POS) + row0;
                a.qn_g = FIN(I_BQNG) + l * 64; a.qr_g = FIN(I_BQRG) + l * 32; a.kn_g = FIN(I_BKNG) + l * 64;
                a.QB = ABUF(bf16_t, A_QB); a.KB = ABUF(bf16_t, A_KB); a.VBT = ABUF(bf16_t, A_VBT); a.R = RT; TB(8); pp2_rows(a, lds + wave * 8192, gwl, ngwl, tid & 63); TE(8); }
            SEAM();
            if (EN(6) && RUN()) for (int rep_ = 0; rep_ < (int)REPS(6); ++rep_) {
                PHASE_ENV();
                unsigned* head = ctl + CW_Q + 64 * (2 * (l * NCHUNK + ch) + rep_);
                bf16_t* const Y = ABUF(bf16_t, A_Y);
                TB(28);
                for (;;) {
                    TB(17); const int u = q_next(head, MISC + 16, wave); TE(17);
                    if (u >= 512 + 1024 + 1024) break;
                    if (u < 512) { if (!(MK_ATT & 1) || (rep_ && !(MK_ATT_REP & 1))) continue;
                        const int qb = 31 - u / 16, bl = (u % 16) / 4, h = u % 4; const int rowb = bl * SEQ; const int q0w = 256 * qb + 32 * wave;
                        fa_unit<96>(lds, wave, ABUF(bf16_t, A_QB) + (size_t)(rowb + q0w) * 384 + h * 96, 384, ABUF(bf16_t, A_KB) + (size_t)rowb * 384 + h * 96, 384, ABUF(bf16_t, A_VBT) + (size_t)(bl * 4 + h) * 64 * SEQ,
                                    0, 4 * qb + 4, q0w, 0, -INFINITY, 0.f, Y + (size_t)(rowb + q0w) * DM + 256 + h * 64, DM);
                    } else if (u < 512 + 1024) { if (!(MK_ATT & 2) || (rep_ && !(MK_ATT_REP & 2))) continue;
                        const int v = u - 512; const int qb32 = 255 - v / 4, bl = v % 4;
                        IdxArgs ia{ABUF(bf16_t, A_IQ), ABUF(bf16_t, A_IK), ABUF(float, A_IW), ABUF(unsigned short, A_SEL), ABUF(int, A_SELN)};
                        TB(14); idx_unit(lds, wave, ia, bl * SEQ, qb32); TE(14);
                    } else { if (!(MK_ATT & 4) || (rep_ && !(MK_ATT_REP & 4))) continue;
                        const int v = u - 1536; const int bl = v / 256, kvh = (v / 128) % 2, qt = v % 128; const int rowb = bl * SEQ;
                        const int hq = kvh * 4 + (wave >> 1), q0w = 64 * qt + 32 * (wave & 1);
                        const float sink = (FIN(I_SINK) + l * 8)[hq];
                        fa_unit<64>(lds, wave, ABUF(bf16_t, A_QC) + (size_t)(rowb + q0w) * 512 + hq * 64, 512, ABUF(bf16_t, A_KC) + (size_t)rowb * 128 + kvh * 64, 128, ABUF(bf16_t, A_VCT) + (size_t)(bl * 2 + kvh) * 64 * SEQ,
                                    qt >= 2 ? qt - 2 : 0, qt + 1, q0w, 128, sink * LOG2E, 1.f, Y + (size_t)(rowb + q0w) * DM + 512 + hq * 64, DM);
                    }
                }
                TE(28);
            }
            SEAM();
            if (EN(7) && RUN()) for (int rep_ = 0; rep_ < (int)REPS(7); ++rep_) { if (rep_) { __syncthreads(); } PHASE_ENV(); SpaArgs sa{ABUF(bf16_t, A_QA), ABUF(bf16_t, A_KA), ABUF(bf16_t, A_VA), ABUF(unsigned short, A_SEL), ABUF(int, A_SELN), ABUF(bf16_t, A_Y)}; LAS unsigned char* wl = lds + wave * 16384;
                TB(11); { int lane_ = tid & 63; asm volatile("" : "+v"(lane_)); SpaPre P, Pn; P = SpaPre{}; Pn = SpaPre{};
                    if (gwl < TCH) sparse_prefetch(P, sa, gwl, (gwl + ngwl < TCH) ? gwl + ngwl : gwl, lane_);
                    for (int tok = gwl; tok < TCH; tok += 2 * ngwl) { const int tk2 = (tok + ngwl < TCH) ? tok + ngwl : tok; const int nt1 = tok + 2 * ngwl, nt2 = (nt1 + ngwl < TCH) ? nt1 + ngwl : nt1;
                        if (nt1 < TCH) sparse_prefetch(Pn, sa, nt1, nt2, lane_);
                        sparse_pair(wl, sa, P, (tok / SEQ) * SEQ, tok % SEQ, (tk2 / SEQ) * SEQ, tk2 % SEQ, lane_);
                        P = Pn; } } TE(11); }
            SEAM();
            if (EN(8) && RUN()) for (int rep_ = 0; rep_ < (int)REPS(8); ++rep_) { if (rep_) { __syncthreads(); } PHASE_ENV(); pg8::SegOrder S; S.S.init(TCH / 256, DM / 256, G, bx);
                pg8::Gemm g{ABUF(bf16_t, A_Y), DM, ABUF(bf16_t, A_Y), 1 << 30, (const bf16_t*)(lw + OFF_WAO), DM, nullptr, 0, 3, 256, 512}; pg8::EpiMerge E{HB, ABUF(unsigned char, A_G), ws + WS_HF8, S_MG};
                TB(22); pg8::gemm_phase<pg8::EpiMerge, pg8::SegOrder>(lds + RING_OFF, wave, g, S, E); TE(22); }
            SEAM();
            if (EN(9) && RUN()) { PHASE_ENV(); pg8::Gemm g{(const bf16_t*)(ws + WS_HF8), DM / 2, (const bf16_t*)(ws + WS_HF8), 1 << 30, (const bf16_t*)(lw + OFF_WO8), DM / 2, nullptr, 0, 1, 0, 0}; pg8::StaticOrder S; S.init(TCH / 256, DM / 256, G, bx);
                pg8::EpiResidS E{(l == 0 ? FIN(I_X) : (const float*)out) + row0 * DM, out + row0 * DM, 1.0f / (S_MG * S_WO)}; TB(23); pg8::gemm_phase<pg8::EpiResidS, pg8::StaticOrder, true>(lds + RING_OFF, wave, g, S, E); TE(23); }
            SEAM();
            if (l == 0) {
                if (EN(10) && RUN()) { PHASE_ENV(); RouteArgs ra{}; TB(10); norm2_rows<false>(out + row0 * DM, FIN(I_FNG) + l * DM, HB, ws + WS_HF8, ra, (LAS unsigned*)(lds + MISC_OFF + 128), vcu, wave, tid & 63, G); TE(10); }
                SEAM();
                if (EN(11) && RUN()) { PHASE_ENV(); pg8::Gemm g{(const bf16_t*)(ws + WS_HF8), DM / 2, (const bf16_t*)(ws + WS_HF8), 1 << 30, (const bf16_t*)(ws + WS_W13), DM / 2, nullptr, 0, 1, 0, 0}; pg8::StaticOrder S; S.init(TCH / 256, 2 * DFF / 256, G, bx);
                    pg8::EpiSwigluF8 E{ABUF(unsigned char, F_ACT), DFF, 1.0f / S_W13, S_ACT}; TB(24); pg8::gemm_phase<pg8::EpiSwigluF8, pg8::StaticOrder, true>(lds + RING_OFF, wave, g, S, E); TE(24); }
                SEAM();
                if (EN(12) && RUN()) { PHASE_ENV(); pg8::Gemm g{ABUF(bf16_t, F_ACT), DFF / 2, ABUF(bf16_t, F_ACT), 1 << 30, (const bf16_t*)(ws + WS_W2), DFF / 2, nullptr, 0, 1, 0, 0}; pg8::StaticOrder S; S.init(TCH / 256, DM / 256, G, bx);
                    pg8::EpiResidS E{out + row0 * DM, out + row0 * DM, 1.0f / (S_ACT * S_W2)}; TB(25); pg8::gemm_phase<pg8::EpiResidS, pg8::StaticOrder, true>(lds + RING_OFF, wave, g, S, E); TE(25); }
                SEAM();
            } else {
                if (EN(13) && RUN()) { PHASE_ENV(); RouteArgs ra{FIN(I_RW), ABUF(int, F_TOPE), ABUF(float, F_TOPG), ABUF(int, F_TOPD), ctl + CW_MOE + 64 * ch};
                    TB(10); norm2_rows<true>(out + row0 * DM, FIN(I_FNG) + l * DM, HB, nullptr, ra, (LAS unsigned*)(lds + MISC_OFF + 128), vcu, wave, tid & 63, G); TE(10); }
                SEAM();
                if (EN(14) && RUN()) { PHASE_ENV(); TB(12); moe_scatter(ctl + CW_MOE + 64 * ch, ABUF(int, F_TOPE), ABUF(int, F_TOPD), HB, ABUF(bf16_t, F_YM), ABUF(int, F_BLKE), gwl, ngwl, tid & 63); TE(12); }
                SEAM();
                if (EN(15) && RUN()) for (int rep_ = 0; rep_ < (int)REPS(15); ++rep_) { if (rep_) { __syncthreads(); } PHASE_ENV(); int ps[NEXP + 1]; moe_layout(ctl + CW_MOE + 64 * ch, ps); const int nblk = ps[NEXP] / 256;
                    pg8::Gemm g{ABUF(bf16_t, F_YM), DM / 2, ABUF(bf16_t, F_YM), 1 << 30, (const bf16_t*)(ws + WS_E13), DM / 2, ABUF(int, F_BLKE), SZ_E13 / 2, 1, 0, 0}; pg8::StaticOrder S; S.init(nblk, 2 * EFF / 256, G, bx);
                    pg8::EpiSwigluF8 E{ABUF(unsigned char, F_ACT), EFF, 1.0f / S_W13, S_ACT}; TB(26); pg8::gemm_phase<pg8::EpiSwigluF8, pg8::StaticOrder, true>(lds + RING_OFF, wave, g, S, E); TE(26); }
                SEAM();
                if (EN(16) && RUN()) for (int rep_ = 0; rep_ < (int)REPS(16); ++rep_) { if (rep_) { __syncthreads(); } PHASE_ENV(); int ps[NEXP + 1]; moe_layout(ctl + CW_MOE + 64 * ch, ps); const int nblk = ps[NEXP] / 256;
                    pg8::Gemm g{ABUF(bf16_t, F_ACT), EFF / 2, ABUF(bf16_t, F_ACT), 1 << 30, (const bf16_t*)(ws + WS_E2), EFF / 2, ABUF(int, F_BLKE), SZ_E2 / 2, 1, 0, 0}; pg8::StaticOrder S; S.init(nblk, DM / 256, G, bx);
                    pg8::EpiBf16S E{ABUF(bf16_t, F_YM), DM, 1.0f / (S_ACT * S_W2)}; TB(27); pg8::gemm_phase<pg8::EpiBf16S, pg8::StaticOrder, true>(lds + RING_OFF, wave, g, S, E); TE(27); }
                SEAM();
                if (EN(17) && RUN()) { PHASE_ENV(); TB(13); moe_combine(out + row0 * DM, ABUF(bf16_t, F_YM), ABUF(int, F_TOPD), ABUF(float, F_TOPG), gwl, ngwl, tid & 63); TE(13); }
                SEAM();
            }
        }
    }
    if (MK_TIMER != 0 && bx == 0 && args.ph_hi >= N_PHASES_C) { __syncthreads(); const unsigned long long t0 = __builtin_amdgcn_s_memrealtime(); const unsigned long long T = (unsigned long long)(*TMR_ACC) / NWAVES;
        while (__builtin_amdgcn_s_memrealtime() - t0 < T) __builtin_amdgcn_s_sleep(8); }
#undef RUN
#undef SEAM
#undef tid
}
constexpr int N_PHASES = 1 + NCHUNK * (9 + 3) + NCHUNK * (9 + 5);

extern "C" void kernel_launch(void* const* d_in, const int* in_sizes, int n_in, void* d_out, int out_size, void* d_ws, size_t ws_size, hipStream_t stream) {
    static int grid = 0;
    if (grid == 0) {
        if (n_in != 29 || in_sizes[0] != NTOK * DM || out_size != NTOK * DM || ws_size < WS_END) {
            fprintf(stderr, "kernel_launch: built for 29 inputs, x/out of %d floats, >= %zu bytes of workspace; got n_in %d, in0 %d, out %d, ws %zu; nothing launched\n", NTOK * DM, (size_t)WS_END, n_in, n_in > 0 ? in_sizes[0] : -1, out_size, ws_size); grid = -1; return; }
        int dev = 0, cus = 0, per_cu = 0;
        if (hipGetDevice(&dev) != hipSuccess || hipDeviceGetAttribute(&cus, hipDeviceAttributeMultiprocessorCount, dev) != hipSuccess) { fprintf(stderr, "kernel_launch: device query failed\n"); grid = -1; return; }
        if (hipFuncSetAttribute((const void*)mk_fwd, hipFuncAttributeMaxDynamicSharedMemorySize, LDS_BYTES) != hipSuccess) { fprintf(stderr, "kernel_launch: hipFuncSetAttribute failed\n"); grid = -1; return; }
        if (hipOccupancyMaxActiveBlocksPerMultiprocessor(&per_cu, (const void*)mk_fwd, NWAVES * 64, LDS_BYTES) != hipSuccess || per_cu < 1)
            fprintf(stderr, "kernel_launch: note: occupancy query reports %d workgroups per CU\n", per_cu);
        (void)hipGetLastError();
        grid = cus;
        if (grid != 256) fprintf(stderr, "kernel_launch: note: %d CUs (built and tuned for 256)\n", grid);
    }
    if (grid < 0) return;
    if (hipMemsetAsync((char*)d_ws + WS_CTL, 0, CTL_ZERO_BYTES, stream) != hipSuccess) { fprintf(stderr, "kernel_launch: memset failed\n"); return; }
    Args a{};
    for (int i = 0; i < 29; ++i) a.in[i] = d_in[i];
    a.out = (float*)d_out; a.ws = (unsigned char*)d_ws;
#if MK_PER_PHASE
    for (int p = 0; p < N_PHASES; ++p) { a.ph_lo = p; a.ph_hi = p + 1; hipLaunchKernelGGL(mk_fwd, dim3(grid), dim3(NWAVES * 64), LDS_BYTES, stream, a); }
#elif MK_CHECK
    {
        const int base = 1 + (MK_CHECK_L == 0 ? MK_CHECK_CH * 12 : 24 + MK_CHECK_CH * 14);
        a.ph_lo = 0; a.ph_hi = base + 7; a.pad0 = 0; hipLaunchKernelGGL(mk_fwd, dim3(grid), dim3(NWAVES * 64), LDS_BYTES, stream, a);
        hipLaunchKernelGGL(chk_kernel, dim3(grid), dim3(NWAVES * 64), 0, stream, a, 0, MK_CHECK_L, MK_CHECK_CH);
        a.ph_lo = base + 7; a.ph_hi = base + 9; a.pad0 = 1; hipLaunchKernelGGL(mk_fwd, dim3(grid), dim3(NWAVES * 64), LDS_BYTES, stream, a);
        hipLaunchKernelGGL(chk_kernel, dim3(grid), dim3(NWAVES * 64), 0, stream, a, 1, MK_CHECK_L, MK_CHECK_CH);
        a.ph_lo = base + 9; a.ph_hi = N_PHASES; a.pad0 = 2; hipLaunchKernelGGL(mk_fwd, dim3(grid), dim3(NWAVES * 64), LDS_BYTES, stream, a);
        hipLaunchKernelGGL(chk_kernel, dim3(1), dim3(64), 0, stream, a, 2, MK_CHECK_L, MK_CHECK_CH);
    }
#else
    a.ph_lo = 0; a.ph_hi = N_PHASES;
    hipLaunchKernelGGL(mk_fwd, dim3(grid), dim3(NWAVES * 64), LDS_BYTES, stream, a);
#endif
    const hipError_t le = hipPeekAtLastError();
    if (le != hipSuccess) fprintf(stderr, "kernel_launch: launch failed: %s\n", hipGetErrorName(le));
}
```

```cpp
#include <hip/hip_runtime.h>
#include <cstdio>
#include <cstdint>

#define GAS __attribute__((address_space(1)))
#define LAS __attribute__((address_space(3)))
typedef unsigned short bf16_t;
typedef short bf16x8 __attribute__((ext_vector_type(8)));
typedef float f32x2 __attribute__((ext_vector_type(2)));
typedef float f32x4 __attribute__((ext_vector_type(4)));
typedef float f32x16 __attribute__((ext_vector_type(16)));
typedef unsigned u32x2 __attribute__((ext_vector_type(2)));
typedef unsigned u32x4 __attribute__((ext_vector_type(4)));
typedef int i32x4 __attribute__((ext_vector_type(4)));
typedef int i32x8 __attribute__((ext_vector_type(8)));

constexpr int NB = 8, SEQ = 8192, NTOK = NB * SEQ, DM = 1024, DEPTH = 2;
constexpr int DIN = 4936;
constexpr int CHB = 4, TCH = CHB * SEQ, NCHUNK = NB / CHB;
constexpr int DFF = 2816, NEXP = 8, EFF = 3584;
constexpr int P1W = 2048, GW = 3072;
constexpr int NINP = P1W + GW;
constexpr float EPS = 1e-6f;
constexpr float LOG2E = 1.4426950408889634f;
constexpr int C_QA = 0, C_KA = 256, C_VA = 320, C_IQ = 384, C_IK = 640, C_IW = 672, C_CQ = 680, C_CKV = 936, C_KR = 1064, C_QC = 1096, C_KC = 1608, C_VC = 1736, C_G = 1864;
constexpr int NPOS = 12288;
constexpr int MOE_ROWS = 2 * TCH + NEXP * 256;

__device__ __forceinline__ float bf2f(bf16_t v) { return __uint_as_float((unsigned)v << 16); }
__device__ __forceinline__ float bflo(unsigned w) { return __uint_as_float(w << 16); }
__device__ __forceinline__ float bfhi(unsigned w) { return __uint_as_float(w & 0xffff0000u); }
__device__ __forceinline__ unsigned f2bf(float f) { unsigned u = __float_as_uint(f); return (u + 0x7fffu + ((u >> 16) & 1u)) >> 16; }
__device__ __forceinline__ unsigned pk2(float lo, float hi) { return f2bf(lo) | (f2bf(hi) << 16); }
__device__ __forceinline__ unsigned cvt_pk_bf16(float lo, float hi) { unsigned r; asm volatile("v_cvt_pk_bf16_f32 %0, %1, %2" : "=v"(r) : "v"(lo), "v"(hi)); return r; }
__device__ __forceinline__ unsigned pk4_u8(float a, float b, float c, float d) { unsigned w = 0u; w = __builtin_amdgcn_cvt_pk_u8_f32(a, 0u, w); w = __builtin_amdgcn_cvt_pk_u8_f32(b, 1u, w); w = __builtin_amdgcn_cvt_pk_u8_f32(c, 2u, w); w = __builtin_amdgcn_cvt_pk_u8_f32(d, 3u, w); return w; }
__device__ __forceinline__ unsigned pk4_fp8(float a, float b, float c, float d) { unsigned w = 0u; w = (unsigned)__builtin_amdgcn_cvt_pk_fp8_f32(a, b, (int)w, false); w = (unsigned)__builtin_amdgcn_cvt_pk_fp8_f32(c, d, (int)w, true); return w; }
__device__ __forceinline__ float fast_exp2(float x) { return __builtin_amdgcn_exp2f(x); }
__device__ __forceinline__ float fast_rcp(float x) { return __builtin_amdgcn_rcpf(x); }
__device__ __forceinline__ float sigmoidf_(float x) { return fast_rcp(1.0f + fast_exp2(-LOG2E * x)); }
template <int O> __device__ __forceinline__ float xor_lane(float v) {
    return __int_as_float(__builtin_amdgcn_ds_swizzle(__float_as_int(v), (O << 10) | 0x1f)); }
__device__ __forceinline__ float half_sum(float v) { const auto rr = __builtin_amdgcn_permlane32_swap(__float_as_uint(v), __float_as_uint(v), false, false); return __uint_as_float(rr[0]) + __uint_as_float(rr[1]); }
__device__ __forceinline__ float half_max(float v) { const auto rr = __builtin_amdgcn_permlane32_swap(__float_as_uint(v), __float_as_uint(v), false, false); return fmaxf(__uint_as_float(rr[0]), __uint_as_float(rr[1])); }
__device__ __forceinline__ float sum16(float v) { v += xor_lane<1>(v); v += xor_lane<2>(v); v += xor_lane<4>(v); v += xor_lane<8>(v); return v; }
__device__ __forceinline__ float max16(float v) { v = fmaxf(v, xor_lane<1>(v)); v = fmaxf(v, xor_lane<2>(v)); v = fmaxf(v, xor_lane<4>(v)); v = fmaxf(v, xor_lane<8>(v)); return v; }
__device__ __forceinline__ float sum32(float v) { v = sum16(v); v += xor_lane<16>(v); return v; }
__device__ __forceinline__ float wave_sum(float v) { return half_sum(sum32(v)); }
__device__ __forceinline__ int lane_get(int v, int src_lane) { return __builtin_amdgcn_ds_bpermute(src_lane << 2, v); }
__device__ __forceinline__ int lane_bcast(int v, int uniform_lane) { return __builtin_amdgcn_readlane(v, uniform_lane); }
__device__ __forceinline__ unsigned lds_add(LAS unsigned* p, unsigned v) { return __hip_atomic_fetch_add(p, v, __ATOMIC_RELAXED, __HIP_MEMORY_SCOPE_WORKGROUP); }
__device__ __forceinline__ unsigned lds_or(LAS unsigned* p, unsigned v) { return __hip_atomic_fetch_or(p, v, __ATOMIC_RELAXED, __HIP_MEMORY_SCOPE_WORKGROUP); }
__device__ __forceinline__ int lane_id() { int l; asm volatile("v_mbcnt_lo_u32_b32 %0, -1, 0\n\tv_mbcnt_hi_u32_b32 %0, -1, %0" : "=v"(l)); return l; }
#define LDS_WAIT() asm volatile("s_waitcnt lgkmcnt(0)" ::: "memory")
#define VM_WAIT() asm volatile("s_waitcnt vmcnt(0)" ::: "memory")

namespace pg8 {
constexpr int BM = 256, BK = 64, HALF = 128, HTB = HALF * BK * 2, STAGE_BYTES = 8 * HTB, NXCD = 8, WGM = 8;
__host__ __device__ __forceinline__ int lds_byte(int r, int c) { const int st = (r >> 4) * 2 + (c >> 5), rr = r & 15, cc = c & 31, ob = rr * 64 + cc * 2; return st * 1024 + (ob ^ (((ob >> 9) & 1) << 5)); }
__host__ __device__ __forceinline__ void stage_rc(int b, int& R, int& C) { const int st = b / 1024, sb = b % 1024, swz = sb ^ (((sb >> 9) & 1) << 5); R = (st >> 1) * 16 + swz / 64; C = (st & 1) * 32 + (swz % 64) / 2; }
__host__ __device__ __forceinline__ int perm32(int rho) { const int n = rho >> 4, i = rho & 15; return 8 * (i >> 2) + 4 * n + (i & 3); }

struct Unit { int pm, pn, seg; };
struct Gemm {
    const bf16_t* A; int lda;
    const bf16_t* A2; int pn_split;
    const bf16_t* Bt; int K;
    const int* blk_e; size_t e_stride;
    int nseg, k1, k2;
};
struct StaticOrder {
    int nM, nN, nwg, G, c;
    __device__ void init(int nM_, int nN_, int G_, int c_) { nM = nM_; nN = nN_; nwg = nM * nN; G = G_; c = c_; }
    __device__ bool next(int i, Unit& u) const {
        const long L = (long)i * G + c; if (L >= nwg) return false;
        int wgid = (int)L; { const int q = nwg / NXCD, r = nwg % NXCD, xcd = wgid % NXCD, off = wgid / NXCD; wgid = (xcd < r ? xcd * (q + 1) : r * (q + 1) + (xcd - r) * q) + off; }
        const int nig = WGM * nN, gid = wgid / nig, fm = gid * WGM, gsz = (nM - fm) < WGM ? (nM - fm) : WGM;
        u.pm = fm + ((wgid % nig) % gsz); u.pn = (wgid % nig) / gsz; u.seg = 0; return true;
    }
};
struct GateOrder { StaticOrder S;
    __device__ bool next(int i, Unit& u) const { if (!S.next(i, u)) return false; u.pn += 8; return true; } };
struct SegOrder { StaticOrder S;
    __device__ bool next(int i, Unit& u) const { const int q = i / 3; if (!S.next(q, u)) return false; u.seg = i - 3 * q; return true; } };

template <class Epi, class Sched, bool FP8 = false>
__device__ __forceinline__ void gemm_phase(LAS unsigned char* lds, int wave_, const Gemm g, const Sched& S, const Epi& E) {
    int tid = wave_ * 64 + lane_id(); asm volatile("" : "+v"(tid));
    const int wid = __builtin_amdgcn_readfirstlane(tid >> 6), lane = tid & 63, wr = wid >> 2, wc = wid & 3, fr = lane & 15, fq = lane >> 4;
    int K = g.K; asm volatile("" : "+s"(K));
    unsigned voffA[2], voffB[2];
#pragma unroll
    for (int i = 0; i < 2; ++i) { int R, C; stage_rc(tid * 16 + i * 8192, R, C); const int Rb = Epi::PERM ? ((R & ~31) + perm32(R & 31)) : R;
        voffA[i] = (unsigned)(R * g.lda + C) * 2u; voffB[i] = (unsigned)(Rb * K + C) * 2u; }
    const size_t kstep = (size_t)(BK * 2);
    const size_t hstepB = (size_t)HALF * K * 2, tstepB = 2 * hstepB;
    const size_t hstepA = (size_t)HALF * g.lda * 2, tstepA = 2 * hstepA;
    const unsigned ldsw = (unsigned)wid * 1024u;
    const int aoff0 = FP8 ? lds_byte(wr * 64 + fr, (2 * (fq & 1)) * 8) + (fq >> 1) * 1024 : lds_byte(wr * 64 + fr, fq * 8);
    const int boff0 = FP8 ? lds_byte(wc * 32 + fr, (2 * (fq & 1)) * 8) + (fq >> 1) * 1024 : lds_byte(wc * 32 + fr, fq * 8);
    constexpr int OFF1 = FP8 ? 16 : 1024;
#define PG8_SA(b, h) (((b) * 2 + (h)) * HTB)
#define PG8_SB(b, h) ((4 + (b) * 2 + (h)) * HTB)
#define PG8_STAGE(bufoff, gbase, voff) do { _Pragma("unroll") for (int _i = 0; _i < 2; ++_i) \
        __builtin_amdgcn_global_load_lds((const unsigned*)((const char*)(gbase) + (voff)[_i]), (LAS unsigned*)(lds + (bufoff) + ldsw + _i * 8192), 16, 0, 0); } while (0)
#define PG8_LDA(dst, b, h) do { _Pragma("unroll") for (int m = 0; m < 4; ++m) { \
        if constexpr (FP8) { dst##8[m].lo = *(const LAS i32x4*)(lds + PG8_SA(b, h) + aoff0 + m * 2048); dst##8[m].hi = *(const LAS i32x4*)(lds + PG8_SA(b, h) + aoff0 + OFF1 + m * 2048); } \
        else { dst[m][0] = *(const LAS bf16x8*)(lds + PG8_SA(b, h) + aoff0 + m * 2048); dst[m][1] = *(const LAS bf16x8*)(lds + PG8_SA(b, h) + aoff0 + OFF1 + m * 2048); } } } while (0)
#define PG8_LDB(dst, b, h) do { _Pragma("unroll") for (int n = 0; n < 2; ++n) { \
        if constexpr (FP8) { dst##8[n].lo = *(const LAS i32x4*)(lds + PG8_SB(b, h) + boff0 + n * 2048); dst##8[n].hi = *(const LAS i32x4*)(lds + PG8_SB(b, h) + boff0 + OFF1 + n * 2048); } \
        else { dst[n][0] = *(const LAS bf16x8*)(lds + PG8_SB(b, h) + boff0 + n * 2048); dst[n][1] = *(const LAS bf16x8*)(lds + PG8_SB(b, h) + boff0 + OFF1 + n * 2048); } } } while (0)
#define PG8_MMA(ai, bj, At, Bt) do { __builtin_amdgcn_s_setprio(1); _Pragma("unroll") for (int m = 0; m < 4; ++m) _Pragma("unroll") for (int n = 0; n < 2; ++n) { \
        if constexpr (FP8) asm volatile("v_mfma_scale_f32_16x16x128_f8f6f4 %0, %1, %2, %0, %3, %3 op_sel_hi:[0,0,0]" : "+v"(acc[ai][bj][m][n]) : "v"(Bt##8[n]), "v"(At##8[m]), "v"(one_scale));   \
        else { _Pragma("unroll") for (int k = 0; k < 2; ++k) acc[ai][bj][m][n] = __builtin_amdgcn_mfma_f32_16x16x32_bf16(Bt[n][k], At[m][k], acc[ai][bj][m][n], 0, 0, 0); } } \
        __builtin_amdgcn_s_setprio(0); } while (0)
#define PG8_WAIT_V(n) asm volatile("s_waitcnt vmcnt(" #n ")" ::: "memory")
#define PG8_WAIT_L(n) asm volatile("s_waitcnt lgkmcnt(" #n ")" ::: "memory")
#define PG8_BAR __builtin_amdgcn_s_barrier()
#define PG8_SCHED __builtin_amdgcn_sched_barrier(0)
#define PG8_K0(u) ((u).seg == 0 ? 0 : ((u).seg == 1 ? g.k1 : g.k2))
#define PG8_NT(u) ((g.nseg == 1 ? K : ((u).seg == 0 ? g.k1 : ((u).seg == 1 ? g.k2 - g.k1 : K - g.k2))) / BK)
#define PG8_BPTR(u) ((const char*)g.Bt + ((g.blk_e ? (size_t)g.blk_e[(u).pm] * g.e_stride * 2 : (size_t)0) + (size_t)(u).pn * tstepB + (size_t)PG8_K0(u) * 2))
    Unit cur, nxt; int ui = 0;
    if (!S.next(0, cur)) return;
    f32x4 acc[2][2][4][2];
#pragma unroll
    for (int a = 0; a < 2; ++a)
#pragma unroll
        for (int b = 0; b < 2; ++b)
#pragma unroll
            for (int m = 0; m < 4; ++m)
#pragma unroll
                for (int n = 0; n < 2; ++n) acc[a][b][m][n] = (f32x4){0.f, 0.f, 0.f, 0.f};
    bf16x8 At[4][2], B0[2][2], B1[2][2];
    i32x8 At8[4], B08[2], B18[2];
    int one_scale = 0x7f7f7f7f; asm volatile("" : "+v"(one_scale));
    const char* cA = (const char*)(cur.pn >= g.pn_split ? g.A2 : g.A) + (size_t)cur.pm * tstepA + (size_t)PG8_K0(cur) * 2; const char* cB = PG8_BPTR(cur);
    int nt = PG8_NT(cur);
    PG8_STAGE(PG8_SB(0, 0), cB, voffB); PG8_STAGE(PG8_SB(0, 1), cB + hstepB, voffB); PG8_STAGE(PG8_SA(0, 0), cA, voffA); PG8_STAGE(PG8_SA(0, 1), cA + hstepA, voffA);
    if (wr == 1) PG8_BAR;
    PG8_WAIT_V(2); PG8_BAR;
    PG8_STAGE(PG8_SB(1, 0), cB + kstep, voffB); PG8_STAGE(PG8_SA(1, 0), cA + kstep, voffA); PG8_STAGE(PG8_SB(1, 1), cB + hstepB + kstep, voffB);
    PG8_WAIT_V(6); PG8_BAR;
    for (;;) {
        const bool has_next = S.next(ui + 1, nxt);
        const char* nA = has_next ? (const char*)(nxt.pn >= g.pn_split ? g.A2 : g.A) + (size_t)nxt.pm * tstepA + (size_t)PG8_K0(nxt) * 2 : cA; const char* nB = has_next ? PG8_BPTR(nxt) : cB;
        for (int t = 0; t < nt; t += 2) {
            const bool last = (t == nt - 2);
            const char* a1 = cA + (size_t)(t + 1) * kstep;
            const char* a2 = last ? nA : cA + (size_t)(t + 2) * kstep; const char* b2 = last ? nB : cB + (size_t)(t + 2) * kstep;
            const char* a3 = a2 + kstep; const char* b3 = b2 + kstep;
            PG8_LDB(B0, 0, 0); PG8_LDB(B1, 0, 1); PG8_SCHED; PG8_LDA(At, 0, 0); PG8_STAGE(PG8_SA(1, 1), a1 + hstepA, voffA);
            PG8_WAIT_V(8); PG8_WAIT_L(0); PG8_BAR; PG8_MMA(0, 0, At, B0); PG8_MMA(0, 1, At, B1); PG8_BAR; PG8_SCHED;
            PG8_LDA(At, 0, 1); PG8_STAGE(PG8_SB(0, 0), b2, voffB); PG8_STAGE(PG8_SB(0, 1), b2 + hstepB, voffB); PG8_STAGE(PG8_SA(0, 0), a2, voffA);
            PG8_WAIT_V(8); PG8_WAIT_L(0); PG8_BAR; PG8_MMA(1, 0, At, B0); PG8_MMA(1, 1, At, B1); PG8_BAR; PG8_SCHED;
            PG8_LDB(B0, 1, 0); PG8_LDB(B1, 1, 1); PG8_SCHED; PG8_LDA(At, 1, 0); PG8_STAGE(PG8_SA(0, 1), a2 + hstepA, voffA);
            PG8_WAIT_V(8); PG8_WAIT_L(0); PG8_BAR; PG8_MMA(0, 0, At, B0); PG8_MMA(0, 1, At, B1); PG8_BAR; PG8_SCHED;
            PG8_LDA(At, 1, 1); PG8_STAGE(PG8_SB(1, 0), b3, voffB); PG8_STAGE(PG8_SB(1, 1), b3 + hstepB, voffB); PG8_STAGE(PG8_SA(1, 0), a3, voffA);
            PG8_WAIT_V(8); PG8_WAIT_L(0); PG8_BAR; PG8_MMA(1, 0, At, B0); PG8_MMA(1, 1, At, B1); PG8_BAR; PG8_SCHED;
        }
        if (wr == 0) PG8_BAR;
        if constexpr (FP8) { asm volatile("s_nop 15\n\ts_nop 7" ::: "memory");
#pragma unroll
            for (int a = 0; a < 2; ++a)
#pragma unroll
                for (int b = 0; b < 2; ++b)
#pragma unroll
                    for (int m = 0; m < 4; ++m)
#pragma unroll
                        for (int n = 0; n < 2; ++n) asm volatile("" : "+v"(acc[a][b][m][n])); }
        E(acc, cur, wr, wc, fr, fq);
        if (!has_next) break;
#pragma unroll
        for (int a = 0; a < 2; ++a)
#pragma unroll
            for (int b = 0; b < 2; ++b)
#pragma unroll
                for (int m = 0; m < 4; ++m)
#pragma unroll
                    for (int n = 0; n < 2; ++n) acc[a][b][m][n] = (f32x4){0.f, 0.f, 0.f, 0.f};
        cur = nxt; cA = nA; cB = nB; ++ui; nt = PG8_NT(cur);
        if (wr == 1) PG8_BAR;
    }
    PG8_WAIT_V(0);
    PG8_BAR;
#undef PG8_SA
#undef PG8_SB
#undef PG8_STAGE
#undef PG8_LDA
#undef PG8_LDB
#undef PG8_MMA
#undef PG8_WAIT_V
#undef PG8_WAIT_L
#undef PG8_BAR
#undef PG8_SCHED
#undef PG8_BPTR
#undef PG8_K0
#undef PG8_NT
}

typedef const f32x4 (&AccRef)[2][2][4][2];
struct EpiInProj {
    static constexpr bool PERM = true;
    bf16_t* P1; unsigned char* G; float sg;
    __device__ __forceinline__ void operator()(AccRef acc, const Unit& u, int wr, int wc, int fr, int fq) const {
        const int row0 = u.pm * BM + wr * 64 + fr; const bool gate = u.pn >= 8;
        const int col0 = (gate ? (u.pn - 8) : u.pn) * BM + wc * 32 + 8 * fq;
#pragma unroll
        for (int ai = 0; ai < 2; ++ai)
#pragma unroll
            for (int m = 0; m < 4; ++m) { const size_t row = (size_t)(row0 + ai * HALF + m * 16);
#pragma unroll
                for (int bj = 0; bj < 2; ++bj) { f32x4 v0 = acc[ai][bj][m][0], v1 = acc[ai][bj][m][1];
                    if (gate) {
#pragma unroll
                        for (int j = 0; j < 4; ++j) { v0[j] = 255.0f * sigmoidf_(v0[j] * sg); v1[j] = 255.0f * sigmoidf_(v1[j] * sg); }
                        u32x2 q; q.x = pk4_u8(v0[0], v0[1], v0[2], v0[3]); q.y = pk4_u8(v1[0], v1[1], v1[2], v1[3]);
                        *(u32x2*)(G + row * GW + col0 + bj * HALF) = q;
                    } else {
                        u32x4 w; w.x = cvt_pk_bf16(v0[0], v0[1]); w.y = cvt_pk_bf16(v0[2], v0[3]); w.z = cvt_pk_bf16(v1[0], v1[1]); w.w = cvt_pk_bf16(v1[2], v1[3]);
                        *(u32x4*)(P1 + row * P1W + col0 + bj * HALF) = w; } } }
    }
};
struct EpiBf16 {
    static constexpr bool PERM = true;
    bf16_t* O; int ldc;
    __device__ __forceinline__ void operator()(AccRef acc, const Unit& u, int wr, int wc, int fr, int fq) const {
        const int row0 = u.pm * BM + wr * 64 + fr; const int col0 = u.pn * BM + wc * 32 + 8 * fq;
#pragma unroll
        for (int ai = 0; ai < 2; ++ai)
#pragma unroll
            for (int m = 0; m < 4; ++m) { bf16_t* rowp = O + (size_t)(row0 + ai * HALF + m * 16) * ldc + col0;
#pragma unroll
                for (int bj = 0; bj < 2; ++bj) { const f32x4 v0 = acc[ai][bj][m][0], v1 = acc[ai][bj][m][1];
                    u32x4 w; w.x = cvt_pk_bf16(v0[0], v0[1]); w.y = cvt_pk_bf16(v0[2], v0[3]); w.z = cvt_pk_bf16(v1[0], v1[1]); w.w = cvt_pk_bf16(v1[2], v1[3]);
                    *(u32x4*)(rowp + bj * HALF) = w; } }
    }
};
struct EpiMerge {
    static constexpr bool PERM = true;
    bf16_t* Mg; const unsigned char* G; unsigned char* M8; float s8;
    __device__ __forceinline__ void operator()(AccRef acc, const Unit& u, int wr, int wc, int fr, int fq) const {
        const int row0 = u.pm * BM + wr * 64 + fr; const int col0 = u.pn * BM + wc * 32 + 8 * fq; const int goff = u.seg * DM; const bool accum = u.seg != 0;
#pragma unroll
        for (int ai = 0; ai < 2; ++ai) {
            u32x2 gv[8]; u32x4 ov[8];
#pragma unroll
            for (int m = 0; m < 4; ++m)
#pragma unroll
                for (int bj = 0; bj < 2; ++bj) { const size_t row = (size_t)(row0 + ai * HALF + m * 16);
                    gv[m * 2 + bj] = *(const u32x2*)(G + row * GW + goff + col0 + bj * HALF);
                    if (accum) ov[m * 2 + bj] = *(const u32x4*)(Mg + row * DM + col0 + bj * HALF); }
#pragma unroll
            for (int m = 0; m < 4; ++m)
#pragma unroll
                for (int bj = 0; bj < 2; ++bj) { const size_t row = (size_t)(row0 + ai * HALF + m * 16); const f32x4 v0 = acc[ai][bj][m][0], v1 = acc[ai][bj][m][1]; const u32x2 gw = gv[m * 2 + bj]; constexpr float I255 = 1.0f / 255.0f;
                    float r[8] = { (float)(gw.x & 255u) * I255 * v0[0], (float)((gw.x >> 8) & 255u) * I255 * v0[1], (float)((gw.x >> 16) & 255u) * I255 * v0[2], (float)(gw.x >> 24) * I255 * v0[3],
                                   (float)(gw.y & 255u) * I255 * v1[0], (float)((gw.y >> 8) & 255u) * I255 * v1[1], (float)((gw.y >> 16) & 255u) * I255 * v1[2], (float)(gw.y >> 24) * I255 * v1[3] };
                    if (accum) { const u32x4 o = ov[m * 2 + bj]; r[0] += bflo(o.x); r[1] += bfhi(o.x); r[2] += bflo(o.y); r[3] += bfhi(o.y); r[4] += bflo(o.z); r[5] += bfhi(o.z); r[6] += bflo(o.w); r[7] += bfhi(o.w); }
                    u32x4 w; w.x = cvt_pk_bf16(r[0], r[1]); w.y = cvt_pk_bf16(r[2], r[3]); w.z = cvt_pk_bf16(r[4], r[5]); w.w = cvt_pk_bf16(r[6], r[7]);
                    *(u32x4*)(Mg + row * DM + col0 + bj * HALF) = w;
                    if (u.seg == 2) { u32x2 q; q.x = pk4_fp8(r[0] * s8, r[1] * s8, r[2] * s8, r[3] * s8); q.y = pk4_fp8(r[4] * s8, r[5] * s8, r[6] * s8, r[7] * s8); *(u32x2*)(M8 + row * DM + col0 + bj * HALF) = q; } }
        }
    }
};
struct EpiResid {
    static constexpr bool PERM = false;
    const float* R; float* O;
    __device__ __forceinline__ void operator()(AccRef acc, const Unit& u, int wr, int wc, int fr, int fq) const {
        const int row0 = u.pm * BM + wr * 64 + fr, col0 = u.pn * BM + wc * 32 + 4 * fq;
#pragma unroll
        for (int ai = 0; ai < 2; ++ai) {
            f32x4 rv[16];
#pragma unroll
            for (int m = 0; m < 4; ++m)
#pragma unroll
                for (int bj = 0; bj < 2; ++bj)
#pragma unroll
                    for (int n = 0; n < 2; ++n) rv[m * 4 + bj * 2 + n] = *(const f32x4*)(R + (size_t)(row0 + ai * HALF + m * 16) * DM + col0 + bj * HALF + n * 16);
#pragma unroll
            for (int m = 0; m < 4; ++m)
#pragma unroll
                for (int bj = 0; bj < 2; ++bj)
#pragma unroll
                    for (int n = 0; n < 2; ++n) *(f32x4*)(O + (size_t)(row0 + ai * HALF + m * 16) * DM + col0 + bj * HALF + n * 16) = rv[m * 4 + bj * 2 + n] + acc[ai][bj][m][n];
            asm volatile("" ::: "memory"); }
    }
};
struct EpiResidS {
    static constexpr bool PERM = false;
    const float* R; float* O; float s;
    __device__ __forceinline__ void operator()(AccRef acc, const Unit& u, int wr, int wc, int fr, int fq) const {
        const int row0 = u.pm * BM + wr * 64 + fr, col0 = u.pn * BM + wc * 32 + 4 * fq;
#pragma unroll
        for (int ai = 0; ai < 2; ++ai) {
            f32x4 rv[16];
#pragma unroll
            for (int m = 0; m < 4; ++m)
#pragma unroll
                for (int bj = 0; bj < 2; ++bj)
#pragma unroll
                    for (int n = 0; n < 2; ++n) rv[m * 4 + bj * 2 + n] = *(const f32x4*)(R + (size_t)(row0 + ai * HALF + m * 16) * DM + col0 + bj * HALF + n * 16);
#pragma unroll
            for (int m = 0; m < 4; ++m)
#pragma unroll
                for (int bj = 0; bj < 2; ++bj)
#pragma unroll
                    for (int n = 0; n < 2; ++n) *(f32x4*)(O + (size_t)(row0 + ai * HALF + m * 16) * DM + col0 + bj * HALF + n * 16) = rv[m * 4 + bj * 2 + n] + acc[ai][bj][m][n] * s;
            asm volatile("" ::: "memory"); }
    }
};
struct EpiSwiglu {
    static constexpr bool PERM = true;
    bf16_t* O; int ldc;
    __device__ __forceinline__ void operator()(AccRef acc, const Unit& u, int wr, int wc, int fr, int fq) const {
        const int row0 = u.pm * BM + wr * 64 + fr; const int col0 = u.pn * HALF + wc * 32 + 8 * fq;
#pragma unroll
        for (int ai = 0; ai < 2; ++ai)
#pragma unroll
            for (int m = 0; m < 4; ++m) { bf16_t* rowp = O + (size_t)(row0 + ai * HALF + m * 16) * ldc + col0;
                float r[8];
#pragma unroll
                for (int n = 0; n < 2; ++n)
#pragma unroll
                    for (int j = 0; j < 4; ++j) { const float gt = acc[ai][0][m][n][j], up = acc[ai][1][m][n][j]; r[4 * n + j] = gt * sigmoidf_(gt) * up; }
                u32x4 w; w.x = cvt_pk_bf16(r[0], r[1]); w.y = cvt_pk_bf16(r[2], r[3]); w.z = cvt_pk_bf16(r[4], r[5]); w.w = cvt_pk_bf16(r[6], r[7]);
                *(u32x4*)rowp = w; }
    }
};
struct EpiSwigluF8 {
    static constexpr bool PERM = true;
    unsigned char* O; int ldc; float s_in, s_out;
    __device__ __forceinline__ void operator()(AccRef acc, const Unit& u, int wr, int wc, int fr, int fq) const {
        const int row0 = u.pm * BM + wr * 64 + fr; const int col0 = u.pn * HALF + wc * 32 + 8 * fq;
#pragma unroll
        for (int ai = 0; ai < 2; ++ai)
#pragma unroll
            for (int m = 0; m < 4; ++m) { unsigned char* rowp = O + (size_t)(row0 + ai * HALF + m * 16) * ldc + col0;
                float r[8];
#pragma unroll
                for (int n = 0; n < 2; ++n)
#pragma unroll
                    for (int j = 0; j < 4; ++j) { const float gt = acc[ai][0][m][n][j] * s_in, up = acc[ai][1][m][n][j] * s_in; r[4 * n + j] = gt * sigmoidf_(gt) * up * s_out; }
                u32x2 w; w.x = pk4_fp8(r[0], r[1], r[2], r[3]); w.y = pk4_fp8(r[4], r[5], r[6], r[7]);
                *(u32x2*)rowp = w; }
    }
};
struct EpiBf16S {
    static constexpr bool PERM = true;
    bf16_t* O; int ldc; float s;
    __device__ __forceinline__ void operator()(AccRef acc, const Unit& u, int wr, int wc, int fr, int fq) const {
        const int row0 = u.pm * BM + wr * 64 + fr; const int col0 = u.pn * BM + wc * 32 + 8 * fq;
#pragma unroll
        for (int ai = 0; ai < 2; ++ai)
#pragma unroll
            for (int m = 0; m < 4; ++m) { bf16_t* rowp = O + (size_t)(row0 + ai * HALF + m * 16) * ldc + col0;
#pragma unroll
                for (int bj = 0; bj < 2; ++bj) { const f32x4 v0 = acc[ai][bj][m][0] * s, v1 = acc[ai][bj][m][1] * s;
                    u32x4 w; w.x = cvt_pk_bf16(v0[0], v0[1]); w.y = cvt_pk_bf16(v0[2], v0[3]); w.z = cvt_pk_bf16(v1[0], v1[1]); w.w = cvt_pk_bf16(v1[2], v1[3]);
                    *(u32x4*)(rowp + bj * HALF) = w; } }
    }
};
}
struct Args { const void* in[29]; float* out; unsigned char* ws; int ph_lo, ph_hi, pad0, pad1; };
enum { I_X = 0, I_POS, I_ANG, I_WIN, I_AQG, I_AKG, I_BCQG, I_BCKVG, I_WUQ, I_WUKV, I_BQNG, I_BQRG, I_BKNG, I_BKRG, I_CQG, I_CKG, I_SINK, I_WAO, I_WBO, I_WCO, I_WO, I_FNG, I_FW1, I_FW3, I_FW2, I_RW, I_MW1, I_MW3, I_MW2 };

constexpr size_t MiB = 1u << 20;
constexpr size_t WS_CTL = 0, CTL_ZERO_BYTES = 1 * MiB;
constexpr size_t SZ_WIN = (size_t)NINP * DM * 2;
constexpr size_t SZ_WUQ = (size_t)512 * 256 * 2, SZ_WUKV = SZ_WUQ;
constexpr size_t SZ_WAO = (size_t)DM * 256 * 2, SZ_WBO = SZ_WAO, SZ_WCO = (size_t)DM * 512 * 2, SZ_WO = (size_t)DM * DM * 2;
constexpr size_t SZ_WIN8 = (size_t)GW * DM;
constexpr size_t SZ_WO8 = (size_t)DM * DM;
constexpr size_t SZ_LAYERW = SZ_WIN + SZ_WUQ + SZ_WUKV + SZ_WAO + SZ_WBO + SZ_WCO + SZ_WO + SZ_WIN8 + SZ_WO8;
constexpr size_t WS_LAYERW = 1 * MiB;
constexpr size_t OFF_WIN = 0, OFF_WUQ = OFF_WIN + SZ_WIN, OFF_WUKV = OFF_WUQ + SZ_WUQ, OFF_WAO = OFF_WUKV + SZ_WUKV, OFF_WBO = OFF_WAO + SZ_WAO, OFF_WCO = OFF_WBO + SZ_WBO, OFF_WO = OFF_WCO + SZ_WCO, OFF_WIN8 = OFF_WO + SZ_WO, OFF_WO8 = OFF_WIN8 + SZ_WIN8;
constexpr size_t WS_W13 = WS_LAYERW + 2 * SZ_LAYERW;
constexpr size_t SZ_W13 = (size_t)2 * DFF * DM * 2, SZ_W2 = (size_t)DM * DFF * 2;
constexpr size_t WS_W2 = WS_W13 + SZ_W13;
constexpr size_t WS_E13 = WS_W2 + SZ_W2;
constexpr size_t SZ_E13 = (size_t)2 * EFF * DM, SZ_E2 = (size_t)DM * EFF;
constexpr float S_W13 = 32.f, S_W2 = 64.f, S_ACT = 4.f, S_WG = 32.f, S_WO = 32.f, S_MG = 8.f;
constexpr size_t WS_E2 = WS_E13 + NEXP * SZ_E13;
constexpr size_t WS_ROPE = WS_E2 + NEXP * SZ_E2;
constexpr size_t SZ_ROPE = (size_t)NPOS * (32 + 32 + 16 + 16) * 4;
constexpr size_t WS_HB = ((WS_ROPE + SZ_ROPE + MiB - 1) / MiB) * MiB;
constexpr size_t SZ_HB = (size_t)(TCH + 1) * DM * 2;
constexpr size_t WS_HF8 = ((WS_HB + SZ_HB + MiB - 1) / MiB) * MiB;
constexpr size_t WS_ACT = WS_HF8 + (size_t)TCH * DM;
constexpr size_t A_P1 = 0;                                  constexpr size_t SZ_P1 = (size_t)TCH * P1W * 2;
constexpr size_t A_G = A_P1 + SZ_P1;                        constexpr size_t SZ_G = (size_t)TCH * GW * 2;
constexpr size_t A_QA = A_G + SZ_G;
constexpr size_t A_KA = A_QA + (size_t)TCH * 256 * 2;
constexpr size_t A_VA = A_KA + (size_t)TCH * 64 * 2;
constexpr size_t A_IQ = A_VA + (size_t)TCH * 64 * 2;
constexpr size_t A_IK = A_IQ + (size_t)TCH * 256 * 2;
constexpr size_t A_IW = A_IK + (size_t)TCH * 32 * 2;
constexpr size_t A_CQN = A_IW + (size_t)TCH * 8 * 4;
constexpr size_t A_CKVN = A_CQN + (size_t)TCH * 256 * 2;
constexpr size_t A_KR = A_CKVN + (size_t)TCH * 256 * 2;
constexpr size_t A_QC = A_KR + (size_t)TCH * 32 * 2;
constexpr size_t A_KC = A_QC + (size_t)TCH * 512 * 2;
constexpr size_t A_VCT = A_KC + (size_t)TCH * 128 * 2;
constexpr size_t A_QBR = A_VCT + (size_t)TCH * 128 * 2;
constexpr size_t A_KVBR = A_QBR + (size_t)TCH * 512 * 2;
constexpr size_t A_QB = A_KVBR + (size_t)TCH * 512 * 2;
constexpr size_t A_KB = A_QB + (size_t)TCH * 384 * 2;
constexpr size_t A_VBT = A_KB + (size_t)TCH * 384 * 2;
constexpr size_t A_SEL = A_VBT + (size_t)TCH * 256 * 2;
constexpr size_t A_SELN = A_SEL + (size_t)TCH * 256 * 2;
constexpr size_t A_Y = A_SELN + (size_t)TCH * 4;
constexpr size_t A_END = A_Y + (size_t)TCH * DM * 2;
constexpr size_t F_ACT = 0;
constexpr size_t F_YM = F_ACT + (size_t)MOE_ROWS * EFF * 2;
constexpr size_t F_ROWTOK = F_YM + (size_t)MOE_ROWS * DM * 2;
constexpr size_t F_TOPD = F_ROWTOK + (size_t)MOE_ROWS * 4;
constexpr size_t F_TOPE = F_TOPD + (size_t)TCH * 2 * 4;
constexpr size_t F_TOPG = F_TOPE + (size_t)TCH * 2 * 4;
constexpr size_t F_BLKE = F_TOPG + (size_t)TCH * 2 * 4;
constexpr size_t F_END = F_BLKE + 4096;
constexpr size_t WS_END = WS_ACT + (A_END > F_END ? A_END : F_END);
constexpr int CW_BAR = 4096;
constexpr int CW_Q = 16384;
constexpr int CW_MOE = 32768;
constexpr int CW_DBG = 65536;

constexpr int RING_OFF = 0;
constexpr int IDX_HP = 1028;
constexpr int IDX_HIST = 0, IDX_BITMAP = 0, IDX_CANDK = 32768, IDX_CANDI = 98304, IDX_QT = 131584  , IDX_SUBH = IDX_QT  ,
              IDX_QPAR = 152576, IDX_CCNT = 153600, IDX_FLAG = 153728;
constexpr int IDX_CCAP = 512, IDX_RCAP = 256;
constexpr int MISC_OFF = 153856;
constexpr int LDS_BYTES = 155648;
constexpr int NWAVES = 8;
#ifndef MK_TIMER
#define MK_TIMER 0
#endif
#define TMR_ACC ((LAS unsigned*)(size_t)(MISC_OFF + 192))
#define TB(id) unsigned long long tb_##id = 0ull; if (MK_TIMER == (id)) tb_##id = __builtin_amdgcn_s_memrealtime()
#define TE(id) do { if (MK_TIMER == (id)) { const unsigned d_ = (unsigned)(__builtin_amdgcn_s_memrealtime() - tb_##id); if (lane_id() == 0) lds_add(TMR_ACC, d_); } } while (0)

#define XB_TMO      128
#define XB_XCNT(j)  (256  + 64 * (j))
#define XB_XSUB(j)  (1280 + 64 * (j))
#define XB_XGEN(j)  (2304 + 64 * (j))
#define XB_TOP      3328
#define XB_TOPGEN   3392
#define XCD_BAR_WORDS 3456
#define XB_SPIN_CAP (1u << 18)

__device__ __forceinline__ unsigned xb_ld(unsigned* p)              { return __hip_atomic_load(p, __ATOMIC_RELAXED, __HIP_MEMORY_SCOPE_AGENT); }
__device__ __forceinline__ unsigned xb_add(unsigned* p, unsigned v) { return __hip_atomic_fetch_add(p, v, __ATOMIC_RELAXED, __HIP_MEMORY_SCOPE_AGENT); }
__device__ __forceinline__ unsigned xb_xcc_id() { return (unsigned)__builtin_amdgcn_s_getreg((3 << 11) | 20) & 0xFu; }
#define XB_SPIN(cond, bar) do { unsigned _sp = 0; while (cond) { __builtin_amdgcn_s_sleep(1); \
    if ((++_sp & 255u) == 0u) { if (xb_ld(&(bar)[XB_TMO])) break; if (_sp > XB_SPIN_CAP) { atomicAdd(&(bar)[XB_TMO], 1u); break; } } } } while (0)

struct XcdBarrier {
    unsigned* bar; unsigned x;
    volatile LAS unsigned* st;
};
__device__ __forceinline__ XcdBarrier xcd_barrier_post(unsigned* bar, volatile LAS unsigned* st, int wave_) {
    XcdBarrier b; b.bar = bar; b.x = xb_xcc_id(); b.st = st;
    if (wave_ == 0 && lane_id() == 0) (void)xb_add(&bar[XB_XCNT(b.x)], 1u);
    return b;
}
__device__ __forceinline__ void xcd_barrier_complete(unsigned* bar, unsigned x, unsigned& nloc, unsigned& nx) {
    const unsigned G = gridDim.x * gridDim.y * gridDim.z;
    unsigned sum, cnt, mine, sp = 0u;
    for (;;) {
        sum = 0u; cnt = 0u; mine = 0u;
#pragma unroll
        for (unsigned j = 0; j < 16; ++j) { const unsigned c = xb_ld(&bar[XB_XCNT(j)]); sum += c; cnt += (c > 0u) ? 1u : 0u; mine = (j == x) ? c : mine; }
        if (sum == G) break;
        __builtin_amdgcn_s_sleep(1);
        if ((++sp & 255u) == 0u) { if (xb_ld(&bar[XB_TMO])) break; if (sp > XB_SPIN_CAP) { atomicAdd(&bar[XB_TMO], 1u); break; } }
    }
    nloc = mine > 0u ? mine : 1u; nx = cnt > 0u ? cnt : 1u;
}
__device__ __forceinline__ void xcd_barrier(const XcdBarrier& b, int wave_) {
    asm volatile("s_waitcnt vmcnt(0)" ::: "memory");
    __syncthreads();
    if (wave_ == 0 && lane_id() == 0) {
        unsigned* bar = b.bar;
        __builtin_amdgcn_s_waitcnt(0);
        unsigned nloc = b.st[0], nx = b.st[1];
        if (nloc == 0u) { xcd_barrier_complete(bar, b.x, nloc, nx); b.st[0] = nloc; b.st[1] = nx; }
        const unsigned old = xb_add(&bar[XB_XSUB(b.x)], 1u);
        const unsigned gen = old / nloc;
        if (old + 1u == (gen + 1u) * nloc) {
            __builtin_amdgcn_fence(__ATOMIC_RELEASE, "agent");
            asm volatile("s_waitcnt vmcnt(0)" ::: "memory");
            const unsigned og = xb_add(&bar[XB_TOP], 1u);
            const unsigned tg = og / nx;
            if (og + 1u == (tg + 1u) * nx) xb_add(&bar[XB_TOPGEN], 1u);
            else XB_SPIN(xb_ld(&bar[XB_TOPGEN]) == tg, bar);
            __builtin_amdgcn_fence(__ATOMIC_ACQUIRE, "agent");
            xb_add(&bar[XB_XGEN(b.x)], 1u);
            asm volatile("s_waitcnt vmcnt(0)" ::: "memory");
        } else {
            XB_SPIN(xb_ld(&bar[XB_XGEN(b.x)]) == gen, bar);
            __builtin_amdgcn_fence(__ATOMIC_ACQUIRE, "agent");
            asm volatile("s_waitcnt vmcnt(0)" ::: "memory");
        }
    }
    __syncthreads();
}

template <int MAP> __device__ __forceinline__ int wt_row(int n) {
    if (MAP == 1) return n < C_G ? n : n + (P1W - C_G);
    if (MAP == 2) return 256 * (n >> 7) + (n & 127);
    if (MAP == 3) return 256 * (n >> 7) + 128 + (n & 127);
    return n;
}
template <int MAP>
__device__ __forceinline__ void transpose_item(const float* W, int K, int N, bf16_t* WT, int ldk, LAS float* scr, int item, int lane) {
    const int nblk = (N + 31) / 32, kb = item / nblk, nb = item % nblk, k0 = 64 * kb, n0 = 32 * nb;
    const int nn = n0 + (lane & 31); const bool nok = nn < N;
#pragma unroll
    for (int i = 0; i < 32; ++i) { const int kk = 2 * i + (lane >> 5); scr[kk * 33 + (lane & 31)] = nok ? W[(size_t)(k0 + kk) * N + nn] : 0.f; }
    LDS_WAIT(); asm volatile("" ::: "memory");
    const int c = lane & 7;
#pragma unroll
    for (int j = 0; j < 4; ++j) { const int n = (lane >> 3) + 8 * j; const LAS float* s = scr + (8 * c) * 33 + n;
        u32x4 o; o.x = pk2(s[0 * 33], s[1 * 33]); o.y = pk2(s[2 * 33], s[3 * 33]); o.z = pk2(s[4 * 33], s[5 * 33]); o.w = pk2(s[6 * 33], s[7 * 33]);
        if (n0 + n < N) *(u32x4*)(WT + (size_t)wt_row<MAP>(n0 + n) * ldk + k0 + 8 * c) = o; }
    LDS_WAIT(); asm volatile("" ::: "memory");
}

template <int MAP>
__device__ __forceinline__ void transpose_item_f8(const float* W, int K, int N, unsigned char* WT, int ldk, float sc, LAS float* scr, int item, int lane, int ldn = 0  ) {
    if (ldn == 0) ldn = N;
    const int nblk = (N + 31) / 32, kb = item / nblk, nb = item % nblk, n0 = 32 * nb;
    const int nn = n0 + (lane & 31); const bool nok = nn < N;
    const int c = lane & 7;
#pragma unroll 1
    for (int h = 0; h < 2; ++h) { const int k0 = 128 * kb + 64 * h;
#pragma unroll
        for (int i = 0; i < 32; ++i) { const int kk = 2 * i + (lane >> 5); scr[kk * 33 + (lane & 31)] = nok ? W[(size_t)(k0 + kk) * ldn + nn] * sc : 0.f; }
        LDS_WAIT(); asm volatile("" ::: "memory");
#pragma unroll
        for (int j = 0; j < 4; ++j) { const int n = (lane >> 3) + 8 * j; const LAS float* s = scr + (8 * c) * 33 + n;
            u32x2 o; o.x = pk4_fp8(s[0 * 33], s[1 * 33], s[2 * 33], s[3 * 33]); o.y = pk4_fp8(s[4 * 33], s[5 * 33], s[6 * 33], s[7 * 33]);
            if (n0 + n < N) *(u32x2*)(WT + (size_t)wt_row<MAP>(n0 + n) * ldk + k0 + 8 * c) = o; }
        LDS_WAIT(); asm volatile("" ::: "memory"); }
}
struct RopeTab { const float* c64; const float* s64; const float* c32; const float* s32; };

__device__ __forceinline__ void rope_cs(const RopeTab& R, int pos, int i, int half, float& c, float& s) {
    pos = pos < 0 ? 0 : (pos >= NPOS ? NPOS - 1 : pos);
    if (half == 32) { c = R.c64[pos * 32 + i]; s = R.s64[pos * 32 + i]; } else { c = R.c32[pos * 16 + i]; s = R.s32[pos * 16 + i]; }
}

__device__ __forceinline__ void norm_rows(const float* x, const float* g, bf16_t* HB, unsigned char* HF8, int gw, int ngw, int lane) {
    asm volatile("" : "+v"(lane));
    f32x4 gv[4];
#pragma unroll
    for (int j = 0; j < 4; ++j) gv[j] = *(const f32x4*)(g + 4 * lane + 256 * j);
    for (int tok = gw; tok < TCH; tok += ngw) {
        const float* xr = x + (size_t)tok * DM; f32x4 v[4]; float ss = 0.f;
#pragma unroll
        for (int j = 0; j < 4; ++j) { v[j] = *(const f32x4*)(xr + 4 * lane + 256 * j); ss += (v[j].x * v[j].x + v[j].y * v[j].y) + (v[j].z * v[j].z + v[j].w * v[j].w); }
        const float rstd = 1.0f / sqrtf(wave_sum(ss) * (1.0f / DM) + EPS);
        bf16_t* o = HB + (size_t)tok * DM;
#pragma unroll
        for (int j = 0; j < 4; ++j) { const float y0 = v[j].x * rstd * gv[j].x, y1 = v[j].y * rstd * gv[j].y, y2 = v[j].z * rstd * gv[j].z, y3 = v[j].w * rstd * gv[j].w;
            u32x2 w; w.x = pk2(y0, y1); w.y = pk2(y2, y3); *(u32x2*)(o + 4 * lane + 256 * j) = w;
            *(unsigned*)(HF8 + (size_t)tok * DM + 4 * lane + 256 * j) = pk4_fp8(y0, y1, y2, y3); }
    }
}

struct PP1Args {
    const bf16_t* P1; const int* pos;
    const float *aq_g, *ak_g, *cq_g, *ckv_g, *kr_g, *qc_g, *kc_g;
    unsigned char* act;
    RopeTab R;
};
constexpr float SC_A = 0.125f * LOG2E;
constexpr float SC_B = 0.10206207261596577f * LOG2E;
constexpr float SC_IW = 0.35355339059327373f * 0.17677669529663687f;
__device__ __forceinline__ void pp1_rows(const PP1Args& a, LAS unsigned char* wl  , int gw, int ngw, int lane) {
    asm volatile("" : "+v"(lane));
    const int k16 = lane & 15, g16 = lane >> 4, k8 = lane & 7, g8 = lane >> 3;
    const f32x2 gaq1 = *(const f32x2*)(a.aq_g + 2 * k16), gaq2 = *(const f32x2*)(a.aq_g + 32 + 2 * k16), gak1 = *(const f32x2*)(a.ak_g + 2 * k16), gak2 = *(const f32x2*)(a.ak_g + 32 + 2 * k16);
    const f32x2 gqc1 = *(const f32x2*)(a.qc_g + 2 * k16), gqc2 = *(const f32x2*)(a.qc_g + 32 + 2 * k16), gkc1 = *(const f32x2*)(a.kc_g + 2 * k16), gkc2 = *(const f32x2*)(a.kc_g + 32 + 2 * k16);
    const f32x2 gkr1 = *(const f32x2*)(a.kr_g + 2 * k8), gkr2 = *(const f32x2*)(a.kr_g + 16 + 2 * k8);
    u32x4 nx[4]; int npos = 0;
    if (gw < TCH) { const u32x4* src = (const u32x4*)(a.P1 + (size_t)gw * P1W);
#pragma unroll
        for (int j = 0; j < 4; ++j) nx[j] = src[lane + 64 * j];
        npos = a.pos[gw]; }
    int buf = 0;
    for (int tok = gw; tok < TCH; tok += ngw, buf ^= 1) {
        LAS unsigned char* rowb = wl + buf * 4096;
#pragma unroll
        for (int j = 0; j < 4; ++j) *(LAS u32x4*)(rowb + (lane + 64 * j) * 16) = nx[j];
        const int pos = npos;
        if (tok + ngw < TCH) { const u32x4* src = (const u32x4*)(a.P1 + (size_t)(tok + ngw) * P1W);
#pragma unroll
            for (int j = 0; j < 4; ++j) nx[j] = src[lane + 64 * j];
            npos = a.pos[tok + ngw]; }
        const LAS bf16_t* p = (const LAS bf16_t*)rowb;
        const int bl = tok / SEQ, s = tok % SEQ;
        float c64a, s64a, c64b, s64b, c32a, s32a, c32b, s32b;
        rope_cs(a.R, pos, 2 * k16, 32, c64a, s64a); rope_cs(a.R, pos, 2 * k16 + 1, 32, c64b, s64b); rope_cs(a.R, pos, 2 * k8, 16, c32a, s32a); rope_cs(a.R, pos, 2 * k8 + 1, 16, c32b, s32b);
#pragma unroll
        for (int it = 0; it < 4; ++it) {
            const int hh = 4 * it + g16;
            const int kind = hh < 4 ? 0 : (hh == 4 ? 1 : (hh < 13 ? 2 : 3));
            const int hsub = kind == 0 ? hh : (kind == 1 ? 0 : (kind == 2 ? hh - 5 : ((hh - 13) & 1)));
            const int src = (kind == 0 ? C_QA : (kind == 1 ? C_KA : (kind == 2 ? C_QC : C_KC))) + 64 * hsub;
            const size_t dbase = kind == 0 ? A_QA : (kind == 1 ? A_KA : (kind == 2 ? A_QC : A_KC));
            const int dpitch = kind == 0 ? 256 : (kind == 1 ? 64 : (kind == 2 ? 512 : 128));
            const float g1a = kind == 0 ? gaq1.x : (kind == 1 ? gak1.x : (kind == 2 ? gqc1.x : gkc1.x)), g1b = kind == 0 ? gaq1.y : (kind == 1 ? gak1.y : (kind == 2 ? gqc1.y : gkc1.y));
            const float g2a = kind == 0 ? gaq2.x : (kind == 1 ? gak2.x : (kind == 2 ? gqc2.x : gkc2.x)), g2b = kind == 0 ? gaq2.y : (kind == 1 ? gak2.y : (kind == 2 ? gqc2.y : gkc2.y));
            const float sc = (kind == 0 || kind == 2) ? SC_A : 1.f;
            bf16_t* dst = (bf16_t*)(a.act + dbase) + (size_t)tok * dpitch + 64 * hsub;
            const unsigned wA = *(const LAS unsigned*)(p + src + 2 * k16), wB = *(const LAS unsigned*)(p + src + 32 + 2 * k16);
            const float x1a = bflo(wA), x1b = bfhi(wA), x2a = bflo(wB), x2b = bfhi(wB);
            const float rstd = 1.0f / sqrtf(sum16((x1a * x1a + x1b * x1b) + (x2a * x2a + x2b * x2b)) * (1.0f / 64.0f) + EPS);
            const float y1a = x1a * rstd * g1a, y1b = x1b * rstd * g1b, y2a = x2a * rstd * g2a, y2b = x2b * rstd * g2b;
            if (hh < 15) { *(unsigned*)(dst + 2 * k16) = pk2((y1a * c64a - y2a * s64a) * sc, (y1b * c64b - y2b * s64b) * sc);
                           *(unsigned*)(dst + 32 + 2 * k16) = pk2((y2a * c64a + y1a * s64a) * sc, (y2b * c64b + y1b * s64b) * sc); }
        }
#pragma unroll
        for (int it = 0; it < 2; ++it) {
            const int hh = 8 * it + g8; const int kind = hh < 8 ? 0 : (hh == 8 ? 1 : 2);
            const int src = kind == 0 ? C_IQ + 32 * hh : (kind == 1 ? C_IK : C_KR);
            const size_t dbase = kind == 0 ? A_IQ : (kind == 1 ? A_IK : A_KR);
            bf16_t* dst = (bf16_t*)(a.act + dbase) + (size_t)tok * (kind == 0 ? 256 : 32) + (kind == 0 ? 32 * hh : 0);
            const unsigned wA = (hh < 10) ? *(const LAS unsigned*)(p + src + 2 * k8) : 0u, wB = (hh < 10) ? *(const LAS unsigned*)(p + src + 16 + 2 * k8) : 0u;
            float x1a = bflo(wA), x1b = bfhi(wA), x2a = bflo(wB), x2b = bfhi(wB);
            float ss = (x1a * x1a + x1b * x1b) + (x2a * x2a + x2b * x2b); ss += xor_lane<1>(ss); ss += xor_lane<2>(ss); ss += xor_lane<4>(ss);
            if (kind == 2) { const float rstd = 1.0f / sqrtf(ss * (1.0f / 32.0f) + EPS); x1a *= rstd * gkr1.x; x1b *= rstd * gkr1.y; x2a *= rstd * gkr2.x; x2b *= rstd * gkr2.y; }
            if (hh < 10) { *(unsigned*)(dst + 2 * k8) = pk2(x1a * c32a - x2a * s32a, x1b * c32b - x2b * s32b);
                           *(unsigned*)(dst + 16 + 2 * k8) = pk2(x2a * c32a + x1a * s32a, x2b * c32b + x1b * s32b); }
        }
        if (lane < 8) ((float*)(a.act + A_IW))[(size_t)tok * 8 + lane] = bf2f(p[C_IW + lane]) * SC_IW;
        ((bf16_t*)(a.act + A_VA))[(size_t)tok * 64 + lane] = p[C_VA + lane];
        { const u32x2 w = *(const LAS u32x2*)(p + C_CQ + 4 * lane); const float x0 = bflo(w.x), x1 = bfhi(w.x), x2 = bflo(w.y), x3 = bfhi(w.y);
          const float rstd = 1.0f / sqrtf(wave_sum((x0 * x0 + x1 * x1) + (x2 * x2 + x3 * x3)) * (1.0f / 256.0f) + EPS);
          const f32x4 g = *(const f32x4*)(a.cq_g + 4 * lane);
          u32x2 o; o.x = pk2(x0 * rstd * g.x, x1 * rstd * g.y); o.y = pk2(x2 * rstd * g.z, x3 * rstd * g.w); *(u32x2*)((bf16_t*)(a.act + A_CQN) + (size_t)tok * 256 + 4 * lane) = o; }
        { const unsigned w = *(const LAS unsigned*)(p + C_CKV + 2 * lane); const float x0 = bflo(w), x1 = bfhi(w);
          const float rstd = 1.0f / sqrtf(wave_sum(x0 * x0 + x1 * x1) * (1.0f / 128.0f) + EPS);
          const f32x2 g = *(const f32x2*)(a.ckv_g + 2 * lane);
          bf16_t* ck = (bf16_t*)(a.act + A_CKVN) + (size_t)tok * 256;
          *(unsigned*)(ck + 2 * lane) = pk2(x0 * rstd * g.x, x1 * rstd * g.y);
          *(unsigned*)(ck + 128 + 2 * lane) = 0u; }
#pragma unroll
        for (int kvh = 0; kvh < 2; ++kvh) ((bf16_t*)(a.act + A_VCT))[((size_t)(bl * 2 + kvh) * 64 + lane) * SEQ + s] = p[C_VC + 64 * kvh + lane];
    }
}

struct PP2Args {
    const bf16_t *QBR, *KVBR, *KR; const int* pos;
    const float *qn_g, *qr_g, *kn_g;
    bf16_t *QB, *KB, *VBT; RopeTab R;
};
__device__ __forceinline__ void pp2_rows(const PP2Args& a, LAS unsigned char* wl  , int gw, int ngw, int lane) {
    asm volatile("" : "+v"(lane));
    const int i32 = lane & 31, hf = lane >> 5;
    u32x4 nx[2]; unsigned nkr = 0u; int npos = 0;
    if (gw < TCH) { const u32x4* src = (const u32x4*)(a.QBR + (size_t)gw * 1024); nx[0] = src[lane]; nx[1] = src[64 + lane]; if (lane < 16) nkr = ((const unsigned*)(a.KR + (size_t)gw * 32))[lane]; npos = a.pos[gw]; }
    int buf = 0;
    for (int tok = gw; tok < TCH; tok += ngw, buf ^= 1) {
        LAS unsigned char* rowb = wl + buf * 4096;
        *(LAS u32x4*)(rowb + lane * 16) = nx[0]; *(LAS u32x4*)(rowb + (64 + lane) * 16) = nx[1]; if (lane < 16) *(LAS unsigned*)(rowb + 2048 + lane * 4) = nkr;
        const int pos = npos;
        if (tok + ngw < TCH) { const u32x4* src = (const u32x4*)(a.QBR + (size_t)(tok + ngw) * 1024); nx[0] = src[lane]; nx[1] = src[64 + lane]; if (lane < 16) nkr = ((const unsigned*)(a.KR + (size_t)(tok + ngw) * 32))[lane]; npos = a.pos[tok + ngw]; }
        const int bl = tok / SEQ, s = tok % SEQ;
        float c32 = 0.f, s32 = 0.f; if (i32 < 16) rope_cs(a.R, pos, i32, 16, c32, s32);
        const LAS bf16_t* q = (const LAS bf16_t*)rowb; const LAS bf16_t* kv = q + 512; const LAS bf16_t* krl = q + 1024;
        bf16_t* qo = a.QB + (size_t)tok * 384; bf16_t* ko = a.KB + (size_t)tok * 384;
#pragma unroll
        for (int it = 0; it < 2; ++it) {
            const int h = 2 * it + hf;
            { const float x1 = bf2f(q[h * 96 + i32]), x2 = bf2f(q[h * 96 + 32 + i32]);
              const float rstd = 1.0f / sqrtf(sum32(x1 * x1 + x2 * x2) * (1.0f / 64.0f) + EPS);
              qo[h * 96 + i32] = (bf16_t)f2bf(x1 * rstd * a.qn_g[i32] * SC_B); qo[h * 96 + 32 + i32] = (bf16_t)f2bf(x2 * rstd * a.qn_g[32 + i32] * SC_B); }
            { const bool on = i32 < 16; const float x1 = on ? bf2f(q[h * 96 + 64 + i32]) : 0.f, x2 = on ? bf2f(q[h * 96 + 80 + i32]) : 0.f;
              const float rstd = 1.0f / sqrtf(sum32(x1 * x1 + x2 * x2) * (1.0f / 32.0f) + EPS);
              const float y1 = x1 * rstd * (on ? a.qr_g[i32] : 0.f), y2 = x2 * rstd * (on ? a.qr_g[16 + i32] : 0.f);
              if (on) { qo[h * 96 + 64 + i32] = (bf16_t)f2bf((y1 * c32 - y2 * s32) * SC_B); qo[h * 96 + 80 + i32] = (bf16_t)f2bf((y2 * c32 + y1 * s32) * SC_B); } }
            { const float x1 = bf2f(kv[h * 128 + i32]), x2 = bf2f(kv[h * 128 + 32 + i32]);
              const float rstd = 1.0f / sqrtf(sum32(x1 * x1 + x2 * x2) * (1.0f / 64.0f) + EPS);
              ko[h * 96 + i32] = (bf16_t)f2bf(x1 * rstd * a.kn_g[i32]); ko[h * 96 + 32 + i32] = (bf16_t)f2bf(x2 * rstd * a.kn_g[32 + i32]);
              ko[h * 96 + 64 + i32] = krl[i32];
              a.VBT[((size_t)(bl * 4 + h) * 64 + i32) * SEQ + s] = kv[h * 128 + 64 + i32];
              a.VBT[((size_t)(bl * 4 + h) * 64 + 32 + i32) * SEQ + s] = kv[h * 128 + 96 + i32]; }
        }
    }
}

struct RouteArgs { const float* rw; int* TOPE; float* TOPG; int* TOPD; unsigned* cursor; };
template <bool ROUTE>
__device__ __forceinline__ void norm2_rows(const float* x, const float* g, bf16_t* HB, unsigned char* HF8  , const RouteArgs& ra, LAS unsigned* lcnt  , int vcu, int wave, int lane, int G) {
    asm volatile("" : "+v"(lane));
    int tidx = wave * 64 + lane;
    const int tpw = TCH / G; const int t0 = vcu * tpw;
    f32x4 gv[4];
#pragma unroll
    for (int j = 0; j < 4; ++j) gv[j] = *(const f32x4*)(g + 4 * lane + 256 * j);
    for (int tl = wave; tl < tpw; tl += NWAVES) {
        const int tok = t0 + tl;
        const float* xr = x + (size_t)tok * DM; f32x4 v[4]; float ss = 0.f;
#pragma unroll
        for (int j = 0; j < 4; ++j) { v[j] = *(const f32x4*)(xr + 4 * lane + 256 * j); ss += (v[j].x * v[j].x + v[j].y * v[j].y) + (v[j].z * v[j].z + v[j].w * v[j].w); }
        const float rstd = 1.0f / sqrtf(wave_sum(ss) * (1.0f / DM) + EPS);
        bf16_t* o = HB + (size_t)tok * DM;
#pragma unroll
        for (int j = 0; j < 4; ++j) { v[j].x *= rstd * gv[j].x; v[j].y *= rstd * gv[j].y; v[j].z *= rstd * gv[j].z; v[j].w *= rstd * gv[j].w;
            u32x2 w; w.x = pk2(v[j].x, v[j].y); w.y = pk2(v[j].z, v[j].w); *(u32x2*)(o + 4 * lane + 256 * j) = w;
            if (!ROUTE) *(unsigned*)(HF8 + (size_t)tok * DM + 4 * lane + 256 * j) = pk4_fp8(v[j].x, v[j].y, v[j].z, v[j].w); }
        if (ROUTE) {
            float lg[NEXP];
#pragma unroll
            for (int e = 0; e < NEXP; ++e) lg[e] = 0.f;
#pragma unroll
            for (int j = 0; j < 4; ++j)
#pragma unroll
                for (int c = 0; c < 4; ++c) { const float hv = v[j][c]; const float* wr = ra.rw + (size_t)(4 * lane + 256 * j + c) * NEXP;
                    const f32x4 w0 = *(const f32x4*)wr, w1 = *(const f32x4*)(wr + 4);
                    lg[0] += hv * w0.x; lg[1] += hv * w0.y; lg[2] += hv * w0.z; lg[3] += hv * w0.w; lg[4] += hv * w1.x; lg[5] += hv * w1.y; lg[6] += hv * w1.z; lg[7] += hv * w1.w; }
#pragma unroll
            for (int e = 0; e < NEXP; ++e) lg[e] = wave_sum(lg[e]);
            int e1 = 0; float l1 = lg[0];
#pragma unroll
            for (int e = 1; e < NEXP; ++e) if (lg[e] > l1) { l1 = lg[e]; e1 = e; }
            int e2 = -1; float l2 = -INFINITY;
#pragma unroll
            for (int e = 0; e < NEXP; ++e) if (e != e1 && lg[e] > l2) { l2 = lg[e]; e2 = e; }
            const float ex = __expf(l2 - l1); const float g1 = 1.0f / (1.0f + ex), g2 = ex / (1.0f + ex);
            if (lane == 0) {
                const unsigned p1 = lds_add(lcnt + e1, 1u), p2 = lds_add(lcnt + e2, 1u);
                ra.TOPE[2 * tok] = e1; ra.TOPE[2 * tok + 1] = e2; ra.TOPG[2 * tok] = g1; ra.TOPG[2 * tok + 1] = g2; ra.TOPD[2 * tok] = (int)p1; ra.TOPD[2 * tok + 1] = (int)p2;
            }
        }
    }
    if (ROUTE) {
        VM_WAIT(); __syncthreads();
        if (tidx < NEXP) { const unsigned n = lcnt[tidx]; lcnt[8 + tidx] = __hip_atomic_fetch_add(ra.cursor + tidx, n, __ATOMIC_RELAXED, __HIP_MEMORY_SCOPE_AGENT); }
        __syncthreads();
        for (int i = tidx; i < 2 * tpw; i += NWAVES * 64) { const int idx = 2 * t0 + i; const int e = ra.TOPE[idx]; ra.TOPD[idx] += (int)lcnt[8 + e]; }
        __syncthreads();
        if (tidx < 16) lcnt[tidx] = 0u;
        __syncthreads();
    }
}

__device__ __forceinline__ void moe_layout(const unsigned* cursor, int* pstart  ) {
    int acc = 0;
#pragma unroll
    for (int e = 0; e < NEXP; ++e) { pstart[e] = acc; const int c = (int)__hip_atomic_load(cursor + e, __ATOMIC_RELAXED, __HIP_MEMORY_SCOPE_AGENT); acc += (c + 255) / 256 * 256; }
    pstart[NEXP] = acc;
}
__device__ __forceinline__ void moe_scatter(const unsigned* cursor, const int* TOPE, int* TOPD, const bf16_t* HB, bf16_t* XB, int* BLKE, int gw, int ngw, int lane) {
    asm volatile("" : "+v"(lane));
    int ps[NEXP + 1]; moe_layout(cursor, ps);
    for (int i = gw; i < 2 * TCH; i += ngw) { const int e = TOPE[i];
        int base = 0;
#pragma unroll
        for (int k = 1; k < NEXP; ++k) base = (e == k) ? ps[k] : base;
        const int dest = base + TOPD[i];
        const u32x4* src = (const u32x4*)(HB + (size_t)(i >> 1) * DM); u32x4* dst = (u32x4*)((unsigned char*)XB + (size_t)dest * DM);
        const u32x4 v0 = src[2 * lane], v1 = src[2 * lane + 1];
        u32x4 o; o.x = pk4_fp8(bflo(v0.x), bfhi(v0.x), bflo(v0.y), bfhi(v0.y)); o.y = pk4_fp8(bflo(v0.z), bfhi(v0.z), bflo(v0.w), bfhi(v0.w));
        o.z = pk4_fp8(bflo(v1.x), bfhi(v1.x), bflo(v1.y), bfhi(v1.y)); o.w = pk4_fp8(bflo(v1.z), bfhi(v1.z), bflo(v1.w), bfhi(v1.w));
        dst[lane] = o;
        if (lane == 0) TOPD[i] = dest; }
#pragma unroll
    for (int e = 0; e < NEXP; ++e) { const int cnt = (int)__hip_atomic_load(cursor + e, __ATOMIC_RELAXED, __HIP_MEMORY_SCOPE_AGENT);
        for (int r = ps[e] + cnt + gw; r < ps[e + 1]; r += ngw) { u32x4* dst = (u32x4*)((unsigned char*)XB + (size_t)r * DM); dst[lane] = (u32x4){0u, 0u, 0u, 0u}; }
        for (int blk = ps[e] / 256 + gw * 64 + lane; blk < ps[e + 1] / 256; blk += ngw * 64) BLKE[blk] = e; }
}
__device__ __forceinline__ void moe_combine(float* xio, const bf16_t* YM, const int* TOPD, const float* TOPG, int gw, int ngw, int lane) {
    asm volatile("" : "+v"(lane));
    for (int tok = gw; tok < TCH; tok += ngw) {
        const int d1 = TOPD[2 * tok], d2 = TOPD[2 * tok + 1]; const float g1 = TOPG[2 * tok], g2 = TOPG[2 * tok + 1];
        float* xr = xio + (size_t)tok * DM; const bf16_t* y1 = YM + (size_t)d1 * DM; const bf16_t* y2 = YM + (size_t)d2 * DM;
#pragma unroll
        for (int j = 0; j < 4; ++j) { const int c = 4 * lane + 256 * j; f32x4 v = *(const f32x4*)(xr + c); const u32x2 a = *(const u32x2*)(y1 + c), b = *(const u32x2*)(y2 + c);
            v.x += bflo(a.x) * g1 + bflo(b.x) * g2; v.y += bfhi(a.x) * g1 + bfhi(b.x) * g2; v.z += bflo(a.y) * g1 + bflo(b.y) * g2; v.w += bfhi(a.y) * g1 + bfhi(b.y) * g2;
            *(f32x4*)(xr + c) = v; }
    }
}

__device__ __forceinline__ int kappa32(int m) { return (m & ~12) | ((m & 8) >> 1) | ((m & 4) << 1); }
template <int DQK>
__device__ __forceinline__ void fa_unit(LAS unsigned char* lds, int wave_, const bf16_t* Qw, int qpitch, const bf16_t* Kb, int kpitch, const bf16_t* VTb,
                                        int tile_lo, int tile_hi, int qpos0w, int window, float m_init, float l_init, bf16_t* Ow, int opitch) {
    constexpr int KP = DQK * 2 + 16, VP = 144, KBUF = 64 * KP, VBUF = 64 * VP, KCH = DQK / 8, NKC = 64 * KCH;
    int tid = wave_ * 64 + lane_id(); asm volatile("" : "+v"(tid));
    const int lane = tid & 63, r32 = lane & 31, hi = lane >> 5;
    bf16x8 qf[DQK / 16];
#pragma unroll
    for (int d0 = 0; d0 < DQK / 16; ++d0) qf[d0] = *(const bf16x8*)(Qw + (size_t)r32 * qpitch + d0 * 16 + hi * 8);
    const int kr0 = tid / KCH, kc0 = tid % KCH, kr1 = (tid + 512) / KCH, kc1 = (tid + 512) % KCH; const bool has1 = (tid + 512) < NKC;
    const int vr = tid >> 3, vc = tid & 7;
    u32x4 pk0, pk1 = (u32x4){0u, 0u, 0u, 0u}, pv;
#define FA_LOAD(t) do { const bf16_t* kt_ = Kb + (size_t)(64 * (t)) * kpitch; pk0 = *(const u32x4*)(kt_ + (size_t)kr0 * kpitch + kc0 * 8); if (has1) pk1 = *(const u32x4*)(kt_ + (size_t)kr1 * kpitch + kc1 * 8); \
        pv = *(const u32x4*)(VTb + (size_t)vr * SEQ + 64 * (t) + vc * 8); } while (0)
#define FA_STORE(b) do { LAS unsigned char* kd_ = lds + (b) * KBUF; *(LAS u32x4*)(kd_ + kr0 * KP + kc0 * 16) = pk0; if (has1) *(LAS u32x4*)(kd_ + kr1 * KP + kc1 * 16) = pk1; \
        *(LAS u32x4*)(lds + 2 * KBUF + (b) * VBUF + vr * VP + vc * 16) = pv; } while (0)
    float m_run = m_init, l_run = (hi == 0) ? l_init : 0.f;
    f32x16 o0, o1;
#pragma unroll
    for (int i = 0; i < 16; ++i) { o0[i] = 0.f; o1[i] = 0.f; }
    const int qpos = qpos0w + r32; const int krow = kappa32(r32);
    __syncthreads();
    FA_LOAD(tile_lo); FA_STORE(0);
    __syncthreads();
    for (int t = tile_lo; t < tile_hi; ++t) {
        const int buf = (t - tile_lo) & 1;
        if (t + 1 < tile_hi) FA_LOAD(t + 1);
        const int kbase = 64 * t;
        const bool active = (kbase <= qpos0w + 31) && (window == 0 || kbase + 63 > qpos0w - window);
        if (active) {
            const LAS unsigned char* Kt = lds + buf * KBUF; const LAS unsigned char* Vt = lds + 2 * KBUF + buf * VBUF;
            f32x16 s0, s1;
#pragma unroll
            for (int i = 0; i < 16; ++i) { s0[i] = 0.f; s1[i] = 0.f; }
#pragma unroll
            for (int d0 = 0; d0 < DQK / 16; ++d0) {
                const bf16x8 k0 = *(const LAS bf16x8*)(Kt + krow * KP + d0 * 32 + hi * 16);
                const bf16x8 k1 = *(const LAS bf16x8*)(Kt + (32 + krow) * KP + d0 * 32 + hi * 16);
                s0 = __builtin_amdgcn_mfma_f32_32x32x16_bf16(k0, qf[d0], s0, 0, 0, 0);
                s1 = __builtin_amdgcn_mfma_f32_32x32x16_bf16(k1, qf[d0], s1, 0, 0, 0);
            }
            const bool need_mask = (kbase + 63 > qpos0w) || (window != 0 && kbase <= qpos0w + 31 - window);
            if (need_mask) {
#pragma unroll
                for (int i = 0; i < 16; ++i) { const int key = kbase + 16 * (i >> 3) + 8 * hi + (i & 7);
                    const bool ok0 = (key <= qpos) && (window == 0 || key > qpos - window), ok1 = (key + 32 <= qpos) && (window == 0 || key + 32 > qpos - window);
                    s0[i] = ok0 ? s0[i] : -INFINITY; s1[i] = ok1 ? s1[i] : -INFINITY; }
            }
            float mx = fmaxf(s0[0], s1[0]);
#pragma unroll
            for (int i = 1; i < 16; ++i) mx = fmaxf(mx, fmaxf(s0[i], s1[i]));
            mx = half_max(mx);
            const float m_new = fmaxf(m_run, mx); const float m_use = (m_new == -INFINITY) ? 0.f : m_new;
            const float alpha = fast_exp2(m_run - m_use);
            m_run = m_new;
            float rs = 0.f;
#pragma unroll
            for (int i = 0; i < 16; ++i) { s0[i] = fast_exp2(s0[i] - m_use); s1[i] = fast_exp2(s1[i] - m_use); rs += s0[i] + s1[i]; }
            l_run = l_run * alpha + rs;
#pragma unroll
            for (int i = 0; i < 16; ++i) { o0[i] *= alpha; o1[i] *= alpha; }
            u32x4 w0, w1, w2, w3;
            w0.x = cvt_pk_bf16(s0[0], s0[1]); w0.y = cvt_pk_bf16(s0[2], s0[3]); w0.z = cvt_pk_bf16(s0[4], s0[5]); w0.w = cvt_pk_bf16(s0[6], s0[7]);
            w1.x = cvt_pk_bf16(s0[8], s0[9]); w1.y = cvt_pk_bf16(s0[10], s0[11]); w1.z = cvt_pk_bf16(s0[12], s0[13]); w1.w = cvt_pk_bf16(s0[14], s0[15]);
            w2.x = cvt_pk_bf16(s1[0], s1[1]); w2.y = cvt_pk_bf16(s1[2], s1[3]); w2.z = cvt_pk_bf16(s1[4], s1[5]); w2.w = cvt_pk_bf16(s1[6], s1[7]);
            w3.x = cvt_pk_bf16(s1[8], s1[9]); w3.y = cvt_pk_bf16(s1[10], s1[11]); w3.z = cvt_pk_bf16(s1[12], s1[13]); w3.w = cvt_pk_bf16(s1[14], s1[15]);
            const bf16x8 pa0 = __builtin_bit_cast(bf16x8, w0), pa1 = __builtin_bit_cast(bf16x8, w1), pa2 = __builtin_bit_cast(bf16x8, w2), pa3 = __builtin_bit_cast(bf16x8, w3);
#define FA_PV(o, dt) do { const LAS unsigned char* vrow_ = Vt + (32 * (dt) + r32) * VP + hi * 16; \
                o = __builtin_amdgcn_mfma_f32_32x32x16_bf16(*(const LAS bf16x8*)(vrow_), pa0, o, 0, 0, 0); o = __builtin_amdgcn_mfma_f32_32x32x16_bf16(*(const LAS bf16x8*)(vrow_ + 32), pa1, o, 0, 0, 0); \
                o = __builtin_amdgcn_mfma_f32_32x32x16_bf16(*(const LAS bf16x8*)(vrow_ + 64), pa2, o, 0, 0, 0); o = __builtin_amdgcn_mfma_f32_32x32x16_bf16(*(const LAS bf16x8*)(vrow_ + 96), pa3, o, 0, 0, 0); } while (0)
            FA_PV(o0, 0); FA_PV(o1, 1);
#undef FA_PV
        }
        if (t + 1 < tile_hi) FA_STORE(buf ^ 1);
        __syncthreads();
    }
#undef FA_LOAD
#undef FA_STORE
    const float l_tot = half_sum(l_run); const float inv = 1.0f / l_tot;
    bf16_t* orow = Ow + (size_t)r32 * opitch + 4 * hi;
#pragma unroll
    for (int g = 0; g < 4; ++g) {
        u32x2 a; a.x = cvt_pk_bf16(o0[4 * g] * inv, o0[4 * g + 1] * inv); a.y = cvt_pk_bf16(o0[4 * g + 2] * inv, o0[4 * g + 3] * inv); *(u32x2*)(orow + 8 * g) = a;
        u32x2 b; b.x = cvt_pk_bf16(o1[4 * g] * inv, o1[4 * g + 1] * inv); b.y = cvt_pk_bf16(o1[4 * g + 2] * inv, o1[4 * g + 3] * inv); *(u32x2*)(orow + 32 + 8 * g) = b;
    }
}

struct IdxArgs { const bf16_t* IQ; const bf16_t* IK; const float* IW; unsigned short* SEL; int* SELN; };
__device__ __forceinline__ unsigned mono_key(float f) { const unsigned u = __float_as_uint(f); return u ^ ((unsigned)((int)u >> 31) | 0x80000000u); }
__device__ __forceinline__ int crow32(int i, int hi) { return (i & 3) + 8 * (i >> 2) + 4 * hi; }

#ifndef MK_SC2
#define MK_SC2 0
#endif
constexpr int IDX_QP = 656;
__device__ __forceinline__ void idx_scores(f32x16& sc, const LAS unsigned char* qrow  , const float (&c)[8], const bf16x8 ka0, const bf16x8 ka1) {
    f32x16 z[8], zero;
#pragma unroll
    for (int i = 0; i < 16; ++i) zero[i] = 0.f;
#define IDX_F(slot, ks) (*(const LAS bf16x8*)(qrow + (slot) * 64 + (ks) * 32))
    bf16x8 f0 = IDX_F(8, 0), f1 = IDX_F(0, 0);
    sc = __builtin_amdgcn_mfma_f32_32x32x16_bf16(ka0, f0, zero, 0, 0, 0); f0 = IDX_F(1, 0);
#pragma unroll
    for (int h = 0; h < 8; h += 2) {
        z[h] = __builtin_amdgcn_mfma_f32_32x32x16_bf16(ka0, f1, zero, 0, 0, 0); f1 = (h + 2 < 8) ? IDX_F(h + 2, 0) : IDX_F(9, 0);
        z[h + 1] = __builtin_amdgcn_mfma_f32_32x32x16_bf16(ka0, f0, zero, 0, 0, 0); f0 = (h + 3 < 8) ? IDX_F(h + 3, 0) : IDX_F(8, 1);
    }
    sc = __builtin_amdgcn_mfma_f32_32x32x16_bf16(ka0, f1, sc, 0, 0, 0); f1 = IDX_F(0, 1);
    sc = __builtin_amdgcn_mfma_f32_32x32x16_bf16(ka1, f0, sc, 0, 0, 0); f0 = IDX_F(1, 1);
#pragma unroll
    for (int h = 0; h < 8; h += 2) {
        z[h] = __builtin_amdgcn_mfma_f32_32x32x16_bf16(ka1, f1, z[h], 0, 0, 0); f1 = (h + 2 < 8) ? IDX_F(h + 2, 1) : IDX_F(9, 1);
        z[h + 1] = __builtin_amdgcn_mfma_f32_32x32x16_bf16(ka1, f0, z[h + 1], 0, 0, 0); if (h + 3 < 8) f0 = IDX_F(h + 3, 1);
    }
    sc = __builtin_amdgcn_mfma_f32_32x32x16_bf16(ka1, f1, sc, 0, 0, 0);
#undef IDX_F
#pragma unroll
    for (int h = 0; h < 8; ++h)
#pragma unroll
        for (int i = 0; i < 16; ++i) sc[i] = __builtin_fmaf(__builtin_fabsf(z[h][i]), c[h], sc[i]);
}
#define IDX_LOADK(k0, k1, tile_) do { const bf16_t* ikt_ = ikb + (size_t)(tile_) * 32 * 32; k0 = *(const bf16x8*)(ikt_ + r32 * 32 + hi * 8); k1 = *(const bf16x8*)(ikt_ + r32 * 32 + 16 + hi * 8); } while (0)
template <int WPL>
__device__ __forceinline__ bool hist_scan(const LAS unsigned* hw, int lane, unsigned need, int& bin, unsigned& above, unsigned& nb) {
    asm volatile("" : "+v"(lane));
    unsigned w[WPL]; unsigned tot = 0;
#pragma unroll
    for (int i = 0; i < WPL; i += 4) { const u32x4 v = *(const LAS u32x4*)(hw + WPL * lane + i); w[i] = v.x; w[i + 1] = v.y; w[i + 2] = v.z; w[i + 3] = v.w; }
#pragma unroll
    for (int i = 0; i < WPL; ++i) tot += (w[i] & 0xffffu) + (w[i] >> 16);
    unsigned suf = tot;
#pragma unroll
    for (int d = 1; d < 64; d <<= 1) { const unsigned t = (unsigned)lane_get((int)suf, (lane + d) & 63); if (lane + d < 64) suf += t; }
    const unsigned total = (unsigned)lane_bcast((int)suf, 0);
    if (total < need) { above = total; return false; }
    const unsigned ab = suf - tot;
    const bool mine = (ab < need) && (need <= suf);
    int b_ = 0; unsigned a_ = 0, n_ = 0;
    if (mine) { unsigned acc = ab; bool done = false;
#pragma unroll
        for (int i = WPL - 1; i >= 0; --i) {
            const unsigned chi = w[i] >> 16, clo = w[i] & 0xffffu;
            if (!done && acc + chi >= need) { done = true; b_ = 2 * (WPL * lane + i) + 1; a_ = acc; n_ = chi; } if (!done) acc += chi;
            if (!done && acc + clo >= need) { done = true; b_ = 2 * (WPL * lane + i); a_ = acc; n_ = clo; } if (!done) acc += clo; } }
    const unsigned long long bal = __ballot(mine); const int src = __ffsll((long long)bal) - 1;
    bin = lane_bcast(b_, src); above = (unsigned)lane_bcast((int)a_, src); nb = (unsigned)lane_bcast((int)n_, src);
    return true;
}
template <int P>
__device__ __forceinline__ void idx_hist_tiles(LAS unsigned* hrow, const LAS unsigned char* qrow, const float (&w)[8], const bf16_t* ikb, int wid, int ntile, int qpos, int r32, int hi, bool mine, unsigned pfx) {
    bf16x8 kb[4][2];
#pragma unroll
    for (int u = 0; u < 4; ++u) if (wid + 8 * u < ntile) IDX_LOADK(kb[u][0], kb[u][1], wid + 8 * u);
#pragma unroll 1
    for (int base = wid; base < ntile; base += 32) {
#pragma unroll
        for (int u = 0; u < 4; ++u) { const int tile = base + 8 * u; if (tile < ntile) {
            const bf16x8 ka0 = kb[u][0], ka1 = kb[u][1];
            f32x16 sc; idx_scores(sc, qrow, w, ka0, ka1);
            if (tile + 32 < ntile) IDX_LOADK(kb[u][0], kb[u][1], tile + 32);
            const int lim = (tile == ntile - 1) ? qpos - 32 * tile : 64;
#pragma unroll
            for (int i = 0; i < 16; ++i) {
                bool ok = mine && (crow32(i, hi) <= lim); unsigned bin;
                if (P == 0) { bin = mono_key(sc[i]) >> 21; }
                else { const unsigned k = mono_key(sc[i]);
                    if (P == 1) { ok = false; bin = 0u; }
                    else if (P == 2) { ok = ok && ((k >> 21) == pfx); bin = (k >> 10) & 2047u; }
                    else { ok = ok && ((k >> 10) == pfx); bin = k & 1023u; } }
                if (ok) lds_add(hrow + (bin >> 1), 1u << (16 * (bin & 1u))); }
            __builtin_amdgcn_sched_barrier(0);
        } }
    }
}
__device__ __forceinline__ void idx_unit(LAS unsigned char* lds, int wave_, const IdxArgs& a, int rowb  , int qb32) {
    int tid = wave_ * 64 + lane_id(); asm volatile("" : "+v"(tid));
    const int lane = tid & 63, wid = wave_, r32 = lane & 31, hi = lane >> 5;
    const int q0 = 32 * qb32, ntile = qb32 + 1, qpos = q0 + r32;
    LAS unsigned* hist = (LAS unsigned*)(lds + IDX_HIST);
    LAS unsigned* bitmap = (LAS unsigned*)(lds + IDX_BITMAP);
    LAS unsigned* candk = (LAS unsigned*)(lds + IDX_CANDK);
    LAS unsigned short* candi = (LAS unsigned short*)(lds + IDX_CANDI);
    LAS unsigned* subh = (LAS unsigned*)(lds + IDX_SUBH) + wid * 512;
    LAS unsigned* qpar = (LAS unsigned*)(lds + IDX_QPAR);
    LAS unsigned* ccnt = (LAS unsigned*)(lds + IDX_CCNT);
    LAS unsigned* flag = (LAS unsigned*)(lds + IDX_FLAG);
    if (q0 + 32 <= 256) {
        __syncthreads();
        for (int q = wid; q < 32; q += NWAVES) { const int t = q0 + q; unsigned short* sp = a.SEL + (size_t)(rowb + t) * 256;
#pragma unroll
            for (int j = 0; j < 4; ++j) { const int k = lane + 64 * j; sp[k] = (unsigned short)(k <= t ? k : 0); }
            if (lane == 0) a.SELN[rowb + t] = t + 1; }
        return;
    }
    float w[8];
#pragma unroll
    for (int h = 0; h < 8; ++h) w[h] = 0.5f * a.IW[(size_t)(rowb + qpos) * 8 + h];
    const LAS unsigned char* qrow = lds + IDX_QT + r32 * IDX_QP + hi * 16;
    const bf16_t* ikb = a.IK + (size_t)rowb * 32;
    __syncthreads();
#pragma unroll
    for (int i = 0; i < 2; ++i) { const int c = tid + 512 * i, row = c >> 5, c16 = c & 31;
        *(LAS u32x4*)(lds + IDX_QT + row * IDX_QP + c16 * 16) = *(const u32x4*)(a.IQ + (size_t)(rowb + q0 + row) * 256 + c16 * 8); }
    __syncthreads();
    { const int q = tid >> 4, d2 = (tid & 15) * 2; const float* wq = a.IW + (size_t)(rowb + q0 + q) * 8; float s0 = 0.f, s1 = 0.f;
#pragma unroll
      for (int h = 0; h < 8; ++h) { const unsigned pr = *(const LAS unsigned*)(lds + IDX_QT + q * IDX_QP + h * 64 + d2 * 2); const float wh = 0.5f * wq[h]; s0 += wh * bflo(pr); s1 += wh * bfhi(pr); }
      const unsigned h0 = f2bf(s0), h1 = f2bf(s1); const float r0 = s0 - bf2f((bf16_t)h0), r1 = s1 - bf2f((bf16_t)h1);
      *(LAS unsigned*)(lds + IDX_QT + q * IDX_QP + 8 * 64 + d2 * 2) = h0 | (h1 << 16);
      *(LAS unsigned*)(lds + IDX_QT + q * IDX_QP + 9 * 64 + d2 * 2) = pk2(r0, r1); }
    if (tid < 256) { const int q = tid >> 3, f = tid & 7; const bool all = (q0 + q + 1 <= 256); qpar[tid] = (f == 0) ? (all ? 2u : 0u) : ((f == 2) ? 256u : 0u); }
    if (tid < 32) ccnt[tid] = 0u;
    if (tid < 8) flag[tid] = (tid == 0) ? 1u : 0u;
#pragma unroll 1
    for (int p = 0; p < 4; ++p) {
        __syncthreads();
        if (flag[p] == 0u) continue;
        for (int i = tid; i < 32 * IDX_HP / 4; i += NWAVES * 64) ((LAS u32x4*)hist)[i] = (u32x4){0u, 0u, 0u, 0u};
        __syncthreads();
        const bool mine = (qpar[8 * r32] == 0u) && (qpar[8 * r32 + 4] == (unsigned)p); const unsigned pfx = qpar[8 * r32 + 1];
        TB(1);
        if (__any(mine)) {
            LAS unsigned* hrow = hist + r32 * IDX_HP;
            if (p == 0) idx_hist_tiles<0>(hrow, qrow, w, ikb, wid, ntile, qpos, r32, hi, mine, pfx);
            else if (p == 1) idx_hist_tiles<1>(hrow, qrow, w, ikb, wid, ntile, qpos, r32, hi, mine, pfx);
            else if (p == 2) idx_hist_tiles<2>(hrow, qrow, w, ikb, wid, ntile, qpos, r32, hi, mine, pfx);
            else idx_hist_tiles<3>(hrow, qrow, w, ikb, wid, ntile, qpos, r32, hi, mine, pfx);
        }
        TE(1);
        __syncthreads();
        TB(2);
        for (int j = 0; j < 4; ++j) { const int q = 4 * wid + j; const unsigned qs = qpar[8 * q], need = qpar[8 * q + 2], qp = qpar[8 * q + 1];
            if (qs != 0u || qpar[8 * q + 4] != (unsigned)p) continue;
            int bin; unsigned above, nb; const bool found = hist_scan<16>(hist + q * IDX_HP, lane, need, bin, above, nb);
            if (lane == 0) {
                if (!found) { if (false) { }
                              else { qpar[8 * q] = 2u; qpar[8 * q + 2] = 0u; } }
                else { const unsigned np = (p == 0) ? (unsigned)bin : (p == 2 ? ((qp << 11) | (unsigned)bin) : ((qp << 10) | (unsigned)bin));
                    qpar[8 * q + 1] = np; qpar[8 * q + 2] = need - above; qpar[8 * q + 3] = (p <= 1) ? 21u : (p == 2 ? 10u : 0u);
                    const unsigned shn = (p <= 1) ? 21u : (p == 2 ? 10u : 0u); const unsigned klo = np << shn; const unsigned long long khi = ((unsigned long long)np + 1ull) << shn;
                    qpar[8 * q + 5] = (klo & 0x80000000u) ? (klo ^ 0x80000000u) : ~klo;
                    qpar[8 * q + 6] = (khi >> 32) ? 0x7f800000u : (((unsigned)khi & 0x80000000u) ? ((unsigned)khi ^ 0x80000000u) : ~(unsigned)khi);
                    if (nb <= (unsigned)IDX_CCAP || p == 3) qpar[8 * q] = 1u; else { const unsigned nx = (p <= 1) ? 2u : 3u; qpar[8 * q + 4] = nx; flag[nx] = 1u; } } }
        }
        TE(2);
    }
    __syncthreads();
    for (int i = tid; i < 32 * 256 / 4; i += NWAVES * 64) ((LAS u32x4*)bitmap)[i] = (u32x4){0u, 0u, 0u, 0u};
    __syncthreads();
    TB(3);
    { const unsigned st = qpar[8 * r32]; const float tcand = (st == 2u) ? -INFINITY : __uint_as_float(qpar[8 * r32 + 5]), tsel = (st == 2u) ? -INFINITY : __uint_as_float(qpar[8 * r32 + 6]);
      bf16x8 kb[4][2];
#pragma unroll
      for (int u = 0; u < 4; ++u) if (wid + 8 * u < ntile) IDX_LOADK(kb[u][0], kb[u][1], wid + 8 * u);
#pragma unroll 1
      for (int base = wid; base < ntile; base += 32) {
#pragma unroll
          for (int u = 0; u < 4; ++u) { const int tile = base + 8 * u; if (tile < ntile) {
              const bf16x8 ka0 = kb[u][0], ka1 = kb[u][1];
              f32x16 sc; idx_scores(sc, qrow, w, ka0, ka1);
#if MK_SC2
              asm volatile("" : "+v"(sc)); { bf16x8 kx0 = ka0, kx1 = ka1; asm volatile("" : "+v"(kx0), "+v"(kx1)); idx_scores(sc, qrow, w, kx0, kx1); asm volatile("" : "+v"(sc)); }
#endif
              if (tile + 32 < ntile) IDX_LOADK(kb[u][0], kb[u][1], tile + 32);
              const int lim = (tile == ntile - 1) ? qpos - 32 * tile : 64;
#pragma unroll
              for (int i = 0; i < 16; ++i) {
                  if (sc[i] >= tcand && crow32(i, hi) <= lim) { const int key = 32 * tile + crow32(i, hi);
                      if (sc[i] >= tsel) lds_or(bitmap + r32 * 256 + (key >> 5), 1u << (key & 31));
                      else { const unsigned pos = lds_add(ccnt + r32, 1u); if (pos < (unsigned)IDX_CCAP) { candk[r32 * IDX_CCAP + pos] = mono_key(sc[i]); candi[r32 * IDX_CCAP + pos] = (unsigned short)key; } } } }
              __builtin_amdgcn_sched_barrier(0);
          } }
      } }
    TE(3);
    __syncthreads();
    TB(4);
    for (int j = 0; j < 4; ++j) {
        const int q = 4 * wid + j; const unsigned st = qpar[8 * q]; unsigned need = qpar[8 * q + 2]; const unsigned sh = qpar[8 * q + 3];
        const int nc = (st == 1u) ? (int)min(ccnt[q], (unsigned)IDX_CCAP) : 0;
        LAS unsigned* bm = bitmap + q * 256; const LAS unsigned* ck = candk + q * IDX_CCAP; const LAS unsigned short* ci = candi + q * IDX_CCAP;
        if (nc > 0) {
            if ((unsigned)nc <= need) { for (int c = lane; c < nc; c += 64) { const unsigned key = ci[c]; lds_or(bm + (key >> 5), 1u << (key & 31)); } }
            else {
                int nR = 0; LAS unsigned long long* R = (LAS unsigned long long*)subh;
                if (sh > 0u) {
                    const int nbit = sh >= 10u ? 10 : (int)sh, fs = (int)sh - nbit; const unsigned smask = (1u << nbit) - 1u;
#pragma unroll
                    for (int i = 0; i < 8; ++i) subh[8 * lane + i] = 0u;
                    LDS_WAIT();
                    for (int c = lane; c < nc; c += 64) { const unsigned sub = (ck[c] >> fs) & smask; lds_add(subh + (sub >> 1), 1u << (16 * (sub & 1u))); }
                    LDS_WAIT();
                    int b2; unsigned ab2, nb2; (void)hist_scan<8>(subh, lane, need, b2, ab2, nb2);
                    need -= ab2; LDS_WAIT();
                    for (int c0 = 0; c0 < nc; c0 += 64) { const int c = c0 + lane; bool inb = false; unsigned k = 0, key = 0;
                        if (c < nc) { k = ck[c]; key = ci[c]; const int sub = (int)((k >> fs) & smask); if (sub > b2) lds_or(bm + (key >> 5), 1u << (key & 31)); inb = (sub == b2); }
                        const unsigned long long bal = __ballot(inb); const int pos = nR + __popcll(bal & ((1ull << lane) - 1ull));
                        if (inb && pos < IDX_RCAP) R[pos] = ((unsigned long long)k << 13) | (unsigned long long)(8191u - key);
                        nR += __popcll(bal); }
                } else {
                    for (int c0 = 0; c0 < nc; c0 += 64) { const int c = c0 + lane; if (c < nc && c < IDX_RCAP) R[c] = ((unsigned long long)ck[c] << 13) | (unsigned long long)(8191u - ci[c]); }
                    nR = nc;
                }
                nR = min(nR, IDX_RCAP); LDS_WAIT();
                for (int r = lane; r < nR; r += 64) { const unsigned long long me = R[r]; unsigned better = 0;
                    for (int x = 0; x < nR; ++x) better += (R[x] > me) ? 1u : 0u;
                    if (better < need) { const unsigned key = 8191u - (unsigned)(me & 8191ull); lds_or(bm + (key >> 5), 1u << (key & 31)); } }
            }
        }
        LDS_WAIT();
        { const u32x4 bw = *(const LAS u32x4*)(bm + 4 * lane); unsigned wv[4] = {bw.x, bw.y, bw.z, bw.w};
          const int mycnt = __popc(wv[0]) + __popc(wv[1]) + __popc(wv[2]) + __popc(wv[3]);
          int pre = mycnt;
#pragma unroll
          for (int d = 1; d < 64; d <<= 1) { const int t = lane_get(pre, (lane - d) & 63); if (lane >= d) pre += t; }
          const int total = lane_bcast(pre, 63); int pos = pre - mycnt;
          unsigned short* sp = a.SEL + (size_t)(rowb + q0 + q) * 256;
#pragma unroll
          for (int wi = 0; wi < 4; ++wi) { unsigned m = wv[wi]; while (m) { const int b = __ffs((int)m) - 1; m &= m - 1u; if (pos < 256) sp[pos] = (unsigned short)(32 * (4 * lane + wi) + b); ++pos; } }
          if (lane == 0) a.SELN[rowb + q0 + q] = min(total, 256); }
        LDS_WAIT();
    }
    TE(4);
}

#undef IDX_LOADK
struct SpaArgs { const bf16_t* QA; const bf16_t* KA; const bf16_t* VA; const unsigned short* SEL; const int* SELN; bf16_t* Y; };
struct SpaPre { int nv[2]; u32x2 s4[2]; };
__device__ __forceinline__ void sparse_prefetch(SpaPre& P, const SpaArgs& a, int rowA, int rowB, int lane) {
    const int row[2] = {rowA, rowB};
#pragma unroll
    for (int q = 0; q < 2; ++q) { P.nv[q] = a.SELN[row[q]]; P.s4[q] = *(const u32x2*)(a.SEL + (size_t)row[q] * 256 + 4 * lane); }
}
__device__ __forceinline__ void sparse_pair(LAS unsigned char* wl, const SpaArgs& a, const SpaPre& P, int rowbA, int tA, int rowbB, int tB, int lane) {
    const int rowb[2] = {rowbA, rowbB}; const int row[2] = {rowbA + tA, rowbB + tB};
    LAS float* lg[2]; LAS unsigned short* sl[2]; int nv[2];
#pragma unroll
    for (int q = 0; q < 2; ++q) { lg[q] = (LAS float*)(wl + q * 8192); sl[q] = (LAS unsigned short*)(wl + q * 8192 + 4096); nv[q] = P.nv[q]; *(LAS u32x2*)(sl[q] + 4 * lane) = P.s4[q]; }
    LDS_WAIT();
    const int m16 = lane & 15, kq = lane >> 4;
    bf16x8 qf0[2], qf1[2];
#pragma unroll
    for (int q = 0; q < 2; ++q) { qf0[q] = (bf16x8){0, 0, 0, 0, 0, 0, 0, 0}; qf1[q] = qf0[q];
        if (m16 < 4) { const bf16_t* qp = a.QA + (size_t)row[q] * 256 + m16 * 64 + kq * 8; qf0[q] = *(const bf16x8*)qp; qf1[q] = *(const bf16x8*)(qp + 32); } }
#pragma unroll
    for (int tile = 0; tile < 16; ++tile)
#pragma unroll
        for (int q = 0; q < 2; ++q) {
            const int j = 16 * tile + m16; const int s = (j < nv[q]) ? (int)sl[q][j] : 0;
            const bf16_t* kp = a.KA + (size_t)(rowb[q] + s) * 64 + kq * 8;
            const bf16x8 k0 = *(const bf16x8*)kp, k1 = *(const bf16x8*)(kp + 32);
            f32x4 acc = (f32x4){0.f, 0.f, 0.f, 0.f};
            acc = __builtin_amdgcn_mfma_f32_16x16x32_bf16(qf0[q], k0, acc, 0, 0, 0);
            acc = __builtin_amdgcn_mfma_f32_16x16x32_bf16(qf1[q], k1, acc, 0, 0, 0);
            if (kq == 0) { const bool ok = j < nv[q]; f32x4 v; v.x = ok ? acc.x : -INFINITY; v.y = ok ? acc.y : -INFINITY; v.z = ok ? acc.z : -INFINITY; v.w = ok ? acc.w : -INFINITY; *(LAS f32x4*)(lg[q] + 4 * j) = v; }
        }
    LDS_WAIT();
    const int h = lane >> 4; float sm[2];
#pragma unroll
    for (int q = 0; q < 2; ++q) { float pv[16]; float mx = -INFINITY;
#pragma unroll
        for (int i = 0; i < 16; ++i) { pv[i] = lg[q][4 * (m16 + 16 * i) + h]; mx = fmaxf(mx, pv[i]); }
        mx = max16(mx);
        float s_ = 0.f;
#pragma unroll
        for (int i = 0; i < 16; ++i) { pv[i] = fast_exp2(pv[i] - mx); s_ += pv[i]; }
        sm[q] = sum16(s_);
#pragma unroll
        for (int i = 0; i < 16; ++i) lg[q][4 * (m16 + 16 * i) + h] = pv[i]; }
    LDS_WAIT();
    const int g = lane >> 3, c8 = lane & 7;
    float acc[2][4][8];
#pragma unroll
    for (int q = 0; q < 2; ++q)
#pragma unroll
        for (int h4 = 0; h4 < 4; ++h4)
#pragma unroll
            for (int c = 0; c < 8; ++c) acc[q][h4][c] = 0.f;
    const int nvm = nv[0] > nv[1] ? nv[0] : nv[1]; const int nit = (nvm + 7) >> 3;
#pragma unroll 8
    for (int it = 0; it < nit; ++it)
#pragma unroll
        for (int q = 0; q < 2; ++q) {
            const int j = 8 * it + g; const int srow = (j < nv[q]) ? (int)sl[q][j] : 0;
            const u32x4 v = *(const u32x4*)(a.VA + (size_t)(rowb[q] + srow) * 64 + c8 * 8);
            const f32x4 p = *(const LAS f32x4*)(lg[q] + 4 * j);
            const float vv[8] = {bflo(v.x), bfhi(v.x), bflo(v.y), bfhi(v.y), bflo(v.z), bfhi(v.z), bflo(v.w), bfhi(v.w)};
#pragma unroll
            for (int c = 0; c < 8; ++c) { acc[q][0][c] += p.x * vv[c]; acc[q][1][c] += p.y * vv[c]; acc[q][2][c] += p.z * vv[c]; acc[q][3][c] += p.w * vv[c]; }
        }
    LDS_WAIT();
#pragma unroll
    for (int q = 0; q < 2; ++q) {
        const float l0 = __int_as_float(lane_bcast(__float_as_int(sm[q]), 0)), l1 = __int_as_float(lane_bcast(__float_as_int(sm[q]), 16)), l2 = __int_as_float(lane_bcast(__float_as_int(sm[q]), 32)), l3 = __int_as_float(lane_bcast(__float_as_int(sm[q]), 48));
        LAS float* red = (LAS float*)(wl + q * 8192);
#pragma unroll
        for (int h4 = 0; h4 < 4; ++h4) { *(LAS f32x4*)(red + g * 256 + h4 * 64 + c8 * 8) = (f32x4){acc[q][h4][0], acc[q][h4][1], acc[q][h4][2], acc[q][h4][3]}; *(LAS f32x4*)(red + g * 256 + h4 * 64 + c8 * 8 + 4) = (f32x4){acc[q][h4][4], acc[q][h4][5], acc[q][h4][6], acc[q][h4][7]}; }
        LDS_WAIT();
        f32x4 o = (f32x4){0.f, 0.f, 0.f, 0.f};
#pragma unroll
        for (int gg = 0; gg < 8; ++gg) o += *(const LAS f32x4*)(red + gg * 256 + 4 * lane);
        const int ho = lane >> 4; const float li = 1.0f / (ho == 0 ? l0 : (ho == 1 ? l1 : (ho == 2 ? l2 : l3)));
        u32x2 w; w.x = pk2(o.x * li, o.y * li); w.y = pk2(o.z * li, o.w * li);
        if (q == 0 || row[1] != row[0]) *(u32x2*)(a.Y + (size_t)row[q] * DM + 4 * lane) = w; }
    LDS_WAIT();
}

#ifndef MK_CHECK
#define MK_CHECK 0
#endif
#ifndef MK_CHECK_L
#define MK_CHECK_L 0
#define MK_CHECK_CH 0
#endif
#ifndef MK_PER_PHASE
#define MK_PER_PHASE 0
#endif

__device__ __forceinline__ int q_next(unsigned* head, volatile LAS unsigned* bc, int wave_) {
    __syncthreads();
    if (wave_ == 0 && lane_id() == 0) bc[0] = __hip_atomic_fetch_add(head, 1u, __ATOMIC_RELAXED, __HIP_MEMORY_SCOPE_AGENT);
    __syncthreads();
    return (int)bc[0];
}

constexpr int N_PHASES_C = 1 + NCHUNK * (9 + 3) + NCHUNK * (9 + 5);
typedef __attribute__((address_space(4))) const unsigned char* kptr_t;
#define PHASE_ENV() kptr_t kp_ = (kptr_t)__builtin_amdgcn_kernarg_segment_ptr(); asm volatile("; MKPHASE %1" : "+s"(kp_) : "n"(__LINE__)); \
    unsigned char* const ws = *(unsigned char* const __attribute__((address_space(4)))*)(kp_ + 240); float* const out = *(float* const __attribute__((address_space(4)))*)(kp_ + 232); \
    unsigned char* const act = ws + WS_ACT; bf16_t* const HB = (bf16_t*)(ws + WS_HB); unsigned* const ctl = (unsigned*)(ws + WS_CTL); \
    const size_t row0 = (size_t)ch * TCH; const unsigned char* const lw = ws + WS_LAYERW + (size_t)l * SZ_LAYERW; \
    int gwl = gw, ngwl = ngw; asm volatile("" : "+s"(gwl), "+s"(ngwl)); \
    (void)out; (void)act; (void)HB; (void)ctl; (void)row0; (void)lw; (void)gwl; (void)ngwl
#define INP(k) (*(const void* const __attribute__((address_space(4)))*)(kp_ + 8 * (k)))
#define FIN(k) ((const float*)INP(k))
#define ROPE_TAB(RT) RopeTab RT; RT.c64 = (const float*)(ws + WS_ROPE); RT.s64 = RT.c64 + (size_t)NPOS * 32; RT.c32 = RT.s64 + (size_t)NPOS * 32; RT.s32 = RT.c32 + (size_t)NPOS * 16
#define ABUF(T, off) ((T*)(act + (off)))

#ifndef MK_NV
#define MK_NV 256
#endif
#ifndef MK_LB
#define MK_LB 2
#endif
__global__ void __launch_bounds__(NWAVES * 64, MK_LB) mk_fwd(Args args) {
    extern __shared__ __attribute__((aligned(16))) unsigned char lds_raw[];
    LAS unsigned char* lds = (LAS unsigned char*)lds_raw;
    volatile LAS unsigned* MISC = (volatile LAS unsigned*)(lds + MISC_OFF);
    const int wave = __builtin_amdgcn_readfirstlane((int)threadIdx.x >> 6);
#define tid (wave * 64 + lane_id())
    const int G = gridDim.x; const int bx = blockIdx.x; const int vcu = (G % 8 == 0) ? (bx % 8) * (G / 8) + bx / 8 : bx;
    const int gw = vcu * NWAVES + wave, ngw = G * NWAVES;
    for (int u = tid; u < 64; u += NWAVES * 64) MISC[u] = 0u;
    __syncthreads();
    XcdBarrier bar; bar.bar = (unsigned*)(args.ws + WS_CTL) + CW_BAR + args.pad0 * XCD_BAR_WORDS; bar.x = 0; bar.st = nullptr;
    if (!MK_PER_PHASE) bar = xcd_barrier_post((unsigned*)(args.ws + WS_CTL) + CW_BAR + args.pad0 * XCD_BAR_WORDS, MISC + 8, wave);
    int pid = 0;
#ifndef MK_ATT
#define MK_ATT 7
#endif
#ifndef MK_EN
#define MK_EN 0xffffffffu
#endif
#define EN(k) (((MK_EN) >> (k)) & 1u)
#ifndef MK_ATT_REP
#define MK_ATT_REP 7
#endif
#ifndef MK_SPA_REP
#define MK_SPA_REP 1
#endif
#ifndef MK_REP
#define MK_REP 0u
#endif
#define REPS(k) (1 + (((MK_REP) >> (k)) & 1u))
#define RUN() (args.ph_lo <= pid && pid < args.ph_hi)
#define SEAM() do { if (args.ph_lo <= pid && pid + 1 < args.ph_hi) { TB(5); xcd_barrier(bar, wave); TE(5); } ++pid; } while (0)

    if (EN(0) && RUN()) for (int rep_ = 0; rep_ < (int)REPS(0); ++rep_) {
        const int l = 0, ch = 0; PHASE_ENV();
        int lane = tid & 63; asm volatile("" : "+v"(lane)); int tid0 = tid; asm volatile("" : "+v"(tid0));
        LAS float* scr = (LAS float*)(lds + wave * 16384);
        constexpr int IT_WIN = (DM / 64) * ((DIN + 31) / 32), IT_WUQ = (256 / 64) * (384 / 32), IT_WUKV = (128 / 64) * (512 / 32), IT_WAO = (256 / 64) * (DM / 32), IT_WCO = (512 / 64) * (DM / 32), IT_WO = (DM / 128) * (DM / 32);
        constexpr int IT_WG8 = (DM / 128) * (GW / 32);
        constexpr int IT_LAYER = IT_WIN + IT_WG8 + IT_WUQ + IT_WUKV + 2 * IT_WAO + IT_WCO + IT_WO;
        constexpr int IT_F1 = (DM / 128) * (DFF / 32), IT_F2 = (DFF / 128) * (DM / 32), IT_E1 = (DM / 128) * (EFF / 32), IT_E2 = (EFF / 128) * (DM / 32);
        constexpr int IT_FFN = 2 * IT_F1 + IT_F2, IT_EXP = 2 * IT_E1 + IT_E2;
        constexpr int NITEMS = 2 * IT_LAYER + IT_FFN + NEXP * IT_EXP;
        for (int it = gwl; it < NITEMS; it += ngwl) {
            int r = it;
            if (r < 2 * IT_LAYER) {
                const int ll = r / IT_LAYER; r -= ll * IT_LAYER; unsigned char* lwp = ws + WS_LAYERW + (size_t)ll * SZ_LAYERW;
                if (r < IT_WIN) { transpose_item<1>(FIN(I_WIN) + (size_t)ll * DM * DIN, DM, DIN, (bf16_t*)(lwp + OFF_WIN), DM, scr, r, lane); continue; } r -= IT_WIN;
                if (r < IT_WG8) { transpose_item_f8<0>(FIN(I_WIN) + (size_t)ll * DM * DIN + C_G, DM, GW, lwp + OFF_WIN8, DM, S_WG, scr, r, lane, DIN); continue; } r -= IT_WG8;
                if (r < IT_WUQ) { transpose_item<0>(FIN(I_WUQ) + (size_t)ll * 256 * 384, 256, 384, (bf16_t*)(lwp + OFF_WUQ), 256, scr, r, lane); continue; } r -= IT_WUQ;
                if (r < IT_WUKV) { transpose_item<0>(FIN(I_WUKV) + (size_t)ll * 128 * 512, 128, 512, (bf16_t*)(lwp + OFF_WUKV), 256, scr, r, lane); continue; } r -= IT_WUKV;
                if (r < IT_WAO) { transpose_item<0>(FIN(I_WAO) + (size_t)ll * 256 * DM, 256, DM, (bf16_t*)(lwp + OFF_WAO), DM, scr, r, lane); continue; } r -= IT_WAO;
                if (r < IT_WAO) { transpose_item<0>(FIN(I_WBO) + (size_t)ll * 256 * DM, 256, DM, (bf16_t*)(lwp + OFF_WAO) + 256, DM, scr, r, lane); continue; } r -= IT_WAO;
                if (r < IT_WCO) { transpose_item<0>(FIN(I_WCO) + (size_t)ll * 512 * DM, 512, DM, (bf16_t*)(lwp + OFF_WAO) + 512, DM, scr, r, lane); continue; } r -= IT_WCO;
                transpose_item_f8<0>(FIN(I_WO) + (size_t)ll * DM * DM, DM, DM, lwp + OFF_WO8, DM, S_WO, scr, r, lane); continue;
            }
            r -= 2 * IT_LAYER;
            if (r < IT_FFN) {
                if (r < IT_F1) { transpose_item_f8<2>(FIN(I_FW1), DM, DFF, ws + WS_W13, DM, S_W13, scr, r, lane); continue; } r -= IT_F1;
                if (r < IT_F1) { transpose_item_f8<3>(FIN(I_FW3), DM, DFF, ws + WS_W13, DM, S_W13, scr, r, lane); continue; } r -= IT_F1;
                transpose_item_f8<0>(FIN(I_FW2), DFF, DM, ws + WS_W2, DFF, S_W2, scr, r, lane); continue;
            }
            r -= IT_FFN;
            { const int e = r / IT_EXP; r -= e * IT_EXP;
              if (r < IT_E1) { transpose_item_f8<2>(FIN(I_MW1) + (size_t)e * DM * EFF, DM, EFF, ws + WS_E13 + (size_t)e * SZ_E13, DM, S_W13, scr, r, lane); continue; } r -= IT_E1;
              if (r < IT_E1) { transpose_item_f8<3>(FIN(I_MW3) + (size_t)e * DM * EFF, DM, EFF, ws + WS_E13 + (size_t)e * SZ_E13, DM, S_W13, scr, r, lane); continue; } r -= IT_E1;
              transpose_item_f8<0>(FIN(I_MW2) + (size_t)e * EFF * DM, EFF, DM, ws + WS_E2 + (size_t)e * SZ_E2, EFF, S_W2, scr, r, lane); }
        }
        const int gt = vcu * NWAVES * 64 + tid0, ngt = G * NWAVES * 64;
        for (int ll = 0; ll < DEPTH; ++ll) { unsigned char* lwp = ws + WS_LAYERW + (size_t)ll * SZ_LAYERW;
            for (int i = gt; i < (P1W - C_G) * DM / 8; i += ngt) ((u32x4*)(lwp + OFF_WIN + (size_t)C_G * DM * 2))[i] = (u32x4){0u, 0u, 0u, 0u};
            for (int i = gt; i < 128 * 256 / 8; i += ngt) ((u32x4*)(lwp + OFF_WUQ + (size_t)384 * 256 * 2))[i] = (u32x4){0u, 0u, 0u, 0u};
            for (int i = gt; i < 512 * 128 / 8; i += ngt) { const int rr = i / 16, cc = i % 16; ((u32x4*)(lwp + OFF_WUKV + (size_t)rr * 512 + 256))[cc] = (u32x4){0u, 0u, 0u, 0u}; } }
        for (int i = gt; i < DM / 8; i += ngt) ((u32x4*)(HB + (size_t)TCH * DM))[i] = (u32x4){0u, 0u, 0u, 0u};
        float* c64 = (float*)(ws + WS_ROPE); float* s64 = c64 + (size_t)NPOS * 32; float* c32 = s64 + (size_t)NPOS * 32; float* s32 = c32 + (size_t)NPOS * 16;
        for (int i = gt; i < NPOS * 32; i += ngt) { const int pos = i >> 5, k = i & 31; const float inv = (float)pow(10000.0, -(double)k / 32.0); const float ang = (float)pos * inv; c64[i] = cosf(ang); s64[i] = sinf(ang); }
        for (int i = gt; i < NPOS * 16; i += ngt) { const int pos = i >> 4, k = i & 15; const float inv = (float)pow(10000.0, -(double)k / 16.0); const float ang = (float)pos * inv; c32[i] = cosf(ang); s32[i] = sinf(ang); }
    }
    SEAM();

#pragma unroll 1
    for (int l = 0; l < DEPTH; ++l) {
#pragma unroll 1
        for (int ch = 0; ch < NCHUNK; ++ch) {
            if (EN(1) && RUN()) for (int rep_ = 0; rep_ < (int)REPS(1); ++rep_) { if (rep_) { __syncthreads(); } PHASE_ENV(); TB(9); norm_rows((l == 0 ? FIN(I_X) : (const float*)out) + row0 * DM, FIN(I_ANG) + l * DM, HB, ws + WS_HF8, gwl, ngwl, tid & 63); TE(9); }
            SEAM();
            if (EN(2) && RUN()) { PHASE_ENV();
                { pg8::Gemm g{HB, DM, HB, 1 << 30, (const bf16_t*)(lw + OFF_WIN), DM, nullptr, 0, 1, 0, 0}; pg8::StaticOrder S; S.init(TCH / 256, P1W / 256, G, bx);
                  pg8::EpiInProj E{ABUF(bf16_t, A_P1), ABUF(unsigned char, A_G), 1.0f}; TB(20); pg8::gemm_phase<pg8::EpiInProj, pg8::StaticOrder>(lds + RING_OFF, wave, g, S, E); TE(20); }
                { pg8::Gemm g{(const bf16_t*)(ws + WS_HF8), DM / 2, (const bf16_t*)(ws + WS_HF8), 1 << 30, (const bf16_t*)(lw + OFF_WIN8 - (size_t)P1W * DM), DM / 2, nullptr, 0, 1, 0, 0};
                  pg8::GateOrder S; S.S.init(TCH / 256, GW / 256, G, bx);
                  pg8::EpiInProj E{ABUF(bf16_t, A_P1), ABUF(unsigned char, A_G), 1.0f / S_WG}; pg8::gemm_phase<pg8::EpiInProj, pg8::GateOrder, true>(lds + RING_OFF, wave, g, S, E); } }
            SEAM();
            if (EN(3) && RUN()) for (int rep_ = 0; rep_ < (int)REPS(3); ++rep_) { if (rep_) { __syncthreads(); } PHASE_ENV(); ROPE_TAB(RT); PP1Args a; a.P1 = ABUF(bf16_t, A_P1); a.pos = (const int*)INP(I_POS) + row0; a.aq_g = FIN(I_AQG) + l * 64; a.ak_g = FIN(I_AKG) + l * 64; a.cq_g = FIN(I_BCQG) + l * 256;
                a.ckv_g = FIN(I_BCKVG) + l * 128; a.kr_g = FIN(I_BKRG) + l * 32; a.qc_g = FIN(I_CQG) + l * 64; a.kc_g = FIN(I_CKG) + l * 64;
                a.act = act; a.R = RT;
                TB(7); pp1_rows(a, lds + wave * 8192, gwl, ngwl, tid & 63); TE(7); }
            SEAM();
            if (EN(4) && RUN()) for (int rep_ = 0; rep_ < (int)REPS(4); ++rep_) { if (rep_) { __syncthreads(); } PHASE_ENV(); pg8::StaticOrder S; S.init(TCH / 256, 4, G, bx);
                pg8::Gemm g{ABUF(bf16_t, A_CQN), 256, ABUF(bf16_t, A_CKVN), 2, (const bf16_t*)(lw + OFF_WUQ), 256, nullptr, 0, 1, 0, 0}; pg8::EpiBf16 E{ABUF(bf16_t, A_QBR), 1024}; TB(21); pg8::gemm_phase<pg8::EpiBf16, pg8::StaticOrder>(lds + RING_OFF, wave, g, S, E); TE(21); }
            SEAM();
            if (EN(5) && RUN()) for (int rep_ = 0; rep_ < (int)REPS(5); ++rep_) { if (rep_) { __syncthreads(); } PHASE_ENV(); ROPE_TAB(RT); PP2Args a; a.QBR = ABUF(bf16_t, A_QBR); a.KVBR = ABUF(bf16_t, A_QBR) + 512; a.KR = ABUF(bf16_t, A_KR); a.pos = (const int*)INP(I_POS) + row0;
                a.qn_g = FIN(I_BQNG) + l * 64; a.qr_g = FIN(I_BQRG) + l * 32; a.kn_g = FIN(I_BKNG) + l * 64;
                a.QB = ABUF(bf16_t, A_QB); a.KB = ABUF(bf16_t, A_KB); a.VBT = ABUF(bf16_t, A_VBT); a.R = RT; TB(8); pp2_rows(a, lds + wave * 8192, gwl, ngwl, tid & 63); TE(8); }
            SEAM();
            if (EN(6) && RUN()) for (int rep_ = 0; rep_ < (int)REPS(6); ++rep_) {
                PHASE_ENV();
                unsigned* head = ctl + CW_Q + 64 * (2 * (l * NCHUNK + ch) + rep_);
                bf16_t* const Y = ABUF(bf16_t, A_Y);
                TB(28);
                for (;;) {
                    TB(17); const int u = q_next(head, MISC + 16, wave); TE(17);
                    if (u >= 512 + 1024 + 1024) break;
                    if (u < 512) { if (!(MK_ATT & 1) || (rep_ && !(MK_ATT_REP & 1))) continue;
                        const int qb = 31 - u / 16, bl = (u % 16) / 4, h = u % 4; const int rowb = bl * SEQ; const int q0w = 256 * qb + 32 * wave;
                        fa_unit<96>(lds, wave, ABUF(bf16_t, A_QB) + (size_t)(rowb + q0w) * 384 + h * 96, 384, ABUF(bf16_t, A_KB) + (size_t)rowb * 384 + h * 96, 384, ABUF(bf16_t, A_VBT) + (size_t)(bl * 4 + h) * 64 * SEQ,
                                    0, 4 * qb + 4, q0w, 0, -INFINITY, 0.f, Y + (size_t)(rowb + q0w) * DM + 256 + h * 64, DM);
                    } else if (u < 512 + 1024) { if (!(MK_ATT & 2) || (rep_ && !(MK_ATT_REP & 2))) continue;
                        const int v = u - 512; const int qb32 = 255 - v / 4, bl = v % 4;
                        IdxArgs ia{ABUF(bf16_t, A_IQ), ABUF(bf16_t, A_IK), ABUF(float, A_IW), ABUF(unsigned short, A_SEL), ABUF(int, A_SELN)};
                        TB(14); idx_unit(lds, wave, ia, bl * SEQ, qb32); TE(14);
                    } else { if (!(MK_ATT & 4) || (rep_ && !(MK_ATT_REP & 4))) continue;
                        const int v = u - 1536; const int bl = v / 256, kvh = (v / 128) % 2, qt = v % 128; const int rowb = bl * SEQ;
                        const int hq = kvh * 4 + (wave >> 1), q0w = 64 * qt + 32 * (wave & 1);
                        const float sink = (FIN(I_SINK) + l * 8)[hq];
                        fa_unit<64>(lds, wave, ABUF(bf16_t, A_QC) + (size_t)(rowb + q0w) * 512 + hq * 64, 512, ABUF(bf16_t, A_KC) + (size_t)rowb * 128 + kvh * 64, 128, ABUF(bf16_t, A_VCT) + (size_t)(bl * 2 + kvh) * 64 * SEQ,
                                    qt >= 2 ? qt - 2 : 0, qt + 1, q0w, 128, sink * LOG2E, 1.f, Y + (size_t)(rowb + q0w) * DM + 512 + hq * 64, DM);
                    }
                }
                TE(28);
            }
            SEAM();
            if (EN(7) && RUN()) for (int rep_ = 0; rep_ < (int)REPS(7); ++rep_) { if (rep_) { __syncthreads(); } PHASE_ENV(); SpaArgs sa{ABUF(bf16_t, A_QA), ABUF(bf16_t, A_KA), ABUF(bf16_t, A_VA), ABUF(unsigned short, A_SEL), ABUF(int, A_SELN), ABUF(bf16_t, A_Y)}; LAS unsigned char* wl = lds + wave * 16384;
                TB(11); { int lane_ = tid & 63; asm volatile("" : "+v"(lane_)); SpaPre P, Pn; P = SpaPre{}; Pn = SpaPre{};
                    if (gwl < TCH) sparse_prefetch(P, sa, gwl, (gwl + ngwl < TCH) ? gwl + ngwl : gwl, lane_);
                    for (int tok = gwl; tok < TCH; tok += 2 * ngwl) { const int tk2 = (tok + ngwl < TCH) ? tok + ngwl : tok; const int nt1 = tok + 2 * ngwl, nt2 = (nt1 + ngwl < TCH) ? nt1 + ngwl : nt1;
                        if (nt1 < TCH) sparse_prefetch(Pn, sa, nt1, nt2, lane_);
                        sparse_pair(wl, sa, P, (tok / SEQ) * SEQ, tok % SEQ, (tk2 / SEQ) * SEQ, tk2 % SEQ, lane_);
                        P = Pn; } } TE(11); }
            SEAM();
            if (EN(8) && RUN()) for (int rep_ = 0; rep_ < (int)REPS(8); ++rep_) { if (rep_) { __syncthreads(); } PHASE_ENV(); pg8::SegOrder S; S.S.init(TCH / 256, DM / 256, G, bx);
                pg8::Gemm g{ABUF(bf16_t, A_Y), DM, ABUF(bf16_t, A_Y), 1 << 30, (const bf16_t*)(lw + OFF_WAO), DM, nullptr, 0, 3, 256, 512}; pg8::EpiMerge E{HB, ABUF(unsigned char, A_G), ws + WS_HF8, S_MG};
                TB(22); pg8::gemm_phase<pg8::EpiMerge, pg8::SegOrder>(lds + RING_OFF, wave, g, S, E); TE(22); }
            SEAM();
            if (EN(9) && RUN()) { PHASE_ENV(); pg8::Gemm g{(const bf16_t*)(ws + WS_HF8), DM / 2, (const bf16_t*)(ws + WS_HF8), 1 << 30, (const bf16_t*)(lw + OFF_WO8), DM / 2, nullptr, 0, 1, 0, 0}; pg8::StaticOrder S; S.init(TCH / 256, DM / 256, G, bx);
                pg8::EpiResidS E{(l == 0 ? FIN(I_X) : (const float*)out) + row0 * DM, out + row0 * DM, 1.0f / (S_MG * S_WO)}; TB(23); pg8::gemm_phase<pg8::EpiResidS, pg8::StaticOrder, true>(lds + RING_OFF, wave, g, S, E); TE(23); }
            SEAM();
            if (l == 0) {
                if (EN(10) && RUN()) { PHASE_ENV(); RouteArgs ra{}; TB(10); norm2_rows<false>(out + row0 * DM, FIN(I_FNG) + l * DM, HB, ws + WS_HF8, ra, (LAS unsigned*)(lds + MISC_OFF + 128), vcu, wave, tid & 63, G); TE(10); }
                SEAM();
                if (EN(11) && RUN()) { PHASE_ENV(); pg8::Gemm g{(const bf16_t*)(ws + WS_HF8), DM / 2, (const bf16_t*)(ws + WS_HF8), 1 << 30, (const bf16_t*)(ws + WS_W13), DM / 2, nullptr, 0, 1, 0, 0}; pg8::StaticOrder S; S.init(TCH / 256, 2 * DFF / 256, G, bx);
                    pg8::EpiSwigluF8 E{ABUF(unsigned char, F_ACT), DFF, 1.0f / S_W13, S_ACT}; TB(24); pg8::gemm_phase<pg8::EpiSwigluF8, pg8::StaticOrder, true>(lds + RING_OFF, wave, g, S, E); TE(24); }
                SEAM();
                if (EN(12) && RUN()) { PHASE_ENV(); pg8::Gemm g{ABUF(bf16_t, F_ACT), DFF / 2, ABUF(bf16_t, F_ACT), 1 << 30, (const bf16_t*)(ws + WS_W2), DFF / 2, nullptr, 0, 1, 0, 0}; pg8::StaticOrder S; S.init(TCH / 256, DM / 256, G, bx);
                    pg8::EpiResidS E{out + row0 * DM, out + row0 * DM, 1.0f / (S_ACT * S_W2)}; TB(25); pg8::gemm_phase<pg8::EpiResidS, pg8::StaticOrder, true>(lds + RING_OFF, wave, g, S, E); TE(25); }
                SEAM();
            } else {
                if (EN(13) && RUN()) { PHASE_ENV(); RouteArgs ra{FIN(I_RW), ABUF(int, F_TOPE), ABUF(float, F_TOPG), ABUF(int, F_TOPD), ctl + CW_MOE + 64 * ch};
                    TB(10); norm2_rows<true>(out + row0 * DM, FIN(I_FNG) + l * DM, HB, nullptr, ra, (LAS unsigned*)(lds + MISC_OFF + 128), vcu, wave, tid & 63, G); TE(10); }
                SEAM();
                if (EN(14) && RUN()) { PHASE_ENV(); TB(12); moe_scatter(ctl + CW_MOE + 64 * ch, ABUF(int, F_TOPE), ABUF(int, F_TOPD), HB, ABUF(bf16_t, F_YM), ABUF(int, F_BLKE), gwl, ngwl, tid & 63); TE(12); }
                SEAM();
                if (EN(15) && RUN()) for (int rep_ = 0; rep_ < (int)REPS(15); ++rep_) { if (rep_) { __syncthreads(); } PHASE_ENV(); int ps[NEXP + 1]; moe_layout(ctl + CW_MOE + 64 * ch, ps); const int nblk = ps[NEXP] / 256;
                    pg8::Gemm g{ABUF(bf16_t, F_YM), DM / 2, ABUF(bf16_t, F_YM), 1 << 30, (const bf16_t*)(ws + WS_E13), DM / 2, ABUF(int, F_BLKE), SZ_E13 / 2, 1, 0, 0}; pg8::StaticOrder S; S.init(nblk, 2 * EFF / 256, G, bx);
                    pg8::EpiSwigluF8 E{ABUF(unsigned char, F_ACT), EFF, 1.0f / S_W13, S_ACT}; TB(26); pg8::gemm_phase<pg8::EpiSwigluF8, pg8::StaticOrder, true>(lds + RING_OFF, wave, g, S, E); TE(26); }
                SEAM();
                if (EN(16) && RUN()) for (int rep_ = 0; rep_ < (int)REPS(16); ++rep_) { if (rep_) { __syncthreads(); } PHASE_ENV(); int ps[NEXP + 1]; moe_layout(ctl + CW_MOE + 64 * ch, ps); const int nblk = ps[NEXP] / 256;
                    pg8::Gemm g{ABUF(bf16_t, F_ACT), EFF / 2, ABUF(bf16_t, F_ACT), 1 << 30, (const bf16_t*)(ws + WS_E2), EFF / 2, ABUF(int, F_BLKE), SZ_E2 / 2, 1, 0, 0}; pg8::StaticOrder S; S.init(nblk, DM / 256, G, bx);
                    pg8::EpiBf16S E{ABUF(bf16_t, F_YM), DM, 1.0f / (S_ACT * S_W2)}; TB(27); pg8::gemm_phase<pg8::EpiBf16S, pg8::StaticOrder, true>(lds + RING_OFF, wave, g, S, E); TE(27); }
                SEAM();
                if (EN(17) && RUN()) { PHASE_ENV(); TB(13); moe_combine(out + row0 * DM, ABUF(bf16_t, F_YM), ABUF(int, F_TOPD), ABUF(float, F_TOPG), gwl, ngwl, tid & 63); TE(13); }
                SEAM();
            }
        }
    }
    if (MK_TIMER != 0 && bx == 0 && args.ph_hi >= N_PHASES_C) { __syncthreads(); const unsigned long long t0 = __builtin_amdgcn_s_memrealtime(); const unsigned long long T = (unsigned long long)(*TMR_ACC) / NWAVES;
        while (__builtin_amdgcn_s_memrealtime() - t0 < T) __builtin_amdgcn_s_sleep(8); }
#undef RUN
#undef SEAM
#undef tid
}
constexpr int N_PHASES = 1 + NCHUNK * (9 + 3) + NCHUNK * (9 + 5);

extern "C" void kernel_launch(void* const* d_in, const int* in_sizes, int n_in, void* d_out, int out_size, void* d_ws, size_t ws_size, hipStream_t stream) {
    static int grid = 0;
    if (grid == 0) {
        if (n_in != 29 || in_sizes[0] != NTOK * DM || out_size != NTOK * DM || ws_size < WS_END) {
            fprintf(stderr, "kernel_launch: built for 29 inputs, x/out of %d floats, >= %zu bytes of workspace; got n_in %d, in0 %d, out %d, ws %zu; nothing launched\n", NTOK * DM, (size_t)WS_END, n_in, n_in > 0 ? in_sizes[0] : -1, out_size, ws_size); grid = -1; return; }
        int dev = 0, cus = 0, per_cu = 0;
        if (hipGetDevice(&dev) != hipSuccess || hipDeviceGetAttribute(&cus, hipDeviceAttributeMultiprocessorCount, dev) != hipSuccess) { fprintf(stderr, "kernel_launch: device query failed\n"); grid = -1; return; }
        if (hipFuncSetAttribute((const void*)mk_fwd, hipFuncAttributeMaxDynamicSharedMemorySize, LDS_BYTES) != hipSuccess) { fprintf(stderr, "kernel_launch: hipFuncSetAttribute failed\n"); grid = -1; return; }
        if (hipOccupancyMaxActiveBlocksPerMultiprocessor(&per_cu, (const void*)mk_fwd, NWAVES * 64, LDS_BYTES) != hipSuccess || per_cu < 1)
            fprintf(stderr, "kernel_launch: note: occupancy query reports %d workgroups per CU\n", per_cu);
        (void)hipGetLastError();
        grid = cus;
        if (grid != 256) fprintf(stderr, "kernel_launch: note: %d CUs (built and tuned for 256)\n", grid);
    }
    if (grid < 0) return;
    if (hipMemsetAsync((char*)d_ws + WS_CTL, 0, CTL_ZERO_BYTES, stream) != hipSuccess) { fprintf(stderr, "kernel_launch: memset failed\n"); return; }
    Args a{};
    for (int i = 0; i < 29; ++i) a.in[i] = d_in[i];
    a.out = (float*)d_out; a.ws = (unsigned char*)d_ws;
#if MK_PER_PHASE
    for (int p = 0; p < N_PHASES; ++p) { a.ph_lo = p; a.ph_hi = p + 1; hipLaunchKernelGGL(mk_fwd, dim3(grid), dim3(NWAVES * 64), LDS_BYTES, stream, a); }
#elif MK_CHECK
    {
        const int base = 1 + (MK_CHECK_L == 0 ? MK_CHECK_CH * 12 : 24 + MK_CHECK_CH * 14);
        a.ph_lo = 0; a.ph_hi = base + 7; a.pad0 = 0; hipLaunchKernelGGL(mk_fwd, dim3(grid), dim3(NWAVES * 64), LDS_BYTES, stream, a);
        hipLaunchKernelGGL(chk_kernel, dim3(grid), dim3(NWAVES * 64), 0, stream, a, 0, MK_CHECK_L, MK_CHECK_CH);
        a.ph_lo = base + 7; a.ph_hi = base + 9; a.pad0 = 1; hipLaunchKernelGGL(mk_fwd, dim3(grid), dim3(NWAVES * 64), LDS_BYTES, stream, a);
        hipLaunchKernelGGL(chk_kernel, dim3(grid), dim3(NWAVES * 64), 0, stream, a, 1, MK_CHECK_L, MK_CHECK_CH);
        a.ph_lo = base + 9; a.ph_hi = N_PHASES; a.pad0 = 2; hipLaunchKernelGGL(mk_fwd, dim3(grid), dim3(NWAVES * 64), LDS_BYTES, stream, a);
        hipLaunchKernelGGL(chk_kernel, dim3(1), dim3(64), 0, stream, a, 2, MK_CHECK_L, MK_CHECK_CH);
    }
#else
    a.ph_lo = 0; a.ph_hi = N_PHASES;
    hipLaunchKernelGGL(mk_fwd, dim3(grid), dim3(NWAVES * 64), LDS_BYTES, stream, a);
#endif
    const hipError_t le = hipPeekAtLastError();
    if (le != hipSuccess) fprintf(stderr, "kernel_launch: launch failed: %s\n", hipGetErrorName(le));
}
```

```cpp
#include <hip/hip_runtime.h>
#include <cstdio>
#include <cstdint>

#define GAS __attribute__((address_space(1)))
#define LAS __attribute__((address_space(3)))
typedef unsigned short bf16_t;
typedef short bf16x8 __attribute__((ext_vector_type(8)));
typedef float f32x2 __attribute__((ext_vector_type(2)));
typedef float f32x4 __attribute__((ext_vector_type(4)));
typedef float f32x16 __attribute__((ext_vector_type(16)));
typedef unsigned u32x2 __attribute__((ext_vector_type(2)));
typedef unsigned u32x4 __attribute__((ext_vector_type(4)));
typedef int i32x4 __attribute__((ext_vector_type(4)));
typedef int i32x8 __attribute__((ext_vector_type(8)));

constexpr int NB = 8, SEQ = 8192, NTOK = NB * SEQ, DM = 1024, DEPTH = 2;
constexpr int DIN = 4936;
constexpr int CHB = 4, TCH = CHB * SEQ, NCHUNK = NB / CHB;
constexpr int DFF = 2816, NEXP = 8, EFF = 3584;
constexpr int P1W = 2048, GW = 3072;
constexpr int NINP = P1W + GW;
constexpr float EPS = 1e-6f;
constexpr float LOG2E = 1.4426950408889634f;
constexpr int C_QA = 0, C_KA = 256, C_VA = 320, C_IQ = 384, C_IK = 640, C_IW = 672, C_CQ = 680, C_CKV = 936, C_KR = 1064, C_QC = 1096, C_KC = 1608, C_VC = 1736, C_G = 1864;
constexpr int NPOS = 12288;
constexpr int MOE_ROWS = 2 * TCH + NEXP * 256;

__device__ __forceinline__ float bf2f(bf16_t v) { return __uint_as_float((unsigned)v << 16); }
__device__ __forceinline__ float bflo(unsigned w) { return __uint_as_float(w << 16); }
__device__ __forceinline__ float bfhi(unsigned w) { return __uint_as_float(w & 0xffff0000u); }
__device__ __forceinline__ unsigned f2bf(float f) { unsigned u = __float_as_uint(f); return (u + 0x7fffu + ((u >> 16) & 1u)) >> 16; }
__device__ __forceinline__ unsigned pk2(float lo, float hi) { return f2bf(lo) | (f2bf(hi) << 16); }
__device__ __forceinline__ unsigned cvt_pk_bf16(float lo, float hi) { unsigned r; asm volatile("v_cvt_pk_bf16_f32 %0, %1, %2" : "=v"(r) : "v"(lo), "v"(hi)); return r; }
__device__ __forceinline__ unsigned pk4_u8(float a, float b, float c, float d) { unsigned w = 0u; w = __builtin_amdgcn_cvt_pk_u8_f32(a, 0u, w); w = __builtin_amdgcn_cvt_pk_u8_f32(b, 1u, w); w = __builtin_amdgcn_cvt_pk_u8_f32(c, 2u, w); w = __builtin_amdgcn_cvt_pk_u8_f32(d, 3u, w); return w; }
__device__ __forceinline__ unsigned pk4_fp8(float a, float b, float c, float d) { unsigned w = 0u; w = (unsigned)__builtin_amdgcn_cvt_pk_fp8_f32(a, b, (int)w, false); w = (unsigned)__builtin_amdgcn_cvt_pk_fp8_f32(c, d, (int)w, true); return w; }
__device__ __forceinline__ float fast_exp2(float x) { return __builtin_amdgcn_exp2f(x); }
__device__ __forceinline__ float max3_(float a, float b, float c) { float r; asm("v_max3_f32 %0, %1, %2, %3" : "=v"(r) : "v"(a), "v"(b), "v"(c)); return r; }
__device__ __forceinline__ float fast_rcp(float x) { return __builtin_amdgcn_rcpf(x); }
__device__ __forceinline__ float sigmoidf_(float x) { return fast_rcp(1.0f + fast_exp2(-LOG2E * x)); }
template <int O> __device__ __forceinline__ float xor_lane(float v) {
    return __int_as_float(__builtin_amdgcn_ds_swizzle(__float_as_int(v), (O << 10) | 0x1f)); }
__device__ __forceinline__ float half_sum(float v) { const auto rr = __builtin_amdgcn_permlane32_swap(__float_as_uint(v), __float_as_uint(v), false, false); return __uint_as_float(rr[0]) + __uint_as_float(rr[1]); }
__device__ __forceinline__ float half_max(float v) { const auto rr = __builtin_amdgcn_permlane32_swap(__float_as_uint(v), __float_as_uint(v), false, false); return fmaxf(__uint_as_float(rr[0]), __uint_as_float(rr[1])); }
__device__ __forceinline__ float sum16(float v) { v += xor_lane<1>(v); v += xor_lane<2>(v); v += xor_lane<4>(v); v += xor_lane<8>(v); return v; }
__device__ __forceinline__ float max16(float v) { v = fmaxf(v, xor_lane<1>(v)); v = fmaxf(v, xor_lane<2>(v)); v = fmaxf(v, xor_lane<4>(v)); v = fmaxf(v, xor_lane<8>(v)); return v; }
__device__ __forceinline__ float sum32(float v) { v = sum16(v); v += xor_lane<16>(v); return v; }
__device__ __forceinline__ float wave_sum(float v) { return half_sum(sum32(v)); }
__device__ __forceinline__ int lane_get(int v, int src_lane) { return __builtin_amdgcn_ds_bpermute(src_lane << 2, v); }
__device__ __forceinline__ int lane_bcast(int v, int uniform_lane) { return __builtin_amdgcn_readlane(v, uniform_lane); }
__device__ __forceinline__ unsigned lds_add(LAS unsigned* p, unsigned v) { return __hip_atomic_fetch_add(p, v, __ATOMIC_RELAXED, __HIP_MEMORY_SCOPE_WORKGROUP); }
__device__ __forceinline__ unsigned lds_or(LAS unsigned* p, unsigned v) { return __hip_atomic_fetch_or(p, v, __ATOMIC_RELAXED, __HIP_MEMORY_SCOPE_WORKGROUP); }
__device__ __forceinline__ int lane_id() { int l; asm volatile("v_mbcnt_lo_u32_b32 %0, -1, 0\n\tv_mbcnt_hi_u32_b32 %0, -1, %0" : "=v"(l)); return l; }
#define LDS_WAIT() asm volatile("s_waitcnt lgkmcnt(0)" ::: "memory")
#define VM_WAIT() asm volatile("s_waitcnt vmcnt(0)" ::: "memory")

namespace pg8 {
constexpr int BM = 256, BK = 64, HALF = 128, HTB = HALF * BK * 2, STAGE_BYTES = 8 * HTB, NXCD = 8, WGM = 8;
__host__ __device__ __forceinline__ int lds_byte(int r, int c) { const int st = (r >> 4) * 2 + (c >> 5), rr = r & 15, cc = c & 31, ob = rr * 64 + cc * 2; return st * 1024 + (ob ^ (((ob >> 9) & 1) << 5)); }
__host__ __device__ __forceinline__ void stage_rc(int b, int& R, int& C) { const int st = b / 1024, sb = b % 1024, swz = sb ^ (((sb >> 9) & 1) << 5); R = (st >> 1) * 16 + swz / 64; C = (st & 1) * 32 + (swz % 64) / 2; }
__host__ __device__ __forceinline__ int perm32(int rho) { const int n = rho >> 4, i = rho & 15; return 8 * (i >> 2) + 4 * n + (i & 3); }

struct Unit { int pm, pn, seg; };
struct Gemm {
    const bf16_t* A; int lda;
    const bf16_t* A2; int pn_split;
    const bf16_t* Bt; int K;
    const int* blk_e; size_t e_stride;
    int nseg, k1, k2;
};
struct StaticOrder {
    int nM, nN, nwg, G, c;
    __device__ void init(int nM_, int nN_, int G_, int c_) { nM = nM_; nN = nN_; nwg = nM * nN; G = G_; c = c_; }
    __device__ bool next(int i, Unit& u) const {
        const long L = (long)i * G + c; if (L >= nwg) return false;
        int wgid = (int)L; { const int q = nwg / NXCD, r = nwg % NXCD, xcd = wgid % NXCD, off = wgid / NXCD; wgid = (xcd < r ? xcd * (q + 1) : r * (q + 1) + (xcd - r) * q) + off; }
        const int nig = WGM * nN, gid = wgid / nig, fm = gid * WGM, gsz = (nM - fm) < WGM ? (nM - fm) : WGM;
        u.pm = fm + ((wgid % nig) % gsz); u.pn = (wgid % nig) / gsz; u.seg = 0; return true;
    }
};
struct GateOrder { StaticOrder S;
    __device__ bool next(int i, Unit& u) const { if (!S.next(i, u)) return false; u.pn += 8; return true; } };
struct SegOrder { StaticOrder S;
    __device__ bool next(int i, Unit& u) const { const int q = i / 3; if (!S.next(q, u)) return false; u.seg = i - 3 * q; return true; } };

template <class Epi, class Sched, bool FP8 = false>
__device__ __forceinline__ void gemm_phase(LAS unsigned char* lds, int wave_, const Gemm g, const Sched& S, const Epi& E) {
    int tid = wave_ * 64 + lane_id(); asm volatile("" : "+v"(tid));
    const int wid = __builtin_amdgcn_readfirstlane(tid >> 6), lane = tid & 63, wr = wid >> 2, wc = wid & 3, fr = lane & 15, fq = lane >> 4;
    int K = g.K; asm volatile("" : "+s"(K));
    unsigned voffA[2], voffB[2];
#pragma unroll
    for (int i = 0; i < 2; ++i) { int R, C; stage_rc(tid * 16 + i * 8192, R, C); const int Rb = Epi::PERM ? ((R & ~31) + perm32(R & 31)) : R;
        voffA[i] = (unsigned)(R * g.lda + C) * 2u; voffB[i] = (unsigned)(Rb * K + C) * 2u; }
    const size_t kstep = (size_t)(BK * 2);
    const size_t hstepB = (size_t)HALF * K * 2, tstepB = 2 * hstepB;
    const size_t hstepA = (size_t)HALF * g.lda * 2, tstepA = 2 * hstepA;
    const unsigned ldsw = (unsigned)wid * 1024u;
    const int aoff0 = FP8 ? lds_byte(wr * 64 + fr, (2 * (fq & 1)) * 8) + (fq >> 1) * 1024 : lds_byte(wr * 64 + fr, fq * 8);
    const int boff0 = FP8 ? lds_byte(wc * 32 + fr, (2 * (fq & 1)) * 8) + (fq >> 1) * 1024 : lds_byte(wc * 32 + fr, fq * 8);
    constexpr int OFF1 = FP8 ? 16 : 1024;
#define PG8_SA(b, h) (((b) * 2 + (h)) * HTB)
#define PG8_SB(b, h) ((4 + (b) * 2 + (h)) * HTB)
#define PG8_STAGE(bufoff, gbase, voff) do { _Pragma("unroll") for (int _i = 0; _i < 2; ++_i) \
        __builtin_amdgcn_global_load_lds((const unsigned*)((const char*)(gbase) + (voff)[_i]), (LAS unsigned*)(lds + (bufoff) + ldsw + _i * 8192), 16, 0, 0); } while (0)
#define PG8_LDA(dst, b, h) do { _Pragma("unroll") for (int m = 0; m < 4; ++m) { \
        if constexpr (FP8) { dst##8[m].lo = *(const LAS i32x4*)(lds + PG8_SA(b, h) + aoff0 + m * 2048); dst##8[m].hi = *(const LAS i32x4*)(lds + PG8_SA(b, h) + aoff0 + OFF1 + m * 2048); } \
        else { dst[m][0] = *(const LAS bf16x8*)(lds + PG8_SA(b, h) + aoff0 + m * 2048); dst[m][1] = *(const LAS bf16x8*)(lds + PG8_SA(b, h) + aoff0 + OFF1 + m * 2048); } } } while (0)
#define PG8_LDB(dst, b, h) do { _Pragma("unroll") for (int n = 0; n < 2; ++n) { \
        if constexpr (FP8) { dst##8[n].lo = *(const LAS i32x4*)(lds + PG8_SB(b, h) + boff0 + n * 2048); dst##8[n].hi = *(const LAS i32x4*)(lds + PG8_SB(b, h) + boff0 + OFF1 + n * 2048); } \
        else { dst[n][0] = *(const LAS bf16x8*)(lds + PG8_SB(b, h) + boff0 + n * 2048); dst[n][1] = *(const LAS bf16x8*)(lds + PG8_SB(b, h) + boff0 + OFF1 + n * 2048); } } } while (0)
#define PG8_MMA(ai, bj, At, Bt) do { __builtin_amdgcn_s_setprio(1); _Pragma("unroll") for (int m = 0; m < 4; ++m) _Pragma("unroll") for (int n = 0; n < 2; ++n) { \
        if constexpr (FP8) asm volatile("v_mfma_scale_f32_16x16x128_f8f6f4 %0, %1, %2, %0, %3, %3 op_sel_hi:[0,0,0]" : "+v"(acc[ai][bj][m][n]) : "v"(Bt##8[n]), "v"(At##8[m]), "v"(one_scale));   \
        else { _Pragma("unroll") for (int k = 0; k < 2; ++k) acc[ai][bj][m][n] = __builtin_amdgcn_mfma_f32_16x16x32_bf16(Bt[n][k], At[m][k], acc[ai][bj][m][n], 0, 0, 0); } } \
        __builtin_amdgcn_s_setprio(0); } while (0)
#define PG8_WAIT_V(n) asm volatile("s_waitcnt vmcnt(" #n ")" ::: "memory")
#define PG8_WAIT_L(n) asm volatile("s_waitcnt lgkmcnt(" #n ")" ::: "memory")
#define PG8_BAR __builtin_amdgcn_s_barrier()
#define PG8_SCHED __builtin_amdgcn_sched_barrier(0)
#define PG8_K0(u) ((u).seg == 0 ? 0 : ((u).seg == 1 ? g.k1 : g.k2))
#define PG8_NT(u) ((g.nseg == 1 ? K : ((u).seg == 0 ? g.k1 : ((u).seg == 1 ? g.k2 - g.k1 : K - g.k2))) / BK)
#define PG8_BPTR(u) ((const char*)g.Bt + ((g.blk_e ? (size_t)g.blk_e[(u).pm] * g.e_stride * 2 : (size_t)0) + (size_t)(u).pn * tstepB + (size_t)PG8_K0(u) * 2))
    Unit cur, nxt; int ui = 0;
    if (!S.next(0, cur)) return;
    f32x4 acc[2][2][4][2];
#pragma unroll
    for (int a = 0; a < 2; ++a)
#pragma unroll
        for (int b = 0; b < 2; ++b)
#pragma unroll
            for (int m = 0; m < 4; ++m)
#pragma unroll
                for (int n = 0; n < 2; ++n) acc[a][b][m][n] = (f32x4){0.f, 0.f, 0.f, 0.f};
    bf16x8 At[4][2], B0[2][2], B1[2][2];
    i32x8 At8[4], B08[2], B18[2];
    int one_scale = 0x7f7f7f7f; asm volatile("" : "+v"(one_scale));
    const char* cA = (const char*)(cur.pn >= g.pn_split ? g.A2 : g.A) + (size_t)cur.pm * tstepA + (size_t)PG8_K0(cur) * 2; const char* cB = PG8_BPTR(cur);
    int nt = PG8_NT(cur);
    PG8_STAGE(PG8_SB(0, 0), cB, voffB); PG8_STAGE(PG8_SB(0, 1), cB + hstepB, voffB); PG8_STAGE(PG8_SA(0, 0), cA, voffA); PG8_STAGE(PG8_SA(0, 1), cA + hstepA, voffA);
    if (wr == 1) PG8_BAR;
    PG8_WAIT_V(2); PG8_BAR;
    PG8_STAGE(PG8_SB(1, 0), cB + kstep, voffB); PG8_STAGE(PG8_SA(1, 0), cA + kstep, voffA); PG8_STAGE(PG8_SB(1, 1), cB + hstepB + kstep, voffB);
    PG8_WAIT_V(6); PG8_BAR;
    for (;;) {
        const bool has_next = S.next(ui + 1, nxt);
        const char* nA = has_next ? (const char*)(nxt.pn >= g.pn_split ? g.A2 : g.A) + (size_t)nxt.pm * tstepA + (size_t)PG8_K0(nxt) * 2 : cA; const char* nB = has_next ? PG8_BPTR(nxt) : cB;
        for (int t = 0; t < nt; t += 2) {
            const bool last = (t == nt - 2);
            const char* a1 = cA + (size_t)(t + 1) * kstep;
            const char* a2 = last ? nA : cA + (size_t)(t + 2) * kstep; const char* b2 = last ? nB : cB + (size_t)(t + 2) * kstep;
            const char* a3 = a2 + kstep; const char* b3 = b2 + kstep;
            PG8_LDB(B0, 0, 0); PG8_LDB(B1, 0, 1); PG8_SCHED; PG8_LDA(At, 0, 0); PG8_STAGE(PG8_SA(1, 1), a1 + hstepA, voffA);
            PG8_WAIT_V(8); PG8_WAIT_L(0); PG8_BAR; PG8_MMA(0, 0, At, B0); PG8_MMA(0, 1, At, B1); PG8_BAR; PG8_SCHED;
            PG8_LDA(At, 0, 1); PG8_STAGE(PG8_SB(0, 0), b2, voffB); PG8_STAGE(PG8_SB(0, 1), b2 + hstepB, voffB); PG8_STAGE(PG8_SA(0, 0), a2, voffA);
            PG8_WAIT_V(8); PG8_WAIT_L(0); PG8_BAR; PG8_MMA(1, 0, At, B0); PG8_MMA(1, 1, At, B1); PG8_BAR; PG8_SCHED;
            PG8_LDB(B0, 1, 0); PG8_LDB(B1, 1, 1); PG8_SCHED; PG8_LDA(At, 1, 0); PG8_STAGE(PG8_SA(0, 1), a2 + hstepA, voffA);
            PG8_WAIT_V(8); PG8_WAIT_L(0); PG8_BAR; PG8_MMA(0, 0, At, B0); PG8_MMA(0, 1, At, B1); PG8_BAR; PG8_SCHED;
            PG8_LDA(At, 1, 1); PG8_STAGE(PG8_SB(1, 0), b3, voffB); PG8_STAGE(PG8_SB(1, 1), b3 + hstepB, voffB); PG8_STAGE(PG8_SA(1, 0), a3, voffA);
            PG8_WAIT_V(8); PG8_WAIT_L(0); PG8_BAR; PG8_MMA(1, 0, At, B0); PG8_MMA(1, 1, At, B1); PG8_BAR; PG8_SCHED;
        }
        if (wr == 0) PG8_BAR;
        if constexpr (FP8) { asm volatile("s_nop 15\n\ts_nop 7" ::: "memory");
#pragma unroll
            for (int a = 0; a < 2; ++a)
#pragma unroll
                for (int b = 0; b < 2; ++b)
#pragma unroll
                    for (int m = 0; m < 4; ++m)
#pragma unroll
                        for (int n = 0; n < 2; ++n) asm volatile("" : "+v"(acc[a][b][m][n])); }
        E(acc, cur, wr, wc, fr, fq);
        if (!has_next) break;
#pragma unroll
        for (int a = 0; a < 2; ++a)
#pragma unroll
            for (int b = 0; b < 2; ++b)
#pragma unroll
                for (int m = 0; m < 4; ++m)
#pragma unroll
                    for (int n = 0; n < 2; ++n) acc[a][b][m][n] = (f32x4){0.f, 0.f, 0.f, 0.f};
        cur = nxt; cA = nA; cB = nB; ++ui; nt = PG8_NT(cur);
        if (wr == 1) PG8_BAR;
    }
    PG8_WAIT_V(0);
    PG8_BAR;
#undef PG8_SA
#undef PG8_SB
#undef PG8_STAGE
#undef PG8_LDA
#undef PG8_LDB
#undef PG8_MMA
#undef PG8_WAIT_V
#undef PG8_WAIT_L
#undef PG8_BAR
#undef PG8_SCHED
#undef PG8_BPTR
#undef PG8_K0
#undef PG8_NT
}

typedef const f32x4 (&AccRef)[2][2][4][2];
struct EpiInProj {
    static constexpr bool PERM = true;
    bf16_t* P1; unsigned char* G; float sg;
    __device__ __forceinline__ void operator()(AccRef acc, const Unit& u, int wr, int wc, int fr, int fq) const {
        const int row0 = u.pm * BM + wr * 64 + fr; const bool gate = u.pn >= 8;
        const int col0 = (gate ? (u.pn - 8) : u.pn) * BM + wc * 32 + 8 * fq;
#pragma unroll
        for (int ai = 0; ai < 2; ++ai)
#pragma unroll
            for (int m = 0; m < 4; ++m) { const size_t row = (size_t)(row0 + ai * HALF + m * 16);
#pragma unroll
                for (int bj = 0; bj < 2; ++bj) { f32x4 v0 = acc[ai][bj][m][0], v1 = acc[ai][bj][m][1];
                    if (gate) {
#pragma unroll
                        for (int j = 0; j < 4; ++j) { v0[j] = 255.0f * sigmoidf_(v0[j] * sg); v1[j] = 255.0f * sigmoidf_(v1[j] * sg); }
                        u32x2 q; q.x = pk4_u8(v0[0], v0[1], v0[2], v0[3]); q.y = pk4_u8(v1[0], v1[1], v1[2], v1[3]);
                        *(u32x2*)(G + row * GW + col0 + bj * HALF) = q;
                    } else {
                        u32x4 w; w.x = cvt_pk_bf16(v0[0], v0[1]); w.y = cvt_pk_bf16(v0[2], v0[3]); w.z = cvt_pk_bf16(v1[0], v1[1]); w.w = cvt_pk_bf16(v1[2], v1[3]);
                        *(u32x4*)(P1 + row * P1W + col0 + bj * HALF) = w; } } }
    }
};
struct EpiBf16 {
    static constexpr bool PERM = true;
    bf16_t* O; int ldc;
    __device__ __forceinline__ void operator()(AccRef acc, const Unit& u, int wr, int wc, int fr, int fq) const {
        const int row0 = u.pm * BM + wr * 64 + fr; const int col0 = u.pn * BM + wc * 32 + 8 * fq;
#pragma unroll
        for (int ai = 0; ai < 2; ++ai)
#pragma unroll
            for (int m = 0; m < 4; ++m) { bf16_t* rowp = O + (size_t)(row0 + ai * HALF + m * 16) * ldc + col0;
#pragma unroll
                for (int bj = 0; bj < 2; ++bj) { const f32x4 v0 = acc[ai][bj][m][0], v1 = acc[ai][bj][m][1];
                    u32x4 w; w.x = cvt_pk_bf16(v0[0], v0[1]); w.y = cvt_pk_bf16(v0[2], v0[3]); w.z = cvt_pk_bf16(v1[0], v1[1]); w.w = cvt_pk_bf16(v1[2], v1[3]);
                    *(u32x4*)(rowp + bj * HALF) = w; } }
    }
};
struct EpiMerge {
    static constexpr bool PERM = true;
    bf16_t* Mg; const unsigned char* G; unsigned char* M8; float s8;
    __device__ __forceinline__ void operator()(AccRef acc, const Unit& u, int wr, int wc, int fr, int fq) const {
        const int row0 = u.pm * BM + wr * 64 + fr; const int col0 = u.pn * BM + wc * 32 + 8 * fq; const int goff = u.seg * DM; const bool accum = u.seg != 0;
#pragma unroll
        for (int ai = 0; ai < 2; ++ai) {
            u32x2 gv[8]; u32x4 ov[8];
#pragma unroll
            for (int m = 0; m < 4; ++m)
#pragma unroll
                for (int bj = 0; bj < 2; ++bj) { const size_t row = (size_t)(row0 + ai * HALF + m * 16);
                    gv[m * 2 + bj] = *(const u32x2*)(G + row * GW + goff + col0 + bj * HALF);
                    if (accum) ov[m * 2 + bj] = *(const u32x4*)(Mg + row * DM + col0 + bj * HALF); }
#pragma unroll
            for (int m = 0; m < 4; ++m)
#pragma unroll
                for (int bj = 0; bj < 2; ++bj) { const size_t row = (size_t)(row0 + ai * HALF + m * 16); const f32x4 v0 = acc[ai][bj][m][0], v1 = acc[ai][bj][m][1]; const u32x2 gw = gv[m * 2 + bj]; constexpr float I255 = 1.0f / 255.0f;
                    float r[8] = { (float)(gw.x & 255u) * I255 * v0[0], (float)((gw.x >> 8) & 255u) * I255 * v0[1], (float)((gw.x >> 16) & 255u) * I255 * v0[2], (float)(gw.x >> 24) * I255 * v0[3],
                                   (float)(gw.y & 255u) * I255 * v1[0], (float)((gw.y >> 8) & 255u) * I255 * v1[1], (float)((gw.y >> 16) & 255u) * I255 * v1[2], (float)(gw.y >> 24) * I255 * v1[3] };
                    if (accum) { const u32x4 o = ov[m * 2 + bj]; r[0] += bflo(o.x); r[1] += bfhi(o.x); r[2] += bflo(o.y); r[3] += bfhi(o.y); r[4] += bflo(o.z); r[5] += bfhi(o.z); r[6] += bflo(o.w); r[7] += bfhi(o.w); }
                    u32x4 w; w.x = cvt_pk_bf16(r[0], r[1]); w.y = cvt_pk_bf16(r[2], r[3]); w.z = cvt_pk_bf16(r[4], r[5]); w.w = cvt_pk_bf16(r[6], r[7]);
                    *(u32x4*)(Mg + row * DM + col0 + bj * HALF) = w;
                    if (u.seg == 2) { u32x2 q; q.x = pk4_fp8(r[0] * s8, r[1] * s8, r[2] * s8, r[3] * s8); q.y = pk4_fp8(r[4] * s8, r[5] * s8, r[6] * s8, r[7] * s8); *(u32x2*)(M8 + row * DM + col0 + bj * HALF) = q; } }
        }
    }
};
struct EpiResid {
    static constexpr bool PERM = false;
    const float* R; float* O;
    __device__ __forceinline__ void operator()(AccRef acc, const Unit& u, int wr, int wc, int fr, int fq) const {
        const int row0 = u.pm * BM + wr * 64 + fr, col0 = u.pn * BM + wc * 32 + 4 * fq;
#pragma unroll
        for (int ai = 0; ai < 2; ++ai) {
            f32x4 rv[16];
#pragma unroll
            for (int m = 0; m < 4; ++m)
#pragma unroll
                for (int bj = 0; bj < 2; ++bj)
#pragma unroll
                    for (int n = 0; n < 2; ++n) rv[m * 4 + bj * 2 + n] = *(const f32x4*)(R + (size_t)(row0 + ai * HALF + m * 16) * DM + col0 + bj * HALF + n * 16);
#pragma unroll
            for (int m = 0; m < 4; ++m)
#pragma unroll
                for (int bj = 0; bj < 2; ++bj)
#pragma unroll
                    for (int n = 0; n < 2; ++n) *(f32x4*)(O + (size_t)(row0 + ai * HALF + m * 16) * DM + col0 + bj * HALF + n * 16) = rv[m * 4 + bj * 2 + n] + acc[ai][bj][m][n];
            asm volatile("" ::: "memory"); }
    }
};
struct EpiResidS {
    static constexpr bool PERM = false;
    const float* R; float* O; float s;
    __device__ __forceinline__ void operator()(AccRef acc, const Unit& u, int wr, int wc, int fr, int fq) const {
        const int row0 = u.pm * BM + wr * 64 + fr, col0 = u.pn * BM + wc * 32 + 4 * fq;
#pragma unroll
        for (int ai = 0; ai < 2; ++ai) {
            f32x4 rv[16];
#pragma unroll
            for (int m = 0; m < 4; ++m)
#pragma unroll
                for (int bj = 0; bj < 2; ++bj)
#pragma unroll
                    for (int n = 0; n < 2; ++n) rv[m * 4 + bj * 2 + n] = *(const f32x4*)(R + (size_t)(row0 + ai * HALF + m * 16) * DM + col0 + bj * HALF + n * 16);
#pragma unroll
            for (int m = 0; m < 4; ++m)
#pragma unroll
                for (int bj = 0; bj < 2; ++bj)
#pragma unroll
                    for (int n = 0; n < 2; ++n) *(f32x4*)(O + (size_t)(row0 + ai * HALF + m * 16) * DM + col0 + bj * HALF + n * 16) = rv[m * 4 + bj * 2 + n] + acc[ai][bj][m][n] * s;
            asm volatile("" ::: "memory"); }
    }
};
struct EpiSwiglu {
    static constexpr bool PERM = true;
    bf16_t* O; int ldc;
    __device__ __forceinline__ void operator()(AccRef acc, const Unit& u, int wr, int wc, int fr, int fq) const {
        const int row0 = u.pm * BM + wr * 64 + fr; const int col0 = u.pn * HALF + wc * 32 + 8 * fq;
#pragma unroll
        for (int ai = 0; ai < 2; ++ai)
#pragma unroll
            for (int m = 0; m < 4; ++m) { bf16_t* rowp = O + (size_t)(row0 + ai * HALF + m * 16) * ldc + col0;
                float r[8];
#pragma unroll
                for (int n = 0; n < 2; ++n)
#pragma unroll
                    for (int j = 0; j < 4; ++j) { const float gt = acc[ai][0][m][n][j], up = acc[ai][1][m][n][j]; r[4 * n + j] = gt * sigmoidf_(gt) * up; }
                u32x4 w; w.x = cvt_pk_bf16(r[0], r[1]); w.y = cvt_pk_bf16(r[2], r[3]); w.z = cvt_pk_bf16(r[4], r[5]); w.w = cvt_pk_bf16(r[6], r[7]);
                *(u32x4*)rowp = w; }
    }
};
struct EpiSwigluF8 {
    static constexpr bool PERM = true;
    unsigned char* O; int ldc; float s_in, s_out;
    __device__ __forceinline__ void operator()(AccRef acc, const Unit& u, int wr, int wc, int fr, int fq) const {
        const int row0 = u.pm * BM + wr * 64 + fr; const int col0 = u.pn * HALF + wc * 32 + 8 * fq;
#pragma unroll
        for (int ai = 0; ai < 2; ++ai)
#pragma unroll
            for (int m = 0; m < 4; ++m) { unsigned char* rowp = O + (size_t)(row0 + ai * HALF + m * 16) * ldc + col0;
                float r[8];
#pragma unroll
                for (int n = 0; n < 2; ++n)
#pragma unroll
                    for (int j = 0; j < 4; ++j) { const float gt = acc[ai][0][m][n][j] * s_in, up = acc[ai][1][m][n][j] * s_in; r[4 * n + j] = gt * sigmoidf_(gt) * up * s_out; }
                u32x2 w; w.x = pk4_fp8(r[0], r[1], r[2], r[3]); w.y = pk4_fp8(r[4], r[5], r[6], r[7]);
                *(u32x2*)rowp = w; }
    }
};
struct EpiBf16S {
    static constexpr bool PERM = true;
    bf16_t* O; int ldc; float s;
    __device__ __forceinline__ void operator()(AccRef acc, const Unit& u, int wr, int wc, int fr, int fq) const {
        const int row0 = u.pm * BM + wr * 64 + fr; const int col0 = u.pn * BM + wc * 32 + 8 * fq;
#pragma unroll
        for (int ai = 0; ai < 2; ++ai)
#pragma unroll
            for (int m = 0; m < 4; ++m) { bf16_t* rowp = O + (size_t)(row0 + ai * HALF + m * 16) * ldc + col0;
#pragma unroll
                for (int bj = 0; bj < 2; ++bj) { const f32x4 v0 = acc[ai][bj][m][0] * s, v1 = acc[ai][bj][m][1] * s;
                    u32x4 w; w.x = cvt_pk_bf16(v0[0], v0[1]); w.y = cvt_pk_bf16(v0[2], v0[3]); w.z = cvt_pk_bf16(v1[0], v1[1]); w.w = cvt_pk_bf16(v1[2], v1[3]);
                    *(u32x4*)(rowp + bj * HALF) = w; } }
    }
};
}
struct Args { const void* in[29]; float* out; unsigned char* ws; int ph_lo, ph_hi, pad0, pad1; };
enum { I_X = 0, I_POS, I_ANG, I_WIN, I_AQG, I_AKG, I_BCQG, I_BCKVG, I_WUQ, I_WUKV, I_BQNG, I_BQRG, I_BKNG, I_BKRG, I_CQG, I_CKG, I_SINK, I_WAO, I_WBO, I_WCO, I_WO, I_FNG, I_FW1, I_FW3, I_FW2, I_RW, I_MW1, I_MW3, I_MW2 };

constexpr size_t MiB = 1u << 20;
constexpr size_t WS_CTL = 0, CTL_ZERO_BYTES = 1 * MiB;
constexpr size_t SZ_WIN = (size_t)NINP * DM * 2;
constexpr size_t SZ_WUQ = (size_t)512 * 256 * 2, SZ_WUKV = SZ_WUQ;
constexpr size_t SZ_WAO = (size_t)DM * 256 * 2, SZ_WBO = SZ_WAO, SZ_WCO = (size_t)DM * 512 * 2, SZ_WO = (size_t)DM * DM * 2;
constexpr size_t SZ_WIN8 = (size_t)GW * DM;
constexpr size_t SZ_WO8 = (size_t)DM * DM;
constexpr size_t SZ_LAYERW = SZ_WIN + SZ_WUQ + SZ_WUKV + SZ_WAO + SZ_WBO + SZ_WCO + SZ_WO + SZ_WIN8 + SZ_WO8;
constexpr size_t WS_LAYERW = 1 * MiB;
constexpr size_t OFF_WIN = 0, OFF_WUQ = OFF_WIN + SZ_WIN, OFF_WUKV = OFF_WUQ + SZ_WUQ, OFF_WAO = OFF_WUKV + SZ_WUKV, OFF_WBO = OFF_WAO + SZ_WAO, OFF_WCO = OFF_WBO + SZ_WBO, OFF_WO = OFF_WCO + SZ_WCO, OFF_WIN8 = OFF_WO + SZ_WO, OFF_WO8 = OFF_WIN8 + SZ_WIN8;
constexpr size_t WS_W13 = WS_LAYERW + 2 * SZ_LAYERW;
constexpr size_t SZ_W13 = (size_t)2 * DFF * DM * 2, SZ_W2 = (size_t)DM * DFF * 2;
constexpr size_t WS_W2 = WS_W13 + SZ_W13;
constexpr size_t WS_E13 = WS_W2 + SZ_W2;
constexpr size_t SZ_E13 = (size_t)2 * EFF * DM, SZ_E2 = (size_t)DM * EFF;
constexpr float S_W13 = 32.f, S_W2 = 64.f, S_ACT = 4.f, S_WG = 32.f, S_WO = 32.f, S_MG = 8.f;
constexpr size_t WS_E2 = WS_E13 + NEXP * SZ_E13;
constexpr size_t WS_ROPE = WS_E2 + NEXP * SZ_E2;
constexpr size_t SZ_ROPE = (size_t)NPOS * (32 + 32 + 16 + 16) * 4;
constexpr size_t WS_HB = ((WS_ROPE + SZ_ROPE + MiB - 1) / MiB) * MiB;
constexpr size_t SZ_HB = (size_t)(TCH + 1) * DM * 2;
constexpr size_t WS_HF8 = ((WS_HB + SZ_HB + MiB - 1) / MiB) * MiB;
constexpr size_t WS_ACT = WS_HF8 + (size_t)TCH * DM;
constexpr size_t A_P1 = 0;                                  constexpr size_t SZ_P1 = (size_t)TCH * P1W * 2;
constexpr size_t A_G = A_P1 + SZ_P1;                        constexpr size_t SZ_G = (size_t)TCH * GW * 2;
constexpr size_t A_QA = A_G + SZ_G;
constexpr size_t A_KA = A_QA + (size_t)TCH * 256 * 2;
constexpr size_t A_VA = A_KA + (size_t)TCH * 64 * 2;
constexpr size_t A_IQ = A_VA + (size_t)TCH * 64 * 2;
constexpr size_t A_IK = A_IQ + (size_t)TCH * 256 * 2;
constexpr size_t A_IW = A_IK + (size_t)TCH * 32 * 2;
constexpr size_t A_CQN = A_IW + (size_t)TCH * 8 * 4;
constexpr size_t A_CKVN = A_CQN + (size_t)TCH * 256 * 2;
constexpr size_t A_KR = A_CKVN + (size_t)TCH * 256 * 2;
constexpr size_t A_QC = A_KR + (size_t)TCH * 32 * 2;
constexpr size_t A_KC = A_QC + (size_t)TCH * 512 * 2;
constexpr size_t A_VCT = A_KC + (size_t)TCH * 128 * 2;
constexpr size_t A_QBR = A_VCT + (size_t)TCH * 128 * 2;
constexpr size_t A_KVBR = A_QBR + (size_t)TCH * 512 * 2;
constexpr size_t A_QB = A_KVBR + (size_t)TCH * 512 * 2;
constexpr size_t A_KB = A_QB + (size_t)TCH * 384 * 2;
constexpr size_t A_VBT = A_KB + (size_t)TCH * 384 * 2;
constexpr size_t A_SEL = A_VBT + (size_t)TCH * 256 * 2;
constexpr size_t A_SELN = A_SEL + (size_t)TCH * 256 * 2;
constexpr size_t A_Y = A_SELN + (size_t)TCH * 4;
constexpr size_t A_END = A_Y + (size_t)TCH * DM * 2;
constexpr size_t F_ACT = 0;
constexpr size_t F_YM = F_ACT + (size_t)MOE_ROWS * EFF * 2;
constexpr size_t F_ROWTOK = F_YM + (size_t)MOE_ROWS * DM * 2;
constexpr size_t F_TOPD = F_ROWTOK + (size_t)MOE_ROWS * 4;
constexpr size_t F_TOPE = F_TOPD + (size_t)TCH * 2 * 4;
constexpr size_t F_TOPG = F_TOPE + (size_t)TCH * 2 * 4;
constexpr size_t F_BLKE = F_TOPG + (size_t)TCH * 2 * 4;
constexpr size_t F_END = F_BLKE + 4096;
constexpr size_t WS_END = WS_ACT + (A_END > F_END ? A_END : F_END);
constexpr int CW_BAR = 4096;
constexpr int CW_Q = 16384;
constexpr int CW_MOE = 32768;
constexpr int CW_DBG = 65536;

constexpr int RING_OFF = 0;
constexpr int IDX_HP = 1028;
constexpr int IDX_HIST = 0, IDX_BITMAP = 0, IDX_CANDK = 32768, IDX_CANDI = 98304, IDX_QT = 131584  , IDX_SUBH = IDX_QT  ,
              IDX_QPAR = 152576, IDX_CCNT = 153600, IDX_FLAG = 153728;
constexpr int IDX_CCAP = 512, IDX_RCAP = 256;
constexpr int MISC_OFF = 153856;
constexpr int LDS_BYTES = 155648;
constexpr int NWAVES = 8;
#ifndef MK_TIMER
#define MK_TIMER 0
#endif
#define TMR_ACC ((LAS unsigned*)(size_t)(MISC_OFF + 192))
#define TB(id) unsigned long long tb_##id = 0ull; if (MK_TIMER == (id)) tb_##id = __builtin_amdgcn_s_memrealtime()
#define TE(id) do { if (MK_TIMER == (id)) { const unsigned d_ = (unsigned)(__builtin_amdgcn_s_memrealtime() - tb_##id); if (lane_id() == 0) lds_add(TMR_ACC, d_); } } while (0)

#define XB_TMO      128
#define XB_XCNT(j)  (256  + 64 * (j))
#define XB_XSUB(j)  (1280 + 64 * (j))
#define XB_XGEN(j)  (2304 + 64 * (j))
#define XB_TOP      3328
#define XB_TOPGEN   3392
#define XCD_BAR_WORDS 3456
#define XB_SPIN_CAP (1u << 18)

__device__ __forceinline__ unsigned xb_ld(unsigned* p)              { return __hip_atomic_load(p, __ATOMIC_RELAXED, __HIP_MEMORY_SCOPE_AGENT); }
__device__ __forceinline__ unsigned xb_add(unsigned* p, unsigned v) { return __hip_atomic_fetch_add(p, v, __ATOMIC_RELAXED, __HIP_MEMORY_SCOPE_AGENT); }
__device__ __forceinline__ unsigned xb_xcc_id() { return (unsigned)__builtin_amdgcn_s_getreg((3 << 11) | 20) & 0xFu; }
#define XB_SPIN(cond, bar) do { unsigned _sp = 0; while (cond) { __builtin_amdgcn_s_sleep(1); \
    if ((++_sp & 255u) == 0u) { if (xb_ld(&(bar)[XB_TMO])) break; if (_sp > XB_SPIN_CAP) { atomicAdd(&(bar)[XB_TMO], 1u); break; } } } } while (0)

struct XcdBarrier {
    unsigned* bar; unsigned x;
    volatile LAS unsigned* st;
};
__device__ __forceinline__ XcdBarrier xcd_barrier_post(unsigned* bar, volatile LAS unsigned* st, int wave_) {
    XcdBarrier b; b.bar = bar; b.x = xb_xcc_id(); b.st = st;
    if (wave_ == 0 && lane_id() == 0) (void)xb_add(&bar[XB_XCNT(b.x)], 1u);
    return b;
}
__device__ __forceinline__ void xcd_barrier_complete(unsigned* bar, unsigned x, unsigned& nloc, unsigned& nx) {
    const unsigned G = gridDim.x * gridDim.y * gridDim.z;
    unsigned sum, cnt, mine, sp = 0u;
    for (;;) {
        sum = 0u; cnt = 0u; mine = 0u;
#pragma unroll
        for (unsigned j = 0; j < 16; ++j) { const unsigned c = xb_ld(&bar[XB_XCNT(j)]); sum += c; cnt += (c > 0u) ? 1u : 0u; mine = (j == x) ? c : mine; }
        if (sum == G) break;
        __builtin_amdgcn_s_sleep(1);
        if ((++sp & 255u) == 0u) { if (xb_ld(&bar[XB_TMO])) break; if (sp > XB_SPIN_CAP) { atomicAdd(&bar[XB_TMO], 1u); break; } }
    }
    nloc = mine > 0u ? mine : 1u; nx = cnt > 0u ? cnt : 1u;
}
__device__ __forceinline__ void xcd_barrier(const XcdBarrier& b, int wave_) {
    asm volatile("s_waitcnt vmcnt(0)" ::: "memory");
    __syncthreads();
    if (wave_ == 0 && lane_id() == 0) {
        unsigned* bar = b.bar;
        __builtin_amdgcn_s_waitcnt(0);
        unsigned nloc = b.st[0], nx = b.st[1];
        if (nloc == 0u) { xcd_barrier_complete(bar, b.x, nloc, nx); b.st[0] = nloc; b.st[1] = nx; }
        const unsigned old = xb_add(&bar[XB_XSUB(b.x)], 1u);
        const unsigned gen = old / nloc;
        if (old + 1u == (gen + 1u) * nloc) {
            __builtin_amdgcn_fence(__ATOMIC_RELEASE, "agent");
            asm volatile("s_waitcnt vmcnt(0)" ::: "memory");
            const unsigned og = xb_add(&bar[XB_TOP], 1u);
            const unsigned tg = og / nx;
            if (og + 1u == (tg + 1u) * nx) xb_add(&bar[XB_TOPGEN], 1u);
            else XB_SPIN(xb_ld(&bar[XB_TOPGEN]) == tg, bar);
            __builtin_amdgcn_fence(__ATOMIC_ACQUIRE, "agent");
            xb_add(&bar[XB_XGEN(b.x)], 1u);
            asm volatile("s_waitcnt vmcnt(0)" ::: "memory");
        } else {
            XB_SPIN(xb_ld(&bar[XB_XGEN(b.x)]) == gen, bar);
            __builtin_amdgcn_fence(__ATOMIC_ACQUIRE, "agent");
            asm volatile("s_waitcnt vmcnt(0)" ::: "memory");
        }
    }
    __syncthreads();
}

template <int MAP> __device__ __forceinline__ int wt_row(int n) {
    if (MAP == 1) return n < C_G ? n : n + (P1W - C_G);
    if (MAP == 2) return 256 * (n >> 7) + (n & 127);
    if (MAP == 3) return 256 * (n >> 7) + 128 + (n & 127);
    return n;
}
template <int MAP>
__device__ __forceinline__ void transpose_item(const float* W, int K, int N, bf16_t* WT, int ldk, LAS float* scr, int item, int lane) {
    const int nblk = (N + 31) / 32, kb = item / nblk, nb = item % nblk, k0 = 64 * kb, n0 = 32 * nb;
    const int nn = n0 + (lane & 31); const bool nok = nn < N;
#pragma unroll
    for (int i = 0; i < 32; ++i) { const int kk = 2 * i + (lane >> 5); scr[kk * 33 + (lane & 31)] = nok ? W[(size_t)(k0 + kk) * N + nn] : 0.f; }
    LDS_WAIT(); asm volatile("" ::: "memory");
    const int c = lane & 7;
#pragma unroll
    for (int j = 0; j < 4; ++j) { const int n = (lane >> 3) + 8 * j; const LAS float* s = scr + (8 * c) * 33 + n;
        u32x4 o; o.x = pk2(s[0 * 33], s[1 * 33]); o.y = pk2(s[2 * 33], s[3 * 33]); o.z = pk2(s[4 * 33], s[5 * 33]); o.w = pk2(s[6 * 33], s[7 * 33]);
        if (n0 + n < N) *(u32x4*)(WT + (size_t)wt_row<MAP>(n0 + n) * ldk + k0 + 8 * c) = o; }
    LDS_WAIT(); asm volatile("" ::: "memory");
}

template <int MAP>
__device__ __forceinline__ void transpose_item_f8(const float* W, int K, int N, unsigned char* WT, int ldk, float sc, LAS float* scr, int item, int lane, int ldn = 0  ) {
    if (ldn == 0) ldn = N;
    const int nblk = (N + 31) / 32, kb = item / nblk, nb = item % nblk, n0 = 32 * nb;
    const int nn = n0 + (lane & 31); const bool nok = nn < N;
    const int c = lane & 7;
#pragma unroll 1
    for (int h = 0; h < 2; ++h) { const int k0 = 128 * kb + 64 * h;
#pragma unroll
        for (int i = 0; i < 32; ++i) { const int kk = 2 * i + (lane >> 5); scr[kk * 33 + (lane & 31)] = nok ? W[(size_t)(k0 + kk) * ldn + nn] * sc : 0.f; }
        LDS_WAIT(); asm volatile("" ::: "memory");
#pragma unroll
        for (int j = 0; j < 4; ++j) { const int n = (lane >> 3) + 8 * j; const LAS float* s = scr + (8 * c) * 33 + n;
            u32x2 o; o.x = pk4_fp8(s[0 * 33], s[1 * 33], s[2 * 33], s[3 * 33]); o.y = pk4_fp8(s[4 * 33], s[5 * 33], s[6 * 33], s[7 * 33]);
            if (n0 + n < N) *(u32x2*)(WT + (size_t)wt_row<MAP>(n0 + n) * ldk + k0 + 8 * c) = o; }
        LDS_WAIT(); asm volatile("" ::: "memory"); }
}
struct RopeTab { const float* c64; const float* s64; const float* c32; const float* s32; };

__device__ __forceinline__ void rope_cs(const RopeTab& R, int pos, int i, int half, float& c, float& s) {
    pos = pos < 0 ? 0 : (pos >= NPOS ? NPOS - 1 : pos);
    if (half == 32) { c = R.c64[pos * 32 + i]; s = R.s64[pos * 32 + i]; } else { c = R.c32[pos * 16 + i]; s = R.s32[pos * 16 + i]; }
}

__device__ __forceinline__ void norm_rows(const float* x, const float* g, bf16_t* HB, unsigned char* HF8, int gw, int ngw, int lane) {
    asm volatile("" : "+v"(lane));
    f32x4 gv[4];
#pragma unroll
    for (int j = 0; j < 4; ++j) gv[j] = *(const f32x4*)(g + 4 * lane + 256 * j);
    for (int tok = gw; tok < TCH; tok += ngw) {
        const float* xr = x + (size_t)tok * DM; f32x4 v[4]; float ss = 0.f;
#pragma unroll
        for (int j = 0; j < 4; ++j) { v[j] = *(const f32x4*)(xr + 4 * lane + 256 * j); ss += (v[j].x * v[j].x + v[j].y * v[j].y) + (v[j].z * v[j].z + v[j].w * v[j].w); }
        const float rstd = 1.0f / sqrtf(wave_sum(ss) * (1.0f / DM) + EPS);
        bf16_t* o = HB + (size_t)tok * DM;
#pragma unroll
        for (int j = 0; j < 4; ++j) { const float y0 = v[j].x * rstd * gv[j].x, y1 = v[j].y * rstd * gv[j].y, y2 = v[j].z * rstd * gv[j].z, y3 = v[j].w * rstd * gv[j].w;
            u32x2 w; w.x = pk2(y0, y1); w.y = pk2(y2, y3); *(u32x2*)(o + 4 * lane + 256 * j) = w;
            *(unsigned*)(HF8 + (size_t)tok * DM + 4 * lane + 256 * j) = pk4_fp8(y0, y1, y2, y3); }
    }
}

struct PP1Args {
    const bf16_t* P1; const int* pos;
    const float *aq_g, *ak_g, *cq_g, *ckv_g, *kr_g, *qc_g, *kc_g;
    unsigned char* act;
    RopeTab R;
};
constexpr float SC_A = 0.125f * LOG2E;
constexpr float SC_B = 0.10206207261596577f * LOG2E;
constexpr float SC_IW = 0.35355339059327373f * 0.17677669529663687f;
__device__ __forceinline__ void pp1_rows(const PP1Args& a, LAS unsigned char* wl  , int gw, int ngw, int lane) {
    asm volatile("" : "+v"(lane));
    const int k16 = lane & 15, g16 = lane >> 4, k8 = lane & 7, g8 = lane >> 3;
    const f32x2 gaq1 = *(const f32x2*)(a.aq_g + 2 * k16), gaq2 = *(const f32x2*)(a.aq_g + 32 + 2 * k16), gak1 = *(const f32x2*)(a.ak_g + 2 * k16), gak2 = *(const f32x2*)(a.ak_g + 32 + 2 * k16);
    const f32x2 gqc1 = *(const f32x2*)(a.qc_g + 2 * k16), gqc2 = *(const f32x2*)(a.qc_g + 32 + 2 * k16), gkc1 = *(const f32x2*)(a.kc_g + 2 * k16), gkc2 = *(const f32x2*)(a.kc_g + 32 + 2 * k16);
    const f32x2 gkr1 = *(const f32x2*)(a.kr_g + 2 * k8), gkr2 = *(const f32x2*)(a.kr_g + 16 + 2 * k8);
    u32x4 nx[4]; int npos = 0;
    if (gw < TCH) { const u32x4* src = (const u32x4*)(a.P1 + (size_t)gw * P1W);
#pragma unroll
        for (int j = 0; j < 4; ++j) nx[j] = src[lane + 64 * j];
        npos = a.pos[gw]; }
    int buf = 0;
    for (int tok = gw; tok < TCH; tok += ngw, buf ^= 1) {
        LAS unsigned char* rowb = wl + buf * 4096;
#pragma unroll
        for (int j = 0; j < 4; ++j) *(LAS u32x4*)(rowb + (lane + 64 * j) * 16) = nx[j];
        const int pos = npos;
        if (tok + ngw < TCH) { const u32x4* src = (const u32x4*)(a.P1 + (size_t)(tok + ngw) * P1W);
#pragma unroll
            for (int j = 0; j < 4; ++j) nx[j] = src[lane + 64 * j];
            npos = a.pos[tok + ngw]; }
        const LAS bf16_t* p = (const LAS bf16_t*)rowb;
        const int bl = tok / SEQ, s = tok % SEQ;
        float c64a, s64a, c64b, s64b, c32a, s32a, c32b, s32b;
        rope_cs(a.R, pos, 2 * k16, 32, c64a, s64a); rope_cs(a.R, pos, 2 * k16 + 1, 32, c64b, s64b); rope_cs(a.R, pos, 2 * k8, 16, c32a, s32a); rope_cs(a.R, pos, 2 * k8 + 1, 16, c32b, s32b);
#pragma unroll
        for (int it = 0; it < 4; ++it) {
            const int hh = 4 * it + g16;
            const int kind = hh < 4 ? 0 : (hh == 4 ? 1 : (hh < 13 ? 2 : 3));
            const int hsub = kind == 0 ? hh : (kind == 1 ? 0 : (kind == 2 ? hh - 5 : ((hh - 13) & 1)));
            const int src = (kind == 0 ? C_QA : (kind == 1 ? C_KA : (kind == 2 ? C_QC : C_KC))) + 64 * hsub;
            const size_t dbase = kind == 0 ? A_QA : (kind == 1 ? A_KA : (kind == 2 ? A_QC : A_KC));
            const int dpitch = kind == 0 ? 256 : (kind == 1 ? 64 : (kind == 2 ? 512 : 128));
            const float g1a = kind == 0 ? gaq1.x : (kind == 1 ? gak1.x : (kind == 2 ? gqc1.x : gkc1.x)), g1b = kind == 0 ? gaq1.y : (kind == 1 ? gak1.y : (kind == 2 ? gqc1.y : gkc1.y));
            const float g2a = kind == 0 ? gaq2.x : (kind == 1 ? gak2.x : (kind == 2 ? gqc2.x : gkc2.x)), g2b = kind == 0 ? gaq2.y : (kind == 1 ? gak2.y : (kind == 2 ? gqc2.y : gkc2.y));
            const float sc = (kind == 0 || kind == 2) ? SC_A : 1.f;
            bf16_t* dst = (bf16_t*)(a.act + dbase) + (size_t)tok * dpitch + 64 * hsub;
            const unsigned wA = *(const LAS unsigned*)(p + src + 2 * k16), wB = *(const LAS unsigned*)(p + src + 32 + 2 * k16);
            const float x1a = bflo(wA), x1b = bfhi(wA), x2a = bflo(wB), x2b = bfhi(wB);
            const float rstd = 1.0f / sqrtf(sum16((x1a * x1a + x1b * x1b) + (x2a * x2a + x2b * x2b)) * (1.0f / 64.0f) + EPS);
            const float y1a = x1a * rstd * g1a, y1b = x1b * rstd * g1b, y2a = x2a * rstd * g2a, y2b = x2b * rstd * g2b;
            if (hh < 15) { *(unsigned*)(dst + 2 * k16) = pk2((y1a * c64a - y2a * s64a) * sc, (y1b * c64b - y2b * s64b) * sc);
                           *(unsigned*)(dst + 32 + 2 * k16) = pk2((y2a * c64a + y1a * s64a) * sc, (y2b * c64b + y1b * s64b) * sc); }
        }
#pragma unroll
        for (int it = 0; it < 2; ++it) {
            const int hh = 8 * it + g8; const int kind = hh < 8 ? 0 : (hh == 8 ? 1 : 2);
            const int src = kind == 0 ? C_IQ + 32 * hh : (kind == 1 ? C_IK : C_KR);
            const size_t dbase = kind == 0 ? A_IQ : (kind == 1 ? A_IK : A_KR);
            bf16_t* dst = (bf16_t*)(a.act + dbase) + (size_t)tok * (kind == 0 ? 256 : 32) + (kind == 0 ? 32 * hh : 0);
            const unsigned wA = (hh < 10) ? *(const LAS unsigned*)(p + src + 2 * k8) : 0u, wB = (hh < 10) ? *(const LAS unsigned*)(p + src + 16 + 2 * k8) : 0u;
            float x1a = bflo(wA), x1b = bfhi(wA), x2a = bflo(wB), x2b = bfhi(wB);
            float ss = (x1a * x1a + x1b * x1b) + (x2a * x2a + x2b * x2b); ss += xor_lane<1>(ss); ss += xor_lane<2>(ss); ss += xor_lane<4>(ss);
            if (kind == 2) { const float rstd = 1.0f / sqrtf(ss * (1.0f / 32.0f) + EPS); x1a *= rstd * gkr1.x; x1b *= rstd * gkr1.y; x2a *= rstd * gkr2.x; x2b *= rstd * gkr2.y; }
            if (hh < 10) { *(unsigned*)(dst + 2 * k8) = pk2(x1a * c32a - x2a * s32a, x1b * c32b - x2b * s32b);
                           *(unsigned*)(dst + 16 + 2 * k8) = pk2(x2a * c32a + x1a * s32a, x2b * c32b + x1b * s32b); }
        }
        if (lane < 8) ((float*)(a.act + A_IW))[(size_t)tok * 8 + lane] = bf2f(p[C_IW + lane]) * SC_IW;
        ((bf16_t*)(a.act + A_VA))[(size_t)tok * 64 + lane] = p[C_VA + lane];
        { const u32x2 w = *(const LAS u32x2*)(p + C_CQ + 4 * lane); const float x0 = bflo(w.x), x1 = bfhi(w.x), x2 = bflo(w.y), x3 = bfhi(w.y);
          const float rstd = 1.0f / sqrtf(wave_sum((x0 * x0 + x1 * x1) + (x2 * x2 + x3 * x3)) * (1.0f / 256.0f) + EPS);
          const f32x4 g = *(const f32x4*)(a.cq_g + 4 * lane);
          u32x2 o; o.x = pk2(x0 * rstd * g.x, x1 * rstd * g.y); o.y = pk2(x2 * rstd * g.z, x3 * rstd * g.w); *(u32x2*)((bf16_t*)(a.act + A_CQN) + (size_t)tok * 256 + 4 * lane) = o; }
        { const unsigned w = *(const LAS unsigned*)(p + C_CKV + 2 * lane); const float x0 = bflo(w), x1 = bfhi(w);
          const float rstd = 1.0f / sqrtf(wave_sum(x0 * x0 + x1 * x1) * (1.0f / 128.0f) + EPS);
          const f32x2 g = *(const f32x2*)(a.ckv_g + 2 * lane);
          bf16_t* ck = (bf16_t*)(a.act + A_CKVN) + (size_t)tok * 256;
          *(unsigned*)(ck + 2 * lane) = pk2(x0 * rstd * g.x, x1 * rstd * g.y);
          *(unsigned*)(ck + 128 + 2 * lane) = 0u; }
#pragma unroll
        for (int kvh = 0; kvh < 2; ++kvh) ((bf16_t*)(a.act + A_VCT))[((size_t)(bl * 2 + kvh) * 64 + lane) * SEQ + s] = p[C_VC + 64 * kvh + lane];
    }
}

struct PP2Args {
    const bf16_t *QBR, *KVBR, *KR; const int* pos;
    const float *qn_g, *qr_g, *kn_g;
    bf16_t *QB, *KB, *VBT; RopeTab R;
};
__device__ __forceinline__ void pp2_rows(const PP2Args& a, LAS unsigned char* wl  , int gw, int ngw, int lane) {
    asm volatile("" : "+v"(lane));
    const int i32 = lane & 31, hf = lane >> 5;
    u32x4 nx[2]; unsigned nkr = 0u; int npos = 0;
    if (gw < TCH) { const u32x4* src = (const u32x4*)(a.QBR + (size_t)gw * 1024); nx[0] = src[lane]; nx[1] = src[64 + lane]; if (lane < 16) nkr = ((const unsigned*)(a.KR + (size_t)gw * 32))[lane]; npos = a.pos[gw]; }
    int buf = 0;
    for (int tok = gw; tok < TCH; tok += ngw, buf ^= 1) {
        LAS unsigned char* rowb = wl + buf * 4096;
        *(LAS u32x4*)(rowb + lane * 16) = nx[0]; *(LAS u32x4*)(rowb + (64 + lane) * 16) = nx[1]; if (lane < 16) *(LAS unsigned*)(rowb + 2048 + lane * 4) = nkr;
        const int pos = npos;
        if (tok + ngw < TCH) { const u32x4* src = (const u32x4*)(a.QBR + (size_t)(tok + ngw) * 1024); nx[0] = src[lane]; nx[1] = src[64 + lane]; if (lane < 16) nkr = ((const unsigned*)(a.KR + (size_t)(tok + ngw) * 32))[lane]; npos = a.pos[tok + ngw]; }
        const int bl = tok / SEQ, s = tok % SEQ;
        float c32 = 0.f, s32 = 0.f; if (i32 < 16) rope_cs(a.R, pos, i32, 16, c32, s32);
        const LAS bf16_t* q = (const LAS bf16_t*)rowb; const LAS bf16_t* kv = q + 512; const LAS bf16_t* krl = q + 1024;
        bf16_t* qo = a.QB + (size_t)tok * 384; bf16_t* ko = a.KB + (size_t)tok * 384;
#pragma unroll
        for (int it = 0; it < 2; ++it) {
            const int h = 2 * it + hf;
            { const float x1 = bf2f(q[h * 96 + i32]), x2 = bf2f(q[h * 96 + 32 + i32]);
              const float rstd = 1.0f / sqrtf(sum32(x1 * x1 + x2 * x2) * (1.0f / 64.0f) + EPS);
              qo[h * 96 + i32] = (bf16_t)f2bf(x1 * rstd * a.qn_g[i32] * SC_B); qo[h * 96 + 32 + i32] = (bf16_t)f2bf(x2 * rstd * a.qn_g[32 + i32] * SC_B); }
            { const bool on = i32 < 16; const float x1 = on ? bf2f(q[h * 96 + 64 + i32]) : 0.f, x2 = on ? bf2f(q[h * 96 + 80 + i32]) : 0.f;
              const float rstd = 1.0f / sqrtf(sum32(x1 * x1 + x2 * x2) * (1.0f / 32.0f) + EPS);
              const float y1 = x1 * rstd * (on ? a.qr_g[i32] : 0.f), y2 = x2 * rstd * (on ? a.qr_g[16 + i32] : 0.f);
              if (on) { qo[h * 96 + 64 + i32] = (bf16_t)f2bf((y1 * c32 - y2 * s32) * SC_B); qo[h * 96 + 80 + i32] = (bf16_t)f2bf((y2 * c32 + y1 * s32) * SC_B); } }
            { const float x1 = bf2f(kv[h * 128 + i32]), x2 = bf2f(kv[h * 128 + 32 + i32]);
              const float rstd = 1.0f / sqrtf(sum32(x1 * x1 + x2 * x2) * (1.0f / 64.0f) + EPS);
              ko[h * 96 + i32] = (bf16_t)f2bf(x1 * rstd * a.kn_g[i32]); ko[h * 96 + 32 + i32] = (bf16_t)f2bf(x2 * rstd * a.kn_g[32 + i32]);
              ko[h * 96 + 64 + i32] = krl[i32];
              a.VBT[((size_t)(bl * 4 + h) * 64 + i32) * SEQ + s] = kv[h * 128 + 64 + i32];
              a.VBT[((size_t)(bl * 4 + h) * 64 + 32 + i32) * SEQ + s] = kv[h * 128 + 96 + i32]; }
        }
    }
}

struct RouteArgs { const float* rw; int* TOPE; float* TOPG; int* TOPD; unsigned* cursor; };
template <bool ROUTE>
__device__ __forceinline__ void norm2_rows(const float* x, const float* g, bf16_t* HB, unsigned char* HF8  , const RouteArgs& ra, LAS unsigned* lcnt  , int vcu, int wave, int lane, int G) {
    asm volatile("" : "+v"(lane));
    int tidx = wave * 64 + lane;
    const int tpw = TCH / G; const int t0 = vcu * tpw;
    f32x4 gv[4];
#pragma unroll
    for (int j = 0; j < 4; ++j) gv[j] = *(const f32x4*)(g + 4 * lane + 256 * j);
    for (int tl = wave; tl < tpw; tl += NWAVES) {
        const int tok = t0 + tl;
        const float* xr = x + (size_t)tok * DM; f32x4 v[4]; float ss = 0.f;
#pragma unroll
        for (int j = 0; j < 4; ++j) { v[j] = *(const f32x4*)(xr + 4 * lane + 256 * j); ss += (v[j].x * v[j].x + v[j].y * v[j].y) + (v[j].z * v[j].z + v[j].w * v[j].w); }
        const float rstd = 1.0f / sqrtf(wave_sum(ss) * (1.0f / DM) + EPS);
        bf16_t* o = HB + (size_t)tok * DM;
#pragma unroll
        for (int j = 0; j < 4; ++j) { v[j].x *= rstd * gv[j].x; v[j].y *= rstd * gv[j].y; v[j].z *= rstd * gv[j].z; v[j].w *= rstd * gv[j].w;
            u32x2 w; w.x = pk2(v[j].x, v[j].y); w.y = pk2(v[j].z, v[j].w); *(u32x2*)(o + 4 * lane + 256 * j) = w;
            if (!ROUTE) *(unsigned*)(HF8 + (size_t)tok * DM + 4 * lane + 256 * j) = pk4_fp8(v[j].x, v[j].y, v[j].z, v[j].w); }
        if (ROUTE) {
            float lg[NEXP];
#pragma unroll
            for (int e = 0; e < NEXP; ++e) lg[e] = 0.f;
#pragma unroll
            for (int j = 0; j < 4; ++j)
#pragma unroll
                for (int c = 0; c < 4; ++c) { const float hv = v[j][c]; const float* wr = ra.rw + (size_t)(4 * lane + 256 * j + c) * NEXP;
                    const f32x4 w0 = *(const f32x4*)wr, w1 = *(const f32x4*)(wr + 4);
                    lg[0] += hv * w0.x; lg[1] += hv * w0.y; lg[2] += hv * w0.z; lg[3] += hv * w0.w; lg[4] += hv * w1.x; lg[5] += hv * w1.y; lg[6] += hv * w1.z; lg[7] += hv * w1.w; }
#pragma unroll
            for (int e = 0; e < NEXP; ++e) lg[e] = wave_sum(lg[e]);
            int e1 = 0; float l1 = lg[0];
#pragma unroll
            for (int e = 1; e < NEXP; ++e) if (lg[e] > l1) { l1 = lg[e]; e1 = e; }
            int e2 = -1; float l2 = -INFINITY;
#pragma unroll
            for (int e = 0; e < NEXP; ++e) if (e != e1 && lg[e] > l2) { l2 = lg[e]; e2 = e; }
            const float ex = __expf(l2 - l1); const float g1 = 1.0f / (1.0f + ex), g2 = ex / (1.0f + ex);
            if (lane == 0) {
                const unsigned p1 = lds_add(lcnt + e1, 1u), p2 = lds_add(lcnt + e2, 1u);
                ra.TOPE[2 * tok] = e1; ra.TOPE[2 * tok + 1] = e2; ra.TOPG[2 * tok] = g1; ra.TOPG[2 * tok + 1] = g2; ra.TOPD[2 * tok] = (int)p1; ra.TOPD[2 * tok + 1] = (int)p2;
            }
        }
    }
    if (ROUTE) {
        VM_WAIT(); __syncthreads();
        if (tidx < NEXP) { const unsigned n = lcnt[tidx]; lcnt[8 + tidx] = __hip_atomic_fetch_add(ra.cursor + tidx, n, __ATOMIC_RELAXED, __HIP_MEMORY_SCOPE_AGENT); }
        __syncthreads();
        for (int i = tidx; i < 2 * tpw; i += NWAVES * 64) { const int idx = 2 * t0 + i; const int e = ra.TOPE[idx]; ra.TOPD[idx] += (int)lcnt[8 + e]; }
        __syncthreads();
        if (tidx < 16) lcnt[tidx] = 0u;
        __syncthreads();
    }
}

__device__ __forceinline__ void moe_layout(const unsigned* cursor, int* pstart  ) {
    int acc = 0;
#pragma unroll
    for (int e = 0; e < NEXP; ++e) { pstart[e] = acc; const int c = (int)__hip_atomic_load(cursor + e, __ATOMIC_RELAXED, __HIP_MEMORY_SCOPE_AGENT); acc += (c + 255) / 256 * 256; }
    pstart[NEXP] = acc;
}
__device__ __forceinline__ void moe_scatter(const unsigned* cursor, const int* TOPE, int* TOPD, const bf16_t* HB, bf16_t* XB, int* BLKE, int gw, int ngw, int lane) {
    asm volatile("" : "+v"(lane));
    int ps[NEXP + 1]; moe_layout(cursor, ps);
    for (int i = gw; i < 2 * TCH; i += ngw) { const int e = TOPE[i];
        int base = 0;
#pragma unroll
        for (int k = 1; k < NEXP; ++k) base = (e == k) ? ps[k] : base;
        const int dest = base + TOPD[i];
        const u32x4* src = (const u32x4*)(HB + (size_t)(i >> 1) * DM); u32x4* dst = (u32x4*)((unsigned char*)XB + (size_t)dest * DM);
        const u32x4 v0 = src[2 * lane], v1 = src[2 * lane + 1];
        u32x4 o; o.x = pk4_fp8(bflo(v0.x), bfhi(v0.x), bflo(v0.y), bfhi(v0.y)); o.y = pk4_fp8(bflo(v0.z), bfhi(v0.z), bflo(v0.w), bfhi(v0.w));
        o.z = pk4_fp8(bflo(v1.x), bfhi(v1.x), bflo(v1.y), bfhi(v1.y)); o.w = pk4_fp8(bflo(v1.z), bfhi(v1.z), bflo(v1.w), bfhi(v1.w));
        dst[lane] = o;
        if (lane == 0) TOPD[i] = dest; }
#pragma unroll
    for (int e = 0; e < NEXP; ++e) { const int cnt = (int)__hip_atomic_load(cursor + e, __ATOMIC_RELAXED, __HIP_MEMORY_SCOPE_AGENT);
        for (int r = ps[e] + cnt + gw; r < ps[e + 1]; r += ngw) { u32x4* dst = (u32x4*)((unsigned char*)XB + (size_t)r * DM); dst[lane] = (u32x4){0u, 0u, 0u, 0u}; }
        for (int blk = ps[e] / 256 + gw * 64 + lane; blk < ps[e + 1] / 256; blk += ngw * 64) BLKE[blk] = e; }
}
__device__ __forceinline__ void moe_combine(float* xio, const bf16_t* YM, const int* TOPD, const float* TOPG, int gw, int ngw, int lane) {
    asm volatile("" : "+v"(lane));
    for (int tok = gw; tok < TCH; tok += ngw) {
        const int d1 = TOPD[2 * tok], d2 = TOPD[2 * tok + 1]; const float g1 = TOPG[2 * tok], g2 = TOPG[2 * tok + 1];
        float* xr = xio + (size_t)tok * DM; const bf16_t* y1 = YM + (size_t)d1 * DM; const bf16_t* y2 = YM + (size_t)d2 * DM;
#pragma unroll
        for (int j = 0; j < 4; ++j) { const int c = 4 * lane + 256 * j; f32x4 v = *(const f32x4*)(xr + c); const u32x2 a = *(const u32x2*)(y1 + c), b = *(const u32x2*)(y2 + c);
            v.x += bflo(a.x) * g1 + bflo(b.x) * g2; v.y += bfhi(a.x) * g1 + bfhi(b.x) * g2; v.z += bflo(a.y) * g1 + bflo(b.y) * g2; v.w += bfhi(a.y) * g1 + bfhi(b.y) * g2;
            *(f32x4*)(xr + c) = v; }
    }
}

__device__ __forceinline__ int kappa32(int m) { return (m & ~12) | ((m & 8) >> 1) | ((m & 4) << 1); }
template <int DQK>
__device__ __forceinline__ void fa_unit(LAS unsigned char* lds, int wave_, const bf16_t* Qw, int qpitch, const bf16_t* Kb, int kpitch, const bf16_t* VTb,
                                        int tile_lo, int tile_hi, int qpos0w, int window, float m_init, float l_init, bf16_t* Ow, int opitch) {
    constexpr int KP = DQK * 2 + 16, VP = 144, KBUF = 64 * KP, VBUF = 64 * VP, KCH = DQK / 8, NKC = 64 * KCH;
    int tid = wave_ * 64 + lane_id(); asm volatile("" : "+v"(tid));
    const int lane = tid & 63, r32 = lane & 31, hi = lane >> 5;
    bf16x8 qf[DQK / 16];
#pragma unroll
    for (int d0 = 0; d0 < DQK / 16; ++d0) qf[d0] = *(const bf16x8*)(Qw + (size_t)r32 * qpitch + d0 * 16 + hi * 8);
    const int kr0 = tid / KCH, kc0 = tid % KCH, kr1 = (tid + 512) / KCH, kc1 = (tid + 512) % KCH; const bool has1 = (tid + 512) < NKC;
    const int vr = tid >> 3, vc = tid & 7;
    u32x4 pk0, pk1 = (u32x4){0u, 0u, 0u, 0u}, pv;
#define FA_LOAD(t) do { const bf16_t* kt_ = Kb + (size_t)(64 * (t)) * kpitch; pk0 = *(const u32x4*)(kt_ + (size_t)kr0 * kpitch + kc0 * 8); if (has1) pk1 = *(const u32x4*)(kt_ + (size_t)kr1 * kpitch + kc1 * 8); \
        pv = *(const u32x4*)(VTb + (size_t)vr * SEQ + 64 * (t) + vc * 8); } while (0)
#define FA_STORE(b) do { LAS unsigned char* kd_ = lds + (b) * KBUF; *(LAS u32x4*)(kd_ + kr0 * KP + kc0 * 16) = pk0; if (has1) *(LAS u32x4*)(kd_ + kr1 * KP + kc1 * 16) = pk1; \
        *(LAS u32x4*)(lds + 2 * KBUF + (b) * VBUF + vr * VP + vc * 16) = pv; } while (0)
    float m_run = m_init, l_run = (hi == 0) ? l_init : 0.f;
    f32x16 o0, o1;
#pragma unroll
    for (int i = 0; i < 16; ++i) { o0[i] = 0.f; o1[i] = 0.f; }
    const int qpos = qpos0w + r32; const int krow = kappa32(r32);
    __syncthreads();
    FA_LOAD(tile_lo); FA_STORE(0);
    __syncthreads();
    for (int t = tile_lo; t < tile_hi; ++t) {
        const int buf = (t - tile_lo) & 1;
        if (t + 1 < tile_hi) FA_LOAD(t + 1);
        const int kbase = 64 * t;
        const bool active = (kbase <= qpos0w + 31) && (window == 0 || kbase + 63 > qpos0w - window);
        if (active) {
            const LAS unsigned char* Kt = lds + buf * KBUF; const LAS unsigned char* Vt = lds + 2 * KBUF + buf * VBUF;
            f32x16 s0, s1;
#pragma unroll
            for (int i = 0; i < 16; ++i) { s0[i] = 0.f; s1[i] = 0.f; }
#pragma unroll
            for (int d0 = 0; d0 < DQK / 16; ++d0) {
                const bf16x8 k0 = *(const LAS bf16x8*)(Kt + krow * KP + d0 * 32 + hi * 16);
                const bf16x8 k1 = *(const LAS bf16x8*)(Kt + (32 + krow) * KP + d0 * 32 + hi * 16);
                s0 = __builtin_amdgcn_mfma_f32_32x32x16_bf16(k0, qf[d0], s0, 0, 0, 0);
                s1 = __builtin_amdgcn_mfma_f32_32x32x16_bf16(k1, qf[d0], s1, 0, 0, 0);
            }
            const bool need_mask = (kbase + 63 > qpos0w) || (window != 0 && kbase <= qpos0w + 31 - window);
            if (need_mask) {
#pragma unroll
                for (int i = 0; i < 16; ++i) { const int key = kbase + 16 * (i >> 3) + 8 * hi + (i & 7);
                    const bool ok0 = (key <= qpos) && (window == 0 || key > qpos - window), ok1 = (key + 32 <= qpos) && (window == 0 || key + 32 > qpos - window);
                    s0[i] = ok0 ? s0[i] : -INFINITY; s1[i] = ok1 ? s1[i] : -INFINITY; }
            }
            float mx0 = max3_(s0[0], s0[1], s0[2]), mx1 = max3_(s0[3], s0[4], s0[5]), mx2 = max3_(s0[6], s0[7], s0[8]), mx3 = max3_(s0[9], s0[10], s0[11]);
            mx0 = max3_(mx0, s0[12], s0[13]); mx1 = max3_(mx1, s0[14], s0[15]); mx2 = max3_(mx2, s1[0], s1[1]); mx3 = max3_(mx3, s1[2], s1[3]);
            mx0 = max3_(mx0, s1[4], s1[5]); mx1 = max3_(mx1, s1[6], s1[7]); mx2 = max3_(mx2, s1[8], s1[9]); mx3 = max3_(mx3, s1[10], s1[11]);
            mx0 = max3_(mx0, s1[12], s1[13]); mx1 = max3_(mx1, s1[14], s1[15]);
            float mx = max3_(max3_(mx0, mx1, mx2), mx3, m_run);
            { const auto rr = __builtin_amdgcn_permlane32_swap(__float_as_uint(mx), __float_as_uint(mx), false, false); mx = max3_(__uint_as_float(rr[0]), __uint_as_float(rr[1]), mx); }
            const float m_new = mx; const float m_use = (m_new == -INFINITY) ? 0.f : m_new;
            const float alpha = fast_exp2(m_run - m_use);
            m_run = m_new;
            const f32x2 mm = (f32x2){m_use, m_use}; f32x2 rs2 = (f32x2){0.f, 0.f};
#pragma unroll
            for (int i = 0; i < 8; ++i) {
                f32x2 d0 = (f32x2){s0[2 * i], s0[2 * i + 1]} - mm, d1 = (f32x2){s1[2 * i], s1[2 * i + 1]} - mm;
                d0.x = fast_exp2(d0.x); d0.y = fast_exp2(d0.y); d1.x = fast_exp2(d1.x); d1.y = fast_exp2(d1.y);
                rs2 += d0; rs2 += d1;
                s0[2 * i] = d0.x; s0[2 * i + 1] = d0.y; s1[2 * i] = d1.x; s1[2 * i + 1] = d1.y; }
            const float rs = rs2.x + rs2.y;
            l_run = l_run * alpha + rs;
#pragma unroll
            for (int i = 0; i < 16; ++i) { o0[i] *= alpha; o1[i] *= alpha; }
            u32x4 w0, w1, w2, w3;
            w0.x = cvt_pk_bf16(s0[0], s0[1]); w0.y = cvt_pk_bf16(s0[2], s0[3]); w0.z = cvt_pk_bf16(s0[4], s0[5]); w0.w = cvt_pk_bf16(s0[6], s0[7]);
            w1.x = cvt_pk_bf16(s0[8], s0[9]); w1.y = cvt_pk_bf16(s0[10], s0[11]); w1.z = cvt_pk_bf16(s0[12], s0[13]); w1.w = cvt_pk_bf16(s0[14], s0[15]);
            w2.x = cvt_pk_bf16(s1[0], s1[1]); w2.y = cvt_pk_bf16(s1[2], s1[3]); w2.z = cvt_pk_bf16(s1[4], s1[5]); w2.w = cvt_pk_bf16(s1[6], s1[7]);
            w3.x = cvt_pk_bf16(s1[8], s1[9]); w3.y = cvt_pk_bf16(s1[10], s1[11]); w3.z = cvt_pk_bf16(s1[12], s1[13]); w3.w = cvt_pk_bf16(s1[14], s1[15]);
            const bf16x8 pa0 = __builtin_bit_cast(bf16x8, w0), pa1 = __builtin_bit_cast(bf16x8, w1), pa2 = __builtin_bit_cast(bf16x8, w2), pa3 = __builtin_bit_cast(bf16x8, w3);
#define FA_PV(o, dt) do { const LAS unsigned char* vrow_ = Vt + (32 * (dt) + r32) * VP + hi * 16; \
                o = __builtin_amdgcn_mfma_f32_32x32x16_bf16(*(const LAS bf16x8*)(vrow_), pa0, o, 0, 0, 0); o = __builtin_amdgcn_mfma_f32_32x32x16_bf16(*(const LAS bf16x8*)(vrow_ + 32), pa1, o, 0, 0, 0); \
                o = __builtin_amdgcn_mfma_f32_32x32x16_bf16(*(const LAS bf16x8*)(vrow_ + 64), pa2, o, 0, 0, 0); o = __builtin_amdgcn_mfma_f32_32x32x16_bf16(*(const LAS bf16x8*)(vrow_ + 96), pa3, o, 0, 0, 0); } while (0)
            FA_PV(o0, 0); FA_PV(o1, 1);
#undef FA_PV
        }
        if (t + 1 < tile_hi) FA_STORE(buf ^ 1);
        __syncthreads();
    }
#undef FA_LOAD
#undef FA_STORE
    const float l_tot = half_sum(l_run); const float inv = 1.0f / l_tot;
    bf16_t* orow = Ow + (size_t)r32 * opitch + 4 * hi;
#pragma unroll
    for (int g = 0; g < 4; ++g) {
        u32x2 a; a.x = cvt_pk_bf16(o0[4 * g] * inv, o0[4 * g + 1] * inv); a.y = cvt_pk_bf16(o0[4 * g + 2] * inv, o0[4 * g + 3] * inv); *(u32x2*)(orow + 8 * g) = a;
        u32x2 b; b.x = cvt_pk_bf16(o1[4 * g] * inv, o1[4 * g + 1] * inv); b.y = cvt_pk_bf16(o1[4 * g + 2] * inv, o1[4 * g + 3] * inv); *(u32x2*)(orow + 32 + 8 * g) = b;
    }
}

struct IdxArgs { const bf16_t* IQ; const bf16_t* IK; const float* IW; unsigned short* SEL; int* SELN; };
__device__ __forceinline__ unsigned mono_key(float f) { const unsigned u = __float_as_uint(f); return u ^ ((unsigned)((int)u >> 31) | 0x80000000u); }
__device__ __forceinline__ int crow32(int i, int hi) { return (i & 3) + 8 * (i >> 2) + 4 * hi; }

#ifndef MK_SC2
#define MK_SC2 0
#endif
constexpr int IDX_QP = 656;
__device__ __forceinline__ void idx_scores(f32x16& sc, const LAS unsigned char* qrow  , const float (&c)[8], const bf16x8 ka0, const bf16x8 ka1) {
    f32x16 z[8], zero;
#pragma unroll
    for (int i = 0; i < 16; ++i) zero[i] = 0.f;
#define IDX_F(slot, ks) (*(const LAS bf16x8*)(qrow + (slot) * 64 + (ks) * 32))
    bf16x8 f0 = IDX_F(8, 0), f1 = IDX_F(0, 0);
    sc = __builtin_amdgcn_mfma_f32_32x32x16_bf16(ka0, f0, zero, 0, 0, 0); f0 = IDX_F(1, 0);
#pragma unroll
    for (int h = 0; h < 8; h += 2) {
        z[h] = __builtin_amdgcn_mfma_f32_32x32x16_bf16(ka0, f1, zero, 0, 0, 0); f1 = (h + 2 < 8) ? IDX_F(h + 2, 0) : IDX_F(9, 0);
        z[h + 1] = __builtin_amdgcn_mfma_f32_32x32x16_bf16(ka0, f0, zero, 0, 0, 0); f0 = (h + 3 < 8) ? IDX_F(h + 3, 0) : IDX_F(8, 1);
    }
    sc = __builtin_amdgcn_mfma_f32_32x32x16_bf16(ka0, f1, sc, 0, 0, 0); f1 = IDX_F(0, 1);
    sc = __builtin_amdgcn_mfma_f32_32x32x16_bf16(ka1, f0, sc, 0, 0, 0); f0 = IDX_F(1, 1);
#pragma unroll
    for (int h = 0; h < 8; h += 2) {
        z[h] = __builtin_amdgcn_mfma_f32_32x32x16_bf16(ka1, f1, z[h], 0, 0, 0); f1 = (h + 2 < 8) ? IDX_F(h + 2, 1) : IDX_F(9, 1);
        z[h + 1] = __builtin_amdgcn_mfma_f32_32x32x16_bf16(ka1, f0, z[h + 1], 0, 0, 0); if (h + 3 < 8) f0 = IDX_F(h + 3, 1);
    }
    sc = __builtin_amdgcn_mfma_f32_32x32x16_bf16(ka1, f1, sc, 0, 0, 0);
#undef IDX_F
#pragma unroll
    for (int h = 0; h < 8; ++h)
#pragma unroll
        for (int i = 0; i < 16; ++i) sc[i] = __builtin_fmaf(__builtin_fabsf(z[h][i]), c[h], sc[i]);
}
#define IDX_LOADK(k0, k1, tile_) do { const bf16_t* ikt_ = ikb + (size_t)(tile_) * 32 * 32; k0 = *(const bf16x8*)(ikt_ + r32 * 32 + hi * 8); k1 = *(const bf16x8*)(ikt_ + r32 * 32 + 16 + hi * 8); } while (0)
template <int WPL>
__device__ __forceinline__ bool hist_scan(const LAS unsigned* hw, int lane, unsigned need, int& bin, unsigned& above, unsigned& nb) {
    asm volatile("" : "+v"(lane));
    unsigned w[WPL]; unsigned tot = 0;
#pragma unroll
    for (int i = 0; i < WPL; i += 4) { const u32x4 v = *(const LAS u32x4*)(hw + WPL * lane + i); w[i] = v.x; w[i + 1] = v.y; w[i + 2] = v.z; w[i + 3] = v.w; }
#pragma unroll
    for (int i = 0; i < WPL; ++i) tot += (w[i] & 0xffffu) + (w[i] >> 16);
    unsigned suf = tot;
#pragma unroll
    for (int d = 1; d < 64; d <<= 1) { const unsigned t = (unsigned)lane_get((int)suf, (lane + d) & 63); if (lane + d < 64) suf += t; }
    const unsigned total = (unsigned)lane_bcast((int)suf, 0);
    if (total < need) { above = total; return false; }
    const unsigned ab = suf - tot;
    const bool mine = (ab < need) && (need <= suf);
    int b_ = 0; unsigned a_ = 0, n_ = 0;
    if (mine) { unsigned acc = ab; bool done = false;
#pragma unroll
        for (int i = WPL - 1; i >= 0; --i) {
            const unsigned chi = w[i] >> 16, clo = w[i] & 0xffffu;
            if (!done && acc + chi >= need) { done = true; b_ = 2 * (WPL * lane + i) + 1; a_ = acc; n_ = chi; } if (!done) acc += chi;
            if (!done && acc + clo >= need) { done = true; b_ = 2 * (WPL * lane + i); a_ = acc; n_ = clo; } if (!done) acc += clo; } }
    const unsigned long long bal = __ballot(mine); const int src = __ffsll((long long)bal) - 1;
    bin = lane_bcast(b_, src); above = (unsigned)lane_bcast((int)a_, src); nb = (unsigned)lane_bcast((int)n_, src);
    return true;
}
template <int P>
__device__ __forceinline__ void idx_hist_tiles(LAS unsigned* hrow, const LAS unsigned char* qrow, const float (&w)[8], const bf16_t* ikb, int wid, int ntile, int qpos, int r32, int hi, bool mine, unsigned pfx) {
    bf16x8 kb[4][2];
#pragma unroll
    for (int u = 0; u < 4; ++u) if (wid + 8 * u < ntile) IDX_LOADK(kb[u][0], kb[u][1], wid + 8 * u);
#pragma unroll 1
    for (int base = wid; base < ntile; base += 32) {
#pragma unroll
        for (int u = 0; u < 4; ++u) { const int tile = base + 8 * u; if (tile < ntile) {
            const bf16x8 ka0 = kb[u][0], ka1 = kb[u][1];
            f32x16 sc; idx_scores(sc, qrow, w, ka0, ka1);
            if (tile + 32 < ntile) IDX_LOADK(kb[u][0], kb[u][1], tile + 32);
            const int lim = (tile == ntile - 1) ? qpos - 32 * tile : 64;
#pragma unroll
            for (int i = 0; i < 16; ++i) {
                bool ok = mine && (crow32(i, hi) <= lim); unsigned bin;
                if (P == 0) { bin = mono_key(sc[i]) >> 21; }
                else { const unsigned k = mono_key(sc[i]);
                    if (P == 1) { ok = false; bin = 0u; }
                    else if (P == 2) { ok = ok && ((k >> 21) == pfx); bin = (k >> 10) & 2047u; }
                    else { ok = ok && ((k >> 10) == pfx); bin = k & 1023u; } }
                if (ok) lds_add(hrow + (bin >> 1), 1u << (16 * (bin & 1u))); }
            __builtin_amdgcn_sched_barrier(0);
        } }
    }
}
__device__ __forceinline__ void idx_unit(LAS unsigned char* lds, int wave_, const IdxArgs& a, int rowb  , int qb32) {
    int tid = wave_ * 64 + lane_id(); asm volatile("" : "+v"(tid));
    const int lane = tid & 63, wid = wave_, r32 = lane & 31, hi = lane >> 5;
    const int q0 = 32 * qb32, ntile = qb32 + 1, qpos = q0 + r32;
    LAS unsigned* hist = (LAS unsigned*)(lds + IDX_HIST);
    LAS unsigned* bitmap = (LAS unsigned*)(lds + IDX_BITMAP);
    LAS unsigned* candk = (LAS unsigned*)(lds + IDX_CANDK);
    LAS unsigned short* candi = (LAS unsigned short*)(lds + IDX_CANDI);
    LAS unsigned* subh = (LAS unsigned*)(lds + IDX_SUBH) + wid * 512;
    LAS unsigned* qpar = (LAS unsigned*)(lds + IDX_QPAR);
    LAS unsigned* ccnt = (LAS unsigned*)(lds + IDX_CCNT);
    LAS unsigned* flag = (LAS unsigned*)(lds + IDX_FLAG);
    if (q0 + 32 <= 256) {
        __syncthreads();
        for (int q = wid; q < 32; q += NWAVES) { const int t = q0 + q; unsigned short* sp = a.SEL + (size_t)(rowb + t) * 256;
#pragma unroll
            for (int j = 0; j < 4; ++j) { const int k = lane + 64 * j; sp[k] = (unsigned short)(k <= t ? k : 0); }
            if (lane == 0) a.SELN[rowb + t] = t + 1; }
        return;
    }
    float w[8];
#pragma unroll
    for (int h = 0; h < 8; ++h) w[h] = 0.5f * a.IW[(size_t)(rowb + qpos) * 8 + h];
    const LAS unsigned char* qrow = lds + IDX_QT + r32 * IDX_QP + hi * 16;
    const bf16_t* ikb = a.IK + (size_t)rowb * 32;
    __syncthreads();
#pragma unroll
    for (int i = 0; i < 2; ++i) { const int c = tid + 512 * i, row = c >> 5, c16 = c & 31;
        *(LAS u32x4*)(lds + IDX_QT + row * IDX_QP + c16 * 16) = *(const u32x4*)(a.IQ + (size_t)(rowb + q0 + row) * 256 + c16 * 8); }
    __syncthreads();
    { const int q = tid >> 4, d2 = (tid & 15) * 2; const float* wq = a.IW + (size_t)(rowb + q0 + q) * 8; float s0 = 0.f, s1 = 0.f;
#pragma unroll
      for (int h = 0; h < 8; ++h) { const unsigned pr = *(const LAS unsigned*)(lds + IDX_QT + q * IDX_QP + h * 64 + d2 * 2); const float wh = 0.5f * wq[h]; s0 += wh * bflo(pr); s1 += wh * bfhi(pr); }
      const unsigned h0 = f2bf(s0), h1 = f2bf(s1); const float r0 = s0 - bf2f((bf16_t)h0), r1 = s1 - bf2f((bf16_t)h1);
      *(LAS unsigned*)(lds + IDX_QT + q * IDX_QP + 8 * 64 + d2 * 2) = h0 | (h1 << 16);
      *(LAS unsigned*)(lds + IDX_QT + q * IDX_QP + 9 * 64 + d2 * 2) = pk2(r0, r1); }
    if (tid < 256) { const int q = tid >> 3, f = tid & 7; const bool all = (q0 + q + 1 <= 256); qpar[tid] = (f == 0) ? (all ? 2u : 0u) : ((f == 2) ? 256u : 0u); }
    if (tid < 32) ccnt[tid] = 0u;
    if (tid < 8) flag[tid] = (tid == 0) ? 1u : 0u;
#pragma unroll 1
    for (int p = 0; p < 4; ++p) {
        __syncthreads();
        if (flag[p] == 0u) continue;
        for (int i = tid; i < 32 * IDX_HP / 4; i += NWAVES * 64) ((LAS u32x4*)hist)[i] = (u32x4){0u, 0u, 0u, 0u};
        __syncthreads();
        const bool mine = (qpar[8 * r32] == 0u) && (qpar[8 * r32 + 4] == (unsigned)p); const unsigned pfx = qpar[8 * r32 + 1];
        TB(1);
        if (__any(mine)) {
            LAS unsigned* hrow = hist + r32 * IDX_HP;
            if (p == 0) idx_hist_tiles<0>(hrow, qrow, w, ikb, wid, ntile, qpos, r32, hi, mine, pfx);
            else if (p == 1) idx_hist_tiles<1>(hrow, qrow, w, ikb, wid, ntile, qpos, r32, hi, mine, pfx);
            else if (p == 2) idx_hist_tiles<2>(hrow, qrow, w, ikb, wid, ntile, qpos, r32, hi, mine, pfx);
            else idx_hist_tiles<3>(hrow, qrow, w, ikb, wid, ntile, qpos, r32, hi, mine, pfx);
        }
        TE(1);
        __syncthreads();
        TB(2);
        for (int j = 0; j < 4; ++j) { const int q = 4 * wid + j; const unsigned qs = qpar[8 * q], need = qpar[8 * q + 2], qp = qpar[8 * q + 1];
            if (qs != 0u || qpar[8 * q + 4] != (unsigned)p) continue;
            int bin; unsigned above, nb; const bool found = hist_scan<16>(hist + q * IDX_HP, lane, need, bin, above, nb);
            if (lane == 0) {
                if (!found) { if (false) { }
                              else { qpar[8 * q] = 2u; qpar[8 * q + 2] = 0u; } }
                else { const unsigned np = (p == 0) ? (unsigned)bin : (p == 2 ? ((qp << 11) | (unsigned)bin) : ((qp << 10) | (unsigned)bin));
                    qpar[8 * q + 1] = np; qpar[8 * q + 2] = need - above; qpar[8 * q + 3] = (p <= 1) ? 21u : (p == 2 ? 10u : 0u);
                    const unsigned shn = (p <= 1) ? 21u : (p == 2 ? 10u : 0u); const unsigned klo = np << shn; const unsigned long long khi = ((unsigned long long)np + 1ull) << shn;
                    qpar[8 * q + 5] = (klo & 0x80000000u) ? (klo ^ 0x80000000u) : ~klo;
                    qpar[8 * q + 6] = (khi >> 32) ? 0x7f800000u : (((unsigned)khi & 0x80000000u) ? ((unsigned)khi ^ 0x80000000u) : ~(unsigned)khi);
                    if (nb <= (unsigned)IDX_CCAP || p == 3) qpar[8 * q] = 1u; else { const unsigned nx = (p <= 1) ? 2u : 3u; qpar[8 * q + 4] = nx; flag[nx] = 1u; } } }
        }
        TE(2);
    }
    __syncthreads();
    for (int i = tid; i < 32 * 256 / 4; i += NWAVES * 64) ((LAS u32x4*)bitmap)[i] = (u32x4){0u, 0u, 0u, 0u};
    __syncthreads();
    TB(3);
    { const unsigned st = qpar[8 * r32]; const float tcand = (st == 2u) ? -INFINITY : __uint_as_float(qpar[8 * r32 + 5]), tsel = (st == 2u) ? -INFINITY : __uint_as_float(qpar[8 * r32 + 6]);
      bf16x8 kb[4][2];
#pragma unroll
      for (int u = 0; u < 4; ++u) if (wid + 8 * u < ntile) IDX_LOADK(kb[u][0], kb[u][1], wid + 8 * u);
#pragma unroll 1
      for (int base = wid; base < ntile; base += 32) {
#pragma unroll
          for (int u = 0; u < 4; ++u) { const int tile = base + 8 * u; if (tile < ntile) {
              const bf16x8 ka0 = kb[u][0], ka1 = kb[u][1];
              f32x16 sc; idx_scores(sc, qrow, w, ka0, ka1);
#if MK_SC2
              asm volatile("" : "+v"(sc)); { bf16x8 kx0 = ka0, kx1 = ka1; asm volatile("" : "+v"(kx0), "+v"(kx1)); idx_scores(sc, qrow, w, kx0, kx1); asm volatile("" : "+v"(sc)); }
#endif
              if (tile + 32 < ntile) IDX_LOADK(kb[u][0], kb[u][1], tile + 32);
              const int lim = (tile == ntile - 1) ? qpos - 32 * tile : 64;
#pragma unroll
              for (int i = 0; i < 16; ++i) {
                  if (sc[i] >= tcand && crow32(i, hi) <= lim) { const int key = 32 * tile + crow32(i, hi);
                      if (sc[i] >= tsel) lds_or(bitmap + r32 * 256 + (key >> 5), 1u << (key & 31));
                      else { const unsigned pos = lds_add(ccnt + r32, 1u); if (pos < (unsigned)IDX_CCAP) { candk[r32 * IDX_CCAP + pos] = mono_key(sc[i]); candi[r32 * IDX_CCAP + pos] = (unsigned short)key; } } } }
              __builtin_amdgcn_sched_barrier(0);
          } }
      } }
    TE(3);
    __syncthreads();
    TB(4);
    for (int j = 0; j < 4; ++j) {
        const int q = 4 * wid + j; const unsigned st = qpar[8 * q]; unsigned need = qpar[8 * q + 2]; const unsigned sh = qpar[8 * q + 3];
        const int nc = (st == 1u) ? (int)min(ccnt[q], (unsigned)IDX_CCAP) : 0;
        LAS unsigned* bm = bitmap + q * 256; const LAS unsigned* ck = candk + q * IDX_CCAP; const LAS unsigned short* ci = candi + q * IDX_CCAP;
        if (nc > 0) {
            if ((unsigned)nc <= need) { for (int c = lane; c < nc; c += 64) { const unsigned key = ci[c]; lds_or(bm + (key >> 5), 1u << (key & 31)); } }
            else {
                int nR = 0; LAS unsigned long long* R = (LAS unsigned long long*)subh;
                if (sh > 0u) {
                    const int nbit = sh >= 10u ? 10 : (int)sh, fs = (int)sh - nbit; const unsigned smask = (1u << nbit) - 1u;
#pragma unroll
                    for (int i = 0; i < 8; ++i) subh[8 * lane + i] = 0u;
                    LDS_WAIT();
                    for (int c = lane; c < nc; c += 64) { const unsigned sub = (ck[c] >> fs) & smask; lds_add(subh + (sub >> 1), 1u << (16 * (sub & 1u))); }
                    LDS_WAIT();
                    int b2; unsigned ab2, nb2; (void)hist_scan<8>(subh, lane, need, b2, ab2, nb2);
                    need -= ab2; LDS_WAIT();
                    for (int c0 = 0; c0 < nc; c0 += 64) { const int c = c0 + lane; bool inb = false; unsigned k = 0, key = 0;
                        if (c < nc) { k = ck[c]; key = ci[c]; const int sub = (int)((k >> fs) & smask); if (sub > b2) lds_or(bm + (key >> 5), 1u << (key & 31)); inb = (sub == b2); }
                        const unsigned long long bal = __ballot(inb); const int pos = nR + __popcll(bal & ((1ull << lane) - 1ull));
                        if (inb && pos < IDX_RCAP) R[pos] = ((unsigned long long)k << 13) | (unsigned long long)(8191u - key);
                        nR += __popcll(bal); }
                } else {
                    for (int c0 = 0; c0 < nc; c0 += 64) { const int c = c0 + lane; if (c < nc && c < IDX_RCAP) R[c] = ((unsigned long long)ck[c] << 13) | (unsigned long long)(8191u - ci[c]); }
                    nR = nc;
                }
                nR = min(nR, IDX_RCAP); LDS_WAIT();
                for (int r = lane; r < nR; r += 64) { const unsigned long long me = R[r]; unsigned better = 0;
                    for (int x = 0; x < nR; ++x) better += (R[x] > me) ? 1u : 0u;
                    if (better < need) { const unsigned key = 8191u - (unsigned)(me & 8191ull); lds_or(bm + (key >> 5), 1u << (key & 31)); } }
            }
        }
        LDS_WAIT();
        { const u32x4 bw = *(const LAS u32x4*)(bm + 4 * lane); unsigned wv[4] = {bw.x, bw.y, bw.z, bw.w};
          const int mycnt = __popc(wv[0]) + __popc(wv[1]) + __popc(wv[2]) + __popc(wv[3]);
          int pre = mycnt;
#pragma unroll
          for (int d = 1; d < 64; d <<= 1) { const int t = lane_get(pre, (lane - d) & 63); if (lane >= d) pre += t; }
          const int total = lane_bcast(pre, 63); int pos = pre - mycnt;
          unsigned short* sp = a.SEL + (size_t)(rowb + q0 + q) * 256;
#pragma unroll
          for (int wi = 0; wi < 4; ++wi) { unsigned m = wv[wi]; while (m) { const int b = __ffs((int)m) - 1; m &= m - 1u; if (pos < 256) sp[pos] = (unsigned short)(32 * (4 * lane + wi) + b); ++pos; } }
          if (lane == 0) a.SELN[rowb + q0 + q] = min(total, 256); }
        LDS_WAIT();
    }
    TE(4);
}

#undef IDX_LOADK
struct SpaArgs { const bf16_t* QA; const bf16_t* KA; const bf16_t* VA; const unsigned short* SEL; const int* SELN; bf16_t* Y; };
struct SpaPre { int nv[2]; u32x2 s4[2]; };
__device__ __forceinline__ void sparse_prefetch(SpaPre& P, const SpaArgs& a, int rowA, int rowB, int lane) {
    const int row[2] = {rowA, rowB};
#pragma unroll
    for (int q = 0; q < 2; ++q) { P.nv[q] = a.SELN[row[q]]; P.s4[q] = *(const u32x2*)(a.SEL + (size_t)row[q] * 256 + 4 * lane); }
}
__device__ __forceinline__ void sparse_pair(LAS unsigned char* wl, const SpaArgs& a, const SpaPre& P, int rowbA, int tA, int rowbB, int tB, int lane) {
    const int rowb[2] = {rowbA, rowbB}; const int row[2] = {rowbA + tA, rowbB + tB};
    LAS float* lg[2]; LAS unsigned short* sl[2]; int nv[2];
#pragma unroll
    for (int q = 0; q < 2; ++q) { lg[q] = (LAS float*)(wl + q * 8192); sl[q] = (LAS unsigned short*)(wl + q * 8192 + 4096); nv[q] = P.nv[q]; *(LAS u32x2*)(sl[q] + 4 * lane) = P.s4[q]; }
    LDS_WAIT();
    const int m16 = lane & 15, kq = lane >> 4;
    bf16x8 qf0[2], qf1[2];
#pragma unroll
    for (int q = 0; q < 2; ++q) { qf0[q] = (bf16x8){0, 0, 0, 0, 0, 0, 0, 0}; qf1[q] = qf0[q];
        if (m16 < 4) { const bf16_t* qp = a.QA + (size_t)row[q] * 256 + m16 * 64 + kq * 8; qf0[q] = *(const bf16x8*)qp; qf1[q] = *(const bf16x8*)(qp + 32); } }
#pragma unroll
    for (int tile = 0; tile < 16; ++tile)
#pragma unroll
        for (int q = 0; q < 2; ++q) {
            const int j = 16 * tile + m16; const int s = (j < nv[q]) ? (int)sl[q][j] : 0;
            const bf16_t* kp = a.KA + (size_t)(rowb[q] + s) * 64 + kq * 8;
            const bf16x8 k0 = *(const bf16x8*)kp, k1 = *(const bf16x8*)(kp + 32);
            f32x4 acc = (f32x4){0.f, 0.f, 0.f, 0.f};
            acc = __builtin_amdgcn_mfma_f32_16x16x32_bf16(qf0[q], k0, acc, 0, 0, 0);
            acc = __builtin_amdgcn_mfma_f32_16x16x32_bf16(qf1[q], k1, acc, 0, 0, 0);
            if (kq == 0) { const bool ok = j < nv[q]; f32x4 v; v.x = ok ? acc.x : -INFINITY; v.y = ok ? acc.y : -INFINITY; v.z = ok ? acc.z : -INFINITY; v.w = ok ? acc.w : -INFINITY; *(LAS f32x4*)(lg[q] + 4 * j) = v; }
        }
    LDS_WAIT();
    const int h = lane >> 4; float sm[2];
#pragma unroll
    for (int q = 0; q < 2; ++q) { float pv[16]; float mx = -INFINITY;
#pragma unroll
        for (int i = 0; i < 16; ++i) { pv[i] = lg[q][4 * (m16 + 16 * i) + h]; mx = fmaxf(mx, pv[i]); }
        mx = max16(mx);
        float s_ = 0.f;
#pragma unroll
        for (int i = 0; i < 16; ++i) { pv[i] = fast_exp2(pv[i] - mx); s_ += pv[i]; }
        sm[q] = sum16(s_);
#pragma unroll
        for (int i = 0; i < 16; ++i) lg[q][4 * (m16 + 16 * i) + h] = pv[i]; }
    LDS_WAIT();
    const int g = lane >> 3, c8 = lane & 7;
    float acc[2][4][8];
#pragma unroll
    for (int q = 0; q < 2; ++q)
#pragma unroll
        for (int h4 = 0; h4 < 4; ++h4)
#pragma unroll
            for (int c = 0; c < 8; ++c) acc[q][h4][c] = 0.f;
    const int nvm = nv[0] > nv[1] ? nv[0] : nv[1]; const int nit = (nvm + 7) >> 3;
#pragma unroll 8
    for (int it = 0; it < nit; ++it)
#pragma unroll
        for (int q = 0; q < 2; ++q) {
            const int j = 8 * it + g; const int srow = (j < nv[q]) ? (int)sl[q][j] : 0;
            const u32x4 v = *(const u32x4*)(a.VA + (size_t)(rowb[q] + srow) * 64 + c8 * 8);
            const f32x4 p = *(const LAS f32x4*)(lg[q] + 4 * j);
            const float vv[8] = {bflo(v.x), bfhi(v.x), bflo(v.y), bfhi(v.y), bflo(v.z), bfhi(v.z), bflo(v.w), bfhi(v.w)};
#pragma unroll
            for (int c = 0; c < 8; ++c) { acc[q][0][c] += p.x * vv[c]; acc[q][1][c] += p.y * vv[c]; acc[q][2][c] += p.z * vv[c]; acc[q][3][c] += p.w * vv[c]; }
        }
    LDS_WAIT();
#pragma unroll
    for (int q = 0; q < 2; ++q) {
        const float l0 = __int_as_float(lane_bcast(__float_as_int(sm[q]), 0)), l1 = __int_as_float(lane_bcast(__float_as_int(sm[q]), 16)), l2 = __int_as_float(lane_bcast(__float_as_int(sm[q]), 32)), l3 = __int_as_float(lane_bcast(__float_as_int(sm[q]), 48));
        LAS float* red = (LAS float*)(wl + q * 8192);
#pragma unroll
        for (int h4 = 0; h4 < 4; ++h4) { *(LAS f32x4*)(red + g * 256 + h4 * 64 + c8 * 8) = (f32x4){acc[q][h4][0], acc[q][h4][1], acc[q][h4][2], acc[q][h4][3]}; *(LAS f32x4*)(red + g * 256 + h4 * 64 + c8 * 8 + 4) = (f32x4){acc[q][h4][4], acc[q][h4][5], acc[q][h4][6], acc[q][h4][7]}; }
        LDS_WAIT();
        f32x4 o = (f32x4){0.f, 0.f, 0.f, 0.f};
#pragma unroll
        for (int gg = 0; gg < 8; ++gg) o += *(const LAS f32x4*)(red + gg * 256 + 4 * lane);
        const int ho = lane >> 4; const float li = 1.0f / (ho == 0 ? l0 : (ho == 1 ? l1 : (ho == 2 ? l2 : l3)));
        u32x2 w; w.x = pk2(o.x * li, o.y * li); w.y = pk2(o.z * li, o.w * li);
        if (q == 0 || row[1] != row[0]) *(u32x2*)(a.Y + (size_t)row[q] * DM + 4 * lane) = w; }
    LDS_WAIT();
}

#ifndef MK_CHECK
#define MK_CHECK 0
#endif
#ifndef MK_CHECK_L
#define MK_CHECK_L 0
#define MK_CHECK_CH 0
#endif
#ifndef MK_PER_PHASE
#define MK_PER_PHASE 0
#endif

__device__ __forceinline__ int q_next(unsigned* head, volatile LAS unsigned* bc, int wave_) {
    __syncthreads();
    if (wave_ == 0 && lane_id() == 0) bc[0] = __hip_atomic_fetch_add(head, 1u, __ATOMIC_RELAXED, __HIP_MEMORY_SCOPE_AGENT);
    __syncthreads();
    return (int)bc[0];
}

constexpr int N_PHASES_C = 1 + NCHUNK * (9 + 3) + NCHUNK * (9 + 5);
typedef __attribute__((address_space(4))) const unsigned char* kptr_t;
#define PHASE_ENV() kptr_t kp_ = (kptr_t)__builtin_amdgcn_kernarg_segment_ptr(); asm volatile("; MKPHASE %1" : "+s"(kp_) : "n"(__LINE__)); \
    unsigned char* const ws = *(unsigned char* const __attribute__((address_space(4)))*)(kp_ + 240); float* const out = *(float* const __attribute__((address_space(4)))*)(kp_ + 232); \
    unsigned char* const act = ws + WS_ACT; bf16_t* const HB = (bf16_t*)(ws + WS_HB); unsigned* const ctl = (unsigned*)(ws + WS_CTL); \
    const size_t row0 = (size_t)ch * TCH; const unsigned char* const lw = ws + WS_LAYERW + (size_t)l * SZ_LAYERW; \
    int gwl = gw, ngwl = ngw; asm volatile("" : "+s"(gwl), "+s"(ngwl)); \
    (void)out; (void)act; (void)HB; (void)ctl; (void)row0; (void)lw; (void)gwl; (void)ngwl
#define INP(k) (*(const void* const __attribute__((address_space(4)))*)(kp_ + 8 * (k)))
#define FIN(k) ((const float*)INP(k))
#define ROPE_TAB(RT) RopeTab RT; RT.c64 = (const float*)(ws + WS_ROPE); RT.s64 = RT.c64 + (size_t)NPOS * 32; RT.c32 = RT.s64 + (size_t)NPOS * 32; RT.s32 = RT.c32 + (size_t)NPOS * 16
#define ABUF(T, off) ((T*)(act + (off)))

#ifndef MK_NV
#define MK_NV 256
#endif
#ifndef MK_LB
#define MK_LB 2
#endif
__global__ void __launch_bounds__(NWAVES * 64, MK_LB) mk_fwd(Args args) {
    extern __shared__ __attribute__((aligned(16))) unsigned char lds_raw[];
    LAS unsigned char* lds = (LAS unsigned char*)lds_raw;
    volatile LAS unsigned* MISC = (volatile LAS unsigned*)(lds + MISC_OFF);
    const int wave = __builtin_amdgcn_readfirstlane((int)threadIdx.x >> 6);
#define tid (wave * 64 + lane_id())
    const int G = gridDim.x; const int bx = blockIdx.x; const int vcu = (G % 8 == 0) ? (bx % 8) * (G / 8) + bx / 8 : bx;
    const int gw = vcu * NWAVES + wave, ngw = G * NWAVES;
    for (int u = tid; u < 64; u += NWAVES * 64) MISC[u] = 0u;
    __syncthreads();
    XcdBarrier bar; bar.bar = (unsigned*)(args.ws + WS_CTL) + CW_BAR + args.pad0 * XCD_BAR_WORDS; bar.x = 0; bar.st = nullptr;
    if (!MK_PER_PHASE) bar = xcd_barrier_post((unsigned*)(args.ws + WS_CTL) + CW_BAR + args.pad0 * XCD_BAR_WORDS, MISC + 8, wave);
    int pid = 0;
#ifndef MK_ATT
#define MK_ATT 7
#endif
#ifndef MK_EN
#define MK_EN 0xffffffffu
#endif
#define EN(k) (((MK_EN) >> (k)) & 1u)
#ifndef MK_ATT_REP
#define MK_ATT_REP 7
#endif
#ifndef MK_SPA_REP
#define MK_SPA_REP 1
#endif
#ifndef MK_REP
#define MK_REP 0u
#endif
#define REPS(k) (1 + (((MK_REP) >> (k)) & 1u))
#define RUN() (args.ph_lo <= pid && pid < args.ph_hi)
#define SEAM() do { if (args.ph_lo <= pid && pid + 1 < args.ph_hi) { TB(5); xcd_barrier(bar, wave); TE(5); } ++pid; } while (0)

    if (EN(0) && RUN()) for (int rep_ = 0; rep_ < (int)REPS(0); ++rep_) {
        const int l = 0, ch = 0; PHASE_ENV();
        int lane = tid & 63; asm volatile("" : "+v"(lane)); int tid0 = tid; asm volatile("" : "+v"(tid0));
        LAS float* scr = (LAS float*)(lds + wave * 16384);
        constexpr int IT_WIN = (DM / 64) * ((DIN + 31) / 32), IT_WUQ = (256 / 64) * (384 / 32), IT_WUKV = (128 / 64) * (512 / 32), IT_WAO = (256 / 64) * (DM / 32), IT_WCO = (512 / 64) * (DM / 32), IT_WO = (DM / 128) * (DM / 32);
        constexpr int IT_WG8 = (DM / 128) * (GW / 32);
        constexpr int IT_LAYER = IT_WIN + IT_WG8 + IT_WUQ + IT_WUKV + 2 * IT_WAO + IT_WCO + IT_WO;
        constexpr int IT_F1 = (DM / 128) * (DFF / 32), IT_F2 = (DFF / 128) * (DM / 32), IT_E1 = (DM / 128) * (EFF / 32), IT_E2 = (EFF / 128) * (DM / 32);
        constexpr int IT_FFN = 2 * IT_F1 + IT_F2, IT_EXP = 2 * IT_E1 + IT_E2;
        constexpr int NITEMS = 2 * IT_LAYER + IT_FFN + NEXP * IT_EXP;
        for (int it = gwl; it < NITEMS; it += ngwl) {
            int r = it;
            if (r < 2 * IT_LAYER) {
                const int ll = r / IT_LAYER; r -= ll * IT_LAYER; unsigned char* lwp = ws + WS_LAYERW + (size_t)ll * SZ_LAYERW;
                if (r < IT_WIN) { transpose_item<1>(FIN(I_WIN) + (size_t)ll * DM * DIN, DM, DIN, (bf16_t*)(lwp + OFF_WIN), DM, scr, r, lane); continue; } r -= IT_WIN;
                if (r < IT_WG8) { transpose_item_f8<0>(FIN(I_WIN) + (size_t)ll * DM * DIN + C_G, DM, GW, lwp + OFF_WIN8, DM, S_WG, scr, r, lane, DIN); continue; } r -= IT_WG8;
                if (r < IT_WUQ) { transpose_item<0>(FIN(I_WUQ) + (size_t)ll * 256 * 384, 256, 384, (bf16_t*)(lwp + OFF_WUQ), 256, scr, r, lane); continue; } r -= IT_WUQ;
                if (r < IT_WUKV) { transpose_item<0>(FIN(I_WUKV) + (size_t)ll * 128 * 512, 128, 512, (bf16_t*)(lwp + OFF_WUKV), 256, scr, r, lane); continue; } r -= IT_WUKV;
                if (r < IT_WAO) { transpose_item<0>(FIN(I_WAO) + (size_t)ll * 256 * DM, 256, DM, (bf16_t*)(lwp + OFF_WAO), DM, scr, r, lane); continue; } r -= IT_WAO;
                if (r < IT_WAO) { transpose_item<0>(FIN(I_WBO) + (size_t)ll * 256 * DM, 256, DM, (bf16_t*)(lwp + OFF_WAO) + 256, DM, scr, r, lane); continue; } r -= IT_WAO;
                if (r < IT_WCO) { transpose_item<0>(FIN(I_WCO) + (size_t)ll * 512 * DM, 512, DM, (bf16_t*)(lwp + OFF_WAO) + 512, DM, scr, r, lane); continue; } r -= IT_WCO;
                transpose_item_f8<0>(FIN(I_WO) + (size_t)ll * DM * DM, DM, DM, lwp + OFF_WO8, DM, S_WO, scr, r, lane); continue;
            }
            r -= 2 * IT_LAYER;
            if (r < IT_FFN) {
                if (r < IT_F1) { transpose_item_f8<2>(FIN(I_FW1), DM, DFF, ws + WS_W13, DM, S_W13, scr, r, lane); continue; } r -= IT_F1;
                if (r < IT_F1) { transpose_item_f8<3>(FIN(I_FW3), DM, DFF, ws + WS_W13, DM, S_W13, scr, r, lane); continue; } r -= IT_F1;
                transpose_item_f8<0>(FIN(I_FW2), DFF, DM, ws + WS_W2, DFF, S_W2, scr, r, lane); continue;
            }
            r -= IT_FFN;
            { const int e = r / IT_EXP; r -= e * IT_EXP;
              if (r < IT_E1) { transpose_item_f8<2>(FIN(I_MW1) + (size_t)e * DM * EFF, DM, EFF, ws + WS_E13 + (size_t)e * SZ_E13, DM, S_W13, scr, r, lane); continue; } r -= IT_E1;
              if (r < IT_E1) { transpose_item_f8<3>(FIN(I_MW3) + (size_t)e * DM * EFF, DM, EFF, ws + WS_E13 + (size_t)e * SZ_E13, DM, S_W13, scr, r, lane); continue; } r -= IT_E1;
              transpose_item_f8<0>(FIN(I_MW2) + (size_t)e * EFF * DM, EFF, DM, ws + WS_E2 + (size_t)e * SZ_E2, EFF, S_W2, scr, r, lane); }
        }
        const int gt = vcu * NWAVES * 64 + tid0, ngt = G * NWAVES * 64;
        for (int ll = 0; ll < DEPTH; ++ll) { unsigned char* lwp = ws + WS_LAYERW + (size_t)ll * SZ_LAYERW;
            for (int i = gt; i < (P1W - C_G) * DM / 8; i += ngt) ((u32x4*)(lwp + OFF_WIN + (size_t)C_G * DM * 2))[i] = (u32x4){0u, 0u, 0u, 0u};
            for (int i = gt; i < 128 * 256 / 8; i += ngt) ((u32x4*)(lwp + OFF_WUQ + (size_t)384 * 256 * 2))[i] = (u32x4){0u, 0u, 0u, 0u};
            for (int i = gt; i < 512 * 128 / 8; i += ngt) { const int rr = i / 16, cc = i % 16; ((u32x4*)(lwp + OFF_WUKV + (size_t)rr * 512 + 256))[cc] = (u32x4){0u, 0u, 0u, 0u}; } }
        for (int i = gt; i < DM / 8; i += ngt) ((u32x4*)(HB + (size_t)TCH * DM))[i] = (u32x4){0u, 0u, 0u, 0u};
        float* c64 = (float*)(ws + WS_ROPE); float* s64 = c64 + (size_t)NPOS * 32; float* c32 = s64 + (size_t)NPOS * 32; float* s32 = c32 + (size_t)NPOS * 16;
        for (int i = gt; i < NPOS * 32; i += ngt) { const int pos = i >> 5, k = i & 31; const float inv = (float)pow(10000.0, -(double)k / 32.0); const float ang = (float)pos * inv; c64[i] = cosf(ang); s64[i] = sinf(ang); }
        for (int i = gt; i < NPOS * 16; i += ngt) { const int pos = i >> 4, k = i & 15; const float inv = (float)pow(10000.0, -(double)k / 16.0); const float ang = (float)pos * inv; c32[i] = cosf(ang); s32[i] = sinf(ang); }
    }
    SEAM();

#pragma unroll 1
    for (int l = 0; l < DEPTH; ++l) {
#pragma unroll 1
        for (int ch = 0; ch < NCHUNK; ++ch) {
            if (EN(1) && RUN()) for (int rep_ = 0; rep_ < (int)REPS(1); ++rep_) { if (rep_) { __syncthreads(); } PHASE_ENV(); TB(9); norm_rows((l == 0 ? FIN(I_X) : (const float*)out) + row0 * DM, FIN(I_ANG) + l * DM, HB, ws + WS_HF8, gwl, ngwl, tid & 63); TE(9); }
            SEAM();
            if (EN(2) && RUN()) { PHASE_ENV();
                { pg8::Gemm g{HB, DM, HB, 1 << 30, (const bf16_t*)(lw + OFF_WIN), DM, nullptr, 0, 1, 0, 0}; pg8::StaticOrder S; S.init(TCH / 256, P1W / 256, G, bx);
                  pg8::EpiInProj E{ABUF(bf16_t, A_P1), ABUF(unsigned char, A_G), 1.0f}; TB(20); pg8::gemm_phase<pg8::EpiInProj, pg8::StaticOrder>(lds + RING_OFF, wave, g, S, E); TE(20); }
                { pg8::Gemm g{(const bf16_t*)(ws + WS_HF8), DM / 2, (const bf16_t*)(ws + WS_HF8), 1 << 30, (const bf16_t*)(lw + OFF_WIN8 - (size_t)P1W * DM), DM / 2, nullptr, 0, 1, 0, 0};
                  pg8::GateOrder S; S.S.init(TCH / 256, GW / 256, G, bx);
                  pg8::EpiInProj E{ABUF(bf16_t, A_P1), ABUF(unsigned char, A_G), 1.0f / S_WG}; pg8::gemm_phase<pg8::EpiInProj, pg8::GateOrder, true>(lds + RING_OFF, wave, g, S, E); } }
            SEAM();
            if (EN(3) && RUN()) for (int rep_ = 0; rep_ < (int)REPS(3); ++rep_) { if (rep_) { __syncthreads(); } PHASE_ENV(); ROPE_TAB(RT); PP1Args a; a.P1 = ABUF(bf16_t, A_P1); a.pos = (const int*)INP(I_POS) + row0; a.aq_g = FIN(I_AQG) + l * 64; a.ak_g = FIN(I_AKG) + l * 64; a.cq_g = FIN(I_BCQG) + l * 256;
                a.ckv_g = FIN(I_BCKVG) + l * 128; a.kr_g = FIN(I_BKRG) + l * 32; a.qc_g = FIN(I_CQG) + l * 64; a.kc_g = FIN(I_CKG) + l * 64;
                a.act = act; a.R = RT;
                TB(7); pp1_rows(a, lds + wave * 8192, gwl, ngwl, tid & 63); TE(7); }
            SEAM();
            if (EN(4) && RUN()) for (int rep_ = 0; rep_ < (int)REPS(4); ++rep_) { if (rep_) { __syncthreads(); } PHASE_ENV(); pg8::StaticOrder S; S.init(TCH / 256, 4, G, bx);
                pg8::Gemm g{ABUF(bf16_t, A_CQN), 256, ABUF(bf16_t, A_CKVN), 2, (const bf16_t*)(lw + OFF_WUQ), 256, nullptr, 0, 1, 0, 0}; pg8::EpiBf16 E{ABUF(bf16_t, A_QBR), 1024}; TB(21); pg8::gemm_phase<pg8::EpiBf16, pg8::StaticOrder>(lds + RING_OFF, wave, g, S, E); TE(21); }
            SEAM();
            if (EN(5) && RUN()) for (int rep_ = 0; rep_ < (int)REPS(5); ++rep_) { if (rep_) { __syncthreads(); } PHASE_ENV(); ROPE_TAB(RT); PP2Args a; a.QBR = ABUF(bf16_t, A_QBR); a.KVBR = ABUF(bf16_t, A_QBR) + 512; a.KR = ABUF(bf16_t, A_KR); a.pos = (const int*)INP(I_POS) + row0;
                a.qn_g = FIN(I_BQNG) + l * 64; a.qr_g = FIN(I_BQRG) + l * 32; a.kn_g = FIN(I_BKNG) + l * 64;
                a.QB = ABUF(bf16_t, A_QB); a.KB = ABUF(bf16_t, A_KB); a.VBT = ABUF(bf16_t, A_VBT); a.R = RT; TB(8); pp2_rows(a, lds + wave * 8192, gwl, ngwl, tid & 63); TE(8); }
            SEAM();
            if (EN(6) && RUN()) for (int rep_ = 0; rep_ < (int)REPS(6); ++rep_) {
                PHASE_ENV();
                unsigned* head = ctl + CW_Q + 64 * (2 * (l * NCHUNK + ch) + rep_);
                bf16_t* const Y = ABUF(bf16_t, A_Y);
                TB(28);
                for (;;) {
                    TB(17); const int u = q_next(head, MISC + 16, wave); TE(17);
                    if (u >= 512 + 1024 + 1024) break;
                    if (u < 512) { if (!(MK_ATT & 1) || (rep_ && !(MK_ATT_REP & 1))) continue;
                        const int qb = 31 - u / 16, bl = (u % 16) / 4, h = u % 4; const int rowb = bl * SEQ; const int q0w = 256 * qb + 32 * wave;
                        fa_unit<96>(lds, wave, ABUF(bf16_t, A_QB) + (size_t)(rowb + q0w) * 384 + h * 96, 384, ABUF(bf16_t, A_KB) + (size_t)rowb * 384 + h * 96, 384, ABUF(bf16_t, A_VBT) + (size_t)(bl * 4 + h) * 64 * SEQ,
                                    0, 4 * qb + 4, q0w, 0, -INFINITY, 0.f, Y + (size_t)(rowb + q0w) * DM + 256 + h * 64, DM);
                    } else if (u < 512 + 1024) { if (!(MK_ATT & 2) || (rep_ && !(MK_ATT_REP & 2))) continue;
                        const int v = u - 512; const int qb32 = 255 - v / 4, bl = v % 4;
                        IdxArgs ia{ABUF(bf16_t, A_IQ), ABUF(bf16_t, A_IK), ABUF(float, A_IW), ABUF(unsigned short, A_SEL), ABUF(int, A_SELN)};
                        TB(14); idx_unit(lds, wave, ia, bl * SEQ, qb32); TE(14);
                    } else { if (!(MK_ATT & 4) || (rep_ && !(MK_ATT_REP & 4))) continue;
                        const int v = u - 1536; const int bl = v / 256, kvh = (v / 128) % 2, qt = v % 128; const int rowb = bl * SEQ;
                        const int hq = kvh * 4 + (wave >> 1), q0w = 64 * qt + 32 * (wave & 1);
                        const float sink = (FIN(I_SINK) + l * 8)[hq];
                        fa_unit<64>(lds, wave, ABUF(bf16_t, A_QC) + (size_t)(rowb + q0w) * 512 + hq * 64, 512, ABUF(bf16_t, A_KC) + (size_t)rowb * 128 + kvh * 64, 128, ABUF(bf16_t, A_VCT) + (size_t)(bl * 2 + kvh) * 64 * SEQ,
                                    qt >= 2 ? qt - 2 : 0, qt + 1, q0w, 128, sink * LOG2E, 1.f, Y + (size_t)(rowb + q0w) * DM + 512 + hq * 64, DM);
                    }
                }
                TE(28);
            }
            SEAM();
            if (EN(7) && RUN()) for (int rep_ = 0; rep_ < (int)REPS(7); ++rep_) { if (rep_) { __syncthreads(); } PHASE_ENV(); SpaArgs sa{ABUF(bf16_t, A_QA), ABUF(bf16_t, A_KA), ABUF(bf16_t, A_VA), ABUF(unsigned short, A_SEL), ABUF(int, A_SELN), ABUF(bf16_t, A_Y)}; LAS unsigned char* wl = lds + wave * 16384;
                TB(11); { int lane_ = tid & 63; asm volatile("" : "+v"(lane_)); SpaPre P, Pn; P = SpaPre{}; Pn = SpaPre{};
                    if (gwl < TCH) sparse_prefetch(P, sa, gwl, (gwl + ngwl < TCH) ? gwl + ngwl : gwl, lane_);
                    for (int tok = gwl; tok < TCH; tok += 2 * ngwl) { const int tk2 = (tok + ngwl < TCH) ? tok + ngwl : tok; const int nt1 = tok + 2 * ngwl, nt2 = (nt1 + ngwl < TCH) ? nt1 + ngwl : nt1;
                        if (nt1 < TCH) sparse_prefetch(Pn, sa, nt1, nt2, lane_);
                        sparse_pair(wl, sa, P, (tok / SEQ) * SEQ, tok % SEQ, (tk2 / SEQ) * SEQ, tk2 % SEQ, lane_);
                        P = Pn; } } TE(11); }
            SEAM();
            if (EN(8) && RUN()) for (int rep_ = 0; rep_ < (int)REPS(8); ++rep_) { if (rep_) { __syncthreads(); } PHASE_ENV(); pg8::SegOrder S; S.S.init(TCH / 256, DM / 256, G, bx);
                pg8::Gemm g{ABUF(bf16_t, A_Y), DM, ABUF(bf16_t, A_Y), 1 << 30, (const bf16_t*)(lw + OFF_WAO), DM, nullptr, 0, 3, 256, 512}; pg8::EpiMerge E{HB, ABUF(unsigned char, A_G), ws + WS_HF8, S_MG};
                TB(22); pg8::gemm_phase<pg8::EpiMerge, pg8::SegOrder>(lds + RING_OFF, wave, g, S, E); TE(22); }
            SEAM();
            if (EN(9) && RUN()) { PHASE_ENV(); pg8::Gemm g{(const bf16_t*)(ws + WS_HF8), DM / 2, (const bf16_t*)(ws + WS_HF8), 1 << 30, (const bf16_t*)(lw + OFF_WO8), DM / 2, nullptr, 0, 1, 0, 0}; pg8::StaticOrder S; S.init(TCH / 256, DM / 256, G, bx);
                pg8::EpiResidS E{(l == 0 ? FIN(I_X) : (const float*)out) + row0 * DM, out + row0 * DM, 1.0f / (S_MG * S_WO)}; TB(23); pg8::gemm_phase<pg8::EpiResidS, pg8::StaticOrder, true>(lds + RING_OFF, wave, g, S, E); TE(23); }
            SEAM();
            if (l == 0) {
                if (EN(10) && RUN()) { PHASE_ENV(); RouteArgs ra{}; TB(10); norm2_rows<false>(out + row0 * DM, FIN(I_FNG) + l * DM, HB, ws + WS_HF8, ra, (LAS unsigned*)(lds + MISC_OFF + 128), vcu, wave, tid & 63, G); TE(10); }
                SEAM();
                if (EN(11) && RUN()) { PHASE_ENV(); pg8::Gemm g{(const bf16_t*)(ws + WS_HF8), DM / 2, (const bf16_t*)(ws + WS_HF8), 1 << 30, (const bf16_t*)(ws + WS_W13), DM / 2, nullptr, 0, 1, 0, 0}; pg8::StaticOrder S; S.init(TCH / 256, 2 * DFF / 256, G, bx);
                    pg8::EpiSwigluF8 E{ABUF(unsigned char, F_ACT), DFF, 1.0f / S_W13, S_ACT}; TB(24); pg8::gemm_phase<pg8::EpiSwigluF8, pg8::StaticOrder, true>(lds + RING_OFF, wave, g, S, E); TE(24); }
                SEAM();
                if (EN(12) && RUN()) { PHASE_ENV(); pg8::Gemm g{ABUF(bf16_t, F_ACT), DFF / 2, ABUF(bf16_t, F_ACT), 1 << 30, (const bf16_t*)(ws + WS_W2), DFF / 2, nullptr, 0, 1, 0, 0}; pg8::StaticOrder S; S.init(TCH / 256, DM / 256, G, bx);
                    pg8::EpiResidS E{out + row0 * DM, out + row0 * DM, 1.0f / (S_ACT * S_W2)}; TB(25); pg8::gemm_phase<pg8::EpiResidS, pg8::StaticOrder, true>(lds + RING_OFF, wave, g, S, E); TE(25); }
                SEAM();
            } else {
                if (EN(13) && RUN()) { PHASE_ENV(); RouteArgs ra{FIN(I_RW), ABUF(int, F_TOPE), ABUF(float, F_TOPG), ABUF(int, F_TOPD), ctl + CW_MOE + 64 * ch};
                    TB(10); norm2_rows<true>(out + row0 * DM, FIN(I_FNG) + l * DM, HB, nullptr, ra, (LAS unsigned*)(lds + MISC_OFF + 128), vcu, wave, tid & 63, G); TE(10); }
                SEAM();
                if (EN(14) && RUN()) { PHASE_ENV(); TB(12); moe_scatter(ctl + CW_MOE + 64 * ch, ABUF(int, F_TOPE), ABUF(int, F_TOPD), HB, ABUF(bf16_t, F_YM), ABUF(int, F_BLKE), gwl, ngwl, tid & 63); TE(12); }
                SEAM();
                if (EN(15) && RUN()) for (int rep_ = 0; rep_ < (int)REPS(15); ++rep_) { if (rep_) { __syncthreads(); } PHASE_ENV(); int ps[NEXP + 1]; moe_layout(ctl + CW_MOE + 64 * ch, ps); const int nblk = ps[NEXP] / 256;
                    pg8::Gemm g{ABUF(bf16_t, F_YM), DM / 2, ABUF(bf16_t, F_YM), 1 << 30, (const bf16_t*)(ws + WS_E13), DM / 2, ABUF(int, F_BLKE), SZ_E13 / 2, 1, 0, 0}; pg8::StaticOrder S; S.init(nblk, 2 * EFF / 256, G, bx);
                    pg8::EpiSwigluF8 E{ABUF(unsigned char, F_ACT), EFF, 1.0f / S_W13, S_ACT}; TB(26); pg8::gemm_phase<pg8::EpiSwigluF8, pg8::StaticOrder, true>(lds + RING_OFF, wave, g, S, E); TE(26); }
                SEAM();
                if (EN(16) && RUN()) for (int rep_ = 0; rep_ < (int)REPS(16); ++rep_) { if (rep_) { __syncthreads(); } PHASE_ENV(); int ps[NEXP + 1]; moe_layout(ctl + CW_MOE + 64 * ch, ps); const int nblk = ps[NEXP] / 256;
                    pg8::Gemm g{ABUF(bf16_t, F_ACT), EFF / 2, ABUF(bf16_t, F_ACT), 1 << 30, (const bf16_t*)(ws + WS_E2), EFF / 2, ABUF(int, F_BLKE), SZ_E2 / 2, 1, 0, 0}; pg8::StaticOrder S; S.init(nblk, DM / 256, G, bx);
                    pg8::EpiBf16S E{ABUF(bf16_t, F_YM), DM, 1.0f / (S_ACT * S_W2)}; TB(27); pg8::gemm_phase<pg8::EpiBf16S, pg8::StaticOrder, true>(lds + RING_OFF, wave, g, S, E); TE(27); }
                SEAM();
                if (EN(17) && RUN()) { PHASE_ENV(); TB(13); moe_combine(out + row0 * DM, ABUF(bf16_t, F_YM), ABUF(int, F_TOPD), ABUF(float, F_TOPG), gwl, ngwl, tid & 63); TE(13); }
                SEAM();
            }
        }
    }
    if (MK_TIMER != 0 && bx == 0 && args.ph_hi >= N_PHASES_C) { __syncthreads(); const unsigned long long t0 = __builtin_amdgcn_s_memrealtime(); const unsigned long long T = (unsigned long long)(*TMR_ACC) / NWAVES;
        while (__builtin_amdgcn_s_memrealtime() - t0 < T) __builtin_amdgcn_s_sleep(8); }
#undef RUN
#undef SEAM
#undef tid
}
constexpr int N_PHASES = 1 + NCHUNK * (9 + 3) + NCHUNK * (9 + 5);

extern "C" void kernel_launch(void* const* d_in, const int* in_sizes, int n_in, void* d_out, int out_size, void* d_ws, size_t ws_size, hipStream_t stream) {
    static int grid = 0;
    if (grid == 0) {
        if (n_in != 29 || in_sizes[0] != NTOK * DM || out_size != NTOK * DM || ws_size < WS_END) {
            fprintf(stderr, "kernel_launch: built for 29 inputs, x/out of %d floats, >= %zu bytes of workspace; got n_in %d, in0 %d, out %d, ws %zu; nothing launched\n", NTOK * DM, (size_t)WS_END, n_in, n_in > 0 ? in_sizes[0] : -1, out_size, ws_size); grid = -1; return; }
        int dev = 0, cus = 0, per_cu = 0;
        if (hipGetDevice(&dev) != hipSuccess || hipDeviceGetAttribute(&cus, hipDeviceAttributeMultiprocessorCount, dev) != hipSuccess) { fprintf(stderr, "kernel_launch: device query failed\n"); grid = -1; return; }
        if (hipFuncSetAttribute((const void*)mk_fwd, hipFuncAttributeMaxDynamicSharedMemorySize, LDS_BYTES) != hipSuccess) { fprintf(stderr, "kernel_launch: hipFuncSetAttribute failed\n"); grid = -1; return; }
        if (hipOccupancyMaxActiveBlocksPerMultiprocessor(&per_cu, (const void*)mk_fwd, NWAVES * 64, LDS_BYTES) != hipSuccess || per_cu < 1)
            fprintf(stderr, "kernel_launch: note: occupancy query reports %d workgroups per CU\n", per_cu);
        (void)hipGetLastError();
        grid = cus;
        if (grid != 256) fprintf(stderr, "kernel_launch: note: %d CUs (built and tuned for 256)\n", grid);
    }
    if (grid < 0) return;
    if (hipMemsetAsync((char*)d_ws + WS_CTL, 0, CTL_ZERO_BYTES, stream) != hipSuccess) { fprintf(stderr, "kernel_launch: memset failed\n"); return; }
    Args a{};
    for (int i = 0; i < 29; ++i) a.in[i] = d_in[i];
    a.out = (float*)d_out; a.ws = (unsigned char*)d_ws;
#if MK_PER_PHASE
    for (int p = 0; p < N_PHASES; ++p) { a.ph_lo = p; a.ph_hi = p + 1; hipLaunchKernelGGL(mk_fwd, dim3(grid), dim3(NWAVES * 64), LDS_BYTES, stream, a); }
#elif MK_CHECK
    {
        const int base = 1 + (MK_CHECK_L == 0 ? MK_CHECK_CH * 12 : 24 + MK_CHECK_CH * 14);
        a.ph_lo = 0; a.ph_hi = base + 7; a.pad0 = 0; hipLaunchKernelGGL(mk_fwd, dim3(grid), dim3(NWAVES * 64), LDS_BYTES, stream, a);
        hipLaunchKernelGGL(chk_kernel, dim3(grid), dim3(NWAVES * 64), 0, stream, a, 0, MK_CHECK_L, MK_CHECK_CH);
        a.ph_lo = base + 7; a.ph_hi = base + 9; a.pad0 = 1; hipLaunchKernelGGL(mk_fwd, dim3(grid), dim3(NWAVES * 64), LDS_BYTES, stream, a);
        hipLaunchKernelGGL(chk_kernel, dim3(grid), dim3(NWAVES * 64), 0, stream, a, 1, MK_CHECK_L, MK_CHECK_CH);
        a.ph_lo = base + 9; a.ph_hi = N_PHASES; a.pad0 = 2; hipLaunchKernelGGL(mk_fwd, dim3(grid), dim3(NWAVES * 64), LDS_BYTES, stream, a);
        hipLaunchKernelGGL(chk_kernel, dim3(1), dim3(64), 0, stream, a, 2, MK_CHECK_L, MK_CHECK_CH);
    }
#else
    a.ph_lo = 0; a.ph_hi = N_PHASES;
    hipLaunchKernelGGL(mk_fwd, dim3(grid), dim3(NWAVES * 64), LDS_BYTES, stream, a);
#endif
    const hipError_t le = hipPeekAtLastError();
    if (le != hipSuccess) fprintf(stderr, "kernel_launch: launch failed: %s\n", hipGetErrorName(le));
}
```

```cpp
#include <hip/hip_runtime.h>
#include <cstdio>
#include <cstdint>

#define GAS __attribute__((address_space(1)))
#define LAS __attribute__((address_space(3)))
typedef unsigned short bf16_t;
typedef short bf16x8 __attribute__((ext_vector_type(8)));
typedef float f32x2 __attribute__((ext_vector_type(2)));
typedef float f32x4 __attribute__((ext_vector_type(4)));
typedef float f32x16 __attribute__((ext_vector_type(16)));
typedef unsigned u32x2 __attribute__((ext_vector_type(2)));
typedef unsigned u32x4 __attribute__((ext_vector_type(4)));
typedef int i32x4 __attribute__((ext_vector_type(4)));
typedef int i32x8 __attribute__((ext_vector_type(8)));

constexpr int NB = 8, SEQ = 8192, NTOK = NB * SEQ, DM = 1024, DEPTH = 2;
constexpr int DIN = 4936;
constexpr int CHB = 4, TCH = CHB * SEQ, NCHUNK = NB / CHB;
constexpr int DFF = 2816, NEXP = 8, EFF = 3584;
constexpr int P1W = 2048, GW = 3072;
constexpr int NINP = P1W + GW;
constexpr float EPS = 1e-6f;
constexpr float LOG2E = 1.4426950408889634f;
constexpr int C_QA = 0, C_KA = 256, C_VA = 320, C_IQ = 384, C_IK = 640, C_IW = 672, C_CQ = 680, C_CKV = 936, C_KR = 1064, C_QC = 1096, C_KC = 1608, C_VC = 1736, C_G = 1864;
constexpr int NPOS = 12288;
constexpr int MOE_ROWS = 2 * TCH + NEXP * 256;

__device__ __forceinline__ float bf2f(bf16_t v) { return __uint_as_float((unsigned)v << 16); }
__device__ __forceinline__ float bflo(unsigned w) { return __uint_as_float(w << 16); }
__device__ __forceinline__ float bfhi(unsigned w) { return __uint_as_float(w & 0xffff0000u); }
__device__ __forceinline__ unsigned f2bf(float f) { unsigned u = __float_as_uint(f); return (u + 0x7fffu + ((u >> 16) & 1u)) >> 16; }
__device__ __forceinline__ unsigned pk2(float lo, float hi) { return f2bf(lo) | (f2bf(hi) << 16); }
__device__ __forceinline__ unsigned cvt_pk_bf16(float lo, float hi) { unsigned r; asm volatile("v_cvt_pk_bf16_f32 %0, %1, %2" : "=v"(r) : "v"(lo), "v"(hi)); return r; }
__device__ __forceinline__ unsigned pk4_u8(float a, float b, float c, float d) { unsigned w = 0u; w = __builtin_amdgcn_cvt_pk_u8_f32(a, 0u, w); w = __builtin_amdgcn_cvt_pk_u8_f32(b, 1u, w); w = __builtin_amdgcn_cvt_pk_u8_f32(c, 2u, w); w = __builtin_amdgcn_cvt_pk_u8_f32(d, 3u, w); return w; }
__device__ __forceinline__ unsigned pk4_fp8(float a, float b, float c, float d) { unsigned w = 0u; w = (unsigned)__builtin_amdgcn_cvt_pk_fp8_f32(a, b, (int)w, false); w = (unsigned)__builtin_amdgcn_cvt_pk_fp8_f32(c, d, (int)w, true); return w; }
__device__ __forceinline__ float fast_exp2(float x) { return __builtin_amdgcn_exp2f(x); }
__device__ __forceinline__ float max3_(float a, float b, float c) { float r; asm("v_max3_f32 %0, %1, %2, %3" : "=v"(r) : "v"(a), "v"(b), "v"(c)); return r; }
__device__ __forceinline__ float fast_rcp(float x) { return __builtin_amdgcn_rcpf(x); }
__device__ __forceinline__ float sigmoidf_(float x) { return fast_rcp(1.0f + fast_exp2(-LOG2E * x)); }
template <int O> __device__ __forceinline__ float xor_lane(float v) {
    return __int_as_float(__builtin_amdgcn_ds_swizzle(__float_as_int(v), (O << 10) | 0x1f)); }
__device__ __forceinline__ float half_sum(float v) { const auto rr = __builtin_amdgcn_permlane32_swap(__float_as_uint(v), __float_as_uint(v), false, false); return __uint_as_float(rr[0]) + __uint_as_float(rr[1]); }
__device__ __forceinline__ float half_max(float v) { const auto rr = __builtin_amdgcn_permlane32_swap(__float_as_uint(v), __float_as_uint(v), false, false); return fmaxf(__uint_as_float(rr[0]), __uint_as_float(rr[1])); }
__device__ __forceinline__ float sum16(float v) { v += xor_lane<1>(v); v += xor_lane<2>(v); v += xor_lane<4>(v); v += xor_lane<8>(v); return v; }
__device__ __forceinline__ float max16(float v) { v = fmaxf(v, xor_lane<1>(v)); v = fmaxf(v, xor_lane<2>(v)); v = fmaxf(v, xor_lane<4>(v)); v = fmaxf(v, xor_lane<8>(v)); return v; }
__device__ __forceinline__ float sum32(float v) { v = sum16(v); v += xor_lane<16>(v); return v; }
__device__ __forceinline__ float wave_sum(float v) { return half_sum(sum32(v)); }
__device__ __forceinline__ int lane_get(int v, int src_lane) { return __builtin_amdgcn_ds_bpermute(src_lane << 2, v); }
__device__ __forceinline__ int lane_bcast(int v, int uniform_lane) { return __builtin_amdgcn_readlane(v, uniform_lane); }
__device__ __forceinline__ unsigned lds_add(LAS unsigned* p, unsigned v) { return __hip_atomic_fetch_add(p, v, __ATOMIC_RELAXED, __HIP_MEMORY_SCOPE_WORKGROUP); }
__device__ __forceinline__ unsigned lds_or(LAS unsigned* p, unsigned v) { return __hip_atomic_fetch_or(p, v, __ATOMIC_RELAXED, __HIP_MEMORY_SCOPE_WORKGROUP); }
__device__ __forceinline__ int lane_id() { int l; asm volatile("v_mbcnt_lo_u32_b32 %0, -1, 0\n\tv_mbcnt_hi_u32_b32 %0, -1, %0" : "=v"(l)); return l; }
#define LDS_WAIT() asm volatile("s_waitcnt lgkmcnt(0)" ::: "memory")
#define VM_WAIT() asm volatile("s_waitcnt vmcnt(0)" ::: "memory")

namespace pg8 {
constexpr int BM = 256, BK = 64, HALF = 128, HTB = HALF * BK * 2, STAGE_BYTES = 8 * HTB, NXCD = 8, WGM = 8;
__host__ __device__ __forceinline__ int lds_byte(int r, int c) { const int st = (r >> 4) * 2 + (c >> 5), rr = r & 15, cc = c & 31, ob = rr * 64 + cc * 2; return st * 1024 + (ob ^ (((ob >> 9) & 1) << 5)); }
__host__ __device__ __forceinline__ void stage_rc(int b, int& R, int& C) { const int st = b / 1024, sb = b % 1024, swz = sb ^ (((sb >> 9) & 1) << 5); R = (st >> 1) * 16 + swz / 64; C = (st & 1) * 32 + (swz % 64) / 2; }
__host__ __device__ __forceinline__ int perm32(int rho) { const int n = rho >> 4, i = rho & 15; return 8 * (i >> 2) + 4 * n + (i & 3); }

struct Unit { int pm, pn, seg; };
struct Gemm {
    const bf16_t* A; int lda;
    const bf16_t* A2; int pn_split;
    const bf16_t* Bt; int K;
    const int* blk_e; size_t e_stride;
    int nseg, k1, k2;
};
struct StaticOrder {
    int nM, nN, nwg, G, c;
    __device__ void init(int nM_, int nN_, int G_, int c_) { nM = nM_; nN = nN_; nwg = nM * nN; G = G_; c = c_; }
    __device__ bool next(int i, Unit& u) const {
        const long L = (long)i * G + c; if (L >= nwg) return false;
        int wgid = (int)L; { const int q = nwg / NXCD, r = nwg % NXCD, xcd = wgid % NXCD, off = wgid / NXCD; wgid = (xcd < r ? xcd * (q + 1) : r * (q + 1) + (xcd - r) * q) + off; }
        const int nig = WGM * nN, gid = wgid / nig, fm = gid * WGM, gsz = (nM - fm) < WGM ? (nM - fm) : WGM;
        u.pm = fm + ((wgid % nig) % gsz); u.pn = (wgid % nig) / gsz; u.seg = 0; return true;
    }
};
struct GateOrder { StaticOrder S;
    __device__ bool next(int i, Unit& u) const { if (!S.next(i, u)) return false; u.pn += 8; return true; } };
struct SegOrder { StaticOrder S;
    __device__ bool next(int i, Unit& u) const { const int q = i / 3; if (!S.next(q, u)) return false; u.seg = i - 3 * q; return true; } };

template <class Epi, class Sched, bool FP8 = false>
__device__ __forceinline__ void gemm_phase(LAS unsigned char* lds, int wave_, const Gemm g, const Sched& S, const Epi& E) {
    int tid = wave_ * 64 + lane_id(); asm volatile("" : "+v"(tid));
    const int wid = __builtin_amdgcn_readfirstlane(tid >> 6), lane = tid & 63, wr = wid >> 2, wc = wid & 3, fr = lane & 15, fq = lane >> 4;
    int K = g.K; asm volatile("" : "+s"(K));
    unsigned voffA[2], voffB[2];
#pragma unroll
    for (int i = 0; i < 2; ++i) { int R, C; stage_rc(tid * 16 + i * 8192, R, C); const int Rb = Epi::PERM ? ((R & ~31) + perm32(R & 31)) : R;
        voffA[i] = (unsigned)(R * g.lda + C) * 2u; voffB[i] = (unsigned)(Rb * K + C) * 2u; }
    const size_t kstep = (size_t)(BK * 2);
    const size_t hstepB = (size_t)HALF * K * 2, tstepB = 2 * hstepB;
    const size_t hstepA = (size_t)HALF * g.lda * 2, tstepA = 2 * hstepA;
    const unsigned ldsw = (unsigned)wid * 1024u;
    const int aoff0 = FP8 ? lds_byte(wr * 64 + fr, (2 * (fq & 1)) * 8) + (fq >> 1) * 1024 : lds_byte(wr * 64 + fr, fq * 8);
    const int boff0 = FP8 ? lds_byte(wc * 32 + fr, (2 * (fq & 1)) * 8) + (fq >> 1) * 1024 : lds_byte(wc * 32 + fr, fq * 8);
    constexpr int OFF1 = FP8 ? 16 : 1024;
#define PG8_SA(b, h) (((b) * 2 + (h)) * HTB)
#define PG8_SB(b, h) ((4 + (b) * 2 + (h)) * HTB)
#define PG8_STAGE(bufoff, gbase, voff) do { _Pragma("unroll") for (int _i = 0; _i < 2; ++_i) \
        __builtin_amdgcn_global_load_lds((const unsigned*)((const char*)(gbase) + (voff)[_i]), (LAS unsigned*)(lds + (bufoff) + ldsw + _i * 8192), 16, 0, 0); } while (0)
#define PG8_LDA(dst, b, h) do { _Pragma("unroll") for (int m = 0; m < 4; ++m) { \
        if constexpr (FP8) { dst##8[m].lo = *(const LAS i32x4*)(lds + PG8_SA(b, h) + aoff0 + m * 2048); dst##8[m].hi = *(const LAS i32x4*)(lds + PG8_SA(b, h) + aoff0 + OFF1 + m * 2048); } \
        else { dst[m][0] = *(const LAS bf16x8*)(lds + PG8_SA(b, h) + aoff0 + m * 2048); dst[m][1] = *(const LAS bf16x8*)(lds + PG8_SA(b, h) + aoff0 + OFF1 + m * 2048); } } } while (0)
#define PG8_LDB(dst, b, h) do { _Pragma("unroll") for (int n = 0; n < 2; ++n) { \
        if constexpr (FP8) { dst##8[n].lo = *(const LAS i32x4*)(lds + PG8_SB(b, h) + boff0 + n * 2048); dst##8[n].hi = *(const LAS i32x4*)(lds + PG8_SB(b, h) + boff0 + OFF1 + n * 2048); } \
        else { dst[n][0] = *(const LAS bf16x8*)(lds + PG8_SB(b, h) + boff0 + n * 2048); dst[n][1] = *(const LAS bf16x8*)(lds + PG8_SB(b, h) + boff0 + OFF1 + n * 2048); } } } while (0)
#define PG8_MMA(ai, bj, At, Bt) do { __builtin_amdgcn_s_setprio(1); _Pragma("unroll") for (int m = 0; m < 4; ++m) _Pragma("unroll") for (int n = 0; n < 2; ++n) { \
        if constexpr (FP8) asm volatile("v_mfma_scale_f32_16x16x128_f8f6f4 %0, %1, %2, %0, %3, %3 op_sel_hi:[0,0,0]" : "+v"(acc[ai][bj][m][n]) : "v"(Bt##8[n]), "v"(At##8[m]), "v"(one_scale));   \
        else { _Pragma("unroll") for (int k = 0; k < 2; ++k) acc[ai][bj][m][n] = __builtin_amdgcn_mfma_f32_16x16x32_bf16(Bt[n][k], At[m][k], acc[ai][bj][m][n], 0, 0, 0); } } \
        __builtin_amdgcn_s_setprio(0); } while (0)
#define PG8_WAIT_V(n) asm volatile("s_waitcnt vmcnt(" #n ")" ::: "memory")
#define PG8_WAIT_L(n) asm volatile("s_waitcnt lgkmcnt(" #n ")" ::: "memory")
#define PG8_BAR __builtin_amdgcn_s_barrier()
#define PG8_SCHED __builtin_amdgcn_sched_barrier(0)
#define PG8_K0(u) ((u).seg == 0 ? 0 : ((u).seg == 1 ? g.k1 : g.k2))
#define PG8_NT(u) ((g.nseg == 1 ? K : ((u).seg == 0 ? g.k1 : ((u).seg == 1 ? g.k2 - g.k1 : K - g.k2))) / BK)
#define PG8_BPTR(u) ((const char*)g.Bt + ((g.blk_e ? (size_t)g.blk_e[(u).pm] * g.e_stride * 2 : (size_t)0) + (size_t)(u).pn * tstepB + (size_t)PG8_K0(u) * 2))
    Unit cur, nxt; int ui = 0;
    if (!S.next(0, cur)) return;
    f32x4 acc[2][2][4][2];
#pragma unroll
    for (int a = 0; a < 2; ++a)
#pragma unroll
        for (int b = 0; b < 2; ++b)
#pragma unroll
            for (int m = 0; m < 4; ++m)
#pragma unroll
                for (int n = 0; n < 2; ++n) acc[a][b][m][n] = (f32x4){0.f, 0.f, 0.f, 0.f};
    bf16x8 At[4][2], B0[2][2], B1[2][2];
    i32x8 At8[4], B08[2], B18[2];
    int one_scale = 0x7f7f7f7f; asm volatile("" : "+v"(one_scale));
    const char* cA = (const char*)(cur.pn >= g.pn_split ? g.A2 : g.A) + (size_t)cur.pm * tstepA + (size_t)PG8_K0(cur) * 2; const char* cB = PG8_BPTR(cur);
    int nt = PG8_NT(cur);
    PG8_STAGE(PG8_SB(0, 0), cB, voffB); PG8_STAGE(PG8_SB(0, 1), cB + hstepB, voffB); PG8_STAGE(PG8_SA(0, 0), cA, voffA); PG8_STAGE(PG8_SA(0, 1), cA + hstepA, voffA);
    if (wr == 1) PG8_BAR;
    PG8_WAIT_V(2); PG8_BAR;
    PG8_STAGE(PG8_SB(1, 0), cB + kstep, voffB); PG8_STAGE(PG8_SA(1, 0), cA + kstep, voffA); PG8_STAGE(PG8_SB(1, 1), cB + hstepB + kstep, voffB);
    PG8_WAIT_V(6); PG8_BAR;
    for (;;) {
        const bool has_next = S.next(ui + 1, nxt);
        const char* nA = has_next ? (const char*)(nxt.pn >= g.pn_split ? g.A2 : g.A) + (size_t)nxt.pm * tstepA + (size_t)PG8_K0(nxt) * 2 : cA; const char* nB = has_next ? PG8_BPTR(nxt) : cB;
        for (int t = 0; t < nt; t += 2) {
            const bool last = (t == nt - 2);
            const char* a1 = cA + (size_t)(t + 1) * kstep;
            const char* a2 = last ? nA : cA + (size_t)(t + 2) * kstep; const char* b2 = last ? nB : cB + (size_t)(t + 2) * kstep;
            const char* a3 = a2 + kstep; const char* b3 = b2 + kstep;
            PG8_LDB(B0, 0, 0); PG8_LDB(B1, 0, 1); PG8_SCHED; PG8_LDA(At, 0, 0); PG8_STAGE(PG8_SA(1, 1), a1 + hstepA, voffA);
            PG8_WAIT_V(8); PG8_WAIT_L(0); PG8_BAR; PG8_MMA(0, 0, At, B0); PG8_MMA(0, 1, At, B1); PG8_BAR; PG8_SCHED;
            PG8_LDA(At, 0, 1); PG8_STAGE(PG8_SB(0, 0), b2, voffB); PG8_STAGE(PG8_SB(0, 1), b2 + hstepB, voffB); PG8_STAGE(PG8_SA(0, 0), a2, voffA);
            PG8_WAIT_V(8); PG8_WAIT_L(0); PG8_BAR; PG8_MMA(1, 0, At, B0); PG8_MMA(1, 1, At, B1); PG8_BAR; PG8_SCHED;
            PG8_LDB(B0, 1, 0); PG8_LDB(B1, 1, 1); PG8_SCHED; PG8_LDA(At, 1, 0); PG8_STAGE(PG8_SA(0, 1), a2 + hstepA, voffA);
            PG8_WAIT_V(8); PG8_WAIT_L(0); PG8_BAR; PG8_MMA(0, 0, At, B0); PG8_MMA(0, 1, At, B1); PG8_BAR; PG8_SCHED;
            PG8_LDA(At, 1, 1); PG8_STAGE(PG8_SB(1, 0), b3, voffB); PG8_STAGE(PG8_SB(1, 1), b3 + hstepB, voffB); PG8_STAGE(PG8_SA(1, 0), a3, voffA);
            PG8_WAIT_V(8); PG8_WAIT_L(0); PG8_BAR; PG8_MMA(1, 0, At, B0); PG8_MMA(1, 1, At, B1); PG8_BAR; PG8_SCHED;
        }
        if (wr == 0) PG8_BAR;
        if constexpr (FP8) { asm volatile("s_nop 15\n\ts_nop 7" ::: "memory");
#pragma unroll
            for (int a = 0; a < 2; ++a)
#pragma unroll
                for (int b = 0; b < 2; ++b)
#pragma unroll
                    for (int m = 0; m < 4; ++m)
#pragma unroll
                        for (int n = 0; n < 2; ++n) asm volatile("" : "+v"(acc[a][b][m][n])); }
        E(acc, cur, wr, wc, fr, fq);
        if (!has_next) break;
#pragma unroll
        for (int a = 0; a < 2; ++a)
#pragma unroll
            for (int b = 0; b < 2; ++b)
#pragma unroll
                for (int m = 0; m < 4; ++m)
#pragma unroll
                    for (int n = 0; n < 2; ++n) acc[a][b][m][n] = (f32x4){0.f, 0.f, 0.f, 0.f};
        cur = nxt; cA = nA; cB = nB; ++ui; nt = PG8_NT(cur);
        if (wr == 1) PG8_BAR;
    }
    PG8_WAIT_V(0);
    PG8_BAR;
#undef PG8_SA
#undef PG8_SB
#undef PG8_STAGE
#undef PG8_LDA
#undef PG8_LDB
#undef PG8_MMA
#undef PG8_WAIT_V
#undef PG8_WAIT_L
#undef PG8_BAR
#undef PG8_SCHED
#undef PG8_BPTR
#undef PG8_K0
#undef PG8_NT
}

typedef const f32x4 (&AccRef)[2][2][4][2];
struct EpiInProj {
    static constexpr bool PERM = true;
    bf16_t* P1; unsigned char* G; float sg;
    __device__ __forceinline__ void operator()(AccRef acc, const Unit& u, int wr, int wc, int fr, int fq) const {
        const int row0 = u.pm * BM + wr * 64 + fr; const bool gate = u.pn >= 8;
        const int col0 = (gate ? (u.pn - 8) : u.pn) * BM + wc * 32 + 8 * fq;
#pragma unroll
        for (int ai = 0; ai < 2; ++ai)
#pragma unroll
            for (int m = 0; m < 4; ++m) { const size_t row = (size_t)(row0 + ai * HALF + m * 16);
#pragma unroll
                for (int bj = 0; bj < 2; ++bj) { f32x4 v0 = acc[ai][bj][m][0], v1 = acc[ai][bj][m][1];
                    if (gate) {
#pragma unroll
                        for (int j = 0; j < 4; ++j) { v0[j] = 255.0f * sigmoidf_(v0[j] * sg); v1[j] = 255.0f * sigmoidf_(v1[j] * sg); }
                        u32x2 q; q.x = pk4_u8(v0[0], v0[1], v0[2], v0[3]); q.y = pk4_u8(v1[0], v1[1], v1[2], v1[3]);
                        *(u32x2*)(G + row * GW + col0 + bj * HALF) = q;
                    } else {
                        v0 *= sg; v1 *= sg; u32x4 w; w.x = cvt_pk_bf16(v0[0], v0[1]); w.y = cvt_pk_bf16(v0[2], v0[3]); w.z = cvt_pk_bf16(v1[0], v1[1]); w.w = cvt_pk_bf16(v1[2], v1[3]);
                        *(u32x4*)(P1 + row * P1W + col0 + bj * HALF) = w; } } }
    }
};
struct EpiBf16 {
    static constexpr bool PERM = true;
    bf16_t* O; int ldc;
    __device__ __forceinline__ void operator()(AccRef acc, const Unit& u, int wr, int wc, int fr, int fq) const {
        const int row0 = u.pm * BM + wr * 64 + fr; const int col0 = u.pn * BM + wc * 32 + 8 * fq;
#pragma unroll
        for (int ai = 0; ai < 2; ++ai)
#pragma unroll
            for (int m = 0; m < 4; ++m) { bf16_t* rowp = O + (size_t)(row0 + ai * HALF + m * 16) * ldc + col0;
#pragma unroll
                for (int bj = 0; bj < 2; ++bj) { const f32x4 v0 = acc[ai][bj][m][0], v1 = acc[ai][bj][m][1];
                    u32x4 w; w.x = cvt_pk_bf16(v0[0], v0[1]); w.y = cvt_pk_bf16(v0[2], v0[3]); w.z = cvt_pk_bf16(v1[0], v1[1]); w.w = cvt_pk_bf16(v1[2], v1[3]);
                    *(u32x4*)(rowp + bj * HALF) = w; } }
    }
};
struct EpiMerge {
    static constexpr bool PERM = true;
    bf16_t* Mg; const unsigned char* G; unsigned char* M8; float s8;
    __device__ __forceinline__ void operator()(AccRef acc, const Unit& u, int wr, int wc, int fr, int fq) const {
        const int row0 = u.pm * BM + wr * 64 + fr; const int col0 = u.pn * BM + wc * 32 + 8 * fq; const int goff = u.seg * DM; const bool accum = u.seg != 0;
#pragma unroll
        for (int ai = 0; ai < 2; ++ai) {
            u32x2 gv[8]; u32x4 ov[8];
#pragma unroll
            for (int m = 0; m < 4; ++m)
#pragma unroll
                for (int bj = 0; bj < 2; ++bj) { const size_t row = (size_t)(row0 + ai * HALF + m * 16);
                    gv[m * 2 + bj] = *(const u32x2*)(G + row * GW + goff + col0 + bj * HALF);
                    if (accum) ov[m * 2 + bj] = *(const u32x4*)(Mg + row * DM + col0 + bj * HALF); }
#pragma unroll
            for (int m = 0; m < 4; ++m)
#pragma unroll
                for (int bj = 0; bj < 2; ++bj) { const size_t row = (size_t)(row0 + ai * HALF + m * 16); const f32x4 v0 = acc[ai][bj][m][0], v1 = acc[ai][bj][m][1]; const u32x2 gw = gv[m * 2 + bj]; constexpr float I255 = 1.0f / 255.0f;
                    float r[8] = { (float)(gw.x & 255u) * I255 * v0[0], (float)((gw.x >> 8) & 255u) * I255 * v0[1], (float)((gw.x >> 16) & 255u) * I255 * v0[2], (float)(gw.x >> 24) * I255 * v0[3],
                                   (float)(gw.y & 255u) * I255 * v1[0], (float)((gw.y >> 8) & 255u) * I255 * v1[1], (float)((gw.y >> 16) & 255u) * I255 * v1[2], (float)(gw.y >> 24) * I255 * v1[3] };
                    if (accum) { const u32x4 o = ov[m * 2 + bj]; r[0] += bflo(o.x); r[1] += bfhi(o.x); r[2] += bflo(o.y); r[3] += bfhi(o.y); r[4] += bflo(o.z); r[5] += bfhi(o.z); r[6] += bflo(o.w); r[7] += bfhi(o.w); }
                    if (u.seg != 2) { u32x4 w; w.x = cvt_pk_bf16(r[0], r[1]); w.y = cvt_pk_bf16(r[2], r[3]); w.z = cvt_pk_bf16(r[4], r[5]); w.w = cvt_pk_bf16(r[6], r[7]);
                        *(u32x4*)(Mg + row * DM + col0 + bj * HALF) = w; }
                    else { u32x2 q; q.x = pk4_fp8(r[0] * s8, r[1] * s8, r[2] * s8, r[3] * s8); q.y = pk4_fp8(r[4] * s8, r[5] * s8, r[6] * s8, r[7] * s8); *(u32x2*)(M8 + row * DM + col0 + bj * HALF) = q; } }
        }
    }
};
struct EpiResid {
    static constexpr bool PERM = false;
    const float* R; float* O;
    __device__ __forceinline__ void operator()(AccRef acc, const Unit& u, int wr, int wc, int fr, int fq) const {
        const int row0 = u.pm * BM + wr * 64 + fr, col0 = u.pn * BM + wc * 32 + 4 * fq;
#pragma unroll
        for (int ai = 0; ai < 2; ++ai) {
            f32x4 rv[16];
#pragma unroll
            for (int m = 0; m < 4; ++m)
#pragma unroll
                for (int bj = 0; bj < 2; ++bj)
#pragma unroll
                    for (int n = 0; n < 2; ++n) rv[m * 4 + bj * 2 + n] = *(const f32x4*)(R + (size_t)(row0 + ai * HALF + m * 16) * DM + col0 + bj * HALF + n * 16);
#pragma unroll
            for (int m = 0; m < 4; ++m)
#pragma unroll
                for (int bj = 0; bj < 2; ++bj)
#pragma unroll
                    for (int n = 0; n < 2; ++n) *(f32x4*)(O + (size_t)(row0 + ai * HALF + m * 16) * DM + col0 + bj * HALF + n * 16) = rv[m * 4 + bj * 2 + n] + acc[ai][bj][m][n];
            asm volatile("" ::: "memory"); }
    }
};
template <bool RF32>
struct EpiResidB {
    static constexpr bool PERM = true;
    const void* R; bf16_t* O; float s;
    __device__ __forceinline__ void operator()(AccRef acc, const Unit& u, int wr, int wc, int fr, int fq) const {
        const int row0 = u.pm * BM + wr * 64 + fr, col0 = u.pn * BM + wc * 32 + 8 * fq;
#pragma unroll
        for (int ai = 0; ai < 2; ++ai) {
            f32x4 ra[RF32 ? 8 : 1], rb[RF32 ? 8 : 1]; u32x4 rh[RF32 ? 1 : 8];
#pragma unroll
            for (int m = 0; m < 4; ++m)
#pragma unroll
                for (int bj = 0; bj < 2; ++bj) { const size_t off = (size_t)(row0 + ai * HALF + m * 16) * DM + col0 + bj * HALF;
                    if (RF32) { ra[m * 2 + bj] = *(const f32x4*)((const float*)R + off); rb[m * 2 + bj] = *(const f32x4*)((const float*)R + off + 4); }
                    else rh[m * 2 + bj] = *(const u32x4*)((const bf16_t*)R + off); }
#pragma unroll
            for (int m = 0; m < 4; ++m)
#pragma unroll
                for (int bj = 0; bj < 2; ++bj) { const size_t off = (size_t)(row0 + ai * HALF + m * 16) * DM + col0 + bj * HALF; const f32x4 v0 = acc[ai][bj][m][0] * s, v1 = acc[ai][bj][m][1] * s;
                    float r[8];
                    if (RF32) { const f32x4 a = ra[m * 2 + bj], b = rb[m * 2 + bj]; r[0] = a.x; r[1] = a.y; r[2] = a.z; r[3] = a.w; r[4] = b.x; r[5] = b.y; r[6] = b.z; r[7] = b.w; }
                    else { const u32x4 h = rh[m * 2 + bj]; r[0] = bflo(h.x); r[1] = bfhi(h.x); r[2] = bflo(h.y); r[3] = bfhi(h.y); r[4] = bflo(h.z); r[5] = bfhi(h.z); r[6] = bflo(h.w); r[7] = bfhi(h.w); }
                    u32x4 w; w.x = cvt_pk_bf16(r[0] + v0[0], r[1] + v0[1]); w.y = cvt_pk_bf16(r[2] + v0[2], r[3] + v0[3]); w.z = cvt_pk_bf16(r[4] + v1[0], r[5] + v1[1]); w.w = cvt_pk_bf16(r[6] + v1[2], r[7] + v1[3]);
                    *(u32x4*)(O + off) = w; }
            asm volatile("" ::: "memory"); }
    }
};
struct EpiSwiglu {
    static constexpr bool PERM = true;
    bf16_t* O; int ldc;
    __device__ __forceinline__ void operator()(AccRef acc, const Unit& u, int wr, int wc, int fr, int fq) const {
        const int row0 = u.pm * BM + wr * 64 + fr; const int col0 = u.pn * HALF + wc * 32 + 8 * fq;
#pragma unroll
        for (int ai = 0; ai < 2; ++ai)
#pragma unroll
            for (int m = 0; m < 4; ++m) { bf16_t* rowp = O + (size_t)(row0 + ai * HALF + m * 16) * ldc + col0;
                float r[8];
#pragma unroll
                for (int n = 0; n < 2; ++n)
#pragma unroll
                    for (int j = 0; j < 4; ++j) { const float gt = acc[ai][0][m][n][j], up = acc[ai][1][m][n][j]; r[4 * n + j] = gt * sigmoidf_(gt) * up; }
                u32x4 w; w.x = cvt_pk_bf16(r[0], r[1]); w.y = cvt_pk_bf16(r[2], r[3]); w.z = cvt_pk_bf16(r[4], r[5]); w.w = cvt_pk_bf16(r[6], r[7]);
                *(u32x4*)rowp = w; }
    }
};
struct EpiSwigluF8 {
    static constexpr bool PERM = true;
    unsigned char* O; int ldc; float s_in, s_out;
    __device__ __forceinline__ void operator()(AccRef acc, const Unit& u, int wr, int wc, int fr, int fq) const {
        const int row0 = u.pm * BM + wr * 64 + fr; const int col0 = u.pn * HALF + wc * 32 + 8 * fq;
#pragma unroll
        for (int ai = 0; ai < 2; ++ai)
#pragma unroll
            for (int m = 0; m < 4; ++m) { unsigned char* rowp = O + (size_t)(row0 + ai * HALF + m * 16) * ldc + col0;
                float r[8];
#pragma unroll
                for (int n = 0; n < 2; ++n)
#pragma unroll
                    for (int j = 0; j < 4; ++j) { const float gt = acc[ai][0][m][n][j] * s_in, up = acc[ai][1][m][n][j] * s_in; r[4 * n + j] = gt * sigmoidf_(gt) * up * s_out; }
                u32x2 w; w.x = pk4_fp8(r[0], r[1], r[2], r[3]); w.y = pk4_fp8(r[4], r[5], r[6], r[7]);
                *(u32x2*)rowp = w; }
    }
};
struct EpiBf16S {
    static constexpr bool PERM = true;
    bf16_t* O; int ldc; float s;
    __device__ __forceinline__ void operator()(AccRef acc, const Unit& u, int wr, int wc, int fr, int fq) const {
        const int row0 = u.pm * BM + wr * 64 + fr; const int col0 = u.pn * BM + wc * 32 + 8 * fq;
#pragma unroll
        for (int ai = 0; ai < 2; ++ai)
#pragma unroll
            for (int m = 0; m < 4; ++m) { bf16_t* rowp = O + (size_t)(row0 + ai * HALF + m * 16) * ldc + col0;
#pragma unroll
                for (int bj = 0; bj < 2; ++bj) { const f32x4 v0 = acc[ai][bj][m][0] * s, v1 = acc[ai][bj][m][1] * s;
                    u32x4 w; w.x = cvt_pk_bf16(v0[0], v0[1]); w.y = cvt_pk_bf16(v0[2], v0[3]); w.z = cvt_pk_bf16(v1[0], v1[1]); w.w = cvt_pk_bf16(v1[2], v1[3]);
                    *(u32x4*)(rowp + bj * HALF) = w; } }
    }
};
}
struct Args { const void* in[29]; float* out; unsigned char* ws; int ph_lo, ph_hi, pad0, pad1; };
enum { I_X = 0, I_POS, I_ANG, I_WIN, I_AQG, I_AKG, I_BCQG, I_BCKVG, I_WUQ, I_WUKV, I_BQNG, I_BQRG, I_BKNG, I_BKRG, I_CQG, I_CKG, I_SINK, I_WAO, I_WBO, I_WCO, I_WO, I_FNG, I_FW1, I_FW3, I_FW2, I_RW, I_MW1, I_MW3, I_MW2 };

constexpr size_t MiB = 1u << 20;
constexpr size_t WS_CTL = 0, CTL_ZERO_BYTES = 1 * MiB;
constexpr size_t SZ_WIN = (size_t)NINP * DM * 2;
constexpr size_t SZ_WUQ = (size_t)512 * 256 * 2, SZ_WUKV = SZ_WUQ;
constexpr size_t SZ_WAO = (size_t)DM * 256 * 2, SZ_WBO = SZ_WAO, SZ_WCO = (size_t)DM * 512 * 2, SZ_WO = (size_t)DM * DM * 2;
constexpr size_t SZ_WIN8 = (size_t)NINP * DM;
constexpr size_t SZ_WO8 = (size_t)DM * DM;
constexpr size_t SZ_LAYERW = SZ_WIN + SZ_WUQ + SZ_WUKV + SZ_WAO + SZ_WBO + SZ_WCO + SZ_WO + SZ_WIN8 + SZ_WO8;
constexpr size_t WS_LAYERW = 1 * MiB;
constexpr size_t OFF_WIN = 0, OFF_WUQ = OFF_WIN + SZ_WIN, OFF_WUKV = OFF_WUQ + SZ_WUQ, OFF_WAO = OFF_WUKV + SZ_WUKV, OFF_WBO = OFF_WAO + SZ_WAO, OFF_WCO = OFF_WBO + SZ_WBO, OFF_WO = OFF_WCO + SZ_WCO, OFF_WIN8 = OFF_WO + SZ_WO, OFF_WO8 = OFF_WIN8 + SZ_WIN8;
constexpr size_t WS_W13 = WS_LAYERW + 2 * SZ_LAYERW;
constexpr size_t SZ_W13 = (size_t)2 * DFF * DM * 2, SZ_W2 = (size_t)DM * DFF * 2;
constexpr size_t WS_W2 = WS_W13 + SZ_W13;
constexpr size_t WS_E13 = WS_W2 + SZ_W2;
constexpr size_t SZ_E13 = (size_t)2 * EFF * DM, SZ_E2 = (size_t)DM * EFF;
constexpr float S_W13 = 32.f, S_W2 = 64.f, S_ACT = 4.f, S_WG = 32.f, S_WO = 32.f, S_MG = 8.f;
constexpr size_t WS_E2 = WS_E13 + NEXP * SZ_E13;
constexpr size_t WS_ROPE = WS_E2 + NEXP * SZ_E2;
constexpr size_t SZ_ROPE = (size_t)NPOS * (32 + 32 + 16 + 16) * 4;
constexpr size_t WS_HB = ((WS_ROPE + SZ_ROPE + MiB - 1) / MiB) * MiB;
constexpr size_t SZ_HB = (size_t)(TCH + 1) * DM * 2;
constexpr size_t WS_HF8 = ((WS_HB + SZ_HB + MiB - 1) / MiB) * MiB;
constexpr size_t WS_ACT = WS_HF8 + (size_t)TCH * DM;
constexpr size_t A_P1 = 0;                                  constexpr size_t SZ_P1 = (size_t)TCH * P1W * 2;
constexpr size_t A_G = A_P1 + SZ_P1;                        constexpr size_t SZ_G = (size_t)TCH * GW;
constexpr size_t A_QA = A_G + SZ_G;
constexpr size_t A_KA = A_QA + (size_t)TCH * 256 * 2;
constexpr size_t A_VA = A_KA + (size_t)TCH * 64 * 2;
constexpr size_t A_IQ = A_VA + (size_t)TCH * 64 * 2;
constexpr size_t A_IK = A_IQ + (size_t)TCH * 256 * 2;
constexpr size_t A_IW = A_IK + (size_t)TCH * 32 * 2;
constexpr size_t A_CQN = A_IW + (size_t)TCH * 8 * 4;
constexpr size_t A_CKVN = A_CQN + (size_t)TCH * 256 * 2;
constexpr size_t A_KR = A_CKVN + (size_t)TCH * 256 * 2;
constexpr size_t A_QC = A_KR + (size_t)TCH * 32 * 2;
constexpr size_t A_KC = A_QC + (size_t)TCH * 512 * 2;
constexpr size_t A_VCT = A_KC + (size_t)TCH * 128 * 2;
constexpr size_t A_QBR = A_VCT + (size_t)TCH * 128 * 2;
constexpr size_t A_KVBR = A_QBR + (size_t)TCH * 512 * 2;
constexpr size_t A_QB = A_KVBR + (size_t)TCH * 512 * 2;
constexpr size_t A_KB = A_QB + (size_t)TCH * 384 * 2;
constexpr size_t A_VBT = A_KB + (size_t)TCH * 384 * 2;
constexpr size_t A_SEL = A_VBT + (size_t)TCH * 256 * 2;
constexpr size_t A_SELN = A_SEL + (size_t)TCH * 256 * 2;
constexpr size_t A_Y = A_SELN + (size_t)TCH * 4;
constexpr size_t A_END = A_Y + (size_t)TCH * DM * 2;
constexpr size_t F_ACT = 0;
constexpr size_t F_YM = F_ACT + (size_t)MOE_ROWS * EFF;
constexpr size_t F_ROWTOK = F_YM + (size_t)MOE_ROWS * DM * 2;
constexpr size_t F_TOPD = F_ROWTOK + (size_t)MOE_ROWS * 4;
constexpr size_t F_TOPE = F_TOPD + (size_t)TCH * 2 * 4;
constexpr size_t F_TOPG = F_TOPE + (size_t)TCH * 2 * 4;
constexpr size_t F_BLKE = F_TOPG + (size_t)TCH * 2 * 4;
constexpr size_t F_END = F_BLKE + 4096;
constexpr size_t WS_XS = WS_ACT + (((A_END > F_END ? A_END : F_END) + MiB - 1) / MiB) * MiB;
constexpr size_t WS_END = WS_XS + (size_t)NTOK * DM * 2;
constexpr int CW_BAR = 4096;
constexpr int CW_Q = 16384;
constexpr int CW_MOE = 32768;
constexpr int CW_DBG = 65536;

constexpr int RING_OFF = 0;
constexpr int IDX_HP = 1028;
constexpr int IDX_HIST = 0, IDX_BITMAP = 0, IDX_CANDK = 32768, IDX_CANDI = 98304, IDX_QT = 131584  , IDX_SUBH = IDX_QT  ,
              IDX_QPAR = 152576, IDX_CCNT = 153600, IDX_FLAG = 153728;
constexpr int IDX_CCAP = 512, IDX_RCAP = 256;
constexpr int MISC_OFF = 153856;
constexpr int LDS_BYTES = 155648;
constexpr int NWAVES = 8;
#ifndef MK_TIMER
#define MK_TIMER 0
#endif
#define TMR_ACC ((LAS unsigned*)(size_t)(MISC_OFF + 192))
#define TB(id) unsigned long long tb_##id = 0ull; if (MK_TIMER == (id)) tb_##id = __builtin_amdgcn_s_memrealtime()
#define TE(id) do { if (MK_TIMER == (id)) { const unsigned d_ = (unsigned)(__builtin_amdgcn_s_memrealtime() - tb_##id); if (lane_id() == 0) lds_add(TMR_ACC, d_); } } while (0)

#define XB_TMO      128
#define XB_XCNT(j)  (256  + 64 * (j))
#define XB_XSUB(j)  (1280 + 64 * (j))
#define XB_XGEN(j)  (2304 + 64 * (j))
#define XB_TOP      3328
#define XB_TOPGEN   3392
#define XCD_BAR_WORDS 3456
#define XB_SPIN_CAP (1u << 18)

__device__ __forceinline__ unsigned xb_ld(unsigned* p)              { return __hip_atomic_load(p, __ATOMIC_RELAXED, __HIP_MEMORY_SCOPE_AGENT); }
__device__ __forceinline__ unsigned xb_add(unsigned* p, unsigned v) { return __hip_atomic_fetch_add(p, v, __ATOMIC_RELAXED, __HIP_MEMORY_SCOPE_AGENT); }
__device__ __forceinline__ unsigned xb_xcc_id() { return (unsigned)__builtin_amdgcn_s_getreg((3 << 11) | 20) & 0xFu; }
#define XB_SPIN(cond, bar) do { unsigned _sp = 0; while (cond) { __builtin_amdgcn_s_sleep(1); \
    if ((++_sp & 255u) == 0u) { if (xb_ld(&(bar)[XB_TMO])) break; if (_sp > XB_SPIN_CAP) { atomicAdd(&(bar)[XB_TMO], 1u); break; } } } } while (0)

struct XcdBarrier {
    unsigned* bar; unsigned x;
    volatile LAS unsigned* st;
};
__device__ __forceinline__ XcdBarrier xcd_barrier_post(unsigned* bar, volatile LAS unsigned* st, int wave_) {
    XcdBarrier b; b.bar = bar; b.x = xb_xcc_id(); b.st = st;
    if (wave_ == 0 && lane_id() == 0) (void)xb_add(&bar[XB_XCNT(b.x)], 1u);
    return b;
}
__device__ __forceinline__ void xcd_barrier_complete(unsigned* bar, unsigned x, unsigned& nloc, unsigned& nx) {
    const unsigned G = gridDim.x * gridDim.y * gridDim.z;
    unsigned sum, cnt, mine, sp = 0u;
    for (;;) {
        sum = 0u; cnt = 0u; mine = 0u;
#pragma unroll
        for (unsigned j = 0; j < 16; ++j) { const unsigned c = xb_ld(&bar[XB_XCNT(j)]); sum += c; cnt += (c > 0u) ? 1u : 0u; mine = (j == x) ? c : mine; }
        if (sum == G) break;
        __builtin_amdgcn_s_sleep(1);
        if ((++sp & 255u) == 0u) { if (xb_ld(&bar[XB_TMO])) break; if (sp > XB_SPIN_CAP) { atomicAdd(&bar[XB_TMO], 1u); break; } }
    }
    nloc = mine > 0u ? mine : 1u; nx = cnt > 0u ? cnt : 1u;
}
__device__ __forceinline__ void xcd_barrier(const XcdBarrier& b, int wave_) {
    asm volatile("s_waitcnt vmcnt(0)" ::: "memory");
    __syncthreads();
    if (wave_ == 0 && lane_id() == 0) {
        unsigned* bar = b.bar;
        __builtin_amdgcn_s_waitcnt(0);
        unsigned nloc = b.st[0], nx = b.st[1];
        if (nloc == 0u) { xcd_barrier_complete(bar, b.x, nloc, nx); b.st[0] = nloc; b.st[1] = nx; }
        const unsigned old = xb_add(&bar[XB_XSUB(b.x)], 1u);
        const unsigned gen = old / nloc;
        if (old + 1u == (gen + 1u) * nloc) {
            __builtin_amdgcn_fence(__ATOMIC_RELEASE, "agent");
            asm volatile("s_waitcnt vmcnt(0)" ::: "memory");
            const unsigned og = xb_add(&bar[XB_TOP], 1u);
            const unsigned tg = og / nx;
            if (og + 1u == (tg + 1u) * nx) xb_add(&bar[XB_TOPGEN], 1u);
            else XB_SPIN(xb_ld(&bar[XB_TOPGEN]) == tg, bar);
            __builtin_amdgcn_fence(__ATOMIC_ACQUIRE, "agent");
            xb_add(&bar[XB_XGEN(b.x)], 1u);
            asm volatile("s_waitcnt vmcnt(0)" ::: "memory");
        } else {
            XB_SPIN(xb_ld(&bar[XB_XGEN(b.x)]) == gen, bar);
            __builtin_amdgcn_fence(__ATOMIC_ACQUIRE, "agent");
            asm volatile("s_waitcnt vmcnt(0)" ::: "memory");
        }
    }
    __syncthreads();
}

template <int MAP> __device__ __forceinline__ int wt_row(int n) {
    if (MAP == 1) return n < C_G ? n : n + (P1W - C_G);
    if (MAP == 2) return 256 * (n >> 7) + (n & 127);
    if (MAP == 3) return 256 * (n >> 7) + 128 + (n & 127);
    return n;
}
template <int MAP>
__device__ __forceinline__ void transpose_item(const float* W, int K, int N, bf16_t* WT, int ldk, LAS float* scr, int item, int lane) {
    const int nblk = (N + 31) / 32, kb = item / nblk, nb = item % nblk, k0 = 64 * kb, n0 = 32 * nb;
    const int nn = n0 + (lane & 31); const bool nok = nn < N;
#pragma unroll
    for (int i = 0; i < 32; ++i) { const int kk = 2 * i + (lane >> 5); scr[kk * 33 + (lane & 31)] = nok ? W[(size_t)(k0 + kk) * N + nn] : 0.f; }
    LDS_WAIT(); asm volatile("" ::: "memory");
    const int c = lane & 7;
#pragma unroll
    for (int j = 0; j < 4; ++j) { const int n = (lane >> 3) + 8 * j; const LAS float* s = scr + (8 * c) * 33 + n;
        u32x4 o; o.x = pk2(s[0 * 33], s[1 * 33]); o.y = pk2(s[2 * 33], s[3 * 33]); o.z = pk2(s[4 * 33], s[5 * 33]); o.w = pk2(s[6 * 33], s[7 * 33]);
        if (n0 + n < N) *(u32x4*)(WT + (size_t)wt_row<MAP>(n0 + n) * ldk + k0 + 8 * c) = o; }
    LDS_WAIT(); asm volatile("" ::: "memory");
}

template <int MAP>
__device__ __forceinline__ void transpose_item_f8(const float* W, int K, int N, unsigned char* WT, int ldk, float sc, LAS float* scr, int item, int lane, int ldn = 0  ) {
    if (ldn == 0) ldn = N;
    const int nblk = (N + 31) / 32, kb = item / nblk, nb = item % nblk, n0 = 32 * nb;
    const int nn = n0 + (lane & 31); const bool nok = nn < N;
    const int c = lane & 7;
#pragma unroll 1
    for (int h = 0; h < 2; ++h) { const int k0 = 128 * kb + 64 * h;
#pragma unroll
        for (int i = 0; i < 32; ++i) { const int kk = 2 * i + (lane >> 5); scr[kk * 33 + (lane & 31)] = nok ? W[(size_t)(k0 + kk) * ldn + nn] * sc : 0.f; }
        LDS_WAIT(); asm volatile("" ::: "memory");
#pragma unroll
        for (int j = 0; j < 4; ++j) { const int n = (lane >> 3) + 8 * j; const LAS float* s = scr + (8 * c) * 33 + n;
            u32x2 o; o.x = pk4_fp8(s[0 * 33], s[1 * 33], s[2 * 33], s[3 * 33]); o.y = pk4_fp8(s[4 * 33], s[5 * 33], s[6 * 33], s[7 * 33]);
            if (n0 + n < N) *(u32x2*)(WT + (size_t)wt_row<MAP>(n0 + n) * ldk + k0 + 8 * c) = o; }
        LDS_WAIT(); asm volatile("" ::: "memory"); }
}
struct RopeTab { const float* c64; const float* s64; const float* c32; const float* s32; };

__device__ __forceinline__ void rope_cs(const RopeTab& R, int pos, int i, int half, float& c, float& s) {
    pos = pos < 0 ? 0 : (pos >= NPOS ? NPOS - 1 : pos);
    if (half == 32) { c = R.c64[pos * 32 + i]; s = R.s64[pos * 32 + i]; } else { c = R.c32[pos * 16 + i]; s = R.s32[pos * 16 + i]; }
}

template <bool XF32>
__device__ __forceinline__ void norm_rows(const void* x, const float* g, bf16_t* HB, unsigned char* HF8, int gw, int ngw, int lane) {
    asm volatile("" : "+v"(lane));
    f32x4 gv[4];
#pragma unroll
    for (int j = 0; j < 4; ++j) gv[j] = *(const f32x4*)(g + 4 * lane + 256 * j);
    for (int tok = gw; tok < TCH; tok += ngw) {
        f32x4 v[4]; float ss = 0.f;
#pragma unroll
        for (int j = 0; j < 4; ++j) {
            if (XF32) v[j] = *(const f32x4*)((const float*)x + (size_t)tok * DM + 4 * lane + 256 * j);
            else { const u32x2 h = *(const u32x2*)((const bf16_t*)x + (size_t)tok * DM + 4 * lane + 256 * j); v[j] = (f32x4){bflo(h.x), bfhi(h.x), bflo(h.y), bfhi(h.y)}; }
            ss += (v[j].x * v[j].x + v[j].y * v[j].y) + (v[j].z * v[j].z + v[j].w * v[j].w); }
        const float rstd = 1.0f / sqrtf(wave_sum(ss) * (1.0f / DM) + EPS);
#pragma unroll
        for (int j = 0; j < 4; ++j) { const float y0 = v[j].x * rstd * gv[j].x, y1 = v[j].y * rstd * gv[j].y, y2 = v[j].z * rstd * gv[j].z, y3 = v[j].w * rstd * gv[j].w;
            *(unsigned*)(HF8 + (size_t)tok * DM + 4 * lane + 256 * j) = pk4_fp8(y0, y1, y2, y3); }
    }
}

struct PP1Args {
    const bf16_t* P1; const int* pos;
    const float *aq_g, *ak_g, *cq_g, *ckv_g, *kr_g, *qc_g, *kc_g;
    unsigned char* act;
    RopeTab R;
};
constexpr float SC_A = 0.125f * LOG2E;
constexpr float SC_B = 0.10206207261596577f * LOG2E;
constexpr float SC_IW = 0.35355339059327373f * 0.17677669529663687f;
__device__ __forceinline__ void pp1_rows(const PP1Args& a, LAS unsigned char* wl  , int gw, int ngw, int lane) {
    asm volatile("" : "+v"(lane));
    const int k16 = lane & 15, g16 = lane >> 4, k8 = lane & 7, g8 = lane >> 3;
    const f32x2 gaq1 = *(const f32x2*)(a.aq_g + 2 * k16), gaq2 = *(const f32x2*)(a.aq_g + 32 + 2 * k16), gak1 = *(const f32x2*)(a.ak_g + 2 * k16), gak2 = *(const f32x2*)(a.ak_g + 32 + 2 * k16);
    const f32x2 gqc1 = *(const f32x2*)(a.qc_g + 2 * k16), gqc2 = *(const f32x2*)(a.qc_g + 32 + 2 * k16), gkc1 = *(const f32x2*)(a.kc_g + 2 * k16), gkc2 = *(const f32x2*)(a.kc_g + 32 + 2 * k16);
    const f32x2 gkr1 = *(const f32x2*)(a.kr_g + 2 * k8), gkr2 = *(const f32x2*)(a.kr_g + 16 + 2 * k8);
    const f32x4 gcq4 = *(const f32x4*)(a.cq_g + 4 * lane); const f32x2 gckv2 = *(const f32x2*)(a.ckv_g + 2 * lane);
    u32x4 nx[4]; int npos = 0; float nr[8];
#pragma unroll
    for (int k = 0; k < 8; ++k) nr[k] = 0.f;
    if (gw < TCH) { const u32x4* src = (const u32x4*)(a.P1 + (size_t)gw * P1W);
#pragma unroll
        for (int j = 0; j < 4; ++j) nx[j] = src[lane + 64 * j];
        const int p0 = a.pos[gw];
        rope_cs(a.R, p0, 2 * k16, 32, nr[0], nr[1]); rope_cs(a.R, p0, 2 * k16 + 1, 32, nr[2], nr[3]); rope_cs(a.R, p0, 2 * k8, 16, nr[4], nr[5]); rope_cs(a.R, p0, 2 * k8 + 1, 16, nr[6], nr[7]);
        if (gw + ngw < TCH) npos = a.pos[gw + ngw]; }
    int buf = 0;
    for (int tok = gw; tok < TCH; tok += ngw, buf ^= 1) {
        LAS unsigned char* rowb = wl + buf * 4096;
#pragma unroll
        for (int j = 0; j < 4; ++j) *(LAS u32x4*)(rowb + (lane + 64 * j) * 16) = nx[j];
        const float c64a = nr[0], s64a = nr[1], c64b = nr[2], s64b = nr[3], c32a = nr[4], s32a = nr[5], c32b = nr[6], s32b = nr[7];
        if (tok + ngw < TCH) { const u32x4* src = (const u32x4*)(a.P1 + (size_t)(tok + ngw) * P1W);
#pragma unroll
            for (int j = 0; j < 4; ++j) nx[j] = src[lane + 64 * j];
            const int p1 = npos;
            rope_cs(a.R, p1, 2 * k16, 32, nr[0], nr[1]); rope_cs(a.R, p1, 2 * k16 + 1, 32, nr[2], nr[3]); rope_cs(a.R, p1, 2 * k8, 16, nr[4], nr[5]); rope_cs(a.R, p1, 2 * k8 + 1, 16, nr[6], nr[7]);
            if (tok + 2 * ngw < TCH) npos = a.pos[tok + 2 * ngw]; }
        const LAS bf16_t* p = (const LAS bf16_t*)rowb;
        const int bl = tok / SEQ, s = tok % SEQ;
#pragma unroll
        for (int it = 0; it < 4; ++it) {
            const int hh = 4 * it + g16;
            const int kind = hh < 4 ? 0 : (hh == 4 ? 1 : (hh < 13 ? 2 : 3));
            const int hsub = kind == 0 ? hh : (kind == 1 ? 0 : (kind == 2 ? hh - 5 : ((hh - 13) & 1)));
            const int src = (kind == 0 ? C_QA : (kind == 1 ? C_KA : (kind == 2 ? C_QC : C_KC))) + 64 * hsub;
            const size_t dbase = kind == 0 ? A_QA : (kind == 1 ? A_KA : (kind == 2 ? A_QC : A_KC));
            const int dpitch = kind == 0 ? 256 : (kind == 1 ? 64 : (kind == 2 ? 512 : 128));
            const float g1a = kind == 0 ? gaq1.x : (kind == 1 ? gak1.x : (kind == 2 ? gqc1.x : gkc1.x)), g1b = kind == 0 ? gaq1.y : (kind == 1 ? gak1.y : (kind == 2 ? gqc1.y : gkc1.y));
            const float g2a = kind == 0 ? gaq2.x : (kind == 1 ? gak2.x : (kind == 2 ? gqc2.x : gkc2.x)), g2b = kind == 0 ? gaq2.y : (kind == 1 ? gak2.y : (kind == 2 ? gqc2.y : gkc2.y));
            const float sc = (kind == 0 || kind == 2) ? SC_A : 1.f;
            bf16_t* dst = (bf16_t*)(a.act + dbase) + (size_t)tok * dpitch + 64 * hsub;
            const unsigned wA = *(const LAS unsigned*)(p + src + 2 * k16), wB = *(const LAS unsigned*)(p + src + 32 + 2 * k16);
            const float x1a = bflo(wA), x1b = bfhi(wA), x2a = bflo(wB), x2b = bfhi(wB);
            const float rstd = 1.0f / sqrtf(sum16((x1a * x1a + x1b * x1b) + (x2a * x2a + x2b * x2b)) * (1.0f / 64.0f) + EPS);
            const float y1a = x1a * rstd * g1a, y1b = x1b * rstd * g1b, y2a = x2a * rstd * g2a, y2b = x2b * rstd * g2b;
            if (hh < 15) { *(unsigned*)(dst + 2 * k16) = pk2((y1a * c64a - y2a * s64a) * sc, (y1b * c64b - y2b * s64b) * sc);
                           *(unsigned*)(dst + 32 + 2 * k16) = pk2((y2a * c64a + y1a * s64a) * sc, (y2b * c64b + y1b * s64b) * sc); }
        }
#pragma unroll
        for (int it = 0; it < 2; ++it) {
            const int hh = 8 * it + g8; const int kind = hh < 8 ? 0 : (hh == 8 ? 1 : 2);
            const int src = kind == 0 ? C_IQ + 32 * hh : (kind == 1 ? C_IK : C_KR);
            const size_t dbase = kind == 0 ? A_IQ : (kind == 1 ? A_IK : A_KR);
            bf16_t* dst = (bf16_t*)(a.act + dbase) + (size_t)tok * (kind == 0 ? 256 : 32) + (kind == 0 ? 32 * hh : 0);
            const unsigned wA = (hh < 10) ? *(const LAS unsigned*)(p + src + 2 * k8) : 0u, wB = (hh < 10) ? *(const LAS unsigned*)(p + src + 16 + 2 * k8) : 0u;
            float x1a = bflo(wA), x1b = bfhi(wA), x2a = bflo(wB), x2b = bfhi(wB);
            float ss = (x1a * x1a + x1b * x1b) + (x2a * x2a + x2b * x2b); ss += xor_lane<1>(ss); ss += xor_lane<2>(ss); ss += xor_lane<4>(ss);
            if (kind == 2) { const float rstd = 1.0f / sqrtf(ss * (1.0f / 32.0f) + EPS); x1a *= rstd * gkr1.x; x1b *= rstd * gkr1.y; x2a *= rstd * gkr2.x; x2b *= rstd * gkr2.y; }
            if (hh < 10) { *(unsigned*)(dst + 2 * k8) = pk2(x1a * c32a - x2a * s32a, x1b * c32b - x2b * s32b);
                           *(unsigned*)(dst + 16 + 2 * k8) = pk2(x2a * c32a + x1a * s32a, x2b * c32b + x1b * s32b); }
        }
        if (lane < 8) ((float*)(a.act + A_IW))[(size_t)tok * 8 + lane] = bf2f(p[C_IW + lane]) * SC_IW;
        ((bf16_t*)(a.act + A_VA))[(size_t)tok * 64 + lane] = p[C_VA + lane];
        { const u32x2 w = *(const LAS u32x2*)(p + C_CQ + 4 * lane); const float x0 = bflo(w.x), x1 = bfhi(w.x), x2 = bflo(w.y), x3 = bfhi(w.y);
          const float rstd = 1.0f / sqrtf(wave_sum((x0 * x0 + x1 * x1) + (x2 * x2 + x3 * x3)) * (1.0f / 256.0f) + EPS);
          const f32x4 g = gcq4;
          u32x2 o; o.x = pk2(x0 * rstd * g.x, x1 * rstd * g.y); o.y = pk2(x2 * rstd * g.z, x3 * rstd * g.w); *(u32x2*)((bf16_t*)(a.act + A_CQN) + (size_t)tok * 256 + 4 * lane) = o; }
        { const unsigned w = *(const LAS unsigned*)(p + C_CKV + 2 * lane); const float x0 = bflo(w), x1 = bfhi(w);
          const float rstd = 1.0f / sqrtf(wave_sum(x0 * x0 + x1 * x1) * (1.0f / 128.0f) + EPS);
          const f32x2 g = gckv2;
          bf16_t* ck = (bf16_t*)(a.act + A_CKVN) + (size_t)tok * 256;
          *(unsigned*)(ck + 2 * lane) = pk2(x0 * rstd * g.x, x1 * rstd * g.y);
          *(unsigned*)(ck + 128 + 2 * lane) = 0u; }
#pragma unroll
        for (int kvh = 0; kvh < 2; ++kvh) ((bf16_t*)(a.act + A_VCT))[((size_t)(bl * 2 + kvh) * 64 + lane) * SEQ + s] = p[C_VC + 64 * kvh + lane];
    }
}

struct PP2Args {
    const bf16_t *QBR, *KVBR, *KR; const int* pos;
    const float *qn_g, *qr_g, *kn_g;
    bf16_t *QB, *KB, *VBT; RopeTab R;
};
__device__ __forceinline__ void pp2_rows(const PP2Args& a, LAS unsigned char* wl  , int gw, int ngw, int lane) {
    asm volatile("" : "+v"(lane));
    const int i32 = lane & 31, hf = lane >> 5;
    const float gqn1 = a.qn_g[i32], gqn2 = a.qn_g[32 + i32], gkn1 = a.kn_g[i32], gkn2 = a.kn_g[32 + i32], gqr1 = (i32 < 16) ? a.qr_g[i32] : 0.f, gqr2 = (i32 < 16) ? a.qr_g[16 + i32] : 0.f;
    u32x4 nx[2]; unsigned nkr = 0u; int npos = 0; float nc32 = 0.f, ns32 = 0.f;
    if (gw < TCH) { const u32x4* src = (const u32x4*)(a.QBR + (size_t)gw * 1024); nx[0] = src[lane]; nx[1] = src[64 + lane]; if (lane < 16) nkr = ((const unsigned*)(a.KR + (size_t)gw * 32))[lane];
        const int p0 = a.pos[gw]; if (i32 < 16) rope_cs(a.R, p0, i32, 16, nc32, ns32); if (gw + ngw < TCH) npos = a.pos[gw + ngw]; }
    int buf = 0;
    for (int tok = gw; tok < TCH; tok += ngw, buf ^= 1) {
        LAS unsigned char* rowb = wl + buf * 4096;
        *(LAS u32x4*)(rowb + lane * 16) = nx[0]; *(LAS u32x4*)(rowb + (64 + lane) * 16) = nx[1]; if (lane < 16) *(LAS unsigned*)(rowb + 2048 + lane * 4) = nkr;
        const float c32 = nc32, s32 = ns32;
        if (tok + ngw < TCH) { const u32x4* src = (const u32x4*)(a.QBR + (size_t)(tok + ngw) * 1024); nx[0] = src[lane]; nx[1] = src[64 + lane]; if (lane < 16) nkr = ((const unsigned*)(a.KR + (size_t)(tok + ngw) * 32))[lane];
            const int p1 = npos; if (i32 < 16) rope_cs(a.R, p1, i32, 16, nc32, ns32); if (tok + 2 * ngw < TCH) npos = a.pos[tok + 2 * ngw]; }
        const int bl = tok / SEQ, s = tok % SEQ;
        const LAS bf16_t* q = (const LAS bf16_t*)rowb; const LAS bf16_t* kv = q + 512; const LAS bf16_t* krl = q + 1024;
        bf16_t* qo = a.QB + (size_t)tok * 384; bf16_t* ko = a.KB + (size_t)tok * 384;
#pragma unroll
        for (int it = 0; it < 2; ++it) {
            const int h = 2 * it + hf;
            { const float x1 = bf2f(q[h * 96 + i32]), x2 = bf2f(q[h * 96 + 32 + i32]);
              const float rstd = 1.0f / sqrtf(sum32(x1 * x1 + x2 * x2) * (1.0f / 64.0f) + EPS);
              qo[h * 96 + i32] = (bf16_t)f2bf(x1 * rstd * gqn1 * SC_B); qo[h * 96 + 32 + i32] = (bf16_t)f2bf(x2 * rstd * gqn2 * SC_B); }
            { const bool on = i32 < 16; const float x1 = on ? bf2f(q[h * 96 + 64 + i32]) : 0.f, x2 = on ? bf2f(q[h * 96 + 80 + i32]) : 0.f;
              const float rstd = 1.0f / sqrtf(sum32(x1 * x1 + x2 * x2) * (1.0f / 32.0f) + EPS);
              const float y1 = x1 * rstd * gqr1, y2 = x2 * rstd * gqr2;
              if (on) { qo[h * 96 + 64 + i32] = (bf16_t)f2bf((y1 * c32 - y2 * s32) * SC_B); qo[h * 96 + 80 + i32] = (bf16_t)f2bf((y2 * c32 + y1 * s32) * SC_B); } }
            { const float x1 = bf2f(kv[h * 128 + i32]), x2 = bf2f(kv[h * 128 + 32 + i32]);
              const float rstd = 1.0f / sqrtf(sum32(x1 * x1 + x2 * x2) * (1.0f / 64.0f) + EPS);
              ko[h * 96 + i32] = (bf16_t)f2bf(x1 * rstd * gkn1); ko[h * 96 + 32 + i32] = (bf16_t)f2bf(x2 * rstd * gkn2);
              ko[h * 96 + 64 + i32] = krl[i32];
              a.VBT[((size_t)(bl * 4 + h) * 64 + i32) * SEQ + s] = kv[h * 128 + 64 + i32];
              a.VBT[((size_t)(bl * 4 + h) * 64 + 32 + i32) * SEQ + s] = kv[h * 128 + 96 + i32]; }
        }
    }
}

struct RouteArgs { const float* rw; int* TOPE; float* TOPG; int* TOPD; unsigned* cursor; };
template <bool ROUTE>
__device__ __forceinline__ void norm2_rows(const bf16_t* x, const float* g, bf16_t* HB, unsigned char* HF8  , const RouteArgs& ra, LAS unsigned* lcnt  , int vcu, int wave, int lane, int G) {
    asm volatile("" : "+v"(lane));
    int tidx = wave * 64 + lane;
    const int tpw = TCH / G; const int t0 = vcu * tpw;
    f32x4 gv[4];
#pragma unroll
    for (int j = 0; j < 4; ++j) gv[j] = *(const f32x4*)(g + 4 * lane + 256 * j);
    for (int tl = wave; tl < tpw; tl += NWAVES) {
        const int tok = t0 + tl;
        const bf16_t* xr = x + (size_t)tok * DM; f32x4 v[4]; float ss = 0.f;
#pragma unroll
        for (int j = 0; j < 4; ++j) { const u32x2 h = *(const u32x2*)(xr + 4 * lane + 256 * j); v[j] = (f32x4){bflo(h.x), bfhi(h.x), bflo(h.y), bfhi(h.y)}; ss += (v[j].x * v[j].x + v[j].y * v[j].y) + (v[j].z * v[j].z + v[j].w * v[j].w); }
        const float rstd = 1.0f / sqrtf(wave_sum(ss) * (1.0f / DM) + EPS);
#pragma unroll
        for (int j = 0; j < 4; ++j) { v[j].x *= rstd * gv[j].x; v[j].y *= rstd * gv[j].y; v[j].z *= rstd * gv[j].z; v[j].w *= rstd * gv[j].w;
            *(unsigned*)(HF8 + (size_t)tok * DM + 4 * lane + 256 * j) = pk4_fp8(v[j].x, v[j].y, v[j].z, v[j].w); }
        if (ROUTE) {
            float lg[NEXP];
#pragma unroll
            for (int e = 0; e < NEXP; ++e) lg[e] = 0.f;
#pragma unroll
            for (int j = 0; j < 4; ++j)
#pragma unroll
                for (int c = 0; c < 4; ++c) { const float hv = v[j][c]; const float* wr = ra.rw + (size_t)(4 * lane + 256 * j + c) * NEXP;
                    const f32x4 w0 = *(const f32x4*)wr, w1 = *(const f32x4*)(wr + 4);
                    lg[0] += hv * w0.x; lg[1] += hv * w0.y; lg[2] += hv * w0.z; lg[3] += hv * w0.w; lg[4] += hv * w1.x; lg[5] += hv * w1.y; lg[6] += hv * w1.z; lg[7] += hv * w1.w; }
#pragma unroll
            for (int e = 0; e < NEXP; ++e) lg[e] = wave_sum(lg[e]);
            int e1 = 0; float l1 = lg[0];
#pragma unroll
            for (int e = 1; e < NEXP; ++e) if (lg[e] > l1) { l1 = lg[e]; e1 = e; }
            int e2 = -1; float l2 = -INFINITY;
#pragma unroll
            for (int e = 0; e < NEXP; ++e) if (e != e1 && lg[e] > l2) { l2 = lg[e]; e2 = e; }
            const float ex = __expf(l2 - l1); const float g1 = 1.0f / (1.0f + ex), g2 = ex / (1.0f + ex);
            if (lane == 0) {
                const unsigned p1 = lds_add(lcnt + e1, 1u), p2 = lds_add(lcnt + e2, 1u);
                ra.TOPE[2 * tok] = e1; ra.TOPE[2 * tok + 1] = e2; ra.TOPG[2 * tok] = g1; ra.TOPG[2 * tok + 1] = g2; ra.TOPD[2 * tok] = (int)p1; ra.TOPD[2 * tok + 1] = (int)p2;
            }
        }
    }
    if (ROUTE) {
        VM_WAIT(); __syncthreads();
        if (tidx < NEXP) { const unsigned n = lcnt[tidx]; lcnt[8 + tidx] = __hip_atomic_fetch_add(ra.cursor + tidx, n, __ATOMIC_RELAXED, __HIP_MEMORY_SCOPE_AGENT); }
        __syncthreads();
        for (int i = tidx; i < 2 * tpw; i += NWAVES * 64) { const int idx = 2 * t0 + i; const int e = ra.TOPE[idx]; ra.TOPD[idx] += (int)lcnt[8 + e]; }
        __syncthreads();
        if (tidx < 16) lcnt[tidx] = 0u;
        __syncthreads();
    }
}

__device__ __forceinline__ void moe_layout(const unsigned* cursor, int* pstart  ) {
    int acc = 0;
#pragma unroll
    for (int e = 0; e < NEXP; ++e) { pstart[e] = acc; const int c = (int)__hip_atomic_load(cursor + e, __ATOMIC_RELAXED, __HIP_MEMORY_SCOPE_AGENT); acc += (c + 255) / 256 * 256; }
    pstart[NEXP] = acc;
}
__device__ __forceinline__ void moe_scatter(const unsigned* cursor, const int* TOPE, int* TOPD, const unsigned char* H8, bf16_t* XB, int* BLKE, int gw, int ngw, int lane) {
    asm volatile("" : "+v"(lane));
    int ps[NEXP + 1]; moe_layout(cursor, ps);
    for (int i = gw; i < 2 * TCH; i += ngw) { const int e = TOPE[i];
        int base = 0;
#pragma unroll
        for (int k = 1; k < NEXP; ++k) base = (e == k) ? ps[k] : base;
        const int dest = base + TOPD[i];
        const u32x4* src = (const u32x4*)(H8 + (size_t)(i >> 1) * DM); u32x4* dst = (u32x4*)((unsigned char*)XB + (size_t)dest * DM);
        dst[lane] = src[lane];
        if (lane == 0) TOPD[i] = dest; }
#pragma unroll
    for (int e = 0; e < NEXP; ++e) { const int cnt = (int)__hip_atomic_load(cursor + e, __ATOMIC_RELAXED, __HIP_MEMORY_SCOPE_AGENT);
        for (int r = ps[e] + cnt + gw; r < ps[e + 1]; r += ngw) { u32x4* dst = (u32x4*)((unsigned char*)XB + (size_t)r * DM); dst[lane] = (u32x4){0u, 0u, 0u, 0u}; }
        for (int blk = ps[e] / 256 + gw * 64 + lane; blk < ps[e + 1] / 256; blk += ngw * 64) BLKE[blk] = e; }
}
__device__ __forceinline__ void moe_combine(const bf16_t* xs, float* xout, const bf16_t* YM, const int* TOPD, const float* TOPG, int gw, int ngw, int lane) {
    asm volatile("" : "+v"(lane));
    for (int tok = gw; tok < TCH; tok += ngw) {
        const int d1 = TOPD[2 * tok], d2 = TOPD[2 * tok + 1]; const float g1 = TOPG[2 * tok], g2 = TOPG[2 * tok + 1];
        const bf16_t* xr = xs + (size_t)tok * DM; float* xo = xout + (size_t)tok * DM; const bf16_t* y1 = YM + (size_t)d1 * DM; const bf16_t* y2 = YM + (size_t)d2 * DM;
#pragma unroll
        for (int j = 0; j < 4; ++j) { const int c = 4 * lane + 256 * j; const u32x2 h = *(const u32x2*)(xr + c); f32x4 v = (f32x4){bflo(h.x), bfhi(h.x), bflo(h.y), bfhi(h.y)}; const u32x2 a = *(const u32x2*)(y1 + c), b = *(const u32x2*)(y2 + c);
            v.x += bflo(a.x) * g1 + bflo(b.x) * g2; v.y += bfhi(a.x) * g1 + bfhi(b.x) * g2; v.z += bflo(a.y) * g1 + bflo(b.y) * g2; v.w += bfhi(a.y) * g1 + bfhi(b.y) * g2;
            *(f32x4*)(xo + c) = v; }
    }
}

__device__ __forceinline__ int kappa32(int m) { return (m & ~12) | ((m & 8) >> 1) | ((m & 4) << 1); }
template <int DQK>
__device__ __forceinline__ void fa_unit(LAS unsigned char* lds, int wave_, const bf16_t* Qw, int qpitch, const bf16_t* Kb, int kpitch, const bf16_t* VTb,
                                        int tile_lo, int tile_hi, int qpos0w, int window, float m_init, float l_init, bf16_t* Ow, int opitch) {
    constexpr int KP = DQK * 2 + 16, VP = 144, KBUF = 64 * KP, VBUF = 64 * VP, KCH = DQK / 8, NKC = 64 * KCH;
    int tid = wave_ * 64 + lane_id(); asm volatile("" : "+v"(tid));
    const int lane = tid & 63, r32 = lane & 31, hi = lane >> 5;
    bf16x8 qf[DQK / 16];
#pragma unroll
    for (int d0 = 0; d0 < DQK / 16; ++d0) qf[d0] = *(const bf16x8*)(Qw + (size_t)r32 * qpitch + d0 * 16 + hi * 8);
    const int kr0 = tid / KCH, kc0 = tid % KCH, kr1 = (tid + 512) / KCH, kc1 = (tid + 512) % KCH; const bool has1 = (tid + 512) < NKC;
    const int vr = tid >> 3, vc = tid & 7;
    u32x4 pk0, pk1 = (u32x4){0u, 0u, 0u, 0u}, pv;
#define FA_LOAD(t) do { const bf16_t* kt_ = Kb + (size_t)(64 * (t)) * kpitch; pk0 = *(const u32x4*)(kt_ + (size_t)kr0 * kpitch + kc0 * 8); if (has1) pk1 = *(const u32x4*)(kt_ + (size_t)kr1 * kpitch + kc1 * 8); \
        pv = *(const u32x4*)(VTb + (size_t)vr * SEQ + 64 * (t) + vc * 8); } while (0)
#define FA_STORE(b) do { LAS unsigned char* kd_ = lds + (b) * KBUF; *(LAS u32x4*)(kd_ + kr0 * KP + kc0 * 16) = pk0; if (has1) *(LAS u32x4*)(kd_ + kr1 * KP + kc1 * 16) = pk1; \
        *(LAS u32x4*)(lds + 2 * KBUF + (b) * VBUF + vr * VP + vc * 16) = pv; } while (0)
    float m_run = m_init, l_run = (hi == 0) ? l_init : 0.f;
    f32x16 o0, o1;
#pragma unroll
    for (int i = 0; i < 16; ++i) { o0[i] = 0.f; o1[i] = 0.f; }
    const int qpos = qpos0w + r32; const int krow = kappa32(r32);
    __syncthreads();
    FA_LOAD(tile_lo); FA_STORE(0);
    __syncthreads();
    for (int t = tile_lo; t < tile_hi; ++t) {
        const int buf = (t - tile_lo) & 1;
        if (t + 1 < tile_hi) FA_LOAD(t + 1);
        const int kbase = 64 * t;
        const bool active = (kbase <= qpos0w + 31) && (window == 0 || kbase + 63 > qpos0w - window);
        if (active) {
            const LAS unsigned char* Kt = lds + buf * KBUF; const LAS unsigned char* Vt = lds + 2 * KBUF + buf * VBUF;
            f32x16 s0, s1;
#pragma unroll
            for (int i = 0; i < 16; ++i) { s0[i] = 0.f; s1[i] = 0.f; }
#pragma unroll
            for (int d0 = 0; d0 < DQK / 16; ++d0) {
                const bf16x8 k0 = *(const LAS bf16x8*)(Kt + krow * KP + d0 * 32 + hi * 16);
                const bf16x8 k1 = *(const LAS bf16x8*)(Kt + (32 + krow) * KP + d0 * 32 + hi * 16);
                s0 = __builtin_amdgcn_mfma_f32_32x32x16_bf16(k0, qf[d0], s0, 0, 0, 0);
                s1 = __builtin_amdgcn_mfma_f32_32x32x16_bf16(k1, qf[d0], s1, 0, 0, 0);
            }
            const bool need_mask = (kbase + 63 > qpos0w) || (window != 0 && kbase <= qpos0w + 31 - window);
            if (need_mask) {
#pragma unroll
                for (int i = 0; i < 16; ++i) { const int key = kbase + 16 * (i >> 3) + 8 * hi + (i & 7);
                    const bool ok0 = (key <= qpos) && (window == 0 || key > qpos - window), ok1 = (key + 32 <= qpos) && (window == 0 || key + 32 > qpos - window);
                    s0[i] = ok0 ? s0[i] : -INFINITY; s1[i] = ok1 ? s1[i] : -INFINITY; }
            }
            float mx0 = max3_(s0[0], s0[1], s0[2]), mx1 = max3_(s0[3], s0[4], s0[5]), mx2 = max3_(s0[6], s0[7], s0[8]), mx3 = max3_(s0[9], s0[10], s0[11]);
            mx0 = max3_(mx0, s0[12], s0[13]); mx1 = max3_(mx1, s0[14], s0[15]); mx2 = max3_(mx2, s1[0], s1[1]); mx3 = max3_(mx3, s1[2], s1[3]);
            mx0 = max3_(mx0, s1[4], s1[5]); mx1 = max3_(mx1, s1[6], s1[7]); mx2 = max3_(mx2, s1[8], s1[9]); mx3 = max3_(mx3, s1[10], s1[11]);
            mx0 = max3_(mx0, s1[12], s1[13]); mx1 = max3_(mx1, s1[14], s1[15]);
            float mx = max3_(max3_(mx0, mx1, mx2), mx3, m_run);
            { const auto rr = __builtin_amdgcn_permlane32_swap(__float_as_uint(mx), __float_as_uint(mx), false, false); mx = max3_(__uint_as_float(rr[0]), __uint_as_float(rr[1]), mx); }
            const float m_new = mx; const float m_use = (m_new == -INFINITY) ? 0.f : m_new;
            const float alpha = fast_exp2(m_run - m_use);
            m_run = m_new;
            const f32x2 mm = (f32x2){m_use, m_use}; f32x2 rs2 = (f32x2){0.f, 0.f};
#pragma unroll
            for (int i = 0; i < 8; ++i) {
                f32x2 d0 = (f32x2){s0[2 * i], s0[2 * i + 1]} - mm, d1 = (f32x2){s1[2 * i], s1[2 * i + 1]} - mm;
                d0.x = fast_exp2(d0.x); d0.y = fast_exp2(d0.y); d1.x = fast_exp2(d1.x); d1.y = fast_exp2(d1.y);
                rs2 += d0; rs2 += d1;
                s0[2 * i] = d0.x; s0[2 * i + 1] = d0.y; s1[2 * i] = d1.x; s1[2 * i + 1] = d1.y; }
            const float rs = rs2.x + rs2.y;
            l_run = l_run * alpha + rs;
#pragma unroll
            for (int i = 0; i < 16; ++i) { o0[i] *= alpha; o1[i] *= alpha; }
            u32x4 w0, w1, w2, w3;
            w0.x = cvt_pk_bf16(s0[0], s0[1]); w0.y = cvt_pk_bf16(s0[2], s0[3]); w0.z = cvt_pk_bf16(s0[4], s0[5]); w0.w = cvt_pk_bf16(s0[6], s0[7]);
            w1.x = cvt_pk_bf16(s0[8], s0[9]); w1.y = cvt_pk_bf16(s0[10], s0[11]); w1.z = cvt_pk_bf16(s0[12], s0[13]); w1.w = cvt_pk_bf16(s0[14], s0[15]);
            w2.x = cvt_pk_bf16(s1[0], s1[1]); w2.y = cvt_pk_bf16(s1[2], s1[3]); w2.z = cvt_pk_bf16(s1[4], s1[5]); w2.w = cvt_pk_bf16(s1[6], s1[7]);
            w3.x = cvt_pk_bf16(s1[8], s1[9]); w3.y = cvt_pk_bf16(s1[10], s1[11]); w3.z = cvt_pk_bf16(s1[12], s1[13]); w3.w = cvt_pk_bf16(s1[14], s1[15]);
            const bf16x8 pa0 = __builtin_bit_cast(bf16x8, w0), pa1 = __builtin_bit_cast(bf16x8, w1), pa2 = __builtin_bit_cast(bf16x8, w2), pa3 = __builtin_bit_cast(bf16x8, w3);
#define FA_PV(o, dt) do { const LAS unsigned char* vrow_ = Vt + (32 * (dt) + r32) * VP + hi * 16; \
                o = __builtin_amdgcn_mfma_f32_32x32x16_bf16(*(const LAS bf16x8*)(vrow_), pa0, o, 0, 0, 0); o = __builtin_amdgcn_mfma_f32_32x32x16_bf16(*(const LAS bf16x8*)(vrow_ + 32), pa1, o, 0, 0, 0); \
                o = __builtin_amdgcn_mfma_f32_32x32x16_bf16(*(const LAS bf16x8*)(vrow_ + 64), pa2, o, 0, 0, 0); o = __builtin_amdgcn_mfma_f32_32x32x16_bf16(*(const LAS bf16x8*)(vrow_ + 96), pa3, o, 0, 0, 0); } while (0)
            FA_PV(o0, 0); FA_PV(o1, 1);
#undef FA_PV
        }
        if (t + 1 < tile_hi) FA_STORE(buf ^ 1);
        __syncthreads();
    }
#undef FA_LOAD
#undef FA_STORE
    const float l_tot = half_sum(l_run); const float inv = 1.0f / l_tot;
    bf16_t* orow = Ow + (size_t)r32 * opitch + 4 * hi;
#pragma unroll
    for (int g = 0; g < 4; ++g) {
        u32x2 a; a.x = cvt_pk_bf16(o0[4 * g] * inv, o0[4 * g + 1] * inv); a.y = cvt_pk_bf16(o0[4 * g + 2] * inv, o0[4 * g + 3] * inv); *(u32x2*)(orow + 8 * g) = a;
        u32x2 b; b.x = cvt_pk_bf16(o1[4 * g] * inv, o1[4 * g + 1] * inv); b.y = cvt_pk_bf16(o1[4 * g + 2] * inv, o1[4 * g + 3] * inv); *(u32x2*)(orow + 32 + 8 * g) = b;
    }
}

struct IdxArgs { const bf16_t* IQ; const bf16_t* IK; const float* IW; unsigned short* SEL; int* SELN; };
__device__ __forceinline__ unsigned mono_key(float f) { const unsigned u = __float_as_uint(f); return u ^ ((unsigned)((int)u >> 31) | 0x80000000u); }
__device__ __forceinline__ int crow32(int i, int hi) { return (i & 3) + 8 * (i >> 2) + 4 * hi; }

#ifndef MK_SC2
#define MK_SC2 0
#endif
constexpr int IDX_QP = 656;
__device__ __forceinline__ void idx_scores(f32x16& sc, const LAS unsigned char* qrow  , const float (&c)[8], const bf16x8 ka0, const bf16x8 ka1) {
    f32x16 z[8], zero;
#pragma unroll
    for (int i = 0; i < 16; ++i) zero[i] = 0.f;
#define IDX_F(slot, ks) (*(const LAS bf16x8*)(qrow + (slot) * 64 + (ks) * 32))
    bf16x8 f0 = IDX_F(8, 0), f1 = IDX_F(0, 0);
    sc = __builtin_amdgcn_mfma_f32_32x32x16_bf16(ka0, f0, zero, 0, 0, 0); f0 = IDX_F(1, 0);
#pragma unroll
    for (int h = 0; h < 8; h += 2) {
        z[h] = __builtin_amdgcn_mfma_f32_32x32x16_bf16(ka0, f1, zero, 0, 0, 0); f1 = (h + 2 < 8) ? IDX_F(h + 2, 0) : IDX_F(9, 0);
        z[h + 1] = __builtin_amdgcn_mfma_f32_32x32x16_bf16(ka0, f0, zero, 0, 0, 0); f0 = (h + 3 < 8) ? IDX_F(h + 3, 0) : IDX_F(8, 1);
    }
    sc = __builtin_amdgcn_mfma_f32_32x32x16_bf16(ka0, f1, sc, 0, 0, 0); f1 = IDX_F(0, 1);
    sc = __builtin_amdgcn_mfma_f32_32x32x16_bf16(ka1, f0, sc, 0, 0, 0); f0 = IDX_F(1, 1);
#pragma unroll
    for (int h = 0; h < 8; h += 2) {
        z[h] = __builtin_amdgcn_mfma_f32_32x32x16_bf16(ka1, f1, z[h], 0, 0, 0); f1 = (h + 2 < 8) ? IDX_F(h + 2, 1) : IDX_F(9, 1);
        z[h + 1] = __builtin_amdgcn_mfma_f32_32x32x16_bf16(ka1, f0, z[h + 1], 0, 0, 0); if (h + 3 < 8) f0 = IDX_F(h + 3, 1);
    }
    sc = __builtin_amdgcn_mfma_f32_32x32x16_bf16(ka1, f1, sc, 0, 0, 0);
#undef IDX_F
#pragma unroll
    for (int h = 0; h < 8; ++h)
#pragma unroll
        for (int i = 0; i < 16; ++i) sc[i] = __builtin_fmaf(__builtin_fabsf(z[h][i]), c[h], sc[i]);
}
#define IDX_LOADK(k0, k1, tile_) do { const bf16_t* ikt_ = ikb + (size_t)(tile_) * 32 * 32; k0 = *(const bf16x8*)(ikt_ + r32 * 32 + hi * 8); k1 = *(const bf16x8*)(ikt_ + r32 * 32 + 16 + hi * 8); } while (0)
template <int WPL>
__device__ __forceinline__ bool hist_scan(const LAS unsigned* hw, int lane, unsigned need, int& bin, unsigned& above, unsigned& nb) {
    asm volatile("" : "+v"(lane));
    unsigned w[WPL]; unsigned tot = 0;
#pragma unroll
    for (int i = 0; i < WPL; i += 4) { const u32x4 v = *(const LAS u32x4*)(hw + WPL * lane + i); w[i] = v.x; w[i + 1] = v.y; w[i + 2] = v.z; w[i + 3] = v.w; }
#pragma unroll
    for (int i = 0; i < WPL; ++i) tot += (w[i] & 0xffffu) + (w[i] >> 16);
    unsigned suf = tot;
#pragma unroll
    for (int d = 1; d < 64; d <<= 1) { const unsigned t = (unsigned)lane_get((int)suf, (lane + d) & 63); if (lane + d < 64) suf += t; }
    const unsigned total = (unsigned)lane_bcast((int)suf, 0);
    if (total < need) { above = total; return false; }
    const unsigned ab = suf - tot;
    const bool mine = (ab < need) && (need <= suf);
    int b_ = 0; unsigned a_ = 0, n_ = 0;
    if (mine) { unsigned acc = ab; bool done = false;
#pragma unroll
        for (int i = WPL - 1; i >= 0; --i) {
            const unsigned chi = w[i] >> 16, clo = w[i] & 0xffffu;
            if (!done && acc + chi >= need) { done = true; b_ = 2 * (WPL * lane + i) + 1; a_ = acc; n_ = chi; } if (!done) acc += chi;
            if (!done && acc + clo >= need) { done = true; b_ = 2 * (WPL * lane + i); a_ = acc; n_ = clo; } if (!done) acc += clo; } }
    const unsigned long long bal = __ballot(mine); const int src = __ffsll((long long)bal) - 1;
    bin = lane_bcast(b_, src); above = (unsigned)lane_bcast((int)a_, src); nb = (unsigned)lane_bcast((int)n_, src);
    return true;
}
template <int P>
__device__ __forceinline__ void idx_hist_tiles(LAS unsigned* hrow, const LAS unsigned char* qrow, const float (&w)[8], const bf16_t* ikb, int wid, int ntile, int qpos, int r32, int hi, bool mine, unsigned pfx) {
    bf16x8 kb[4][2];
#pragma unroll
    for (int u = 0; u < 4; ++u) if (wid + 8 * u < ntile) IDX_LOADK(kb[u][0], kb[u][1], wid + 8 * u);
#pragma unroll 1
    for (int base = wid; base < ntile; base += 32) {
#pragma unroll
        for (int u = 0; u < 4; ++u) { const int tile = base + 8 * u; if (tile < ntile) {
            const bf16x8 ka0 = kb[u][0], ka1 = kb[u][1];
            f32x16 sc; idx_scores(sc, qrow, w, ka0, ka1);
            if (tile + 32 < ntile) IDX_LOADK(kb[u][0], kb[u][1], tile + 32);
            const int lim = (tile == ntile - 1) ? qpos - 32 * tile : 64;
#pragma unroll
            for (int i = 0; i < 16; ++i) {
                bool ok = mine && (crow32(i, hi) <= lim); unsigned bin;
                if (P == 0) { bin = mono_key(sc[i]) >> 21; }
                else { const unsigned k = mono_key(sc[i]);
                    if (P == 1) { ok = false; bin = 0u; }
                    else if (P == 2) { ok = ok && ((k >> 21) == pfx); bin = (k >> 10) & 2047u; }
                    else { ok = ok && ((k >> 10) == pfx); bin = k & 1023u; } }
                if (ok) lds_add(hrow + (bin >> 1), 1u << (16 * (bin & 1u))); }
            __builtin_amdgcn_sched_barrier(0);
        } }
    }
}
__device__ __forceinline__ void idx_unit(LAS unsigned char* lds, int wave_, const IdxArgs& a, int rowb  , int qb32) {
    int tid = wave_ * 64 + lane_id(); asm volatile("" : "+v"(tid));
    const int lane = tid & 63, wid = wave_, r32 = lane & 31, hi = lane >> 5;
    const int q0 = 32 * qb32, ntile = qb32 + 1, qpos = q0 + r32;
    LAS unsigned* hist = (LAS unsigned*)(lds + IDX_HIST);
    LAS unsigned* bitmap = (LAS unsigned*)(lds + IDX_BITMAP);
    LAS unsigned* candk = (LAS unsigned*)(lds + IDX_CANDK);
    LAS unsigned short* candi = (LAS unsigned short*)(lds + IDX_CANDI);
    LAS unsigned* subh = (LAS unsigned*)(lds + IDX_SUBH) + wid * 512;
    LAS unsigned* qpar = (LAS unsigned*)(lds + IDX_QPAR);
    LAS unsigned* ccnt = (LAS unsigned*)(lds + IDX_CCNT);
    LAS unsigned* flag = (LAS unsigned*)(lds + IDX_FLAG);
    if (q0 + 32 <= 256) {
        __syncthreads();
        for (int q = wid; q < 32; q += NWAVES) { const int t = q0 + q; unsigned short* sp = a.SEL + (size_t)(rowb + t) * 256;
#pragma unroll
            for (int j = 0; j < 4; ++j) { const int k = lane + 64 * j; sp[k] = (unsigned short)(k <= t ? k : 0); }
            if (lane == 0) a.SELN[rowb + t] = t + 1; }
        return;
    }
    float w[8];
#pragma unroll
    for (int h = 0; h < 8; ++h) w[h] = 0.5f * a.IW[(size_t)(rowb + qpos) * 8 + h];
    const LAS unsigned char* qrow = lds + IDX_QT + r32 * IDX_QP + hi * 16;
    const bf16_t* ikb = a.IK + (size_t)rowb * 32;
    __syncthreads();
#pragma unroll
    for (int i = 0; i < 2; ++i) { const int c = tid + 512 * i, row = c >> 5, c16 = c & 31;
        *(LAS u32x4*)(lds + IDX_QT + row * IDX_QP + c16 * 16) = *(const u32x4*)(a.IQ + (size_t)(rowb + q0 + row) * 256 + c16 * 8); }
    __syncthreads();
    { const int q = tid >> 4, d2 = (tid & 15) * 2; const float* wq = a.IW + (size_t)(rowb + q0 + q) * 8; float s0 = 0.f, s1 = 0.f;
#pragma unroll
      for (int h = 0; h < 8; ++h) { const unsigned pr = *(const LAS unsigned*)(lds + IDX_QT + q * IDX_QP + h * 64 + d2 * 2); const float wh = 0.5f * wq[h]; s0 += wh * bflo(pr); s1 += wh * bfhi(pr); }
      const unsigned h0 = f2bf(s0), h1 = f2bf(s1); const float r0 = s0 - bf2f((bf16_t)h0), r1 = s1 - bf2f((bf16_t)h1);
      *(LAS unsigned*)(lds + IDX_QT + q * IDX_QP + 8 * 64 + d2 * 2) = h0 | (h1 << 16);
      *(LAS unsigned*)(lds + IDX_QT + q * IDX_QP + 9 * 64 + d2 * 2) = pk2(r0, r1); }
    if (tid < 256) { const int q = tid >> 3, f = tid & 7; const bool all = (q0 + q + 1 <= 256); qpar[tid] = (f == 0) ? (all ? 2u : 0u) : ((f == 2) ? 256u : 0u); }
    if (tid < 32) ccnt[tid] = 0u;
    if (tid < 8) flag[tid] = (tid == 0) ? 1u : 0u;
#pragma unroll 1
    for (int p = 0; p < 4; ++p) {
        __syncthreads();
        if (flag[p] == 0u) continue;
        for (int i = tid; i < 32 * IDX_HP / 4; i += NWAVES * 64) ((LAS u32x4*)hist)[i] = (u32x4){0u, 0u, 0u, 0u};
        __syncthreads();
        const bool mine = (qpar[8 * r32] == 0u) && (qpar[8 * r32 + 4] == (unsigned)p); const unsigned pfx = qpar[8 * r32 + 1];
        TB(1);
        if (__any(mine)) {
            LAS unsigned* hrow = hist + r32 * IDX_HP;
            if (p == 0) idx_hist_tiles<0>(hrow, qrow, w, ikb, wid, ntile, qpos, r32, hi, mine, pfx);
            else if (p == 1) idx_hist_tiles<1>(hrow, qrow, w, ikb, wid, ntile, qpos, r32, hi, mine, pfx);
            else if (p == 2) idx_hist_tiles<2>(hrow, qrow, w, ikb, wid, ntile, qpos, r32, hi, mine, pfx);
            else idx_hist_tiles<3>(hrow, qrow, w, ikb, wid, ntile, qpos, r32, hi, mine, pfx);
        }
        TE(1);
        __syncthreads();
        TB(2);
        for (int j = 0; j < 4; ++j) { const int q = 4 * wid + j; const unsigned qs = qpar[8 * q], need = qpar[8 * q + 2], qp = qpar[8 * q + 1];
            if (qs != 0u || qpar[8 * q + 4] != (unsigned)p) continue;
            int bin; unsigned above, nb; const bool found = hist_scan<16>(hist + q * IDX_HP, lane, need, bin, above, nb);
            if (lane == 0) {
                if (!found) { if (false) { }
                              else { qpar[8 * q] = 2u; qpar[8 * q + 2] = 0u; } }
                else { const unsigned np = (p == 0) ? (unsigned)bin : (p == 2 ? ((qp << 11) | (unsigned)bin) : ((qp << 10) | (unsigned)bin));
                    qpar[8 * q + 1] = np; qpar[8 * q + 2] = need - above; qpar[8 * q + 3] = (p <= 1) ? 21u : (p == 2 ? 10u : 0u);
                    const unsigned shn = (p <= 1) ? 21u : (p == 2 ? 10u : 0u); const unsigned klo = np << shn; const unsigned long long khi = ((unsigned long long)np + 1ull) << shn;
                    qpar[8 * q + 5] = (klo & 0x80000000u) ? (klo ^ 0x80000000u) : ~klo;
                    qpar[8 * q + 6] = (khi >> 32) ? 0x7f800000u : (((unsigned)khi & 0x80000000u) ? ((unsigned)khi ^ 0x80000000u) : ~(unsigned)khi);
                    if (nb <= (unsigned)IDX_CCAP || p == 3) qpar[8 * q] = 1u; else { const unsigned nx = (p <= 1) ? 2u : 3u; qpar[8 * q + 4] = nx; flag[nx] = 1u; } } }
        }
        TE(2);
    }
    __syncthreads();
    for (int i = tid; i < 32 * 256 / 4; i += NWAVES * 64) ((LAS u32x4*)bitmap)[i] = (u32x4){0u, 0u, 0u, 0u};
    __syncthreads();
    TB(3);
    { const unsigned st = qpar[8 * r32]; const float tcand = (st == 2u) ? -INFINITY : __uint_as_float(qpar[8 * r32 + 5]), tsel = (st == 2u) ? -INFINITY : __uint_as_float(qpar[8 * r32 + 6]);
      bf16x8 kb[4][2];
#pragma unroll
      for (int u = 0; u < 4; ++u) if (wid + 8 * u < ntile) IDX_LOADK(kb[u][0], kb[u][1], wid + 8 * u);
#pragma unroll 1
      for (int base = wid; base < ntile; base += 32) {
#pragma unroll
          for (int u = 0; u < 4; ++u) { const int tile = base + 8 * u; if (tile < ntile) {
              const bf16x8 ka0 = kb[u][0], ka1 = kb[u][1];
              f32x16 sc; idx_scores(sc, qrow, w, ka0, ka1);
#if MK_SC2
              asm volatile("" : "+v"(sc)); { bf16x8 kx0 = ka0, kx1 = ka1; asm volatile("" : "+v"(kx0), "+v"(kx1)); idx_scores(sc, qrow, w, kx0, kx1); asm volatile("" : "+v"(sc)); }
#endif
              if (tile + 32 < ntile) IDX_LOADK(kb[u][0], kb[u][1], tile + 32);
              const int lim = (tile == ntile - 1) ? qpos - 32 * tile : 64;
#pragma unroll
              for (int i = 0; i < 16; ++i) {
                  if (sc[i] >= tcand && crow32(i, hi) <= lim) { const int key = 32 * tile + crow32(i, hi);
                      if (sc[i] >= tsel) lds_or(bitmap + r32 * 256 + (key >> 5), 1u << (key & 31));
                      else { const unsigned pos = lds_add(ccnt + r32, 1u); if (pos < (unsigned)IDX_CCAP) { candk[r32 * IDX_CCAP + pos] = mono_key(sc[i]); candi[r32 * IDX_CCAP + pos] = (unsigned short)key; } } } }
              __builtin_amdgcn_sched_barrier(0);
          } }
      } }
    TE(3);
    __syncthreads();
    TB(4);
    for (int j = 0; j < 4; ++j) {
        const int q = 4 * wid + j; const unsigned st = qpar[8 * q]; unsigned need = qpar[8 * q + 2]; const unsigned sh = qpar[8 * q + 3];
        const int nc = (st == 1u) ? (int)min(ccnt[q], (unsigned)IDX_CCAP) : 0;
        LAS unsigned* bm = bitmap + q * 256; const LAS unsigned* ck = candk + q * IDX_CCAP; const LAS unsigned short* ci = candi + q * IDX_CCAP;
        if (nc > 0) {
            if ((unsigned)nc <= need) { for (int c = lane; c < nc; c += 64) { const unsigned key = ci[c]; lds_or(bm + (key >> 5), 1u << (key & 31)); } }
            else {
                int nR = 0; LAS unsigned long long* R = (LAS unsigned long long*)subh;
                if (sh > 0u) {
                    const int nbit = sh >= 10u ? 10 : (int)sh, fs = (int)sh - nbit; const unsigned smask = (1u << nbit) - 1u;
#pragma unroll
                    for (int i = 0; i < 8; ++i) subh[8 * lane + i] = 0u;
                    LDS_WAIT();
                    for (int c = lane; c < nc; c += 64) { const unsigned sub = (ck[c] >> fs) & smask; lds_add(subh + (sub >> 1), 1u << (16 * (sub & 1u))); }
                    LDS_WAIT();
                    int b2; unsigned ab2, nb2; (void)hist_scan<8>(subh, lane, need, b2, ab2, nb2);
                    need -= ab2; LDS_WAIT();
                    for (int c0 = 0; c0 < nc; c0 += 64) { const int c = c0 + lane; bool inb = false; unsigned k = 0, key = 0;
                        if (c < nc) { k = ck[c]; key = ci[c]; const int sub = (int)((k >> fs) & smask); if (sub > b2) lds_or(bm + (key >> 5), 1u << (key & 31)); inb = (sub == b2); }
                        const unsigned long long bal = __ballot(inb); const int pos = nR + __popcll(bal & ((1ull << lane) - 1ull));
                        if (inb && pos < IDX_RCAP) R[pos] = ((unsigned long long)k << 13) | (unsigned long long)(8191u - key);
                        nR += __popcll(bal); }
                } else {
                    for (int c0 = 0; c0 < nc; c0 += 64) { const int c = c0 + lane; if (c < nc && c < IDX_RCAP) R[c] = ((unsigned long long)ck[c] << 13) | (unsigned long long)(8191u - ci[c]); }
                    nR = nc;
                }
                nR = min(nR, IDX_RCAP); LDS_WAIT();
                for (int r = lane; r < nR; r += 64) { const unsigned long long me = R[r]; unsigned better = 0;
                    for (int x = 0; x < nR; ++x) better += (R[x] > me) ? 1u : 0u;
                    if (better < need) { const unsigned key = 8191u - (unsigned)(me & 8191ull); lds_or(bm + (key >> 5), 1u << (key & 31)); } }
            }
        }
        LDS_WAIT();
        { const u32x4 bw = *(const LAS u32x4*)(bm + 4 * lane); unsigned wv[4] = {bw.x, bw.y, bw.z, bw.w};
          const int mycnt = __popc(wv[0]) + __popc(wv[1]) + __popc(wv[2]) + __popc(wv[3]);
          int pre = mycnt;
#pragma unroll
          for (int d = 1; d < 64; d <<= 1) { const int t = lane_get(pre, (lane - d) & 63); if (lane >= d) pre += t; }
          const int total = lane_bcast(pre, 63); int pos = pre - mycnt;
          unsigned short* sp = a.SEL + (size_t)(rowb + q0 + q) * 256;
#pragma unroll
          for (int wi = 0; wi < 4; ++wi) { unsigned m = wv[wi]; while (m) { const int b = __ffs((int)m) - 1; m &= m - 1u; if (pos < 256) sp[pos] = (unsigned short)(32 * (4 * lane + wi) + b); ++pos; } }
          if (lane == 0) a.SELN[rowb + q0 + q] = min(total, 256); }
        LDS_WAIT();
    }
    TE(4);
}

#undef IDX_LOADK
struct SpaArgs { const bf16_t* QA; const bf16_t* KA; const bf16_t* VA; const unsigned short* SEL; const int* SELN; bf16_t* Y; };
struct SpaPre { int nv[2]; u32x2 s4[2]; };
__device__ __forceinline__ void sparse_prefetch(SpaPre& P, const SpaArgs& a, int rowA, int rowB, int lane) {
    const int row[2] = {rowA, rowB};
#pragma unroll
    for (int q = 0; q < 2; ++q) { P.nv[q] = a.SELN[row[q]]; P.s4[q] = *(const u32x2*)(a.SEL + (size_t)row[q] * 256 + 4 * lane); }
}
__device__ __forceinline__ void sparse_pair(LAS unsigned char* wl, const SpaArgs& a, const SpaPre& P, int rowbA, int tA, int rowbB, int tB, int lane) {
    const int rowb[2] = {rowbA, rowbB}; const int row[2] = {rowbA + tA, rowbB + tB};
    LAS float* lg[2]; LAS unsigned short* sl[2]; int nv[2];
#pragma unroll
    for (int q = 0; q < 2; ++q) { lg[q] = (LAS float*)(wl + q * 8192); sl[q] = (LAS unsigned short*)(wl + q * 8192 + 4096); nv[q] = P.nv[q]; *(LAS u32x2*)(sl[q] + 4 * lane) = P.s4[q]; }
    LDS_WAIT();
    const int m16 = lane & 15, kq = lane >> 4;
    bf16x8 qf0[2], qf1[2];
#pragma unroll
    for (int q = 0; q < 2; ++q) { qf0[q] = (bf16x8){0, 0, 0, 0, 0, 0, 0, 0}; qf1[q] = qf0[q];
        if (m16 < 4) { const bf16_t* qp = a.QA + (size_t)row[q] * 256 + m16 * 64 + kq * 8; qf0[q] = *(const bf16x8*)qp; qf1[q] = *(const bf16x8*)(qp + 32); } }
#pragma unroll
    for (int tile = 0; tile < 16; ++tile)
#pragma unroll
        for (int q = 0; q < 2; ++q) {
            const int j = 16 * tile + m16; const int s = (j < nv[q]) ? (int)sl[q][j] : 0;
            const bf16_t* kp = a.KA + (size_t)(rowb[q] + s) * 64 + kq * 8;
            const bf16x8 k0 = *(const bf16x8*)kp, k1 = *(const bf16x8*)(kp + 32);
            f32x4 acc = (f32x4){0.f, 0.f, 0.f, 0.f};
            acc = __builtin_amdgcn_mfma_f32_16x16x32_bf16(qf0[q], k0, acc, 0, 0, 0);
            acc = __builtin_amdgcn_mfma_f32_16x16x32_bf16(qf1[q], k1, acc, 0, 0, 0);
            if (kq == 0) { const bool ok = j < nv[q]; f32x4 v; v.x = ok ? acc.x : -INFINITY; v.y = ok ? acc.y : -INFINITY; v.z = ok ? acc.z : -INFINITY; v.w = ok ? acc.w : -INFINITY; *(LAS f32x4*)(lg[q] + 4 * j) = v; }
        }
    LDS_WAIT();
    const int h = lane >> 4; float sm[2];
#pragma unroll
    for (int q = 0; q < 2; ++q) { float pv[16]; float mx = -INFINITY;
#pragma unroll
        for (int i = 0; i < 16; ++i) { pv[i] = lg[q][4 * (m16 + 16 * i) + h]; mx = fmaxf(mx, pv[i]); }
        mx = max16(mx);
        float s_ = 0.f;
#pragma unroll
        for (int i = 0; i < 16; ++i) { pv[i] = fast_exp2(pv[i] - mx); s_ += pv[i]; }
        sm[q] = sum16(s_);
#pragma unroll
        for (int i = 0; i < 16; ++i) lg[q][4 * (m16 + 16 * i) + h] = pv[i]; }
    LDS_WAIT();
    const int g = lane >> 3, c8 = lane & 7;
    float acc[2][4][8];
#pragma unroll
    for (int q = 0; q < 2; ++q)
#pragma unroll
        for (int h4 = 0; h4 < 4; ++h4)
#pragma unroll
            for (int c = 0; c < 8; ++c) acc[q][h4][c] = 0.f;
    const int nvm = nv[0] > nv[1] ? nv[0] : nv[1]; const int nit = (nvm + 7) >> 3;
#pragma unroll 8
    for (int it = 0; it < nit; ++it)
#pragma unroll
        for (int q = 0; q < 2; ++q) {
            const int j = 8 * it + g; const int srow = (j < nv[q]) ? (int)sl[q][j] : 0;
            const u32x4 v = *(const u32x4*)(a.VA + (size_t)(rowb[q] + srow) * 64 + c8 * 8);
            const f32x4 p = *(const LAS f32x4*)(lg[q] + 4 * j);
            const float vv[8] = {bflo(v.x), bfhi(v.x), bflo(v.y), bfhi(v.y), bflo(v.z), bfhi(v.z), bflo(v.w), bfhi(v.w)};
#pragma unroll
            for (int c = 0; c < 8; ++c) { acc[q][0][c] += p.x * vv[c]; acc[q][1][c] += p.y * vv[c]; acc[q][2][c] += p.z * vv[c]; acc[q][3][c] += p.w * vv[c]; }
        }
    LDS_WAIT();
#pragma unroll
    for (int q = 0; q < 2; ++q) {
        const float l0 = __int_as_float(lane_bcast(__float_as_int(sm[q]), 0)), l1 = __int_as_float(lane_bcast(__float_as_int(sm[q]), 16)), l2 = __int_as_float(lane_bcast(__float_as_int(sm[q]), 32)), l3 = __int_as_float(lane_bcast(__float_as_int(sm[q]), 48));
        LAS float* red = (LAS float*)(wl + q * 8192);
#pragma unroll
        for (int h4 = 0; h4 < 4; ++h4) { *(LAS f32x4*)(red + g * 256 + h4 * 64 + c8 * 8) = (f32x4){acc[q][h4][0], acc[q][h4][1], acc[q][h4][2], acc[q][h4][3]}; *(LAS f32x4*)(red + g * 256 + h4 * 64 + c8 * 8 + 4) = (f32x4){acc[q][h4][4], acc[q][h4][5], acc[q][h4][6], acc[q][h4][7]}; }
        LDS_WAIT();
        f32x4 o = (f32x4){0.f, 0.f, 0.f, 0.f};
#pragma unroll
        for (int gg = 0; gg < 8; ++gg) o += *(const LAS f32x4*)(red + gg * 256 + 4 * lane);
        const int ho = lane >> 4; const float li = 1.0f / (ho == 0 ? l0 : (ho == 1 ? l1 : (ho == 2 ? l2 : l3)));
        u32x2 w; w.x = pk2(o.x * li, o.y * li); w.y = pk2(o.z * li, o.w * li);
        if (q == 0 || row[1] != row[0]) *(u32x2*)(a.Y + (size_t)row[q] * DM + 4 * lane) = w; }
    LDS_WAIT();
}

#ifndef MK_CHECK
#define MK_CHECK 0
#endif
#ifndef MK_CHECK_L
#define MK_CHECK_L 0
#define MK_CHECK_CH 0
#endif
#ifndef MK_PER_PHASE
#define MK_PER_PHASE 0
#endif

__device__ __forceinline__ int q_next(unsigned* head, volatile LAS unsigned* bc, int wave_) {
    __syncthreads();
    if (wave_ == 0 && lane_id() == 0) bc[0] = __hip_atomic_fetch_add(head, 1u, __ATOMIC_RELAXED, __HIP_MEMORY_SCOPE_AGENT);
    __syncthreads();
    return (int)bc[0];
}

constexpr int N_PHASES_C = 1 + NCHUNK * (9 + 3) + NCHUNK * (9 + 5);
typedef __attribute__((address_space(4))) const unsigned char* kptr_t;
#define PHASE_ENV() kptr_t kp_ = (kptr_t)__builtin_amdgcn_kernarg_segment_ptr(); asm volatile("; MKPHASE %1" : "+s"(kp_) : "n"(__LINE__)); \
    unsigned char* const ws = *(unsigned char* const __attribute__((address_space(4)))*)(kp_ + 240); float* const out = *(float* const __attribute__((address_space(4)))*)(kp_ + 232); \
    unsigned char* const act = ws + WS_ACT; bf16_t* const HB = (bf16_t*)(ws + WS_HB); bf16_t* const XS = (bf16_t*)(ws + WS_XS); unsigned* const ctl = (unsigned*)(ws + WS_CTL); \
    const size_t row0 = (size_t)ch * TCH; const unsigned char* const lw = ws + WS_LAYERW + (size_t)l * SZ_LAYERW; \
    int gwl = gw, ngwl = ngw; asm volatile("" : "+s"(gwl), "+s"(ngwl)); \
    (void)out; (void)act; (void)HB; (void)XS; (void)ctl; (void)row0; (void)lw; (void)gwl; (void)ngwl
#define INP(k) (*(const void* const __attribute__((address_space(4)))*)(kp_ + 8 * (k)))
#define FIN(k) ((const float*)INP(k))
#define ROPE_TAB(RT) RopeTab RT; RT.c64 = (const float*)(ws + WS_ROPE); RT.s64 = RT.c64 + (size_t)NPOS * 32; RT.c32 = RT.s64 + (size_t)NPOS * 32; RT.s32 = RT.c32 + (size_t)NPOS * 16
#define ABUF(T, off) ((T*)(act + (off)))

#ifndef MK_NV
#define MK_NV 256
#endif
#ifndef MK_LB
#define MK_LB 2
#endif
__global__ void __launch_bounds__(NWAVES * 64, MK_LB) mk_fwd(Args args) {
    extern __shared__ __attribute__((aligned(16))) unsigned char lds_raw[];
    LAS unsigned char* lds = (LAS unsigned char*)lds_raw;
    volatile LAS unsigned* MISC = (volatile LAS unsigned*)(lds + MISC_OFF);
    const int wave = __builtin_amdgcn_readfirstlane((int)threadIdx.x >> 6);
#define tid (wave * 64 + lane_id())
    const int G = gridDim.x; const int bx = blockIdx.x; const int vcu = (G % 8 == 0) ? (bx % 8) * (G / 8) + bx / 8 : bx;
    const int gw = vcu * NWAVES + wave, ngw = G * NWAVES;
    for (int u = tid; u < 64; u += NWAVES * 64) MISC[u] = 0u;
    __syncthreads();
    XcdBarrier bar; bar.bar = (unsigned*)(args.ws + WS_CTL) + CW_BAR + args.pad0 * XCD_BAR_WORDS; bar.x = 0; bar.st = nullptr;
    if (!MK_PER_PHASE) bar = xcd_barrier_post((unsigned*)(args.ws + WS_CTL) + CW_BAR + args.pad0 * XCD_BAR_WORDS, MISC + 8, wave);
    int pid = 0;
#ifndef MK_ATT
#define MK_ATT 7
#endif
#ifndef MK_EN
#define MK_EN 0xffffffffu
#endif
#define EN(k) (((MK_EN) >> (k)) & 1u)
#ifndef MK_ATT_REP
#define MK_ATT_REP 7
#endif
#ifndef MK_SPA_REP
#define MK_SPA_REP 1
#endif
#ifndef MK_REP
#define MK_REP 0u
#endif
#define REPS(k) (1 + (((MK_REP) >> (k)) & 1u))
#define RUN() (args.ph_lo <= pid && pid < args.ph_hi)
#define SEAM() do { if (args.ph_lo <= pid && pid + 1 < args.ph_hi) { TB(5); xcd_barrier(bar, wave); TE(5); } ++pid; } while (0)

    if (EN(0) && RUN()) for (int rep_ = 0; rep_ < (int)REPS(0); ++rep_) {
        const int l = 0, ch = 0; PHASE_ENV();
        int lane = tid & 63; asm volatile("" : "+v"(lane)); int tid0 = tid; asm volatile("" : "+v"(tid0));
        LAS float* scr = (LAS float*)(lds + wave * 16384);
        constexpr int IT_WIN = (DM / 128) * ((C_G + 31) / 32), IT_WUQ = (256 / 64) * (384 / 32), IT_WUKV = (128 / 64) * (512 / 32), IT_WAO = (256 / 64) * (DM / 32), IT_WCO = (512 / 64) * (DM / 32), IT_WO = (DM / 128) * (DM / 32);
        constexpr int IT_WG8 = (DM / 128) * (GW / 32);
        constexpr int IT_LAYER = IT_WIN + IT_WG8 + IT_WUQ + IT_WUKV + 2 * IT_WAO + IT_WCO + IT_WO;
        constexpr int IT_F1 = (DM / 128) * (DFF / 32), IT_F2 = (DFF / 128) * (DM / 32), IT_E1 = (DM / 128) * (EFF / 32), IT_E2 = (EFF / 128) * (DM / 32);
        constexpr int IT_FFN = 2 * IT_F1 + IT_F2, IT_EXP = 2 * IT_E1 + IT_E2;
        constexpr int NITEMS = 2 * IT_LAYER + IT_FFN + NEXP * IT_EXP;
        for (int it = gwl; it < NITEMS; it += ngwl) {
            int r = it;
            if (r < 2 * IT_LAYER) {
                const int ll = r / IT_LAYER; r -= ll * IT_LAYER; unsigned char* lwp = ws + WS_LAYERW + (size_t)ll * SZ_LAYERW;
                if (r < IT_WIN) { transpose_item_f8<0>(FIN(I_WIN) + (size_t)ll * DM * DIN, DM, C_G, lwp + OFF_WIN8, DM, S_WG, scr, r, lane, DIN); continue; } r -= IT_WIN;
                if (r < IT_WG8) { transpose_item_f8<0>(FIN(I_WIN) + (size_t)ll * DM * DIN + C_G, DM, GW, lwp + OFF_WIN8 + (size_t)P1W * DM, DM, S_WG, scr, r, lane, DIN); continue; } r -= IT_WG8;
                if (r < IT_WUQ) { transpose_item<0>(FIN(I_WUQ) + (size_t)ll * 256 * 384, 256, 384, (bf16_t*)(lwp + OFF_WUQ), 256, scr, r, lane); continue; } r -= IT_WUQ;
                if (r < IT_WUKV) { transpose_item<0>(FIN(I_WUKV) + (size_t)ll * 128 * 512, 128, 512, (bf16_t*)(lwp + OFF_WUKV), 256, scr, r, lane); continue; } r -= IT_WUKV;
                if (r < IT_WAO) { transpose_item<0>(FIN(I_WAO) + (size_t)ll * 256 * DM, 256, DM, (bf16_t*)(lwp + OFF_WAO), DM, scr, r, lane); continue; } r -= IT_WAO;
                if (r < IT_WAO) { transpose_item<0>(FIN(I_WBO) + (size_t)ll * 256 * DM, 256, DM, (bf16_t*)(lwp + OFF_WAO) + 256, DM, scr, r, lane); continue; } r -= IT_WAO;
                if (r < IT_WCO) { transpose_item<0>(FIN(I_WCO) + (size_t)ll * 512 * DM, 512, DM, (bf16_t*)(lwp + OFF_WAO) + 512, DM, scr, r, lane); continue; } r -= IT_WCO;
                transpose_item_f8<0>(FIN(I_WO) + (size_t)ll * DM * DM, DM, DM, lwp + OFF_WO8, DM, S_WO, scr, r, lane); continue;
            }
            r -= 2 * IT_LAYER;
            if (r < IT_FFN) {
                if (r < IT_F1) { transpose_item_f8<2>(FIN(I_FW1), DM, DFF, ws + WS_W13, DM, S_W13, scr, r, lane); continue; } r -= IT_F1;
                if (r < IT_F1) { transpose_item_f8<3>(FIN(I_FW3), DM, DFF, ws + WS_W13, DM, S_W13, scr, r, lane); continue; } r -= IT_F1;
                transpose_item_f8<0>(FIN(I_FW2), DFF, DM, ws + WS_W2, DFF, S_W2, scr, r, lane); continue;
            }
            r -= IT_FFN;
            { const int e = r / IT_EXP; r -= e * IT_EXP;
              if (r < IT_E1) { transpose_item_f8<2>(FIN(I_MW1) + (size_t)e * DM * EFF, DM, EFF, ws + WS_E13 + (size_t)e * SZ_E13, DM, S_W13, scr, r, lane); continue; } r -= IT_E1;
              if (r < IT_E1) { transpose_item_f8<3>(FIN(I_MW3) + (size_t)e * DM * EFF, DM, EFF, ws + WS_E13 + (size_t)e * SZ_E13, DM, S_W13, scr, r, lane); continue; } r -= IT_E1;
              transpose_item_f8<0>(FIN(I_MW2) + (size_t)e * EFF * DM, EFF, DM, ws + WS_E2 + (size_t)e * SZ_E2, EFF, S_W2, scr, r, lane); }
        }
        const int gt = vcu * NWAVES * 64 + tid0, ngt = G * NWAVES * 64;
        for (int ll = 0; ll < DEPTH; ++ll) { unsigned char* lwp = ws + WS_LAYERW + (size_t)ll * SZ_LAYERW;
            for (int i = gt; i < (P1W - C_G) * DM / 16; i += ngt) ((u32x4*)(lwp + OFF_WIN8 + (size_t)C_G * DM))[i] = (u32x4){0u, 0u, 0u, 0u};
            for (int i = gt; i < 128 * 256 / 8; i += ngt) ((u32x4*)(lwp + OFF_WUQ + (size_t)384 * 256 * 2))[i] = (u32x4){0u, 0u, 0u, 0u};
            for (int i = gt; i < 512 * 128 / 8; i += ngt) { const int rr = i / 16, cc = i % 16; ((u32x4*)(lwp + OFF_WUKV + (size_t)rr * 512 + 256))[cc] = (u32x4){0u, 0u, 0u, 0u}; } }
        for (int i = gt; i < DM / 8; i += ngt) ((u32x4*)(HB + (size_t)TCH * DM))[i] = (u32x4){0u, 0u, 0u, 0u};
        float* c64 = (float*)(ws + WS_ROPE); float* s64 = c64 + (size_t)NPOS * 32; float* c32 = s64 + (size_t)NPOS * 32; float* s32 = c32 + (size_t)NPOS * 16;
        for (int i = gt; i < NPOS * 32; i += ngt) { const int pos = i >> 5, k = i & 31; const float inv = (float)pow(10000.0, -(double)k / 32.0); const float ang = (float)pos * inv; c64[i] = cosf(ang); s64[i] = sinf(ang); }
        for (int i = gt; i < NPOS * 16; i += ngt) { const int pos = i >> 4, k = i & 15; const float inv = (float)pow(10000.0, -(double)k / 16.0); const float ang = (float)pos * inv; c32[i] = cosf(ang); s32[i] = sinf(ang); }
    }
    SEAM();

#pragma unroll 1
    for (int l = 0; l < DEPTH; ++l) {
#pragma unroll 1
        for (int ch = 0; ch < NCHUNK; ++ch) {
            if (EN(1) && RUN()) for (int rep_ = 0; rep_ < (int)REPS(1); ++rep_) { if (rep_) { __syncthreads(); } PHASE_ENV(); TB(9); if (l == 0) norm_rows<true>(FIN(I_X) + row0 * DM, FIN(I_ANG) + l * DM, HB, ws + WS_HF8, gwl, ngwl, tid & 63); else norm_rows<false>(XS + row0 * DM, FIN(I_ANG) + l * DM, HB, ws + WS_HF8, gwl, ngwl, tid & 63); TE(9); }
            SEAM();
            if (EN(2) && RUN()) { PHASE_ENV();
                { pg8::Gemm g{(const bf16_t*)(ws + WS_HF8), DM / 2, (const bf16_t*)(ws + WS_HF8), 1 << 30, (const bf16_t*)(lw + OFF_WIN8), DM / 2, nullptr, 0, 1, 0, 0}; pg8::StaticOrder S; S.init(TCH / 256, NINP / 256, G, bx);
                  pg8::EpiInProj E{ABUF(bf16_t, A_P1), ABUF(unsigned char, A_G), 1.0f / S_WG}; TB(20); pg8::gemm_phase<pg8::EpiInProj, pg8::StaticOrder, true>(lds + RING_OFF, wave, g, S, E); TE(20); } }
            SEAM();
            if (EN(3) && RUN()) for (int rep_ = 0; rep_ < (int)REPS(3); ++rep_) { if (rep_) { __syncthreads(); } PHASE_ENV(); ROPE_TAB(RT); PP1Args a; a.P1 = ABUF(bf16_t, A_P1); a.pos = (const int*)INP(I_POS) + row0; a.aq_g = FIN(I_AQG) + l * 64; a.ak_g = FIN(I_AKG) + l * 64; a.cq_g = FIN(I_BCQG) + l * 256;
                a.ckv_g = FIN(I_BCKVG) + l * 128; a.kr_g = FIN(I_BKRG) + l * 32; a.qc_g = FIN(I_CQG) + l * 64; a.kc_g = FIN(I_CKG) + l * 64;
                a.act = act; a.R = RT;
                TB(7); pp1_rows(a, lds + wave * 8192, gwl, ngwl, tid & 63); TE(7); }
            SEAM();
            if (EN(4) && RUN()) for (int rep_ = 0; rep_ < (int)REPS(4); ++rep_) { if (rep_) { __syncthreads(); } PHASE_ENV(); pg8::StaticOrder S; S.init(TCH / 256, 4, G, bx);
                pg8::Gemm g{ABUF(bf16_t, A_CQN), 256, ABUF(bf16_t, A_CKVN), 2, (const bf16_t*)(lw + OFF_WUQ), 256, nullptr, 0, 1, 0, 0}; pg8::EpiBf16 E{ABUF(bf16_t, A_QBR), 1024}; TB(21); pg8::gemm_phase<pg8::EpiBf16, pg8::StaticOrder>(lds + RING_OFF, wave, g, S, E); TE(21); }
            SEAM();
            if (EN(5) && RUN()) for (int rep_ = 0; rep_ < (int)REPS(5); ++rep_) { if (rep_) { __syncthreads(); } PHASE_ENV(); ROPE_TAB(RT); PP2Args a; a.QBR = ABUF(bf16_t, A_QBR); a.KVBR = ABUF(bf16_t, A_QBR) + 512; a.KR = ABUF(bf16_t, A_KR); a.pos = (const int*)INP(I_POS) + row0;
                a.qn_g = FIN(I_BQNG) + l * 64; a.qr_g = FIN(I_BQRG) + l * 32; a.kn_g = FIN(I_BKNG) + l * 64;
                a.QB = ABUF(bf16_t, A_QB); a.KB = ABUF(bf16_t, A_KB); a.VBT = ABUF(bf16_t, A_VBT); a.R = RT; TB(8); pp2_rows(a, lds + wave * 8192, gwl, ngwl, tid & 63); TE(8); }
            SEAM();
            if (EN(6) && RUN()) for (int rep_ = 0; rep_ < (int)REPS(6); ++rep_) {
                PHASE_ENV();
                unsigned* head = ctl + CW_Q + 64 * (2 * (l * NCHUNK + ch) + rep_);
                bf16_t* const Y = ABUF(bf16_t, A_Y);
                TB(28);
                for (;;) {
                    TB(17); const int u = q_next(head, MISC + 16, wave); TE(17);
                    if (u >= 512 + 1024 + 1024) break;
                    if (u < 512) { if (!(MK_ATT & 1) || (rep_ && !(MK_ATT_REP & 1))) continue;
                        const int qb = 31 - u / 16, bl = (u % 16) / 4, h = u % 4; const int rowb = bl * SEQ; const int q0w = 256 * qb + 32 * wave;
                        fa_unit<96>(lds, wave, ABUF(bf16_t, A_QB) + (size_t)(rowb + q0w) * 384 + h * 96, 384, ABUF(bf16_t, A_KB) + (size_t)rowb * 384 + h * 96, 384, ABUF(bf16_t, A_VBT) + (size_t)(bl * 4 + h) * 64 * SEQ,
                                    0, 4 * qb + 4, q0w, 0, -INFINITY, 0.f, Y + (size_t)(rowb + q0w) * DM + 256 + h * 64, DM);
                    } else if (u < 512 + 1024) { if (!(MK_ATT & 2) || (rep_ && !(MK_ATT_REP & 2))) continue;
                        const int v = u - 512; const int qb32 = 255 - v / 4, bl = v % 4;
                        IdxArgs ia{ABUF(bf16_t, A_IQ), ABUF(bf16_t, A_IK), ABUF(float, A_IW), ABUF(unsigned short, A_SEL), ABUF(int, A_SELN)};
                        TB(14); idx_unit(lds, wave, ia, bl * SEQ, qb32); TE(14);
                    } else { if (!(MK_ATT & 4) || (rep_ && !(MK_ATT_REP & 4))) continue;
                        const int v = u - 1536; const int bl = v / 256, kvh = (v / 128) % 2, qt = v % 128; const int rowb = bl * SEQ;
                        const int hq = kvh * 4 + (wave >> 1), q0w = 64 * qt + 32 * (wave & 1);
                        const float sink = (FIN(I_SINK) + l * 8)[hq];
                        fa_unit<64>(lds, wave, ABUF(bf16_t, A_QC) + (size_t)(rowb + q0w) * 512 + hq * 64, 512, ABUF(bf16_t, A_KC) + (size_t)rowb * 128 + kvh * 64, 128, ABUF(bf16_t, A_VCT) + (size_t)(bl * 2 + kvh) * 64 * SEQ,
                                    qt >= 2 ? qt - 2 : 0, qt + 1, q0w, 128, sink * LOG2E, 1.f, Y + (size_t)(rowb + q0w) * DM + 512 + hq * 64, DM);
                    }
                }
                TE(28);
            }
            SEAM();
            if (EN(7) && RUN()) for (int rep_ = 0; rep_ < (int)REPS(7); ++rep_) { if (rep_) { __syncthreads(); } PHASE_ENV(); SpaArgs sa{ABUF(bf16_t, A_QA), ABUF(bf16_t, A_KA), ABUF(bf16_t, A_VA), ABUF(unsigned short, A_SEL), ABUF(int, A_SELN), ABUF(bf16_t, A_Y)}; LAS unsigned char* wl = lds + wave * 16384;
                TB(11); { int lane_ = tid & 63; asm volatile("" : "+v"(lane_)); SpaPre P, Pn; P = SpaPre{}; Pn = SpaPre{};
                    if (gwl < TCH) sparse_prefetch(P, sa, gwl, (gwl + ngwl < TCH) ? gwl + ngwl : gwl, lane_);
                    for (int tok = gwl; tok < TCH; tok += 2 * ngwl) { const int tk2 = (tok + ngwl < TCH) ? tok + ngwl : tok; const int nt1 = tok + 2 * ngwl, nt2 = (nt1 + ngwl < TCH) ? nt1 + ngwl : nt1;
                        if (nt1 < TCH) sparse_prefetch(Pn, sa, nt1, nt2, lane_);
                        sparse_pair(wl, sa, P, (tok / SEQ) * SEQ, tok % SEQ, (tk2 / SEQ) * SEQ, tk2 % SEQ, lane_);
                        P = Pn; } } TE(11); }
            SEAM();
            if (EN(8) && RUN()) for (int rep_ = 0; rep_ < (int)REPS(8); ++rep_) { if (rep_) { __syncthreads(); } PHASE_ENV(); pg8::SegOrder S; S.S.init(TCH / 256, DM / 256, G, bx);
                pg8::Gemm g{ABUF(bf16_t, A_Y), DM, ABUF(bf16_t, A_Y), 1 << 30, (const bf16_t*)(lw + OFF_WAO), DM, nullptr, 0, 3, 256, 512}; pg8::EpiMerge E{HB, ABUF(unsigned char, A_G), ws + WS_HF8, S_MG};
                TB(22); pg8::gemm_phase<pg8::EpiMerge, pg8::SegOrder>(lds + RING_OFF, wave, g, S, E); TE(22); }
            SEAM();
            if (EN(9) && RUN()) { PHASE_ENV(); pg8::Gemm g{(const bf16_t*)(ws + WS_HF8), DM / 2, (const bf16_t*)(ws + WS_HF8), 1 << 30, (const bf16_t*)(lw + OFF_WO8), DM / 2, nullptr, 0, 1, 0, 0}; pg8::StaticOrder S; S.init(TCH / 256, DM / 256, G, bx);
                TB(23);
                if (l == 0) { pg8::EpiResidB<true> E{FIN(I_X) + row0 * DM, XS + row0 * DM, 1.0f / (S_MG * S_WO)}; pg8::gemm_phase<pg8::EpiResidB<true>, pg8::StaticOrder, true>(lds + RING_OFF, wave, g, S, E); }
                else { pg8::EpiResidB<false> E{XS + row0 * DM, XS + row0 * DM, 1.0f / (S_MG * S_WO)}; pg8::gemm_phase<pg8::EpiResidB<false>, pg8::StaticOrder, true>(lds + RING_OFF, wave, g, S, E); }
                TE(23); }
            SEAM();
            if (l == 0) {
                if (EN(10) && RUN()) { PHASE_ENV(); RouteArgs ra{}; TB(10); norm2_rows<false>(XS + row0 * DM, FIN(I_FNG) + l * DM, HB, ws + WS_HF8, ra, (LAS unsigned*)(lds + MISC_OFF + 128), vcu, wave, tid & 63, G); TE(10); }
                SEAM();
                if (EN(11) && RUN()) { PHASE_ENV(); pg8::Gemm g{(const bf16_t*)(ws + WS_HF8), DM / 2, (const bf16_t*)(ws + WS_HF8), 1 << 30, (const bf16_t*)(ws + WS_W13), DM / 2, nullptr, 0, 1, 0, 0}; pg8::StaticOrder S; S.init(TCH / 256, 2 * DFF / 256, G, bx);
                    pg8::EpiSwigluF8 E{ABUF(unsigned char, F_ACT), DFF, 1.0f / S_W13, S_ACT}; TB(24); pg8::gemm_phase<pg8::EpiSwigluF8, pg8::StaticOrder, true>(lds + RING_OFF, wave, g, S, E); TE(24); }
                SEAM();
                if (EN(12) && RUN()) { PHASE_ENV(); pg8::Gemm g{ABUF(bf16_t, F_ACT), DFF / 2, ABUF(bf16_t, F_ACT), 1 << 30, (const bf16_t*)(ws + WS_W2), DFF / 2, nullptr, 0, 1, 0, 0}; pg8::StaticOrder S; S.init(TCH / 256, DM / 256, G, bx);
                    pg8::EpiResidB<false> E{XS + row0 * DM, XS + row0 * DM, 1.0f / (S_ACT * S_W2)}; TB(25); pg8::gemm_phase<pg8::EpiResidB<false>, pg8::StaticOrder, true>(lds + RING_OFF, wave, g, S, E); TE(25); }
                SEAM();
            } else {
                if (EN(13) && RUN()) { PHASE_ENV(); RouteArgs ra{FIN(I_RW), ABUF(int, F_TOPE), ABUF(float, F_TOPG), ABUF(int, F_TOPD), ctl + CW_MOE + 64 * ch};
                    TB(10); norm2_rows<true>(XS + row0 * DM, FIN(I_FNG) + l * DM, HB, ws + WS_HF8, ra, (LAS unsigned*)(lds + MISC_OFF + 128), vcu, wave, tid & 63, G); TE(10); }
                SEAM();
                if (EN(14) && RUN()) { PHASE_ENV(); TB(12); moe_scatter(ctl + CW_MOE + 64 * ch, ABUF(int, F_TOPE), ABUF(int, F_TOPD), ws + WS_HF8, ABUF(bf16_t, F_YM), ABUF(int, F_BLKE), gwl, ngwl, tid & 63); TE(12); }
                SEAM();
                if (EN(15) && RUN()) for (int rep_ = 0; rep_ < (int)REPS(15); ++rep_) { if (rep_) { __syncthreads(); } PHASE_ENV(); int ps[NEXP + 1]; moe_layout(ctl + CW_MOE + 64 * ch, ps); const int nblk = ps[NEXP] / 256;
                    pg8::Gemm g{ABUF(bf16_t, F_YM), DM / 2, ABUF(bf16_t, F_YM), 1 << 30, (const bf16_t*)(ws + WS_E13), DM / 2, ABUF(int, F_BLKE), SZ_E13 / 2, 1, 0, 0}; pg8::StaticOrder S; S.init(nblk, 2 * EFF / 256, G, bx);
                    pg8::EpiSwigluF8 E{ABUF(unsigned char, F_ACT), EFF, 1.0f / S_W13, S_ACT}; TB(26); pg8::gemm_phase<pg8::EpiSwigluF8, pg8::StaticOrder, true>(lds + RING_OFF, wave, g, S, E); TE(26); }
                SEAM();
                if (EN(16) && RUN()) for (int rep_ = 0; rep_ < (int)REPS(16); ++rep_) { if (rep_) { __syncthreads(); } PHASE_ENV(); int ps[NEXP + 1]; moe_layout(ctl + CW_MOE + 64 * ch, ps); const int nblk = ps[NEXP] / 256;
                    pg8::Gemm g{ABUF(bf16_t, F_ACT), EFF / 2, ABUF(bf16_t, F_ACT), 1 << 30, (const bf16_t*)(ws + WS_E2), EFF / 2, ABUF(int, F_BLKE), SZ_E2 / 2, 1, 0, 0}; pg8::StaticOrder S; S.init(nblk, DM / 256, G, bx);
                    pg8::EpiBf16S E{ABUF(bf16_t, F_YM), DM, 1.0f / (S_ACT * S_W2)}; TB(27); pg8::gemm_phase<pg8::EpiBf16S, pg8::StaticOrder, true>(lds + RING_OFF, wave, g, S, E); TE(27); }
                SEAM();
                if (EN(17) && RUN()) { PHASE_ENV(); TB(13); moe_combine(XS + row0 * DM, out + row0 * DM, ABUF(bf16_t, F_YM), ABUF(int, F_TOPD), ABUF(float, F_TOPG), gwl, ngwl, tid & 63); TE(13); }
                SEAM();
            }
        }
    }
    if (MK_TIMER != 0 && bx == 0 && args.ph_hi >= N_PHASES_C) { __syncthreads(); const unsigned long long t0 = __builtin_amdgcn_s_memrealtime(); const unsigned long long T = (unsigned long long)(*TMR_ACC) / NWAVES;
        while (__builtin_amdgcn_s_memrealtime() - t0 < T) __builtin_amdgcn_s_sleep(8); }
#undef RUN
#undef SEAM
#undef tid
}
constexpr int N_PHASES = 1 + NCHUNK * (9 + 3) + NCHUNK * (9 + 5);

extern "C" void kernel_launch(void* const* d_in, const int* in_sizes, int n_in, void* d_out, int out_size, void* d_ws, size_t ws_size, hipStream_t stream) {
    static int grid = 0;
    if (grid == 0) {
        if (n_in != 29 || in_sizes[0] != NTOK * DM || out_size != NTOK * DM || ws_size < WS_END) {
            fprintf(stderr, "kernel_launch: built for 29 inputs, x/out of %d floats, >= %zu bytes of workspace; got n_in %d, in0 %d, out %d, ws %zu; nothing launched\n", NTOK * DM, (size_t)WS_END, n_in, n_in > 0 ? in_sizes[0] : -1, out_size, ws_size); grid = -1; return; }
        int dev = 0, cus = 0, per_cu = 0;
        if (hipGetDevice(&dev) != hipSuccess || hipDeviceGetAttribute(&cus, hipDeviceAttributeMultiprocessorCount, dev) != hipSuccess) { fprintf(stderr, "kernel_launch: device query failed\n"); grid = -1; return; }
        if (hipFuncSetAttribute((const void*)mk_fwd, hipFuncAttributeMaxDynamicSharedMemorySize, LDS_BYTES) != hipSuccess) { fprintf(stderr, "kernel_launch: hipFuncSetAttribute failed\n"); grid = -1; return; }
        if (hipOccupancyMaxActiveBlocksPerMultiprocessor(&per_cu, (const void*)mk_fwd, NWAVES * 64, LDS_BYTES) != hipSuccess || per_cu < 1)
            fprintf(stderr, "kernel_launch: note: occupancy query reports %d workgroups per CU\n", per_cu);
        (void)hipGetLastError();
        grid = cus;
        if (grid != 256) fprintf(stderr, "kernel_launch: note: %d CUs (built and tuned for 256)\n", grid);
    }
    if (grid < 0) return;
    if (hipMemsetAsync((char*)d_ws + WS_CTL, 0, CTL_ZERO_BYTES, stream) != hipSuccess) { fprintf(stderr, "kernel_launch: memset failed\n"); return; }
    Args a{};
    for (int i = 0; i < 29; ++i) a.in[i] = d_in[i];
    a.out = (float*)d_out; a.ws = (unsigned char*)d_ws;
#if MK_PER_PHASE
    for (int p = 0; p < N_PHASES; ++p) { a.ph_lo = p; a.ph_hi = p + 1; hipLaunchKernelGGL(mk_fwd, dim3(grid), dim3(NWAVES * 64), LDS_BYTES, stream, a); }
#elif MK_CHECK
    {
        const int base = 1 + (MK_CHECK_L == 0 ? MK_CHECK_CH * 12 : 24 + MK_CHECK_CH * 14);
        a.ph_lo = 0; a.ph_hi = base + 7; a.pad0 = 0; hipLaunchKernelGGL(mk_fwd, dim3(grid), dim3(NWAVES * 64), LDS_BYTES, stream, a);
        hipLaunchKernelGGL(chk_kernel, dim3(grid), dim3(NWAVES * 64), 0, stream, a, 0, MK_CHECK_L, MK_CHECK_CH);
        a.ph_lo = base + 7; a.ph_hi = base + 9; a.pad0 = 1; hipLaunchKernelGGL(mk_fwd, dim3(grid), dim3(NWAVES * 64), LDS_BYTES, stream, a);
        hipLaunchKernelGGL(chk_kernel, dim3(grid), dim3(NWAVES * 64), 0, stream, a, 1, MK_CHECK_L, MK_CHECK_CH);
        a.ph_lo = base + 9; a.ph_hi = N_PHASES; a.pad0 = 2; hipLaunchKernelGGL(mk_fwd, dim3(grid), dim3(NWAVES * 64), LDS_BYTES, stream, a);
        hipLaunchKernelGGL(chk_kernel, dim3(1), dim3(64), 0, stream, a, 2, MK_CHECK_L, MK_CHECK_CH);
    }
#else
    a.ph_lo = 0; a.ph_hi = N_PHASES;
    hipLaunchKernelGGL(mk_fwd, dim3(grid), dim3(NWAVES * 64), LDS_BYTES, stream, a);
#endif
    const hipError_t le = hipPeekAtLastError();
    if (le != hipSuccess) fprintf(stderr, "kernel_launch: launch failed: %s\n", hipGetErrorName(le));
}
```
